# Optimizing an MI355X kernel written in HIP

```python
import math
import jax, jax.numpy as jnp
from jax import lax
import numpy as np

D_MODEL = 1024
BATCH = 4
SEQ = 4096
DEPTH = 2

CHUNK = 64
Q_BLOCK = 128
EPS = 1e-6

N_A = DEPTH // 2
N_B = DEPTH - N_A
N_DENSE = (DEPTH + 1) // 2
N_MOE = DEPTH // 2

RET_QK_DIM = 256
RET_HEADS = D_MODEL // RET_QK_DIM
RET_V_DIM = 2 * RET_QK_DIM
RET_THETA = 10000.0

DIFF_HEAD_DIM = 64
DIFF_HEADS = D_MODEL // (2 * DIFF_HEAD_DIM)
DIFF_V_DIM = 2 * DIFF_HEAD_DIM
ROPE_THETA = 500000.0
ROPE_DIM = DIFF_HEAD_DIM // 4

FFN_DIM = 256 * math.ceil(8 * D_MODEL / 3 / 256)
N_EXPERTS = 8
TOP_K = 2
EXPERT_DIM = 7 * D_MODEL // 2

kernel_name = "yoco_retention_diffattn_moe"


def rms_norm(x, g):
    xf = x.astype(jnp.float32)
    y = xf * lax.rsqrt(jnp.mean(xf * xf, axis=-1, keepdims=True) + EPS)
    return (y * g.astype(jnp.float32)).astype(x.dtype)


def rope_tables(seq, rot_dim, theta):
    inv = 1.0 / (theta ** (jnp.arange(0, rot_dim, 2, dtype=jnp.float32) / rot_dim))
    ang = jnp.arange(seq, dtype=jnp.float32)[:, None] * inv[None, :]
    return jnp.cos(ang), jnp.sin(ang)


def apply_rope(x, cos, sin, rot_dim):
    half = rot_dim // 2
    shape = (1, x.shape[1]) + (1,) * (x.ndim - 3) + (half,)
    c = cos.reshape(shape).astype(x.dtype)
    s = sin.reshape(shape).astype(x.dtype)
    x1 = x[..., :half]
    x2 = x[..., half:rot_dim]
    return jnp.concatenate([x1 * c - x2 * s, x2 * c + x1 * s, x[..., rot_dim:]], axis=-1)


def to_chunks(t):
    b, s, h, d = t.shape
    return t.reshape(b, s // CHUNK, CHUNK, h, d).transpose(1, 0, 3, 2, 4)


def retention_mixer(h, w_in, w_o):
    b, s, _ = h.shape
    dt = h.dtype
    proj = (h @ w_in).astype(jnp.float32)
    d_qk = RET_HEADS * RET_QK_DIM
    d_v = RET_HEADS * RET_V_DIM
    q = proj[..., :d_qk].reshape(b, s, RET_HEADS, RET_QK_DIM)
    k = proj[..., d_qk:2 * d_qk].reshape(b, s, RET_HEADS, RET_QK_DIM)
    v = proj[..., 2 * d_qk:2 * d_qk + d_v].reshape(b, s, RET_HEADS, RET_V_DIM)
    g = proj[..., 2 * d_qk + d_v:]
    cos, sin = rope_tables(s, RET_QK_DIM, RET_THETA)
    q = apply_rope(q, cos, sin, RET_QK_DIM)
    k = apply_rope(k, cos, sin, RET_QK_DIM) * (RET_QK_DIM ** -0.5)

    log_gamma = jnp.log(1.0 - 2.0 ** (-5.0 - jnp.arange(RET_HEADS, dtype=jnp.float32)))
    idx = jnp.arange(CHUNK, dtype=jnp.float32)
    rel = idx[:, None] - idx[None, :]
    inner_decay = jnp.where(rel[None] >= 0,
                            jnp.exp(jnp.maximum(rel, 0.0)[None] * log_gamma[:, None, None]), 0.0)
    q_decay = jnp.exp((idx + 1.0)[None, :] * log_gamma[:, None])[None, :, :, None]
    k_decay = jnp.exp((CHUNK - 1.0 - idx)[None, :] * log_gamma[:, None])[None, :, :, None]
    chunk_decay = jnp.exp(CHUNK * log_gamma)[None, :, None, None]

    def step(state, xs):
        qc, kc, vc = xs
        scores = jnp.einsum('bhnd,bhmd->bhnm', qc, kc) * inner_decay[None]
        out = (jnp.einsum('bhnm,bhmv->bhnv', scores, vc)
               + jnp.einsum('bhnd,bhdv->bhnv', qc, state) * q_decay)
        state = state * chunk_decay + jnp.einsum('bhmd,bhmv->bhdv', kc * k_decay, vc)
        return state, out

    state0 = jnp.zeros((b, RET_HEADS, RET_QK_DIM, RET_V_DIM), jnp.float32)
    _, o = lax.scan(step, state0, (to_chunks(q), to_chunks(k), to_chunks(v)))
    o = o.transpose(1, 0, 3, 2, 4).reshape(b, s, RET_HEADS, RET_V_DIM)
    mu = jnp.mean(o, axis=-1, keepdims=True)
    var = jnp.mean(jnp.square(o - mu), axis=-1, keepdims=True)
    o = ((o - mu) * lax.rsqrt(var + EPS)).reshape(b, s, d_v)
    o = (o * jax.nn.silu(g)).astype(dt)
    return o @ w_o


def shared_kv(x, kv_norm, w_kv, cos, sin):
    b, s, _ = x.shape
    kv = rms_norm(x, kv_norm) @ w_kv
    d_k = DIFF_HEADS * 2 * DIFF_HEAD_DIM
    k = kv[..., :d_k].reshape(b, s, DIFF_HEADS, 2, DIFF_HEAD_DIM)
    k = apply_rope(k, cos, sin, ROPE_DIM).transpose(0, 2, 3, 1, 4)
    v = kv[..., d_k:].reshape(b, s, DIFF_HEADS, DIFF_V_DIM).transpose(0, 2, 1, 3)
    return k, v


def diff_attention(h, k_sh, v_sh, w_q, lq1, lk1, lq2, lk2, subln, w_o, lambda_init, cos, sin):
    b, s, _ = h.shape
    q = (h @ w_q).reshape(b, s, DIFF_HEADS, 2, DIFF_HEAD_DIM)
    q = apply_rope(q, cos, sin, ROPE_DIM)
    n_qb = s // Q_BLOCK
    qb = q.reshape(b, n_qb, Q_BLOCK, DIFF_HEADS, 2, DIFF_HEAD_DIM).transpose(1, 0, 3, 4, 2, 5)
    lam = (jnp.exp(jnp.sum(lq1.astype(jnp.float32) * lk1.astype(jnp.float32)))
           - jnp.exp(jnp.sum(lq2.astype(jnp.float32) * lk2.astype(jnp.float32))) + lambda_init)
    key_chunk = jnp.arange(s) // CHUNK
    scale = DIFF_HEAD_DIM ** -0.5
    neg = jnp.finfo(jnp.float32).min

    def block(args):
        q_blk, bi = args
        q_chunk = (bi * Q_BLOCK + jnp.arange(Q_BLOCK)) // CHUNK
        mask = key_chunk[None, :] <= q_chunk[:, None]
        sc = jnp.einsum('bhcqd,bhckd->bhcqk', q_blk, k_sh).astype(jnp.float32) * scale
        p = jax.nn.softmax(jnp.where(mask, sc, neg), axis=-1)
        a = p[:, :, 0] - lam * p[:, :, 1]
        return jnp.einsum('bhqk,bhkv->bhqv', a.astype(v_sh.dtype), v_sh)

    o = lax.map(block, (qb, jnp.arange(n_qb)))
    o = o.transpose(1, 0, 3, 2, 4).reshape(b, s, DIFF_HEADS, DIFF_V_DIM)
    o = rms_norm(o, subln) * (1.0 - lambda_init)
    return o.reshape(b, s, DIFF_HEADS * DIFF_V_DIM) @ w_o


def swiglu(h, w_gu, w_down):
    f = w_down.shape[0]
    gu = h @ w_gu
    return (jax.nn.silu(gu[..., :f]) * gu[..., f:]) @ w_down


def moe_swiglu(h, router, w_gu, w_down):
    b, s, d = h.shape
    t = h.reshape(b * s, d)
    logits = (t @ router).astype(jnp.float32)
    top_val, top_idx = lax.top_k(logits, TOP_K)
    top_w = jax.nn.softmax(top_val, axis=-1)
    gates = jnp.sum(jax.nn.one_hot(top_idx, N_EXPERTS, dtype=jnp.float32) * top_w[..., None], axis=1)
    gates = gates.astype(t.dtype)
    y = jnp.zeros_like(t)
    for e in range(N_EXPERTS):
        y = y + gates[:, e:e + 1] * swiglu(t, w_gu[e], w_down[e])
    return y.reshape(b, s, d)


def setup_inputs(seed: int = 0) -> dict:
    key = jax.random.key(seed)
    ks = jax.random.split(key, 24)
    D = D_MODEL
    def w(k, shape, fan_in):
        return jax.random.normal(k, shape, jnp.float32) * (fan_in ** -0.5)
    def gain(k, shape):
        return 1.0 + 0.01 * jax.random.normal(k, shape, jnp.float32)
    ret_in_cols = 2 * RET_HEADS * RET_QK_DIM + 2 * RET_HEADS * RET_V_DIM
    ret_v = RET_HEADS * RET_V_DIM
    diff_w = DIFF_HEADS * DIFF_V_DIM
    return {
        "x": jax.random.normal(ks[0], (BATCH, SEQ, D), jnp.float32),
        "ln_mix": gain(ks[1], (DEPTH, D)),
        "ln_ffn": gain(ks[2], (DEPTH, D)),
        "ret_w_in": w(ks[3], (N_A, D, ret_in_cols), D),
        "ret_w_o": w(ks[4], (N_A, ret_v, D), ret_v),
        "kv_norm": gain(ks[5], (D,)),
        "w_kv": w(ks[6], (D, DIFF_HEADS * 2 * DIFF_HEAD_DIM + diff_w), D),
        "diff_w_q": w(ks[7], (N_B, D, DIFF_HEADS * 2 * DIFF_HEAD_DIM), D),
        "lam_q1": 0.1 * jax.random.normal(ks[8], (N_B, DIFF_HEAD_DIM), jnp.float32),
        "lam_k1": 0.1 * jax.random.normal(ks[9], (N_B, DIFF_HEAD_DIM), jnp.float32),
        "lam_q2": 0.1 * jax.random.normal(ks[10], (N_B, DIFF_HEAD_DIM), jnp.float32),
        "lam_k2": 0.1 * jax.random.normal(ks[11], (N_B, DIFF_HEAD_DIM), jnp.float32),
        "diff_subln": gain(ks[12], (N_B, DIFF_V_DIM)),
        "diff_w_o": w(ks[13], (N_B, diff_w, D), diff_w),
        "ffn_w_gu": w(ks[14], (N_DENSE, D, 2 * FFN_DIM), D),
        "ffn_w_down": w(ks[15], (N_DENSE, FFN_DIM, D), FFN_DIM),
        "moe_router": w(ks[16], (N_MOE, D, N_EXPERTS), D),
        "moe_w_gu": w(ks[17], (N_MOE, N_EXPERTS, D, 2 * EXPERT_DIM), D),
        "moe_w_down": w(ks[18], (N_MOE, N_EXPERTS, EXPERT_DIM, D), EXPERT_DIM),
        "final_norm": gain(ks[19], (D,)),
    }


def reference(x, ln_mix, ln_ffn, ret_w_in, ret_w_o, kv_norm, w_kv, diff_w_q, lam_q1, lam_k1,
              lam_q2, lam_k2, diff_subln, diff_w_o, ffn_w_gu, ffn_w_down, moe_router, moe_w_gu,
              moe_w_down, final_norm):
    s = x.shape[1]
    cos, sin = rope_tables(s, ROPE_DIM, ROPE_THETA)
    k_sh, v_sh = (shared_kv(x, kv_norm, w_kv, cos, sin) if N_A == 0 else (None, None))
    for layer in range(DEPTH):
        h = rms_norm(x, ln_mix[layer])
        if layer < N_A:
            x = x + retention_mixer(h, ret_w_in[layer], ret_w_o[layer])
        else:
            bl = layer - N_A
            lambda_init = 0.8 - 0.6 * math.exp(-0.3 * layer)
            x = x + diff_attention(h, k_sh, v_sh, diff_w_q[bl], lam_q1[bl], lam_k1[bl],
                                   lam_q2[bl], lam_k2[bl], diff_subln[bl], diff_w_o[bl],
                                   lambda_init, cos, sin)
        h = rms_norm(x, ln_ffn[layer])
        if layer % 2 == 0:
            x = x + swiglu(h, ffn_w_gu[layer // 2], ffn_w_down[layer // 2])
        else:
            x = x + moe_swiglu(h, moe_router[layer // 2], moe_w_gu[layer // 2], moe_w_down[layer // 2])
        if layer == N_A - 1:
            k_sh, v_sh = shared_kv(x, kv_norm, w_kv, cos, sin)
    return rms_norm(x, final_norm)
```

```cpp
#include <hip/hip_runtime.h>
#include <hip/hip_bf16.h>
#include <cstdio>
#include <cstdint>
#include <cmath>
namespace pg8 {
#define PG8_LAS __attribute__((address_space(3)))
typedef unsigned short bf16_t;
typedef short bf16x8 __attribute__((ext_vector_type(8)));
typedef float f32x4 __attribute__((ext_vector_type(4)));
typedef unsigned u32x4 __attribute__((ext_vector_type(4)));
constexpr int BM = 256, BK = 64, HALF = 128, HTB = HALF * BK * 2  , STAGE_BYTES = 8 * HTB, NXCD = 8, WGM = 8;

__host__ __device__ __forceinline__ int lds_byte(int r, int c) { const int st = (r >> 4) * 2 + (c >> 5), rr = r & 15, cc = c & 31, ob = rr * 64 + cc * 2; return st * 1024 + (ob ^ (((ob >> 9) & 1) << 5)); }
__host__ __device__ __forceinline__ void stage_rc(int b, int& R, int& C) { const int st = b / 1024, sb = b % 1024, swz = sb ^ (((sb >> 9) & 1) << 5); R = (st >> 1) * 16 + swz / 64; C = (st & 1) * 32 + (swz % 64) / 2; }
__host__ __device__ __forceinline__ int perm32(int rho) { const int n = rho >> 4, i = rho & 15; return 8 * (i >> 2) + 4 * n + (i & 3); }

struct Unit { int pm, pn, aux; };
struct Gemm { const bf16_t* A; const bf16_t* Bt; int M, N, K; };

struct StaticOrder {
    int nM, nN, nwg, G, c;
    __host__ __device__ void init(int M, int N, int G_, int c_) { nM = M / BM; nN = N / BM; nwg = nM * nN; G = G_; c = c_; }
    __host__ __device__ bool next(int i, Unit& u) const {
        const long L = (long)i * G + c; if (L >= nwg) return false;
        int wgid = (int)L; { const int q = nwg / NXCD, r = nwg % NXCD, xcd = wgid % NXCD, off = wgid / NXCD; wgid = (xcd < r ? xcd * (q + 1) : r * (q + 1) + (xcd - r) * q) + off; }
        const int nig = WGM * nN, gid = wgid / nig, fm = gid * WGM, gsz = (nM - fm) < WGM ? (nM - fm) : WGM;
        u.pm = fm + ((wgid % nig) % gsz); u.pn = (wgid % nig) / gsz; u.aux = u.pn; return true;
    }
    __device__ __forceinline__ void a_ready(const Unit&) const {}
    __device__ __forceinline__ void done(const Unit&) const {}
};

__device__ __forceinline__ unsigned cvt_pk_bf16(float lo, float hi) { unsigned r; asm volatile("v_cvt_pk_bf16_f32 %0, %1, %2" : "=v"(r) : "v"(lo), "v"(hi)); return r; }
typedef float f32x2 __attribute__((ext_vector_type(2)));
template <class Epi, class Sched, bool ALIGN_EPI = false, bool SP2 = false>
__device__ __forceinline__ void gemm_phase(PG8_LAS unsigned char* lds, const Gemm g, const Sched& S, const Epi& E) {
    int tid = threadIdx.x; asm volatile("" : "+v"(tid)); const int wid = __builtin_amdgcn_readfirstlane(tid >> 6), lane = tid & 63, wr = wid >> 2, wc = wid & 3, fr = lane & 15, fq = lane >> 4;
    const int K = g.K, nt = K / BK;
    unsigned voffA[2], voffB[2];
#pragma unroll
    for (int i = 0; i < 2; ++i) { int R, C; stage_rc(tid * 16 + i * 8192, R, C); const int Rb = Epi::PERM ? ((R & ~31) + perm32(R & 31)) : R;
        voffA[i] = (unsigned)(R * K + C) * 2u; voffB[i] = (unsigned)(Rb * K + C) * 2u; }
    const size_t kstep = (size_t)(BK * 2);
    const size_t hstep = (size_t)HALF * K * 2;
    const size_t tstep = 2 * hstep;
    const unsigned ldsw = (unsigned)wid * 1024u;
    const int aoff = lds_byte(wr * 64 + fr, fq * 8), boff = lds_byte(wc * 32 + fr, fq * 8);
#define PG8_SA(b, h) (((b) * 2 + (h)) * HTB)
#define PG8_SB(b, h) ((4 + (b) * 2 + (h)) * HTB)
#define PG8_STAGE(bufoff, gbase, voff) do { _Pragma("unroll") for (int _i = 0; _i < 2; ++_i) \
        __builtin_amdgcn_global_load_lds((const unsigned*)((const char*)(gbase) + (voff)[_i]), (PG8_LAS unsigned*)(lds + (bufoff) + ldsw + _i * 8192), 16, 0, 0); } while (0)
#define PG8_LDA(dst, b, h) do { _Pragma("unroll") for (int m = 0; m < 4; ++m) _Pragma("unroll") for (int k = 0; k < 2; ++k) dst[m][k] = *(const PG8_LAS bf16x8*)(lds + PG8_SA(b, h) + aoff + m * 2048 + k * 1024); } while (0)
#define PG8_LDB(dst, b, h) do { _Pragma("unroll") for (int n = 0; n < 2; ++n) _Pragma("unroll") for (int k = 0; k < 2; ++k) dst[n][k] = *(const PG8_LAS bf16x8*)(lds + PG8_SB(b, h) + boff + n * 2048 + k * 1024); } while (0)
#define PG8_MMA(ai, bj, At, Bt) do { __builtin_amdgcn_s_setprio(1); _Pragma("unroll") for (int m = 0; m < 4; ++m) _Pragma("unroll") for (int n = 0; n < 2; ++n) _Pragma("unroll") for (int k = 0; k < 2; ++k) \
        acc[ai][bj][m][n] = __builtin_amdgcn_mfma_f32_16x16x32_bf16(Bt[n][k], At[m][k], acc[ai][bj][m][n], 0, 0, 0); __builtin_amdgcn_s_setprio(0); } while (0)
#define PG8_WAIT_V(n) asm volatile("s_waitcnt vmcnt(" #n ")" ::: "memory")
#define PG8_WAIT_L(n) asm volatile("s_waitcnt lgkmcnt(" #n ")" ::: "memory")
#define PG8_BAR __builtin_amdgcn_s_barrier()
#define PG8_SCHED __builtin_amdgcn_sched_barrier(0)
    Unit cur, nxt; int ui = 0;
    if (!S.next(0, cur)) return;
    f32x4 acc[2][2][4][2];
#pragma unroll
    for (int a = 0; a < 2; ++a)
#pragma unroll
        for (int b = 0; b < 2; ++b)
#pragma unroll
            for (int m = 0; m < 4; ++m)
#pragma unroll
                for (int n = 0; n < 2; ++n) acc[a][b][m][n] = (f32x4){0.f, 0.f, 0.f, 0.f};
    bf16x8 At[4][2], B0[2][2], B1[2][2];
    const char* cA = (const char*)g.A + (size_t)cur.pm * tstep; const char* cB = (const char*)g.Bt + (size_t)cur.pn * tstep;
    S.a_ready(cur);
    if constexpr (SP2) {
        PG8_STAGE(PG8_SB(0, 0), cB, voffB); PG8_STAGE(PG8_SB(0, 1), cB + hstep, voffB); PG8_STAGE(PG8_SA(0, 0), cA, voffA); PG8_STAGE(PG8_SA(0, 1), cA + hstep, voffA);
        if (wr == 1) PG8_BAR;
        PG8_WAIT_V(2); PG8_BAR;
        PG8_STAGE(PG8_SB(1, 0), cB + kstep, voffB); PG8_STAGE(PG8_SA(1, 0), cA + kstep, voffA); PG8_STAGE(PG8_SB(1, 1), cB + hstep + kstep, voffB);
        PG8_WAIT_V(6); PG8_BAR;
    } else {
        PG8_STAGE(PG8_SB(0, 0), cB, voffB); PG8_STAGE(PG8_SA(0, 0), cA, voffA); PG8_STAGE(PG8_SB(0, 1), cB + hstep, voffB); PG8_STAGE(PG8_SA(0, 1), cA + hstep, voffA);
        if (wr == 1) PG8_BAR;
        PG8_WAIT_V(4); PG8_BAR;
        PG8_STAGE(PG8_SB(1, 0), cB + kstep, voffB); PG8_STAGE(PG8_SA(1, 0), cA + kstep, voffA); PG8_STAGE(PG8_SB(1, 1), cB + hstep + kstep, voffB);
        PG8_WAIT_V(6); PG8_BAR;
    }
    for (;;) {
        const bool has_next = S.next(ui + 1, nxt);
        const char* nA = has_next ? (const char*)g.A + (size_t)nxt.pm * tstep : cA; const char* nB = has_next ? (const char*)g.Bt + (size_t)nxt.pn * tstep : cB;
        for (int t = 0; t < nt; t += 2) {
            const bool last = (t == nt - 2);
            const char* a1 = cA + (size_t)(t + 1) * kstep;
            const char* a2 = last ? nA : cA + (size_t)(t + 2) * kstep; const char* b2 = last ? nB : cB + (size_t)(t + 2) * kstep;
            const char* a3 = a2 + kstep; const char* b3 = b2 + kstep;
            if (last && has_next) S.a_ready(nxt);
            if constexpr (SP2) {
            PG8_LDB(B0, 0, 0); PG8_LDB(B1, 0, 1); PG8_SCHED; PG8_LDA(At, 0, 0); PG8_STAGE(PG8_SA(1, 1), a1 + hstep, voffA);
            PG8_WAIT_V(8); PG8_WAIT_L(0); PG8_BAR; PG8_MMA(0, 0, At, B0); PG8_MMA(0, 1, At, B1); PG8_BAR; PG8_SCHED;
            PG8_LDA(At, 0, 1); PG8_STAGE(PG8_SB(0, 0), b2, voffB); PG8_STAGE(PG8_SB(0, 1), b2 + hstep, voffB); PG8_STAGE(PG8_SA(0, 0), a2, voffA);
            PG8_WAIT_V(8); PG8_WAIT_L(0); PG8_BAR; PG8_MMA(1, 0, At, B0); PG8_MMA(1, 1, At, B1); PG8_BAR; PG8_SCHED;
            PG8_LDB(B0, 1, 0); PG8_LDB(B1, 1, 1); PG8_SCHED; PG8_LDA(At, 1, 0); PG8_STAGE(PG8_SA(0, 1), a2 + hstep, voffA);
            PG8_WAIT_V(8); PG8_WAIT_L(0); PG8_BAR; PG8_MMA(0, 0, At, B0); PG8_MMA(0, 1, At, B1); PG8_BAR; PG8_SCHED;
            PG8_LDA(At, 1, 1); PG8_STAGE(PG8_SB(1, 0), b3, voffB); PG8_STAGE(PG8_SB(1, 1), b3 + hstep, voffB); PG8_STAGE(PG8_SA(1, 0), a3, voffA);
            PG8_WAIT_V(8); PG8_WAIT_L(0); PG8_BAR; PG8_MMA(1, 0, At, B0); PG8_MMA(1, 1, At, B1); PG8_BAR; PG8_SCHED;
            } else {
            PG8_LDB(B0, 0, 0); PG8_SCHED; PG8_LDA(At, 0, 0); PG8_STAGE(PG8_SA(1, 1), a1 + hstep, voffA);
            PG8_WAIT_L(8); PG8_BAR; PG8_WAIT_L(0); PG8_MMA(0, 0, At, B0); PG8_BAR; PG8_SCHED;
            PG8_LDB(B1, 0, 1); PG8_STAGE(PG8_SB(0, 0), b2, voffB);
            PG8_BAR; PG8_WAIT_L(0); PG8_MMA(0, 1, At, B1); PG8_BAR;
            PG8_LDA(At, 0, 1); PG8_STAGE(PG8_SA(0, 0), a2, voffA);
            PG8_BAR; PG8_WAIT_L(0); PG8_MMA(1, 0, At, B0); PG8_BAR; PG8_SCHED;
            PG8_STAGE(PG8_SB(0, 1), b2 + hstep, voffB);
            PG8_WAIT_V(6); PG8_BAR; PG8_MMA(1, 1, At, B1); PG8_BAR;
            PG8_LDB(B0, 1, 0); PG8_SCHED; PG8_LDA(At, 1, 0); PG8_STAGE(PG8_SA(0, 1), a2 + hstep, voffA);
            PG8_WAIT_L(8); PG8_BAR; PG8_WAIT_L(0); PG8_MMA(0, 0, At, B0); PG8_BAR; PG8_SCHED;
            PG8_LDB(B1, 1, 1); PG8_STAGE(PG8_SB(1, 0), b3, voffB);
            PG8_BAR; PG8_WAIT_L(0); PG8_MMA(0, 1, At, B1); PG8_BAR;
            PG8_LDA(At, 1, 1); PG8_STAGE(PG8_SA(1, 0), a3, voffA);
            PG8_BAR; PG8_WAIT_L(0); PG8_MMA(1, 0, At, B0); PG8_BAR; PG8_SCHED;
            PG8_STAGE(PG8_SB(1, 1), b3 + hstep, voffB);
            PG8_WAIT_V(6); PG8_BAR; PG8_MMA(1, 1, At, B1); PG8_BAR;
            }
        }
        if constexpr (ALIGN_EPI) { if (wr == 0) PG8_BAR; }
        if constexpr (!Epi::AFTER_DRAIN) { E(acc, cur, wr, wc, fr, fq); S.done(cur); }
        if (!has_next) break;
#pragma unroll
        for (int a = 0; a < 2; ++a)
#pragma unroll
            for (int b = 0; b < 2; ++b)
#pragma unroll
                for (int m = 0; m < 4; ++m)
#pragma unroll
                    for (int n = 0; n < 2; ++n) acc[a][b][m][n] = (f32x4){0.f, 0.f, 0.f, 0.f};
        cur = nxt; cA = nA; cB = nB; ++ui;
        if constexpr (ALIGN_EPI) { if (wr == 1) PG8_BAR; }
    }
    PG8_WAIT_V(0);
    if constexpr (!ALIGN_EPI) { if (wr == 0) PG8_BAR; }
    PG8_BAR;
    if constexpr (Epi::AFTER_DRAIN) { E.fused(acc, cur, wr, wc, fr, fq, lds, wid, lane); S.done(cur); }
#undef PG8_SA
#undef PG8_SB
#undef PG8_STAGE
#undef PG8_LDA
#undef PG8_LDB
#undef PG8_MMA
#undef PG8_WAIT_V
#undef PG8_WAIT_L
#undef PG8_BAR
#undef PG8_SCHED
}
}
#define GAS __attribute__((address_space(1)))
#define LAS __attribute__((address_space(3)))
typedef unsigned short bf16;
typedef unsigned v4u __attribute__((ext_vector_type(4)));
typedef float f32x4 __attribute__((ext_vector_type(4)));
typedef short bf16x8 __attribute__((ext_vector_type(8)));
typedef GAS unsigned gu32;
typedef GAS unsigned long long gu64;
#define RLX_AGENT __ATOMIC_RELAXED, __HIP_MEMORY_SCOPE_AGENT
#define LDS_WAIT() asm volatile("s_waitcnt lgkmcnt(0)" ::: "memory")
#define VM_WAIT() asm volatile("s_waitcnt vmcnt(0)" ::: "memory")
__device__ __forceinline__ unsigned long long rt() { return __builtin_amdgcn_s_memrealtime(); }
__device__ __forceinline__ unsigned f2bf(float f) { unsigned u = __builtin_bit_cast(unsigned, f); return (u + 0x7fffu + ((u >> 16) & 1u)) >> 16; }
__device__ __forceinline__ unsigned pk2(float lo, float hi) { return f2bf(lo) | (f2bf(hi) << 16); }

#define XB_TMO      128
#define XB_XCNT(j)  (256  + 64 * (j))
#define XB_XSUB(j)  (1280 + 64 * (j))
#define XB_XGEN(j)  (2304 + 64 * (j))
#define XB_TOP      3328
#define XB_TOPGEN   3392
#define XCD_BAR_WORDS 3456
#define XB_SPIN_CAP (1u << 18)

__device__ __forceinline__ unsigned xb_ld(unsigned* p)              { return __hip_atomic_load(p, __ATOMIC_RELAXED, __HIP_MEMORY_SCOPE_AGENT); }
__device__ __forceinline__ unsigned xb_add(unsigned* p, unsigned v) { return __hip_atomic_fetch_add(p, v, __ATOMIC_RELAXED, __HIP_MEMORY_SCOPE_AGENT); }
__device__ __forceinline__ unsigned xb_xcc_id() { return (unsigned)__builtin_amdgcn_s_getreg((3 << 11) | 20) & 0xFu; }
#define XB_SPIN(cond, bar) do { unsigned _sp = 0; while (cond) { __builtin_amdgcn_s_sleep(1); \
    if ((++_sp & 255u) == 0u) { if (xb_ld(&(bar)[XB_TMO])) break; if (_sp > XB_SPIN_CAP) { atomicAdd(&(bar)[XB_TMO], 1u); break; } } } } while (0)

struct XcdBarrier {
    unsigned* bar; unsigned x;
    volatile LAS unsigned* st;
};

__device__ __forceinline__ XcdBarrier xcd_barrier_post(unsigned* bar, volatile LAS unsigned* st) {
    XcdBarrier b; b.bar = bar; b.x = xb_xcc_id(); b.st = st;
    if (threadIdx.x == 0) (void)xb_add(&bar[XB_XCNT(b.x)], 1u);
    return b;
}
__device__ __forceinline__ void xcd_barrier_complete(unsigned* bar, unsigned x, unsigned& nloc, unsigned& nx) {
    const unsigned G = gridDim.x * gridDim.y * gridDim.z;
    unsigned sum, cnt, mine, sp = 0u;
    for (;;) {
        sum = 0u; cnt = 0u; mine = 0u;
#pragma unroll
        for (unsigned j = 0; j < 16; ++j) { const unsigned c = xb_ld(&bar[XB_XCNT(j)]); sum += c; cnt += (c > 0u) ? 1u : 0u; mine = (j == x) ? c : mine; }
        if (sum == G) break;
        __builtin_amdgcn_s_sleep(1);
        if ((++sp & 255u) == 0u) { if (xb_ld(&bar[XB_TMO])) break; if (sp > XB_SPIN_CAP) { atomicAdd(&bar[XB_TMO], 1u); break; } }
    }
    nloc = mine > 0u ? mine : 1u; nx = cnt > 0u ? cnt : 1u;
}

__device__ __forceinline__ void xcd_barrier(const XcdBarrier& b) {
    asm volatile("s_waitcnt vmcnt(0)" ::: "memory");
    __syncthreads();
    if (threadIdx.x == 0) {
        unsigned* bar = b.bar;
        __builtin_amdgcn_s_waitcnt(0);
        unsigned nloc = b.st[0], nx = b.st[1];
        if (nloc == 0u) { xcd_barrier_complete(bar, b.x, nloc, nx); b.st[0] = nloc; b.st[1] = nx; }
        const unsigned old = xb_add(&bar[XB_XSUB(b.x)], 1u);
        const unsigned gen = old / nloc;
        if (old + 1u == (gen + 1u) * nloc) {
            __builtin_amdgcn_fence(__ATOMIC_RELEASE, "agent");
            asm volatile("s_waitcnt vmcnt(0)" ::: "memory");
            const unsigned og = xb_add(&bar[XB_TOP], 1u);
            const unsigned tg = og / nx;
            if (og + 1u == (tg + 1u) * nx) xb_add(&bar[XB_TOPGEN], 1u);
            else XB_SPIN(xb_ld(&bar[XB_TOPGEN]) == tg, bar);
            __builtin_amdgcn_fence(__ATOMIC_ACQUIRE, "agent");
            xb_add(&bar[XB_XGEN(b.x)], 1u);
            asm volatile("s_waitcnt vmcnt(0)" ::: "memory");
        } else {
            XB_SPIN(xb_ld(&bar[XB_XGEN(b.x)]) == gen, bar);
            __builtin_amdgcn_fence(__ATOMIC_ACQUIRE, "agent");
            asm volatile("s_waitcnt vmcnt(0)" ::: "memory");
        }
    }
    __syncthreads();
}

constexpr int BATCH = 4, SEQ = 4096, D = 1024, M = BATCH * SEQ;
constexpr int RIN = 6144, RVD = 2048;
constexpr int FF = 2816, EF = 3584, NE = 8;
constexpr int KVQ_N = 3072;
constexpr float EPS = 1e-6f;
constexpr float LOG2E = 1.4426950408889634f;

typedef short s16x4 __attribute__((ext_vector_type(4)));
typedef float f32x16 __attribute__((ext_vector_type(16)));
typedef unsigned u32x2 __attribute__((ext_vector_type(2)));

__device__ __forceinline__ float bf2f(unsigned short h) { return __uint_as_float(((unsigned)h) << 16); }
__device__ __forceinline__ float bflo(unsigned w) { return __uint_as_float(w << 16); }
__device__ __forceinline__ float bfhi(unsigned w) { return __uint_as_float(w & 0xffff0000u); }
__device__ __forceinline__ float fast_exp2(float x) { return __builtin_amdgcn_exp2f(x); }
__device__ __forceinline__ float fast_rcp(float x) { return __builtin_amdgcn_rcpf(x); }
__device__ __forceinline__ float silu_f(float x) { return x * fast_rcp(1.0f + fast_exp2(-x * LOG2E)); }
__device__ __forceinline__ float wave_sum(float v) {
#pragma unroll
    for (int o = 1; o < 64; o <<= 1) v += __shfl_xor(v, o);
    return v;
}

namespace pg8 {
__device__ __forceinline__ float rinv_from_ssp(const float* ssp, int row) {
    const f32x4* p = (const f32x4*)(ssp + (size_t)row * 16);
    const f32x4 a = p[0], b = p[1], c = p[2], d = p[3];
    const float s = (((a[0] + a[1]) + (a[2] + a[3])) + ((b[0] + b[1]) + (b[2] + b[3]))) + (((c[0] + c[1]) + (c[2] + c[3])) + ((d[0] + d[1]) + (d[2] + d[3])));
    return __builtin_amdgcn_rsqf(s * (1.0f / 1024.0f) + EPS);
}
__device__ __forceinline__ u32x4 pack8(const f32x4 a, const f32x4 b) {
    u32x4 w; w.x = cvt_pk_bf16(a[0], a[1]); w.y = cvt_pk_bf16(a[2], a[3]); w.z = cvt_pk_bf16(b[0], b[1]); w.w = cvt_pk_bf16(b[2], b[3]); return w;
}
struct EpiInProj {
    static constexpr bool PERM = true, AFTER_DRAIN = false;
    bf16_t* O; const float* ssp; const float* rcos; const float* rsin;
    __device__ __forceinline__ void operator()(const f32x4 (&acc)[2][2][4][2], const Unit& u, int wr, int wc, int fr, int fq) const {
        const int row0 = u.pm * BM + wr * 64 + fr;
        const int cl = wc * 32 + 8 * fq;
        const bool rope = u.pn < 8;
        const float ksc = (u.pn >= 4 && u.pn < 8) ? 0.0625f : 1.0f;
#pragma unroll
        for (int ai = 0; ai < 2; ++ai)
#pragma unroll
            for (int m = 0; m < 4; ++m) {
                const int row = row0 + ai * HALF + m * 16;
                const float r = rinv_from_ssp(ssp, row) * ksc;
                bf16_t* rowp = O + (size_t)row * RIN + u.pn * BM + cl;
                f32x4 a0 = acc[ai][0][m][0] * r, a1 = acc[ai][0][m][1] * r, b0 = acc[ai][1][m][0] * r, b1 = acc[ai][1][m][1] * r;
                if (rope) {
                    const int pos = row & (SEQ - 1);
                    const f32x4 c0 = *(const f32x4*)(rcos + pos * 128 + cl), c1 = *(const f32x4*)(rcos + pos * 128 + cl + 4);
                    const f32x4 s0 = *(const f32x4*)(rsin + pos * 128 + cl), s1 = *(const f32x4*)(rsin + pos * 128 + cl + 4);
                    const f32x4 x0 = a0 * c0 - b0 * s0, x1 = a1 * c1 - b1 * s1, y0 = b0 * c0 + a0 * s0, y1 = b1 * c1 + a1 * s1;
                    a0 = x0; a1 = x1; b0 = y0; b1 = y1;
                }
                *(u32x4*)(rowp) = pack8(a0, a1);
                *(u32x4*)(rowp + HALF) = pack8(b0, b1);
                if (m & 1) asm volatile("" ::: "memory");
            }
    }
};
struct EpiSwiGLU {
    static constexpr bool PERM = true, AFTER_DRAIN = false;
    bf16_t* O; int ldc; const float* ssp; const float* rowr;
    __device__ __forceinline__ void operator()(const f32x4 (&acc)[2][2][4][2], const Unit& u, int wr, int wc, int fr, int fq) const {
        const int row0 = u.pm * BM + wr * 64 + fr;
        const int col = u.aux * HALF + wc * 32 + 8 * fq;
#pragma unroll
        for (int ai = 0; ai < 2; ++ai)
#pragma unroll
            for (int m = 0; m < 4; ++m) {
                const int row = row0 + ai * HALF + m * 16;
                const float r = rowr ? rowr[row] : rinv_from_ssp(ssp, row);
                f32x4 h0, h1;
#pragma unroll
                for (int j = 0; j < 4; ++j) {
                    h0[j] = silu_f(acc[ai][0][m][0][j] * r) * (acc[ai][1][m][0][j] * r);
                    h1[j] = silu_f(acc[ai][0][m][1][j] * r) * (acc[ai][1][m][1][j] * r);
                }
                *(u32x4*)(O + (size_t)row * ldc + col) = pack8(h0, h1);
                if (m & 1) asm volatile("" ::: "memory");
            }
    }
};
struct EpiResid {
    static constexpr bool PERM = false, AFTER_DRAIN = false;
    const float* base; float* outx; bf16_t* xb; float* ssp;
    __device__ __forceinline__ void operator()(const f32x4 (&acc)[2][2][4][2], const Unit& u, int wr, int wc, int fr, int fq) const {
        const int row0 = u.pm * BM + wr * 64 + fr;
        const int col0 = u.pn * BM + wc * 32 + 4 * fq;
#pragma unroll
        for (int ai = 0; ai < 2; ++ai)
#pragma unroll
            for (int m = 0; m < 4; ++m) {
                const int row = row0 + ai * HALF + m * 16;
                const size_t off = (size_t)row * D + col0;
                float ss = 0.f;
#pragma unroll
                for (int bj = 0; bj < 2; ++bj)
#pragma unroll
                    for (int n = 0; n < 2; ++n) {
                        const size_t c = off + bj * HALF + n * 16;
                        const f32x4 v = *(const f32x4*)(base + c) + acc[ai][bj][m][n];
                        *(f32x4*)(outx + c) = v;
                        u32x2 w; w.x = cvt_pk_bf16(v[0], v[1]); w.y = cvt_pk_bf16(v[2], v[3]);
                        *(u32x2*)(xb + c) = w;
                        ss += (v[0] * v[0] + v[1] * v[1]) + (v[2] * v[2] + v[3] * v[3]);
                    }
                ss += __shfl_xor(ss, 16); ss += __shfl_xor(ss, 32);
                if (fq == 0) ssp[(size_t)row * 16 + u.pn * 4 + wc] = ss;
                asm volatile("" ::: "memory");
            }
    }
};
struct EpiKVQ {
    static constexpr bool PERM = true, AFTER_DRAIN = false;
    bf16_t* O; const float* ssp; const float* dcos; const float* dsin; float qscale;
    __device__ __forceinline__ void operator()(const f32x4 (&acc)[2][2][4][2], const Unit& u, int wr, int wc, int fr, int fq) const {
        const int row0 = u.pm * BM + wr * 64 + fr;
        const int cl = wc * 32 + 8 * fq;
        const int kind = u.pn >> 2;
        const bool ropelane = ((wc & 1) == 0) && (fq < 2);
#pragma unroll
        for (int ai = 0; ai < 2; ++ai)
#pragma unroll
            for (int m = 0; m < 4; ++m) {
                const int row = row0 + ai * HALF + m * 16;
                const float r = rinv_from_ssp(ssp, row) * (kind == 2 ? qscale : 1.0f);
                bf16_t* rowp = O + (size_t)row * KVQ_N + u.pn * BM + cl;
                f32x4 c0, c1, s0, s1;
                if (kind != 1) {
                    const int pos = row & (SEQ - 1);
                    c0 = *(const f32x4*)(dcos + pos * 8); c1 = *(const f32x4*)(dcos + pos * 8 + 4);
                    s0 = *(const f32x4*)(dsin + pos * 8); s1 = *(const f32x4*)(dsin + pos * 8 + 4);
                    if (fq != 0) { s0 = -s0; s1 = -s1; }
                }
#pragma unroll
                for (int bj = 0; bj < 2; ++bj) {
                    f32x4 v0 = acc[ai][bj][m][0] * r, v1 = acc[ai][bj][m][1] * r;
                    if (kind != 1) {
                        f32x4 p0, p1;
#pragma unroll
                        for (int j = 0; j < 4; ++j) { p0[j] = __shfl_xor(v0[j], 16); p1[j] = __shfl_xor(v1[j], 16); }
                        if (ropelane) { v0 = v0 * c0 - p0 * s0; v1 = v1 * c1 - p1 * s1; }
                    }
                    *(u32x4*)(rowp + bj * HALF) = pack8(v0, v1);
                }
                if (m & 1) asm volatile("" ::: "memory");
            }
    }
};
struct EpiMoeDown {
    static constexpr bool PERM = true, AFTER_DRAIN = false;
    bf16_t* Y; const int* rowinfo; const float* rowgate;
    __device__ __forceinline__ void operator()(const f32x4 (&acc)[2][2][4][2], const Unit& u, int wr, int wc, int fr, int fq) const {
        const int row0 = u.pm * BM + wr * 64 + fr;
        const int cl = u.aux * BM + wc * 32 + 8 * fq;
#pragma unroll
        for (int ai = 0; ai < 2; ++ai)
#pragma unroll
            for (int m = 0; m < 4; ++m) {
                const int row = row0 + ai * HALF + m * 16;
                const int info = rowinfo[row];
                if (info >= 0) {
                    const float g = rowgate[row];
                    bf16_t* rowp = Y + (size_t)info * D + cl;
                    *(u32x4*)(rowp) = pack8(acc[ai][0][m][0] * g, acc[ai][0][m][1] * g);
                    *(u32x4*)(rowp + HALF) = pack8(acc[ai][1][m][0] * g, acc[ai][1][m][1] * g);
                }
            }
    }
};
struct MoeOrder {
    int nM, nN, nwg, G, c; int ts[9];
    __device__ __forceinline__ bool next(int i, Unit& u) const {
        const long L = (long)i * G + c; if (L >= nwg) return false;
        int wgid = (int)L; { const int q = nwg / NXCD, r = nwg % NXCD, xcd = wgid % NXCD, off = wgid / NXCD; wgid = (xcd < r ? xcd * (q + 1) : r * (q + 1) + (xcd - r) * q) + off; }
        const int nig = WGM * nN, gid = wgid / nig, fm = gid * WGM, gsz = (nM - fm) < WGM ? (nM - fm) : WGM;
        const int pm = fm + ((wgid % nig) % gsz), pnl = (wgid % nig) / gsz;
        int e = 0;
#pragma unroll
        for (int k = 1; k < 8; ++k) e += (pm >= ts[k]) ? 1 : 0;
        u.pm = pm; u.pn = e * nN + pnl; u.aux = pnl; return true;
    }
    __device__ __forceinline__ void a_ready(const Unit&) const {}
    __device__ __forceinline__ void done(const Unit&) const {}
};
}
constexpr size_t MiB = 1u << 20;
constexpr size_t WS_CTL = 0, CTL_ZERO_BYTES = 1 * MiB;
constexpr size_t WS_RCOS = 1 * MiB, WS_RSIN = 3 * MiB;
constexpr size_t WS_DCOS = 5 * MiB, WS_DSIN = 5 * MiB + 256 * 1024;
constexpr size_t WS_SSP = 6 * MiB;
constexpr size_t WS_RWT = 7 * MiB;
constexpr size_t WS_TOPE = 8 * MiB;
constexpr size_t WS_TOPW = 8 * MiB + 128 * 1024;
constexpr size_t WS_TOPR = 8 * MiB + 256 * 1024;
constexpr size_t WS_TOKR = 8 * MiB + 384 * 1024;
constexpr size_t WS_CNT = 8 * MiB + 512 * 1024;
constexpr int XG_ROWS = 2 * M + NE * 256;
constexpr size_t WS_ROWINFO = 9 * MiB;
constexpr size_t WS_ROWGATE = 9 * MiB + 256 * 1024;
constexpr size_t WS_ROWR = 9 * MiB + 512 * 1024;
constexpr size_t WS_S = 10 * MiB;
constexpr size_t WS_W_IN = 20 * MiB, WS_W_RO = 32 * MiB, WS_W_GU = 36 * MiB, WS_W_DN = 47 * MiB, WS_W_KVQ = 53 * MiB, WS_W_DO = 59 * MiB, WS_W_MGU = 61 * MiB, WS_W_MDN = 173 * MiB;
constexpr size_t WS_XM = 232 * MiB;
constexpr size_t WS_XB = 296 * MiB;
constexpr size_t WS_PROJ = 328 * MiB;
constexpr size_t WS_RO = 520 * MiB;
constexpr size_t WS_ORET = 584 * MiB;
constexpr size_t WS_H = 328 * MiB;
constexpr size_t WS_KVQ = 584 * MiB;
constexpr size_t WS_AO = 680 * MiB;
constexpr size_t WS_Y = 712 * MiB;
constexpr size_t WS_HM = 328 * MiB;
constexpr size_t WS_XG = 584 * MiB;
constexpr size_t WS_END = 776 * MiB;
static_assert(WS_W_MDN + (size_t)NE * D * EF * 2 <= WS_XM && WS_HM + (size_t)XG_ROWS * EF * 2 <= WS_KVQ && WS_XG + (size_t)XG_ROWS * D * 2 <= WS_AO && WS_Y + (size_t)2 * M * D * 2 <= WS_END, "d_ws map");
constexpr int CW_BAR = 4096;

constexpr int RING_BYTES = 131072;
constexpr int LDSCTL_OFF = RING_BYTES;
constexpr int LDS_BYTES = 147456;
constexpr int NWAVES = 8, NTHREADS = 512;

#define WG_BAR() do { asm volatile("s_waitcnt vmcnt(0) lgkmcnt(0)" ::: "memory"); __builtin_amdgcn_s_barrier(); asm volatile("" ::: "memory"); } while (0)

#define PHASE_IDS() int tid = threadIdx.x; asm volatile("" : "+v"(tid)); const int lane = tid & 63; const int wave = __builtin_amdgcn_readfirstlane(tid >> 6); (void)lane; (void)wave
__device__ __forceinline__ void tr_item(const float* W, int N, const float* gain, int gmask, float gscale, bf16* WT, int ldk, int k0, int n0, int drow, LAS float* scr, int lane) {
#pragma unroll 8
    for (int i = 0; i < 32; ++i) {
        const int kk = 2 * i + (lane >> 5);
        float v = W[(size_t)(k0 + kk) * N + n0 + (lane & 31)];
        if (gain) v *= gain[(k0 + kk) & gmask] * gscale;
        scr[kk * 33 + (lane & 31)] = v;
    }
    LDS_WAIT(); asm volatile("" ::: "memory");
    const int c = lane & 7;
#pragma unroll
    for (int j = 0; j < 4; ++j) {
        const int n = (lane >> 3) + 8 * j; const LAS float* s = scr + (8 * c) * 33 + n;
        v4u o; o.x = pk2(s[0 * 33], s[1 * 33]); o.y = pk2(s[2 * 33], s[3 * 33]); o.z = pk2(s[4 * 33], s[5 * 33]); o.w = pk2(s[6 * 33], s[7 * 33]);
        *(GAS v4u*)(WT + (size_t)(drow + n) * ldk + k0 + 8 * c) = o;
    }
    LDS_WAIT(); asm volatile("" ::: "memory");
}
__device__ __forceinline__ void tr_matrix_item(const float* W, int K, int N, const float* gain, int gmask, float gscale, bf16* WT, int F, int row_off, int item, LAS float* scr, int lane) {
    const int nblk = N / 32, kb = item / nblk, nb = item % nblk, k0 = 64 * kb, n0 = 32 * nb;
    int drow;
    if (F > 0) { const int up = n0 >= F ? 1 : 0; const int f = n0 - up * F; drow = 256 * (f >> 7) + 128 * up + (f & 127); }
    else drow = n0;
    tr_item(W, N, gain, gmask, gscale, WT, K, k0, n0, row_off + drow, scr, lane);
}

struct Ptrs {
    const float *x, *ln_mix, *ln_ffn, *ret_w_in, *ret_w_o, *kv_norm, *w_kv, *diff_w_q, *lq1, *lk1, *lq2, *lk2, *subln, *diff_w_o, *ffn_w_gu, *ffn_w_down, *router, *moe_w_gu, *moe_w_down, *final_norm;
    float* out; unsigned char* ws;
};

__device__ __forceinline__ void p0_prologue(const Ptrs& P, LAS unsigned char* lds, int vcu, int G, float lambda_init) {
    PHASE_IDS();
    LAS float* scr = (LAS float*)(lds + wave * 16384);
    unsigned char* ws = P.ws;
    const int gw = vcu * NWAVES + wave, NGW = G * NWAVES;
    constexpr int I_IN = (D / 64) * (RIN / 32), I_RO = (RVD / 64) * (D / 32), I_GU = (D / 64) * (2 * FF / 32), I_DN = (FF / 64) * (D / 32), I_KV = (D / 64) * (2048 / 32), I_Q = (D / 64) * (D / 32), I_DO = I_Q;
    constexpr int I_MGU = (D / 64) * (2 * EF / 32), I_MDN = (EF / 64) * (D / 32);
    constexpr int NITEMS = I_IN + I_RO + I_GU + I_DN + I_KV + I_Q + I_DO + NE * I_MGU + NE * I_MDN;
    for (int it = gw; it < NITEMS; it += NGW) {
        int r = it;
        if (r < I_IN) { tr_matrix_item(P.ret_w_in, D, RIN, P.ln_mix, 1023, 1.f, (bf16*)(ws + WS_W_IN), 0, 0, r, scr, lane); continue; } r -= I_IN;
        if (r < I_RO) { tr_matrix_item(P.ret_w_o, RVD, D, nullptr, 0, 1.f, (bf16*)(ws + WS_W_RO), 0, 0, r, scr, lane); continue; } r -= I_RO;
        if (r < I_GU) { tr_matrix_item(P.ffn_w_gu, D, 2 * FF, P.ln_ffn, 1023, 1.f, (bf16*)(ws + WS_W_GU), FF, 0, r, scr, lane); continue; } r -= I_GU;
        if (r < I_DN) { tr_matrix_item(P.ffn_w_down, FF, D, nullptr, 0, 1.f, (bf16*)(ws + WS_W_DN), 0, 0, r, scr, lane); continue; } r -= I_DN;
        if (r < I_KV) { tr_matrix_item(P.w_kv, D, 2048, P.kv_norm, 1023, 1.f, (bf16*)(ws + WS_W_KVQ), 0, 0, r, scr, lane); continue; } r -= I_KV;
        if (r < I_Q) { tr_matrix_item(P.diff_w_q, D, D, P.ln_mix + D, 1023, 1.f, (bf16*)(ws + WS_W_KVQ), 0, 2048, r, scr, lane); continue; } r -= I_Q;
        if (r < I_DO) { tr_matrix_item(P.diff_w_o, D, D, P.subln, 127, 1.0f - lambda_init, (bf16*)(ws + WS_W_DO), 0, 0, r, scr, lane); continue; } r -= I_DO;
        if (r < NE * I_MGU) { const int e = r / I_MGU; tr_matrix_item(P.moe_w_gu + (size_t)e * D * 2 * EF, D, 2 * EF, P.ln_ffn + D, 1023, 1.f, (bf16*)(ws + WS_W_MGU) + (size_t)e * 2 * EF * D, EF, 0, r - e * I_MGU, scr, lane); continue; } r -= NE * I_MGU;
        { const int e = r / I_MDN; tr_matrix_item(P.moe_w_down + (size_t)e * EF * D, EF, D, nullptr, 0, 1.f, (bf16*)(ws + WS_W_MDN) + (size_t)e * D * EF, 0, 0, r - e * I_MDN, scr, lane); }
    }
    {
        const int gt = gw * 64 + lane, NT = NGW * 64;
        float* rc = (float*)(ws + WS_RCOS); float* rs = (float*)(ws + WS_RSIN);
        for (int i = gt; i < SEQ * 128; i += NT) {
            const int pos = i >> 7, f = i & 127;
            const float inv = exp2f(-(float)f * (13.287712379549449f / 128.0f));
            const double rev = (double)((float)pos * inv) * 0.15915494309189535;
            const float fr = (float)(rev - floor(rev));
            rc[i] = __builtin_amdgcn_cosf(fr); rs[i] = __builtin_amdgcn_sinf(fr);
        }
        float* dc = (float*)(ws + WS_DCOS); float* ds = (float*)(ws + WS_DSIN);
        for (int i = gt; i < SEQ * 8; i += NT) {
            const int pos = i >> 3, f = i & 7;
            const float inv = exp2f(-(float)f * (18.931568569324174f / 8.0f));
            const double rev = (double)((float)pos * inv) * 0.15915494309189535;
            const float fr = (float)(rev - floor(rev));
            dc[i] = __builtin_amdgcn_cosf(fr); ds[i] = __builtin_amdgcn_sinf(fr);
        }
        float* rwt = (float*)(ws + WS_RWT);
        for (int i = gt; i < NE * D; i += NT) { const int e = i >> 10, k = i & 1023; rwt[i] = P.router[k * NE + e] * P.ln_ffn[D + k]; }
    }
    {
        bf16* xb = (bf16*)(ws + WS_XB); float* ssp = (float*)(ws + WS_SSP);
        for (int m = gw; m < M; m += NGW) {
            const GAS f32x4* xr = (const GAS f32x4*)(P.x + (size_t)m * D) + lane;
            f32x4 v[4]; float s = 0.f;
#pragma unroll
            for (int j = 0; j < 4; ++j) { v[j] = xr[64 * j]; s += (v[j].x * v[j].x + v[j].y * v[j].y) + (v[j].z * v[j].z + v[j].w * v[j].w); }
            s = wave_sum(s);
            GAS unsigned long long* o8 = (GAS unsigned long long*)(xb + (size_t)m * D) + lane;
#pragma unroll
            for (int j = 0; j < 4; ++j) o8[64 * j] = (unsigned long long)pk2(v[j].x, v[j].y) | ((unsigned long long)pk2(v[j].z, v[j].w) << 32);
            if (lane < 16) ssp[(size_t)m * 16 + lane] = lane == 0 ? s : 0.f;
        }
    }
}

namespace ret {
typedef short v4i16_t __attribute__((ext_vector_type(4)));
__device__ __forceinline__ s16x4 trld(LAS const unsigned char* p) { return __builtin_bit_cast(s16x4, __builtin_amdgcn_ds_read_tr16_b64_v4i16((LAS v4i16_t*)p)); }
__device__ __forceinline__ bf16x8 cat8(s16x4 lo, s16x4 hi) { return (bf16x8){lo[0], lo[1], lo[2], lo[3], hi[0], hi[1], hi[2], hi[3]}; }
constexpr int QSTR = 528, SSTR = 144;
constexpr int LQ = 0, LK = LQ + 64 * QSTR, LV = LK + 64 * 512, LVD = LV + 4096, LS = LVD + 4096, LST = LS + 64 * SSTR, LEND = LST + 256 * 64;
static_assert(LEND <= RING_BYTES && (LK % 16) == 0 && (LV % 16) == 0 && (LS % 16) == 0 && (LST % 16) == 0, "retention LDS map");

__device__ __forceinline__ void scores_phase(const bf16* proj, bf16* sbuf, int vcu, int G) {
    PHASE_IDS();
    const int i = lane & 15, g = lane >> 4;
    for (int u = vcu; u < 1024; u += G) {
        const int bh = u >> 6, c = u & 63, b = bh >> 2, h = bh & 3;
        const size_t R0 = (size_t)b * SEQ + c * 64;
        const float lg = log2f(1.0f - exp2f(-5.0f - (float)h));
#pragma unroll
        for (int tt = 0; tt < 2; ++tt) {
            const int ti = 2 * wave + tt, tn = ti >> 2, tm = ti & 3;
            f32x4 acc = (f32x4){0.f, 0.f, 0.f, 0.f};
            if (tm <= tn) {
                const bf16* kp = proj + (R0 + 16 * tm + i) * RIN + 1024 + h * 256 + 8 * g;
                const bf16* qp = proj + (R0 + 16 * tn + i) * RIN + h * 256 + 8 * g;
#pragma unroll
                for (int s = 0; s < 8; ++s) {
                    const bf16x8 a = *(const bf16x8*)(kp + 32 * s), bq = *(const bf16x8*)(qp + 32 * s);
                    acc = __builtin_amdgcn_mfma_f32_16x16x32_bf16(a, bq, acc, 0, 0, 0);
                }
            }
            const int n = 16 * tn + i, m0 = 16 * tm + 4 * g;
            float v[4];
#pragma unroll
            for (int r = 0; r < 4; ++r) { const int dm = n - (m0 + r); v[r] = dm >= 0 ? acc[r] * exp2f((float)dm * lg) : 0.f; }
            u32x2 w; w.x = pk2(v[0], v[1]); w.y = pk2(v[2], v[3]);
            *(u32x2*)(sbuf + (size_t)u * 4096 + n * 64 + m0) = w;
        }
    }
}

__device__ __forceinline__ void scan_phase(const bf16* proj, const bf16* sbuf, bf16* oret, LAS unsigned char* lds, int vcu, int G) {
    PHASE_IDS();
    const int i = lane & 15, g = lane >> 4, q = i >> 2, p = i & 3;
    const int nt = wave >> 1, vt = wave & 1;
    for (int u = vcu; u < 256; u += G) {
        const int bh = u >> 4, vs = u & 15, b = bh >> 2, h = bh & 3;
        const float lg = log2f(1.0f - exp2f(-5.0f - (float)h));
        const float cdec = exp2f(64.0f * lg);
        float qd[4];
#pragma unroll
        for (int r = 0; r < 4; ++r) qd[r] = exp2f((float)(16 * nt + 4 * g + r + 1) * lg);
        const float kd = exp2f((float)(63 - (tid >> 2)) * lg);
        const int qrow = tid >> 5, qc16 = tid & 31;
        const bf16* gq = proj + ((size_t)b * SEQ + qrow) * RIN + h * 256 + qc16 * 8;
        const bf16* gk = gq + 1024;
        const int kx = (qrow & 3) | (((qrow >> 3) & 1) << 2);
        const int lq_off = LQ + qrow * QSTR + qc16 * 16;
        const int lk_off = LK + qrow * 512 + (((qc16 >> 1) ^ kx) << 5) + (qc16 & 1) * 16;
        const int vrow = tid >> 2, vc16 = tid & 3;
        const bf16* gv = proj + ((size_t)b * SEQ + vrow) * RIN + 2048 + h * 512 + vs * 32 + vc16 * 8;
        const int lv_off = vrow * 64 + ((vc16 * 16) ^ (((vrow >> 3) & 1) << 5));
        const int srow = tid >> 3, sc16 = tid & 7;
        const bf16* gs = sbuf + (size_t)(bh * 64) * 4096 + srow * 64 + sc16 * 8;
        const int ls_off = LS + srow * SSTR + sc16 * 16;
        f32x4 st[2][2];
#pragma unroll
        for (int a = 0; a < 2; ++a)
#pragma unroll
            for (int c2 = 0; c2 < 2; ++c2) st[a][c2] = (f32x4){0.f, 0.f, 0.f, 0.f};
        { LAS v4u* z = (LAS v4u*)(lds + LST) + tid * 2; z[0] = (v4u){0u, 0u, 0u, 0u}; z[1] = (v4u){0u, 0u, 0u, 0u}; }
        v4u pq[4], pk[4], pv, ps;
#pragma unroll
        for (int k = 0; k < 4; ++k) { pq[k] = *(const v4u*)(gq + (size_t)(16 * k) * RIN); pk[k] = *(const v4u*)(gk + (size_t)(16 * k) * RIN); }
        pv = (tid < 256) ? *(const v4u*)gv : (v4u){0u, 0u, 0u, 0u};
        ps = *(const v4u*)gs;
        for (int c = 0; c < 64; ++c) {
#pragma unroll
            for (int k = 0; k < 4; ++k) { *(LAS v4u*)(lds + lq_off + 16 * k * QSTR) = pq[k]; *(LAS v4u*)(lds + lk_off + 16 * k * 512) = pk[k]; }
            if (tid < 256) {
                *(LAS v4u*)(lds + LV + lv_off) = pv;
                v4u d; d.x = pk2(bflo(pv.x) * kd, bfhi(pv.x) * kd); d.y = pk2(bflo(pv.y) * kd, bfhi(pv.y) * kd); d.z = pk2(bflo(pv.z) * kd, bfhi(pv.z) * kd); d.w = pk2(bflo(pv.w) * kd, bfhi(pv.w) * kd);
                *(LAS v4u*)(lds + LVD + lv_off) = d;
            }
            *(LAS v4u*)(lds + ls_off) = ps;
            WG_BAR();
            if (c + 1 < 64) {
                const size_t adv = (size_t)(c + 1) * 64 * RIN;
#pragma unroll
                for (int k = 0; k < 4; ++k) { pq[k] = *(const v4u*)(gq + adv + (size_t)(16 * k) * RIN); pk[k] = *(const v4u*)(gk + adv + (size_t)(16 * k) * RIN); }
                if (tid < 256) pv = *(const v4u*)(gv + adv);
                ps = *(const v4u*)(gs + (size_t)(c + 1) * 4096);
            }
            f32x4 a1 = (f32x4){0.f, 0.f, 0.f, 0.f}, a2 = (f32x4){0.f, 0.f, 0.f, 0.f};
#pragma unroll
            for (int s = 0; s < 2; ++s) {
                const bf16x8 a = *(const LAS bf16x8*)(lds + LS + (16 * nt + i) * SSTR + (32 * s + 8 * g) * 2);
                const int r0 = 32 * s + 8 * g + q, r1 = r0 + 4, cb = (16 * vt + 4 * p) * 2;
                const s16x4 lo = trld(lds + LV + r0 * 64 + (cb ^ (((r0 >> 3) & 1) << 5))), hi = trld(lds + LV + r1 * 64 + (cb ^ (((r1 >> 3) & 1) << 5)));
                a1 = __builtin_amdgcn_mfma_f32_16x16x32_bf16(a, cat8(lo, hi), a1, 0, 0, 0);
            }
#pragma unroll
            for (int s = 0; s < 8; ++s) {
                const bf16x8 a = *(const LAS bf16x8*)(lds + LQ + (16 * nt + i) * QSTR + (32 * s + 8 * g) * 2);
                const int r0 = 32 * s + 8 * g + q, r1 = r0 + 4, cb = (16 * vt + 4 * p) * 2;
                const s16x4 lo = trld(lds + LST + r0 * 64 + (cb ^ (((r0 >> 3) & 1) << 5))), hi = trld(lds + LST + r1 * 64 + (cb ^ (((r1 >> 3) & 1) << 5)));
                a2 = __builtin_amdgcn_mfma_f32_16x16x32_bf16(a, cat8(lo, hi), a2, 0, 0, 0);
            }
            {
                bf16* op = oret + ((size_t)b * SEQ + c * 64 + 16 * nt + 4 * g) * RVD + h * 512 + vs * 32 + 16 * vt + i;
#pragma unroll
                for (int r = 0; r < 4; ++r) op[(size_t)r * RVD] = (bf16)f2bf(a1[r] + qd[r] * a2[r]);
            }
#pragma unroll
            for (int dt = 0; dt < 2; ++dt)
#pragma unroll
                for (int vv = 0; vv < 2; ++vv) st[dt][vv] = st[dt][vv] * cdec;
#pragma unroll
            for (int s = 0; s < 2; ++s) {
                const int r0 = 32 * s + 8 * g + q, r1 = r0 + 4;
                const int x0 = (r0 & 3) | (((r0 >> 3) & 1) << 2), x1 = (r1 & 3) | (((r1 >> 3) & 1) << 2);
                bf16x8 ka[2], vb[2];
#pragma unroll
                for (int dt = 0; dt < 2; ++dt) {
                    const int slot = 2 * wave + dt;
                    ka[dt] = cat8(trld(lds + LK + r0 * 512 + ((slot ^ x0) << 5) + 8 * p), trld(lds + LK + r1 * 512 + ((slot ^ x1) << 5) + 8 * p));
                }
#pragma unroll
                for (int vv = 0; vv < 2; ++vv) {
                    const int cb = (16 * vv + 4 * p) * 2;
                    vb[vv] = cat8(trld(lds + LVD + r0 * 64 + (cb ^ (((r0 >> 3) & 1) << 5))), trld(lds + LVD + r1 * 64 + (cb ^ (((r1 >> 3) & 1) << 5))));
                }
#pragma unroll
                for (int dt = 0; dt < 2; ++dt)
#pragma unroll
                    for (int vv = 0; vv < 2; ++vv) st[dt][vv] = __builtin_amdgcn_mfma_f32_16x16x32_bf16(ka[dt], vb[vv], st[dt][vv], 0, 0, 0);
            }
            WG_BAR();
#pragma unroll
            for (int dt = 0; dt < 2; ++dt)
#pragma unroll
                for (int vv = 0; vv < 2; ++vv)
#pragma unroll
                    for (int r = 0; r < 4; ++r) {
                        const int d = 32 * wave + 16 * dt + 4 * g + r, cb = (16 * vv + i) * 2;
                        *(LAS bf16*)(lds + LST + d * 64 + (cb ^ (((d >> 3) & 1) << 5))) = (bf16)f2bf(st[dt][vv][r]);
                    }
        }
        WG_BAR();
    }
}

__device__ __forceinline__ void norm_gate_phase(const bf16* oret, const bf16* proj, bf16* ro, int vcu, int G) {
    PHASE_IDS();
    const int gw = vcu * NWAVES + wave, NGW = G * NWAVES;
    for (int it = gw; it < M * 4; it += NGW) {
        const int row = it >> 2, h = it & 3;
        const v4u ov = *(const v4u*)(oret + (size_t)row * RVD + h * 512 + lane * 8);
        const v4u gv = *(const v4u*)(proj + (size_t)row * RIN + 4096 + h * 512 + lane * 8);
        float o[8] = {bflo(ov.x), bfhi(ov.x), bflo(ov.y), bfhi(ov.y), bflo(ov.z), bfhi(ov.z), bflo(ov.w), bfhi(ov.w)};
        const float gg[8] = {bflo(gv.x), bfhi(gv.x), bflo(gv.y), bfhi(gv.y), bflo(gv.z), bfhi(gv.z), bflo(gv.w), bfhi(gv.w)};
        float s = 0.f;
#pragma unroll
        for (int j = 0; j < 8; ++j) s += o[j];
        const float mu = wave_sum(s) * (1.0f / 512.0f);
        float s2 = 0.f;
#pragma unroll
        for (int j = 0; j < 8; ++j) { o[j] -= mu; s2 += o[j] * o[j]; }
        const float rstd = __builtin_amdgcn_rsqf(wave_sum(s2) * (1.0f / 512.0f) + EPS);
        float y[8];
#pragma unroll
        for (int j = 0; j < 8; ++j) y[j] = o[j] * rstd * silu_f(gg[j]);
        v4u w; w.x = pk2(y[0], y[1]); w.y = pk2(y[2], y[3]); w.z = pk2(y[4], y[5]); w.w = pk2(y[6], y[7]);
        *(v4u*)(ro + (size_t)row * RVD + h * 512 + lane * 8) = w;
    }
}
}

namespace dat {
constexpr int LK0 = 0, LV0 = 32768, LWS = 67584  , LCB = 0  , CSTR = 132;
__device__ __forceinline__ int crow(int r, int hi) { return (r & 3) + 8 * (r >> 2) + 4 * hi; }
__device__ __forceinline__ float half_swap_max(float m) { auto rr = __builtin_amdgcn_permlane32_swap(__float_as_uint(m), __float_as_uint(m), false, false); return fmaxf(__uint_as_float(rr[0]), __uint_as_float(rr[1])); }
__device__ __forceinline__ float half_swap_sum(float m) { auto rr = __builtin_amdgcn_permlane32_swap(__float_as_uint(m), __float_as_uint(m), false, false); return __uint_as_float(rr[0]) + __uint_as_float(rr[1]); }
__device__ __forceinline__ unsigned cvtpk(float lo, float hi) { return pg8::cvt_pk_bf16(lo, hi); }

__device__ __forceinline__ void attn_unit(int b, int h, int qb, const bf16* kvq, bf16* ao, LAS unsigned char* lds, float lam, int wave, int lane, int tid) {
    const int r32 = lane & 31, hi = lane >> 5, comp = wave >> 2, w4 = wave & 3;
    const size_t rowbase = (size_t)b * SEQ;
    const int q0 = qb * 128;
    const int NT = 2 * qb + 2, ntw = 2 * qb + 1 + (w4 >> 1);
    const bf16* Kh = kvq + rowbase * KVQ_N + h * 128;
    const bf16* Vh = kvq + rowbase * KVQ_N + 1024 + h * 128;
    const bf16* Qw = kvq + (rowbase + q0 + w4 * 32) * KVQ_N + 2048 + h * 128 + comp * 64;
    LAS float* wsf = (LAS float*)(lds + LWS) + wave * 64;
    const bf16* ksrc0 = Kh + (size_t)lane * KVQ_N + wave * 8;
    const bf16* ksrc1 = ksrc0 + 64;
    const bf16* vsrc0 = Vh + (size_t)(16 * (wave & 3) + (lane >> 2)) * KVQ_N + (wave >> 2) * 32 + (lane & 3) * 8;
    const bf16* vsrc1 = vsrc0 + 64;
#define DAT_DMA(t, buf) do { const size_t adv_ = (size_t)(t) * 64 * KVQ_N; \
        __builtin_amdgcn_global_load_lds((const unsigned*)(ksrc0 + adv_), (LAS unsigned*)(lds + LK0 + (buf) * 16384 + wave * 1024), 16, 0, 0); \
        __builtin_amdgcn_global_load_lds((const unsigned*)(ksrc1 + adv_), (LAS unsigned*)(lds + LK0 + (buf) * 16384 + (wave + 8) * 1024), 16, 0, 0); \
        __builtin_amdgcn_global_load_lds((const unsigned*)(vsrc0 + adv_), (LAS unsigned*)(lds + LV0 + (buf) * 16384 + wave * 1024), 16, 0, 0); \
        __builtin_amdgcn_global_load_lds((const unsigned*)(vsrc1 + adv_), (LAS unsigned*)(lds + LV0 + (buf) * 16384 + (wave + 8) * 1024), 16, 0, 0); } while (0)
    DAT_DMA(0, 0);
    bf16x8 qr[4];
#pragma unroll
    for (int d0 = 0; d0 < 4; ++d0) qr[d0] = *(const bf16x8*)(Qw + (size_t)r32 * KVQ_N + d0 * 16 + hi * 8);
    f32x16 o[4];
#pragma unroll
    for (int d = 0; d < 4; ++d)
#pragma unroll
        for (int r = 0; r < 16; ++r) o[d][r] = 0.f;
    float mrun = -1e30f, lrun = 0.f;
    const int vlane = ((lane >> 4) & 1) * 32 + (lane & 3) * 8 + (4 * hi + ((lane & 15) >> 2)) * 64;
    for (int t = 0; t < NT; ++t) {
        WG_BAR();
        if (t + 1 < NT) DAT_DMA(t + 1, (t + 1) & 1);
        if (t < ntw) {
            LAS const unsigned char* Kb = lds + LK0 + (t & 1) * 16384 + (comp * 8 + hi) * 1024 + r32 * 16;
            f32x16 p0, p1;
#pragma unroll
            for (int r = 0; r < 16; ++r) { p0[r] = 0.f; p1[r] = 0.f; }
#pragma unroll
            for (int d0 = 0; d0 < 4; ++d0) {
                const bf16x8 b0 = *(const LAS bf16x8*)(Kb + d0 * 2048), b1 = *(const LAS bf16x8*)(Kb + d0 * 2048 + 512);
                p0 = __builtin_amdgcn_mfma_f32_32x32x16_bf16(b0, qr[d0], p0, 0, 0, 0);
                p1 = __builtin_amdgcn_mfma_f32_32x32x16_bf16(b1, qr[d0], p1, 0, 0, 0);
            }
            float rm = fmaxf(p0[0], p1[0]);
#pragma unroll
            for (int r = 1; r < 16; ++r) rm = fmaxf(rm, fmaxf(p0[r], p1[r]));
            rm = half_swap_max(rm);
            const float mnew = fmaxf(mrun, rm);
            if (__any(mnew > mrun)) {
                const float f = fast_exp2(mrun - mnew);
                lrun *= f; mrun = mnew;
                if (hi == 0) wsf[r32] = f;
                asm volatile("s_waitcnt lgkmcnt(0)" ::: "memory");
#pragma unroll
                for (int r = 0; r < 16; ++r) { const float fr_ = wsf[crow(r, hi)];
#pragma unroll
                    for (int d = 0; d < 4; ++d) o[d][r] *= fr_; }
            }
            float ls = 0.f;
#pragma unroll
            for (int r = 0; r < 16; ++r) { p0[r] = fast_exp2(p0[r] - mrun); p1[r] = fast_exp2(p1[r] - mrun); ls += p0[r] + p1[r]; }
            lrun += ls;
            v4u pw0, pw1, pw2, pw3;
            pw0 = (v4u){cvtpk(p0[0], p0[1]), cvtpk(p0[2], p0[3]), cvtpk(p0[4], p0[5]), cvtpk(p0[6], p0[7])};
            pw1 = (v4u){cvtpk(p0[8], p0[9]), cvtpk(p0[10], p0[11]), cvtpk(p0[12], p0[13]), cvtpk(p0[14], p0[15])};
            pw2 = (v4u){cvtpk(p1[0], p1[1]), cvtpk(p1[2], p1[3]), cvtpk(p1[4], p1[5]), cvtpk(p1[6], p1[7])};
            pw3 = (v4u){cvtpk(p1[8], p1[9]), cvtpk(p1[10], p1[11]), cvtpk(p1[12], p1[13]), cvtpk(p1[14], p1[15])};
            const bf16x8 pa[4] = {__builtin_bit_cast(bf16x8, pw0), __builtin_bit_cast(bf16x8, pw1), __builtin_bit_cast(bf16x8, pw2), __builtin_bit_cast(bf16x8, pw3)};
            LAS const unsigned char* Vb = lds + LV0 + (t & 1) * 16384 + vlane;
#pragma unroll
            for (int d = 0; d < 4; ++d)
#pragma unroll
                for (int ks = 0; ks < 4; ++ks) {
                    const s16x4 lo = ret::trld(Vb + d * 4096 + ks * 1024), hh = ret::trld(Vb + d * 4096 + ks * 1024 + 512);
                    o[d] = __builtin_amdgcn_mfma_f32_32x32x16_bf16(pa[ks], ret::cat8(lo, hh), o[d], 0, 0, 0);
                }
        }
    }
#undef DAT_DMA
    {
        const float lt = half_swap_sum(lrun);
        if (hi == 0) wsf[r32] = (comp ? lam : 1.0f) * fast_rcp(lt);
        asm volatile("s_waitcnt lgkmcnt(0)" ::: "memory");
#pragma unroll
        for (int r = 0; r < 16; ++r) { const float fr_ = wsf[crow(r, hi)];
#pragma unroll
            for (int d = 0; d < 4; ++d) o[d][r] *= fr_; }
    }
    WG_BAR();
    LAS float* cb = (LAS float*)(lds + LCB);
    if (comp == 1) {
#pragma unroll
        for (int d = 0; d < 4; ++d)
#pragma unroll
            for (int r = 0; r < 16; ++r) cb[(w4 * 32 + crow(r, hi)) * CSTR + d * 32 + r32] = o[d][r];
    }
    WG_BAR();
    if (comp == 0) {
#pragma unroll
        for (int d = 0; d < 4; ++d)
#pragma unroll
            for (int r = 0; r < 16; ++r) { LAS float* pc = cb + (w4 * 32 + crow(r, hi)) * CSTR + d * 32 + r32; *pc = o[d][r] - *pc; }
    }
    WG_BAR();
    {
        const int row = tid >> 2, part = tid & 3;
        const LAS f32x4* src = (const LAS f32x4*)(cb + row * CSTR + part * 32);
        f32x4 v[8]; float ss = 0.f;
#pragma unroll
        for (int j = 0; j < 8; ++j) { v[j] = src[j]; ss += (v[j][0] * v[j][0] + v[j][1] * v[j][1]) + (v[j][2] * v[j][2] + v[j][3] * v[j][3]); }
        ss += __shfl_xor(ss, 1); ss += __shfl_xor(ss, 2);
        const float rstd = __builtin_amdgcn_rsqf(ss * (1.0f / 128.0f) + EPS);
        bf16* dst = ao + (rowbase + q0 + row) * D + h * 128 + part * 32;
#pragma unroll
        for (int j = 0; j < 4; ++j) {
            v4u w; w.x = pk2(v[2 * j][0] * rstd, v[2 * j][1] * rstd); w.y = pk2(v[2 * j][2] * rstd, v[2 * j][3] * rstd);
            w.z = pk2(v[2 * j + 1][0] * rstd, v[2 * j + 1][1] * rstd); w.w = pk2(v[2 * j + 1][2] * rstd, v[2 * j + 1][3] * rstd);
            *(v4u*)(dst + 8 * j) = w;
        }
    }
    WG_BAR();
}

__device__ __forceinline__ void attn_phase(const bf16* kvq, bf16* ao, LAS unsigned char* lds, const float* lq1, const float* lk1, const float* lq2, const float* lk2, float lambda_init, int vcu, int G) {
    PHASE_IDS();
    const float lam = __expf(wave_sum(lq1[lane] * lk1[lane])) - __expf(wave_sum(lq2[lane] * lk2[lane])) + lambda_init;
    if (G == 256) {
        const int bh = vcu >> 3, s = vcu & 7;
#pragma unroll 1
        for (int i = 0; i < 4; ++i) { const int qb = (i == 0) ? s : (i == 1) ? 15 - s : (i == 2) ? 16 + s : 31 - s; attn_unit(bh >> 3, bh & 7, qb, kvq, ao, lds, lam, wave, lane, tid); }
    } else {
#pragma unroll 1
        for (int u = vcu; u < 1024; u += G) attn_unit(u >> 8, (u >> 5) & 7, u & 31, kvq, ao, lds, lam, wave, lane, tid);
    }
}
}

__device__ __forceinline__ void route_a(const float* xm, const float* rwt, int* tope, float* topw, int* topr, float* tokr, int* cnt, LAS unsigned char* lds, int vcu, int G) {
    PHASE_IDS();
    LAS float* rw = (LAS float*)lds;
    LAS int* sel = (LAS int*)(lds + 32768);
    for (int k = tid; k < NE * D / 4; k += NTHREADS) ((LAS f32x4*)rw)[k] = ((const f32x4*)rwt)[k];
    WG_BAR();
    for (int tb = vcu; tb < M / 64; tb += G) {
        for (int tk = 0; tk < 8; ++tk) {
            const int tl = wave * 8 + tk, row = tb * 64 + tl;
            const f32x4* xr = (const f32x4*)(xm + (size_t)row * D) + lane;
            f32x4 v[4]; float ss = 0.f;
#pragma unroll
            for (int j = 0; j < 4; ++j) { v[j] = xr[64 * j]; ss += (v[j][0] * v[j][0] + v[j][1] * v[j][1]) + (v[j][2] * v[j][2] + v[j][3] * v[j][3]); }
            ss = wave_sum(ss);
            const float r = __builtin_amdgcn_rsqf(ss * (1.0f / 1024.0f) + EPS);
            float lg[NE];
#pragma unroll
            for (int e = 0; e < NE; ++e) {
                float a = 0.f;
#pragma unroll
                for (int j = 0; j < 4; ++j) { const f32x4 w = ((const LAS f32x4*)(rw + e * D))[lane + 64 * j]; a += (v[j][0] * w[0] + v[j][1] * w[1]) + (v[j][2] * w[2] + v[j][3] * w[3]); }
                lg[e] = wave_sum(a) * r;
            }
            int e1 = 0; float v1 = lg[0];
#pragma unroll
            for (int e = 1; e < NE; ++e) if (lg[e] > v1) { v1 = lg[e]; e1 = e; }
            int e2 = -1; float v2 = -3.0e38f;
#pragma unroll
            for (int e = 0; e < NE; ++e) if (e != e1 && lg[e] > v2) { v2 = lg[e]; e2 = e; }
            const float w1 = fast_rcp(1.0f + __expf(v2 - v1)), w2 = 1.0f - w1;
            if (lane == 0) { tope[row * 2] = e1; tope[row * 2 + 1] = e2; topw[row * 2] = w1; topw[row * 2 + 1] = w2; tokr[row] = r; sel[tl * 2] = e1; sel[tl * 2 + 1] = e2; }
        }
        WG_BAR();
        if (tid < NE) {
            int c = 0;
            for (int k = 0; k < 128; ++k) if (sel[k] == tid) { topr[(tb * 64) * 2 + k] = c; ++c; }
            cnt[tb * NE + tid] = c;
        }
        WG_BAR();
    }
}
__device__ __forceinline__ void route_b(const bf16* xb, const int* tope, const float* topw, const int* topr, const float* tokr, const int* cnt, bf16* xg, int* rowinfo, float* rowgate, float* rowr,
                                        LAS unsigned char* lds, LAS int* ldsctl, int vcu, int G) {
    PHASE_IDS();
    LAS int* ct = (LAS int*)lds;
    LAS int* tot = (LAS int*)(lds + 8192);
    for (int k = tid; k < 256 * NE; k += NTHREADS) ct[k] = cnt[k];
    WG_BAR();
    if (tid < NE) { int run = 0; for (int tb = 0; tb < 256; ++tb) { const int c = ct[tb * NE + tid]; ct[tb * NE + tid] = run; run += c; } tot[tid] = run; }
    WG_BAR();
    if (tid == 0) {
        int ts = 0;
        for (int e = 0; e < NE; ++e) { ldsctl[16 + e] = ts; tot[8 + e] = ts * 256; ts += (tot[e] + 255) >> 8; }
        ldsctl[24] = ts; ldsctl[25] = ts;
    }
    WG_BAR();
    for (int tb = vcu; tb < M / 64; tb += G) {
        for (int k = 0; k < 16; ++k) {
            const int idx = wave * 16 + k, tl = idx >> 1, slot = idx & 1, row = tb * 64 + tl;
            const int e = tope[row * 2 + slot];
            const int pos = tot[8 + e] + ct[tb * NE + e] + topr[row * 2 + slot];
            const v4u* src = (const v4u*)(xb + (size_t)row * D) + lane;
            v4u* dst = (v4u*)(xg + (size_t)pos * D) + lane;
            dst[0] = src[0]; dst[64] = src[64];
            if (lane == 0) { rowinfo[pos] = slot * M + row; rowgate[pos] = topw[row * 2 + slot]; rowr[pos] = tokr[row]; }
        }
    }
    for (int e = vcu; e < NE; e += G) {
        const int beg = tot[8 + e] + tot[e], end = tot[8 + e] + (((tot[e] + 255) >> 8) << 8);
        for (int pos = beg + wave; pos < end; pos += NWAVES) {
            v4u* dst = (v4u*)(xg + (size_t)pos * D) + lane;
            dst[0] = (v4u){0u, 0u, 0u, 0u}; dst[64] = (v4u){0u, 0u, 0u, 0u};
            if (lane == 0) { rowinfo[pos] = -1; rowgate[pos] = 0.f; rowr[pos] = 0.f; }
        }
    }
}
__device__ __forceinline__ void final_phase(const float* xm, const bf16* y, const float* fn, float* out, int vcu, int G) {
    PHASE_IDS();
    const int gw = vcu * NWAVES + wave, NGW = G * NWAVES;
    f32x4 gn[4];
#pragma unroll
    for (int j = 0; j < 4; ++j) gn[j] = ((const f32x4*)fn)[lane + 64 * j];
    for (int m = gw; m < M; m += NGW) {
        const f32x4* xr = (const f32x4*)(xm + (size_t)m * D) + lane;
        const u32x2* y0 = (const u32x2*)(y + (size_t)m * D) + lane;
        const u32x2* y1 = (const u32x2*)(y + (size_t)(M + m) * D) + lane;
        f32x4 v[4]; float ss = 0.f;
#pragma unroll
        for (int j = 0; j < 4; ++j) {
            const u32x2 a = y0[64 * j], b2 = y1[64 * j];
            v[j] = xr[64 * j];
            v[j][0] += bflo(a.x) + bflo(b2.x); v[j][1] += bfhi(a.x) + bfhi(b2.x); v[j][2] += bflo(a.y) + bflo(b2.y); v[j][3] += bfhi(a.y) + bfhi(b2.y);
            ss += (v[j][0] * v[j][0] + v[j][1] * v[j][1]) + (v[j][2] * v[j][2] + v[j][3] * v[j][3]);
        }
        ss = wave_sum(ss);
        const float r = __builtin_amdgcn_rsqf(ss * (1.0f / 1024.0f) + EPS);
        f32x4* orow = (f32x4*)(out + (size_t)m * D) + lane;
#pragma unroll
        for (int j = 0; j < 4; ++j) orow[64 * j] = v[j] * r * gn[j];
    }
}
struct Args { Ptrs p; };
static_assert(sizeof(Args) == 22 * 8, "Args has no padding");

__global__ void __launch_bounds__(NTHREADS, 2) yoco_fwd(Args args) {
    extern __shared__ __attribute__((aligned(16))) unsigned char lds_raw[];
    LAS unsigned char* lds = (LAS unsigned char*)lds_raw;
    const Ptrs& P = args.p;
    unsigned char* ws = P.ws;

    const int G = gridDim.x; const int bx = blockIdx.x;
    const int vcu = (G % 8 == 0) ? (bx % 8) * (G / 8) + bx / 8 : bx;
    LAS int* ldsctl = (LAS int*)(lds + LDSCTL_OFF);
    for (int k = threadIdx.x; k < (LDS_BYTES - LDSCTL_OFF) / 4; k += NTHREADS) ldsctl[k] = 0;
    __syncthreads();
    XcdBarrier bar = xcd_barrier_post((unsigned*)(ws + WS_CTL) + CW_BAR, (volatile LAS unsigned*)ldsctl);

    bf16* XB = (bf16*)(ws + WS_XB); float* XM = (float*)(ws + WS_XM); float* SSP = (float*)(ws + WS_SSP);
    bf16* PROJ = (bf16*)(ws + WS_PROJ); bf16* KVQ = (bf16*)(ws + WS_KVQ);

    const float lambda_init = 0.8f - 0.6f * 0.7408182206817179f;

    p0_prologue(P, lds, vcu, G, lambda_init);
    xcd_barrier(bar);

    {
        pg8::Gemm g{XB, (const bf16*)(ws + WS_W_IN), M, RIN, D}; pg8::StaticOrder S; S.init(M, RIN, G, bx);
        pg8::EpiInProj E{PROJ, SSP, (const float*)(ws + WS_RCOS), (const float*)(ws + WS_RSIN)};
        pg8::gemm_phase<pg8::EpiInProj, pg8::StaticOrder, true, true>(lds, g, S, E);
    }
    xcd_barrier(bar);
    ret::scores_phase(PROJ, (bf16*)(ws + WS_S), vcu, G);
    xcd_barrier(bar);
    ret::scan_phase(PROJ, (const bf16*)(ws + WS_S), (bf16*)(ws + WS_ORET), lds, vcu, G);
    xcd_barrier(bar);
    ret::norm_gate_phase((const bf16*)(ws + WS_ORET), PROJ, (bf16*)(ws + WS_RO), vcu, G);
    xcd_barrier(bar);
    {
        pg8::Gemm g{(const bf16*)(ws + WS_RO), (const bf16*)(ws + WS_W_RO), M, D, RVD}; pg8::StaticOrder S; S.init(M, D, G, bx);
        pg8::EpiResid E{P.x, XM, XB, SSP};
        pg8::gemm_phase<pg8::EpiResid, pg8::StaticOrder, true, true>(lds, g, S, E);
    }
    xcd_barrier(bar);
    {
        pg8::Gemm g{XB, (const bf16*)(ws + WS_W_GU), M, 2 * FF, D}; pg8::StaticOrder S; S.init(M, 2 * FF, G, bx);
        pg8::EpiSwiGLU E{(bf16*)(ws + WS_H), FF, SSP, nullptr};
        pg8::gemm_phase<pg8::EpiSwiGLU, pg8::StaticOrder, true, true>(lds, g, S, E);
    }
    xcd_barrier(bar);
    {
        pg8::Gemm g{(const bf16*)(ws + WS_H), (const bf16*)(ws + WS_W_DN), M, D, FF}; pg8::StaticOrder S; S.init(M, D, G, bx);
        pg8::EpiResid E{XM, XM, XB, SSP};
        pg8::gemm_phase<pg8::EpiResid, pg8::StaticOrder, true, true>(lds, g, S, E);
    }
    xcd_barrier(bar);
    {
        pg8::Gemm g{XB, (const bf16*)(ws + WS_W_KVQ), M, KVQ_N, D}; pg8::StaticOrder S; S.init(M, KVQ_N, G, bx);
        pg8::EpiKVQ E{KVQ, SSP, (const float*)(ws + WS_DCOS), (const float*)(ws + WS_DSIN), 0.125f * LOG2E};
        pg8::gemm_phase<pg8::EpiKVQ, pg8::StaticOrder, true, true>(lds, g, S, E);
    }
    xcd_barrier(bar);
    dat::attn_phase(KVQ, (bf16*)(ws + WS_AO), lds, P.lq1, P.lk1, P.lq2, P.lk2, lambda_init, vcu, G);
    xcd_barrier(bar);
    {
        pg8::Gemm g{(const bf16*)(ws + WS_AO), (const bf16*)(ws + WS_W_DO), M, D, D}; pg8::StaticOrder S; S.init(M, D, G, bx);
        pg8::EpiResid E{XM, XM, XB, SSP};
        pg8::gemm_phase<pg8::EpiResid, pg8::StaticOrder, true, true>(lds, g, S, E);
    }
    xcd_barrier(bar);
    route_a(XM, (const float*)(ws + WS_RWT), (int*)(ws + WS_TOPE), (float*)(ws + WS_TOPW), (int*)(ws + WS_TOPR), (float*)(ws + WS_TOKR), (int*)(ws + WS_CNT), lds, vcu, G);
    xcd_barrier(bar);
    route_b(XB, (const int*)(ws + WS_TOPE), (const float*)(ws + WS_TOPW), (const int*)(ws + WS_TOPR), (const float*)(ws + WS_TOKR), (const int*)(ws + WS_CNT), (bf16*)(ws + WS_XG),
            (int*)(ws + WS_ROWINFO), (float*)(ws + WS_ROWGATE), (float*)(ws + WS_ROWR), lds, ldsctl, vcu, G);
    xcd_barrier(bar);
    {
        pg8::MoeOrder S; S.nM = ldsctl[24]; S.nN = 2 * EF / 256; S.nwg = S.nM * S.nN; S.G = G; S.c = bx;
#pragma unroll
        for (int k = 0; k < 9; ++k) S.ts[k] = ldsctl[16 + k];
        pg8::Gemm g{(const bf16*)(ws + WS_XG), (const bf16*)(ws + WS_W_MGU), XG_ROWS, 2 * EF, D};
        pg8::EpiSwiGLU E{(bf16*)(ws + WS_HM), EF, nullptr, (const float*)(ws + WS_ROWR)};
        pg8::gemm_phase<pg8::EpiSwiGLU, pg8::MoeOrder, true, true>(lds, g, S, E);
    }
    xcd_barrier(bar);
    {
        pg8::MoeOrder S; S.nM = ldsctl[24]; S.nN = D / 256; S.nwg = S.nM * S.nN; S.G = G; S.c = bx;
#pragma unroll
        for (int k = 0; k < 9; ++k) S.ts[k] = ldsctl[16 + k];
        pg8::Gemm g{(const bf16*)(ws + WS_HM), (const bf16*)(ws + WS_W_MDN), XG_ROWS, D, EF};
        pg8::EpiMoeDown E{(bf16*)(ws + WS_Y), (const int*)(ws + WS_ROWINFO), (const float*)(ws + WS_ROWGATE)};
        pg8::gemm_phase<pg8::EpiMoeDown, pg8::MoeOrder, true, true>(lds, g, S, E);
    }
    xcd_barrier(bar);
    final_phase(XM, (const bf16*)(ws + WS_Y), P.final_norm, P.out, vcu, G);
}

extern "C" void kernel_launch(void* const* d_in, const int* in_sizes, int n_in, void* d_out, int out_size, void* d_ws, size_t ws_size, hipStream_t stream) {
    static int grid = 0;
    if (grid == 0) {
        if (n_in != 20 || in_sizes[0] != M * D || out_size != M * D || ws_size < WS_END) { fprintf(stderr, "kernel_launch: unexpected shapes (n_in %d, in0 %d, out %d, ws %zu)\n", n_in, n_in > 0 ? in_sizes[0] : -1, out_size, ws_size); grid = -1; return; }
        int dev = 0, cus = 0, per_cu = 0;
        if (hipGetDevice(&dev) != hipSuccess || hipDeviceGetAttribute(&cus, hipDeviceAttributeMultiprocessorCount, dev) != hipSuccess) { grid = -1; return; }
        if (hipFuncSetAttribute((const void*)yoco_fwd, hipFuncAttributeMaxDynamicSharedMemorySize, LDS_BYTES) != hipSuccess) { fprintf(stderr, "kernel_launch: hipFuncSetAttribute failed\n"); grid = -1; return; }
        if (hipOccupancyMaxActiveBlocksPerMultiprocessor(&per_cu, (const void*)yoco_fwd, NTHREADS, LDS_BYTES) != hipSuccess || per_cu < 1) { fprintf(stderr, "kernel_launch: occupancy query reports %d\n", per_cu); }
        (void)hipGetLastError();
        grid = cus;
    }
    if (grid < 0) return;
    (void)hipMemsetAsync((char*)d_ws + WS_CTL, 0, CTL_ZERO_BYTES, stream);
    Args a{};
    const float** pp = (const float**)&a.p;
    for (int i = 0; i < 20; ++i) pp[i] = (const float*)d_in[i];
    a.p.out = (float*)d_out; a.p.ws = (unsigned char*)d_ws;
    hipLaunchKernelGGL(yoco_fwd, dim3(grid), dim3(NTHREADS), LDS_BYTES, stream, a);
}
```

```cpp
#include <hip/hip_runtime.h>
#include <hip/hip_bf16.h>
#include <cstdio>
#include <cstdint>
#include <cmath>
namespace pg8 {
#define PG8_LAS __attribute__((address_space(3)))
typedef unsigned short bf16_t;
typedef short bf16x8 __attribute__((ext_vector_type(8)));
typedef float f32x4 __attribute__((ext_vector_type(4)));
typedef unsigned u32x4 __attribute__((ext_vector_type(4)));
constexpr int BM = 256, BK = 64, HALF = 128, HTB = HALF * BK * 2  , STAGE_BYTES = 8 * HTB, NXCD = 8, WGM = 8;

__host__ __device__ __forceinline__ int lds_byte(int r, int c) { const int st = (r >> 4) * 2 + (c >> 5), rr = r & 15, cc = c & 31, ob = rr * 64 + cc * 2; return st * 1024 + (ob ^ (((ob >> 9) & 1) << 5)); }
__host__ __device__ __forceinline__ void stage_rc(int b, int& R, int& C) { const int st = b / 1024, sb = b % 1024, swz = sb ^ (((sb >> 9) & 1) << 5); R = (st >> 1) * 16 + swz / 64; C = (st & 1) * 32 + (swz % 64) / 2; }
__host__ __device__ __forceinline__ int perm32(int rho) { const int n = rho >> 4, i = rho & 15; return 8 * (i >> 2) + 4 * n + (i & 3); }

struct Unit { int pm, pn, aux; };
struct Gemm { const bf16_t* A; const bf16_t* Bt; int M, N, K; };

struct StaticOrder {
    int nM, nN, nwg, G, c;
    __host__ __device__ void init(int M, int N, int G_, int c_) { nM = M / BM; nN = N / BM; nwg = nM * nN; G = G_; c = c_; }
    __host__ __device__ bool next(int i, Unit& u) const {
        const long L = (long)i * G + c; if (L >= nwg) return false;
        int wgid = (int)L; { const int q = nwg / NXCD, r = nwg % NXCD, xcd = wgid % NXCD, off = wgid / NXCD; wgid = (xcd < r ? xcd * (q + 1) : r * (q + 1) + (xcd - r) * q) + off; }
        const int nig = WGM * nN, gid = wgid / nig, fm = gid * WGM, gsz = (nM - fm) < WGM ? (nM - fm) : WGM;
        u.pm = fm + ((wgid % nig) % gsz); u.pn = (wgid % nig) / gsz; u.aux = u.pn; return true;
    }
    __device__ __forceinline__ void a_ready(const Unit&) const {}
    __device__ __forceinline__ void done(const Unit&) const {}
};

__device__ __forceinline__ unsigned cvt_pk_bf16(float lo, float hi) { unsigned r; asm volatile("v_cvt_pk_bf16_f32 %0, %1, %2" : "=v"(r) : "v"(lo), "v"(hi)); return r; }
typedef float f32x2 __attribute__((ext_vector_type(2)));
typedef int i32x4 __attribute__((ext_vector_type(4)));
typedef int i32x8 __attribute__((ext_vector_type(8)));
__device__ __forceinline__ i32x8 cat8i(bf16x8 a, bf16x8 b) { const i32x4 x = __builtin_bit_cast(i32x4, a), y = __builtin_bit_cast(i32x4, b); return __builtin_shufflevector(x, y, 0, 1, 2, 3, 4, 5, 6, 7); }
template <class Epi, class Sched, bool ALIGN_EPI = false, bool SP2 = false, bool FP8 = false>
__device__ __forceinline__ void gemm_phase(PG8_LAS unsigned char* lds, const Gemm g, const Sched& S, const Epi& E) {
    int tid = threadIdx.x; asm volatile("" : "+v"(tid)); const int wid = __builtin_amdgcn_readfirstlane(tid >> 6), lane = tid & 63, wr = wid >> 2, wc = wid & 3, fr = lane & 15, fq = lane >> 4;
    const int K = g.K, nt = K / BK;
    unsigned voffA[2], voffB[2];
#pragma unroll
    for (int i = 0; i < 2; ++i) { int R, C; stage_rc(tid * 16 + i * 8192, R, C); const int Rb = Epi::PERM ? ((R & ~31) + perm32(R & 31)) : R;
        voffA[i] = (unsigned)(R * K + C) * 2u; voffB[i] = (unsigned)(Rb * K + C) * 2u; }
    const size_t kstep = (size_t)(BK * 2);
    const size_t hstep = (size_t)HALF * K * 2;
    const size_t tstep = 2 * hstep;
    const unsigned ldsw = (unsigned)wid * 1024u;
    const int aoff = lds_byte(wr * 64 + fr, fq * 8), boff = lds_byte(wc * 32 + fr, fq * 8);
#define PG8_SA(b, h) (((b) * 2 + (h)) * HTB)
#define PG8_SB(b, h) ((4 + (b) * 2 + (h)) * HTB)
#define PG8_STAGE(bufoff, gbase, voff) do { _Pragma("unroll") for (int _i = 0; _i < 2; ++_i) \
        __builtin_amdgcn_global_load_lds((const unsigned*)((const char*)(gbase) + (voff)[_i]), (PG8_LAS unsigned*)(lds + (bufoff) + ldsw + _i * 8192), 16, 0, 0); } while (0)
#define PG8_LDA(dst, b, h) do { _Pragma("unroll") for (int m = 0; m < 4; ++m) _Pragma("unroll") for (int k = 0; k < 2; ++k) dst[m][k] = *(const PG8_LAS bf16x8*)(lds + PG8_SA(b, h) + aoff + m * 2048 + k * 1024); } while (0)
#define PG8_LDB(dst, b, h) do { _Pragma("unroll") for (int n = 0; n < 2; ++n) _Pragma("unroll") for (int k = 0; k < 2; ++k) dst[n][k] = *(const PG8_LAS bf16x8*)(lds + PG8_SB(b, h) + boff + n * 2048 + k * 1024); } while (0)
#define PG8_MMA(ai, bj, At, Bt) do { __builtin_amdgcn_s_setprio(1); \
        if constexpr (FP8) { _Pragma("unroll") for (int m = 0; m < 4; ++m) _Pragma("unroll") for (int n = 0; n < 2; ++n) \
            asm volatile("v_mfma_scale_f32_16x16x128_f8f6f4 %0, %1, %2, %0, %3, %3 op_sel_hi:[0,0,0]" : "+v"(acc[ai][bj][m][n]) : "v"(cat8i(Bt[n][0], Bt[n][1])), "v"(cat8i(At[m][0], At[m][1])), "v"(fp8_unit_scale)); } \
        else { _Pragma("unroll") for (int m = 0; m < 4; ++m) _Pragma("unroll") for (int n = 0; n < 2; ++n) _Pragma("unroll") for (int k = 0; k < 2; ++k) \
            acc[ai][bj][m][n] = __builtin_amdgcn_mfma_f32_16x16x32_bf16(Bt[n][k], At[m][k], acc[ai][bj][m][n], 0, 0, 0); } \
        __builtin_amdgcn_s_setprio(0); } while (0)
#define PG8_WAIT_V(n) asm volatile("s_waitcnt vmcnt(" #n ")" ::: "memory")
#define PG8_WAIT_L(n) asm volatile("s_waitcnt lgkmcnt(" #n ")" ::: "memory")
#define PG8_BAR __builtin_amdgcn_s_barrier()
#define PG8_SCHED __builtin_amdgcn_sched_barrier(0)
    const int fp8_unit_scale = 0x7f7f7f7f; (void)fp8_unit_scale;
    Unit cur, nxt; int ui = 0;
    if (!S.next(0, cur)) return;
    f32x4 acc[2][2][4][2];
#pragma unroll
    for (int a = 0; a < 2; ++a)
#pragma unroll
        for (int b = 0; b < 2; ++b)
#pragma unroll
            for (int m = 0; m < 4; ++m)
#pragma unroll
                for (int n = 0; n < 2; ++n) acc[a][b][m][n] = (f32x4){0.f, 0.f, 0.f, 0.f};
    bf16x8 At[4][2], B0[2][2], B1[2][2];
    const char* cA = (const char*)g.A + (size_t)cur.pm * tstep; const char* cB = (const char*)g.Bt + (size_t)cur.pn * tstep;
    S.a_ready(cur);
    if constexpr (SP2) {
        PG8_STAGE(PG8_SB(0, 0), cB, voffB); PG8_STAGE(PG8_SB(0, 1), cB + hstep, voffB); PG8_STAGE(PG8_SA(0, 0), cA, voffA); PG8_STAGE(PG8_SA(0, 1), cA + hstep, voffA);
        if (wr == 1) PG8_BAR;
        PG8_WAIT_V(2); PG8_BAR;
        PG8_STAGE(PG8_SB(1, 0), cB + kstep, voffB); PG8_STAGE(PG8_SA(1, 0), cA + kstep, voffA); PG8_STAGE(PG8_SB(1, 1), cB + hstep + kstep, voffB);
        PG8_WAIT_V(6); PG8_BAR;
    } else {
        PG8_STAGE(PG8_SB(0, 0), cB, voffB); PG8_STAGE(PG8_SA(0, 0), cA, voffA); PG8_STAGE(PG8_SB(0, 1), cB + hstep, voffB); PG8_STAGE(PG8_SA(0, 1), cA + hstep, voffA);
        if (wr == 1) PG8_BAR;
        PG8_WAIT_V(4); PG8_BAR;
        PG8_STAGE(PG8_SB(1, 0), cB + kstep, voffB); PG8_STAGE(PG8_SA(1, 0), cA + kstep, voffA); PG8_STAGE(PG8_SB(1, 1), cB + hstep + kstep, voffB);
        PG8_WAIT_V(6); PG8_BAR;
    }
    for (;;) {
        const bool has_next = S.next(ui + 1, nxt);
        const char* nA = has_next ? (const char*)g.A + (size_t)nxt.pm * tstep : cA; const char* nB = has_next ? (const char*)g.Bt + (size_t)nxt.pn * tstep : cB;
        for (int t = 0; t < nt; t += 2) {
            const bool last = (t == nt - 2);
            const char* a1 = cA + (size_t)(t + 1) * kstep;
            const char* a2 = last ? nA : cA + (size_t)(t + 2) * kstep; const char* b2 = last ? nB : cB + (size_t)(t + 2) * kstep;
            const char* a3 = a2 + kstep; const char* b3 = b2 + kstep;
            if (last && has_next) S.a_ready(nxt);
            if constexpr (SP2) {
            PG8_LDB(B0, 0, 0); PG8_LDB(B1, 0, 1); PG8_SCHED; PG8_LDA(At, 0, 0); PG8_STAGE(PG8_SA(1, 1), a1 + hstep, voffA);
            PG8_WAIT_V(8); PG8_WAIT_L(0); PG8_BAR; PG8_MMA(0, 0, At, B0); PG8_MMA(0, 1, At, B1); PG8_BAR; PG8_SCHED;
            PG8_LDA(At, 0, 1); PG8_STAGE(PG8_SB(0, 0), b2, voffB); PG8_STAGE(PG8_SB(0, 1), b2 + hstep, voffB); PG8_STAGE(PG8_SA(0, 0), a2, voffA);
            PG8_WAIT_V(8); PG8_WAIT_L(0); PG8_BAR; PG8_MMA(1, 0, At, B0); PG8_MMA(1, 1, At, B1); PG8_BAR; PG8_SCHED;
            PG8_LDB(B0, 1, 0); PG8_LDB(B1, 1, 1); PG8_SCHED; PG8_LDA(At, 1, 0); PG8_STAGE(PG8_SA(0, 1), a2 + hstep, voffA);
            PG8_WAIT_V(8); PG8_WAIT_L(0); PG8_BAR; PG8_MMA(0, 0, At, B0); PG8_MMA(0, 1, At, B1); PG8_BAR; PG8_SCHED;
            PG8_LDA(At, 1, 1); PG8_STAGE(PG8_SB(1, 0), b3, voffB); PG8_STAGE(PG8_SB(1, 1), b3 + hstep, voffB); PG8_STAGE(PG8_SA(1, 0), a3, voffA);
            PG8_WAIT_V(8); PG8_WAIT_L(0); PG8_BAR; PG8_MMA(1, 0, At, B0); PG8_MMA(1, 1, At, B1); PG8_BAR; PG8_SCHED;
            } else {
            PG8_LDB(B0, 0, 0); PG8_SCHED; PG8_LDA(At, 0, 0); PG8_STAGE(PG8_SA(1, 1), a1 + hstep, voffA);
            PG8_WAIT_L(8); PG8_BAR; PG8_WAIT_L(0); PG8_MMA(0, 0, At, B0); PG8_BAR; PG8_SCHED;
            PG8_LDB(B1, 0, 1); PG8_STAGE(PG8_SB(0, 0), b2, voffB);
            PG8_BAR; PG8_WAIT_L(0); PG8_MMA(0, 1, At, B1); PG8_BAR;
            PG8_LDA(At, 0, 1); PG8_STAGE(PG8_SA(0, 0), a2, voffA);
            PG8_BAR; PG8_WAIT_L(0); PG8_MMA(1, 0, At, B0); PG8_BAR; PG8_SCHED;
            PG8_STAGE(PG8_SB(0, 1), b2 + hstep, voffB);
            PG8_WAIT_V(6); PG8_BAR; PG8_MMA(1, 1, At, B1); PG8_BAR;
            PG8_LDB(B0, 1, 0); PG8_SCHED; PG8_LDA(At, 1, 0); PG8_STAGE(PG8_SA(0, 1), a2 + hstep, voffA);
            PG8_WAIT_L(8); PG8_BAR; PG8_WAIT_L(0); PG8_MMA(0, 0, At, B0); PG8_BAR; PG8_SCHED;
            PG8_LDB(B1, 1, 1); PG8_STAGE(PG8_SB(1, 0), b3, voffB);
            PG8_BAR; PG8_WAIT_L(0); PG8_MMA(0, 1, At, B1); PG8_BAR;
            PG8_LDA(At, 1, 1); PG8_STAGE(PG8_SA(1, 0), a3, voffA);
            PG8_BAR; PG8_WAIT_L(0); PG8_MMA(1, 0, At, B0); PG8_BAR; PG8_SCHED;
            PG8_STAGE(PG8_SB(1, 1), b3 + hstep, voffB);
            PG8_WAIT_V(6); PG8_BAR; PG8_MMA(1, 1, At, B1); PG8_BAR;
            }
        }
        if constexpr (ALIGN_EPI) { if (wr == 0) PG8_BAR; }
        if constexpr (FP8) asm volatile("s_nop 15\n\ts_nop 15" ::: "memory");
        if constexpr (!Epi::AFTER_DRAIN) { E(acc, cur, wr, wc, fr, fq); S.done(cur); }
        if (!has_next) break;
#pragma unroll
        for (int a = 0; a < 2; ++a)
#pragma unroll
            for (int b = 0; b < 2; ++b)
#pragma unroll
                for (int m = 0; m < 4; ++m)
#pragma unroll
                    for (int n = 0; n < 2; ++n) acc[a][b][m][n] = (f32x4){0.f, 0.f, 0.f, 0.f};
        cur = nxt; cA = nA; cB = nB; ++ui;
        if constexpr (ALIGN_EPI) { if (wr == 1) PG8_BAR; }
    }
    PG8_WAIT_V(0);
    if constexpr (!ALIGN_EPI) { if (wr == 0) PG8_BAR; }
    PG8_BAR;
    if constexpr (Epi::AFTER_DRAIN) { E.fused(acc, cur, wr, wc, fr, fq, lds, wid, lane); S.done(cur); }
#undef PG8_SA
#undef PG8_SB
#undef PG8_STAGE
#undef PG8_LDA
#undef PG8_LDB
#undef PG8_MMA
#undef PG8_WAIT_V
#undef PG8_WAIT_L
#undef PG8_BAR
#undef PG8_SCHED
}
}
#define GAS __attribute__((address_space(1)))
#define LAS __attribute__((address_space(3)))
typedef unsigned short bf16;
typedef unsigned v4u __attribute__((ext_vector_type(4)));
typedef float f32x4 __attribute__((ext_vector_type(4)));
typedef short bf16x8 __attribute__((ext_vector_type(8)));
typedef GAS unsigned gu32;
typedef GAS unsigned long long gu64;
#define RLX_AGENT __ATOMIC_RELAXED, __HIP_MEMORY_SCOPE_AGENT
#define LDS_WAIT() asm volatile("s_waitcnt lgkmcnt(0)" ::: "memory")
#define VM_WAIT() asm volatile("s_waitcnt vmcnt(0)" ::: "memory")
__device__ __forceinline__ unsigned long long rt() { return __builtin_amdgcn_s_memrealtime(); }
__device__ __forceinline__ unsigned f2bf(float f) { unsigned u = __builtin_bit_cast(unsigned, f); return (u + 0x7fffu + ((u >> 16) & 1u)) >> 16; }
__device__ __forceinline__ unsigned pk2(float lo, float hi) { unsigned r; asm("v_cvt_pk_bf16_f32 %0, %1, %2" : "=v"(r) : "v"(lo), "v"(hi)); return r; }

#define XB_TMO      128
#define XB_XCNT(j)  (256  + 64 * (j))
#define XB_XSUB(j)  (1280 + 64 * (j))
#define XB_XGEN(j)  (2304 + 64 * (j))
#define XB_TOP      3328
#define XB_TOPGEN   3392
#define XCD_BAR_WORDS 3456
#define XB_SPIN_CAP (1u << 18)

__device__ __forceinline__ unsigned xb_ld(unsigned* p)              { return __hip_atomic_load(p, __ATOMIC_RELAXED, __HIP_MEMORY_SCOPE_AGENT); }
__device__ __forceinline__ unsigned xb_add(unsigned* p, unsigned v) { return __hip_atomic_fetch_add(p, v, __ATOMIC_RELAXED, __HIP_MEMORY_SCOPE_AGENT); }
__device__ __forceinline__ unsigned xb_xcc_id() { return (unsigned)__builtin_amdgcn_s_getreg((3 << 11) | 20) & 0xFu; }
#define XB_SPIN(cond, bar) do { unsigned _sp = 0; while (cond) { __builtin_amdgcn_s_sleep(1); \
    if ((++_sp & 255u) == 0u) { if (xb_ld(&(bar)[XB_TMO])) break; if (_sp > XB_SPIN_CAP) { atomicAdd(&(bar)[XB_TMO], 1u); break; } } } } while (0)

struct XcdBarrier {
    unsigned* bar; unsigned x;
    volatile LAS unsigned* st;
};

__device__ __forceinline__ XcdBarrier xcd_barrier_post(unsigned* bar, volatile LAS unsigned* st) {
    XcdBarrier b; b.bar = bar; b.x = xb_xcc_id(); b.st = st;
    if (threadIdx.x == 0) (void)xb_add(&bar[XB_XCNT(b.x)], 1u);
    return b;
}
__device__ __forceinline__ void xcd_barrier_complete(unsigned* bar, unsigned x, unsigned& nloc, unsigned& nx) {
    const unsigned G = gridDim.x * gridDim.y * gridDim.z;
    unsigned sum, cnt, mine, sp = 0u;
    for (;;) {
        sum = 0u; cnt = 0u; mine = 0u;
#pragma unroll
        for (unsigned j = 0; j < 16; ++j) { const unsigned c = xb_ld(&bar[XB_XCNT(j)]); sum += c; cnt += (c > 0u) ? 1u : 0u; mine = (j == x) ? c : mine; }
        if (sum == G) break;
        __builtin_amdgcn_s_sleep(1);
        if ((++sp & 255u) == 0u) { if (xb_ld(&bar[XB_TMO])) break; if (sp > XB_SPIN_CAP) { atomicAdd(&bar[XB_TMO], 1u); break; } }
    }
    nloc = mine > 0u ? mine : 1u; nx = cnt > 0u ? cnt : 1u;
}

__device__ __forceinline__ void xcd_barrier(const XcdBarrier& b) {
    asm volatile("s_waitcnt vmcnt(0)" ::: "memory");
    __syncthreads();
    if (threadIdx.x == 0) {
        unsigned* bar = b.bar;
        __builtin_amdgcn_s_waitcnt(0);
        unsigned nloc = b.st[0], nx = b.st[1];
        if (nloc == 0u) { xcd_barrier_complete(bar, b.x, nloc, nx); b.st[0] = nloc; b.st[1] = nx; }
        const unsigned old = xb_add(&bar[XB_XSUB(b.x)], 1u);
        const unsigned gen = old / nloc;
        if (old + 1u == (gen + 1u) * nloc) {
            __builtin_amdgcn_fence(__ATOMIC_RELEASE, "agent");
            asm volatile("s_waitcnt vmcnt(0)" ::: "memory");
            const unsigned og = xb_add(&bar[XB_TOP], 1u);
            const unsigned tg = og / nx;
            if (og + 1u == (tg + 1u) * nx) xb_add(&bar[XB_TOPGEN], 1u);
            else XB_SPIN(xb_ld(&bar[XB_TOPGEN]) == tg, bar);
            __builtin_amdgcn_fence(__ATOMIC_ACQUIRE, "agent");
            xb_add(&bar[XB_XGEN(b.x)], 1u);
            asm volatile("s_waitcnt vmcnt(0)" ::: "memory");
        } else {
            XB_SPIN(xb_ld(&bar[XB_XGEN(b.x)]) == gen, bar);
            __builtin_amdgcn_fence(__ATOMIC_ACQUIRE, "agent");
            asm volatile("s_waitcnt vmcnt(0)" ::: "memory");
        }
    }
    __syncthreads();
}

constexpr int BATCH = 4, SEQ = 4096, D = 1024, M = BATCH * SEQ;
constexpr int RIN = 6144, RVD = 2048;
constexpr int FF = 2816, EF = 3584, NE = 8;
constexpr int KVQ_N = 3072;
constexpr float EPS = 1e-6f;
constexpr float LOG2E = 1.4426950408889634f;

typedef short s16x4 __attribute__((ext_vector_type(4)));
typedef float f32x16 __attribute__((ext_vector_type(16)));
typedef unsigned u32x2 __attribute__((ext_vector_type(2)));

__device__ __forceinline__ float bf2f(unsigned short h) { return __uint_as_float(((unsigned)h) << 16); }
__device__ __forceinline__ float bflo(unsigned w) { return __uint_as_float(w << 16); }
__device__ __forceinline__ float bfhi(unsigned w) { return __uint_as_float(w & 0xffff0000u); }
__device__ __forceinline__ float fast_exp2(float x) { return __builtin_amdgcn_exp2f(x); }
__device__ __forceinline__ float fast_rcp(float x) { return __builtin_amdgcn_rcpf(x); }
__device__ __forceinline__ float silu_f(float x) { return x * fast_rcp(1.0f + fast_exp2(-x * LOG2E)); }
#define SWZ_XOR(v, m) __int_as_float(__builtin_amdgcn_ds_swizzle(__float_as_int(v), ((m) << 10) | 0x1f))
__device__ __forceinline__ float xor32_sum(float v) { auto rr = __builtin_amdgcn_permlane32_swap(__float_as_uint(v), __float_as_uint(v), false, false); return __uint_as_float(rr[0]) + __uint_as_float(rr[1]); }
__device__ __forceinline__ float wave_sum(float v) {
    v += SWZ_XOR(v, 1); v += SWZ_XOR(v, 2); v += SWZ_XOR(v, 4); v += SWZ_XOR(v, 8); v += SWZ_XOR(v, 16);
    return xor32_sum(v);
}

namespace pg8 {
__device__ __forceinline__ float rinv_from_ssp(const float* ssp, int row) {
    const f32x4* p = (const f32x4*)(ssp + (size_t)row * 16);
    const f32x4 a = p[0], b = p[1], c = p[2], d = p[3];
    const float s = (((a[0] + a[1]) + (a[2] + a[3])) + ((b[0] + b[1]) + (b[2] + b[3]))) + (((c[0] + c[1]) + (c[2] + c[3])) + ((d[0] + d[1]) + (d[2] + d[3])));
    return __builtin_amdgcn_rsqf(s * (1.0f / 1024.0f) + EPS);
}
__device__ __forceinline__ u32x4 pack8(const f32x4 a, const f32x4 b) {
    u32x4 w; w.x = cvt_pk_bf16(a[0], a[1]); w.y = cvt_pk_bf16(a[2], a[3]); w.z = cvt_pk_bf16(b[0], b[1]); w.w = cvt_pk_bf16(b[2], b[3]); return w;
}
struct EpiInProj {
    static constexpr bool PERM = true, AFTER_DRAIN = false;
    bf16_t* O; const float* ssp; const float* rcos; const float* rsin;
    __device__ __forceinline__ void operator()(const f32x4 (&acc)[2][2][4][2], const Unit& u, int wr, int wc, int fr, int fq) const {
        const int row0 = u.pm * BM + wr * 64 + fr;
        const int cl = wc * 32 + 8 * fq;
        const bool rope = u.pn < 8;
        const float ksc = (u.pn >= 4 && u.pn < 8) ? 0.0625f : 1.0f;
#pragma unroll
        for (int ai = 0; ai < 2; ++ai)
#pragma unroll
            for (int m = 0; m < 4; ++m) {
                const int row = row0 + ai * HALF + m * 16;
                const float r = rinv_from_ssp(ssp, row) * ksc;
                bf16_t* rowp = O + (size_t)row * RIN + u.pn * BM + cl;
                f32x4 a0 = acc[ai][0][m][0] * r, a1 = acc[ai][0][m][1] * r, b0 = acc[ai][1][m][0] * r, b1 = acc[ai][1][m][1] * r;
                if (rope) {
                    const int pos = row & (SEQ - 1);
                    const f32x4 c0 = *(const f32x4*)(rcos + pos * 128 + cl), c1 = *(const f32x4*)(rcos + pos * 128 + cl + 4);
                    const f32x4 s0 = *(const f32x4*)(rsin + pos * 128 + cl), s1 = *(const f32x4*)(rsin + pos * 128 + cl + 4);
                    const f32x4 x0 = a0 * c0 - b0 * s0, x1 = a1 * c1 - b1 * s1, y0 = b0 * c0 + a0 * s0, y1 = b1 * c1 + a1 * s1;
                    a0 = x0; a1 = x1; b0 = y0; b1 = y1;
                }
                *(u32x4*)(rowp) = pack8(a0, a1);
                *(u32x4*)(rowp + HALF) = pack8(b0, b1);
                if (m & 1) asm volatile("" ::: "memory");
            }
    }
};
template <bool FP8OUT> struct EpiSwiGLU {
    static constexpr bool PERM = true, AFTER_DRAIN = false;
    unsigned char* O; int ldb  ; const float* ssp; float cscale, oscale;
    __device__ __forceinline__ void operator()(const f32x4 (&acc)[2][2][4][2], const Unit& u, int wr, int wc, int fr, int fq) const {
        const int row0 = u.pm * BM + wr * 64 + fr;
        const int col = u.aux * HALF + wc * 32 + 8 * fq;
#pragma unroll
        for (int ai = 0; ai < 2; ++ai)
#pragma unroll
            for (int m = 0; m < 4; ++m) {
                const int row = row0 + ai * HALF + m * 16;
                const float r = ssp ? rinv_from_ssp(ssp, row) * cscale : cscale;
                const float k1 = -r * LOG2E, qv = fast_rcp(r * r * oscale), c0 = __builtin_amdgcn_logf(qv);
                f32x4 h0, h1;
#pragma unroll
                for (int j = 0; j < 4; ++j) {
                    h0[j] = (acc[ai][0][m][0][j] * acc[ai][1][m][0][j]) * fast_rcp(qv + fast_exp2(__builtin_fmaf(acc[ai][0][m][0][j], k1, c0)));
                    h1[j] = (acc[ai][0][m][1][j] * acc[ai][1][m][1][j]) * fast_rcp(qv + fast_exp2(__builtin_fmaf(acc[ai][0][m][1][j], k1, c0)));
                }
                if constexpr (FP8OUT) {
                    unsigned w0, w1; asm volatile("" : "=v"(w0), "=v"(w1));
                    w0 = __builtin_amdgcn_cvt_pk_fp8_f32(h0[0], h0[1], w0, false); w0 = __builtin_amdgcn_cvt_pk_fp8_f32(h0[2], h0[3], w0, true);
                    w1 = __builtin_amdgcn_cvt_pk_fp8_f32(h1[0], h1[1], w1, false); w1 = __builtin_amdgcn_cvt_pk_fp8_f32(h1[2], h1[3], w1, true);
                    *(u32x2*)(O + (size_t)row * ldb + col) = (u32x2){w0, w1};
                } else {
                    *(u32x4*)(O + (size_t)row * ldb + col * 2) = pack8(h0, h1);
                }
                if (m & 1) asm volatile("" ::: "memory");
            }
    }
};
template <bool BASE_F32>
struct EpiResid {
    static constexpr bool PERM = true, AFTER_DRAIN = false;
    const void* base; bf16_t* xb; float* ssp;
    __device__ __forceinline__ void operator()(const f32x4 (&acc)[2][2][4][2], const Unit& u, int wr, int wc, int fr, int fq) const {
        const int row0 = u.pm * BM + wr * 64 + fr;
        const int col0 = u.pn * BM + wc * 32 + 8 * fq;
#pragma unroll
        for (int ai = 0; ai < 2; ++ai)
#pragma unroll
            for (int m = 0; m < 4; ++m) {
                const int row = row0 + ai * HALF + m * 16;
                const size_t off = (size_t)row * D + col0;
                float ss = 0.f;
#pragma unroll
                for (int bj = 0; bj < 2; ++bj) {
                    const size_t c = off + bj * HALF;
                    f32x4 v0, v1;
                    if constexpr (BASE_F32) { v0 = *(const f32x4*)((const float*)base + c); v1 = *(const f32x4*)((const float*)base + c + 4); }
                    else { const u32x4 b = *(const u32x4*)((const bf16_t*)base + c); v0 = (f32x4){bflo(b.x), bfhi(b.x), bflo(b.y), bfhi(b.y)}; v1 = (f32x4){bflo(b.z), bfhi(b.z), bflo(b.w), bfhi(b.w)}; }
                    v0 += acc[ai][bj][m][0]; v1 += acc[ai][bj][m][1];
                    *(u32x4*)(xb + c) = pack8(v0, v1);
                    ss += ((v0[0] * v0[0] + v0[1] * v0[1]) + (v0[2] * v0[2] + v0[3] * v0[3])) + ((v1[0] * v1[0] + v1[1] * v1[1]) + (v1[2] * v1[2] + v1[3] * v1[3]));
                }
                ss += SWZ_XOR(ss, 16); ss = xor32_sum(ss);
                if (fq == 0) ssp[(size_t)row * 16 + u.pn * 4 + wc] = ss;
                asm volatile("" ::: "memory");
            }
    }
};
struct EpiKVQ {
    static constexpr bool PERM = true, AFTER_DRAIN = false;
    bf16_t* O; const float* ssp; const float* dcos; const float* dsin; float qscale;
    __device__ __forceinline__ void operator()(const f32x4 (&acc)[2][2][4][2], const Unit& u, int wr, int wc, int fr, int fq) const {
        const int row0 = u.pm * BM + wr * 64 + fr;
        const int cl = wc * 32 + 8 * fq;
        const int kind = u.pn >> 2;
        const bool ropelane = ((wc & 1) == 0) && (fq < 2);
#pragma unroll
        for (int ai = 0; ai < 2; ++ai)
#pragma unroll
            for (int m = 0; m < 4; ++m) {
                const int row = row0 + ai * HALF + m * 16;
                const float r = rinv_from_ssp(ssp, row) * (kind == 2 ? qscale : 1.0f);
                bf16_t* rowp = O + (size_t)row * KVQ_N + u.pn * BM + cl;
                f32x4 c0, c1, s0, s1;
                if (kind != 1) {
                    const int pos = row & (SEQ - 1);
                    c0 = *(const f32x4*)(dcos + pos * 8); c1 = *(const f32x4*)(dcos + pos * 8 + 4);
                    s0 = *(const f32x4*)(dsin + pos * 8); s1 = *(const f32x4*)(dsin + pos * 8 + 4);
                    if (fq != 0) { s0 = -s0; s1 = -s1; }
                }
#pragma unroll
                for (int bj = 0; bj < 2; ++bj) {
                    f32x4 v0 = acc[ai][bj][m][0] * r, v1 = acc[ai][bj][m][1] * r;
                    if (kind != 1) {
                        f32x4 p0, p1;
#pragma unroll
                        for (int j = 0; j < 4; ++j) { p0[j] = SWZ_XOR(v0[j], 16); p1[j] = SWZ_XOR(v1[j], 16); }
                        if (ropelane) { v0 = v0 * c0 - p0 * s0; v1 = v1 * c1 - p1 * s1; }
                    }
                    *(u32x4*)(rowp + bj * HALF) = pack8(v0, v1);
                }
                if (m & 1) asm volatile("" ::: "memory");
            }
    }
};
struct EpiMoeDown {
    static constexpr bool PERM = true, AFTER_DRAIN = false;
    bf16_t* Y; const int* rowinfo; const float* rowgate; float cscale;
    __device__ __forceinline__ void operator()(const f32x4 (&acc)[2][2][4][2], const Unit& u, int wr, int wc, int fr, int fq) const {
        const int row0 = u.pm * BM + wr * 64 + fr;
        const int cl = u.aux * BM + wc * 32 + 8 * fq;
#pragma unroll
        for (int ai = 0; ai < 2; ++ai)
#pragma unroll
            for (int m = 0; m < 4; ++m) {
                const int row = row0 + ai * HALF + m * 16;
                const int info = rowinfo[row];
                if (info >= 0) {
                    const float g = rowgate[row] * cscale;
                    bf16_t* rowp = Y + (size_t)info * D + cl;
                    *(u32x4*)(rowp) = pack8(acc[ai][0][m][0] * g, acc[ai][0][m][1] * g);
                    *(u32x4*)(rowp + HALF) = pack8(acc[ai][1][m][0] * g, acc[ai][1][m][1] * g);
                }
            }
    }
};
struct MoeOrder {
    int nM, nN, nwg, G, c; int ts[9];
    __device__ __forceinline__ bool next(int i, Unit& u) const {
        const long L = (long)i * G + c; if (L >= nwg) return false;
        int wgid = (int)L; { const int q = nwg / NXCD, r = nwg % NXCD, xcd = wgid % NXCD, off = wgid / NXCD; wgid = (xcd < r ? xcd * (q + 1) : r * (q + 1) + (xcd - r) * q) + off; }
        const int nig = WGM * nN, gid = wgid / nig, fm = gid * WGM, gsz = (nM - fm) < WGM ? (nM - fm) : WGM;
        const int pm = fm + ((wgid % nig) % gsz), pnl = (wgid % nig) / gsz;
        int e = 0;
#pragma unroll
        for (int k = 1; k < 8; ++k) e += (pm >= ts[k]) ? 1 : 0;
        u.pm = pm; u.pn = e * nN + pnl; u.aux = pnl; return true;
    }
    __device__ __forceinline__ void a_ready(const Unit&) const {}
    __device__ __forceinline__ void done(const Unit&) const {}
};
}
constexpr size_t MiB = 1u << 20;
constexpr size_t WS_CTL = 0, CTL_ZERO_BYTES = 1 * MiB;
constexpr size_t WS_RCOS = 1 * MiB, WS_RSIN = 3 * MiB;
constexpr size_t WS_DCOS = 5 * MiB, WS_DSIN = 5 * MiB + 256 * 1024;
constexpr size_t WS_SSP = 6 * MiB;
constexpr size_t WS_RWT = 7 * MiB;
constexpr size_t WS_TOPE = 8 * MiB;
constexpr size_t WS_TOPW = 8 * MiB + 128 * 1024;
constexpr size_t WS_TOPR = 8 * MiB + 256 * 1024;
constexpr size_t WS_TOKR = 8 * MiB + 384 * 1024;
constexpr size_t WS_CNT = 8 * MiB + 512 * 1024;
constexpr int XG_ROWS = 2 * M + NE * 256;
constexpr size_t WS_ROWINFO = 9 * MiB;
constexpr size_t WS_ROWGATE = 9 * MiB + 256 * 1024;
constexpr size_t WS_ROWR = 9 * MiB + 512 * 1024;
constexpr size_t WS_S = 10 * MiB;
constexpr size_t WS_W_IN = 20 * MiB, WS_W_RO = 32 * MiB, WS_W_GU = 36 * MiB, WS_W_DN = 47 * MiB, WS_W_KVQ = 53 * MiB, WS_W_DO = 59 * MiB, WS_W_MGU = 61 * MiB, WS_W_MDN = 173 * MiB;
constexpr size_t WS_XM = 232 * MiB;
constexpr size_t WS_XB = 296 * MiB;
constexpr size_t WS_PROJ = 328 * MiB;
constexpr size_t WS_RO = 520 * MiB;
constexpr size_t WS_ORET = 584 * MiB;
constexpr size_t WS_H = 328 * MiB;
constexpr size_t WS_KVQ = 584 * MiB;
constexpr size_t WS_AO = 680 * MiB;
constexpr size_t WS_Y = 712 * MiB;
constexpr size_t WS_HM = 328 * MiB;
constexpr size_t WS_XG = 584 * MiB;
constexpr size_t WS_XN8 = 776 * MiB;
constexpr size_t WS_END = 792 * MiB;
static_assert(WS_W_MDN + (size_t)NE * D * EF * 2 <= WS_XM && WS_HM + (size_t)XG_ROWS * EF * 2 <= WS_KVQ && WS_XG + (size_t)XG_ROWS * D * 2 <= WS_AO && WS_Y + (size_t)2 * M * D * 2 <= WS_END, "d_ws map");
constexpr float MOE_WGU_SCALE = 64.0f, MOE_WDN_SCALE = 128.0f, MOE_H_SCALE = 8.0f;
constexpr int CW_BAR = 4096;

constexpr int RING_BYTES = 131072;
constexpr int LDSCTL_OFF = RING_BYTES;
constexpr int LDS_BYTES = 147456;
constexpr int NWAVES = 8, NTHREADS = 512;

#define WG_BAR() do { asm volatile("s_waitcnt vmcnt(0) lgkmcnt(0)" ::: "memory"); __builtin_amdgcn_s_barrier(); asm volatile("" ::: "memory"); } while (0)

#define PHASE_IDS() int tid = threadIdx.x; asm volatile("" : "+v"(tid)); const int lane = tid & 63; const int wave = __builtin_amdgcn_readfirstlane(tid >> 6); (void)lane; (void)wave
struct TrBlk { const float* src; const float* gain; unsigned char* dst; int N, gmask, k0, ldb, fp8; float gscale; };
constexpr int TR_PITCH = 288;
__device__ __forceinline__ void tr_load(const TrBlk& B, f32x4 (&ld)[8], float (&gv)[8], int wave, int lane) {
#pragma unroll
    for (int j = 0; j < 8; ++j) {
        const int k = 16 * wave + 2 * j + (lane >> 5);
        ld[j] = *(const f32x4*)(B.src + (size_t)k * B.N + 4 * (lane & 31));
        gv[j] = B.gain ? B.gain[(B.k0 + k) & B.gmask] * B.gscale : B.gscale;
    }
}
__device__ __forceinline__ void tr_commit(const f32x4 (&ld)[8], const float (&gv)[8], LAS unsigned char* img, int wave, int lane) {
#pragma unroll
    for (int j = 0; j < 8; ++j) {
        const int k = 16 * wave + 2 * j + (lane >> 5);
        u32x2 w; w.x = pk2(ld[j][0] * gv[j], ld[j][1] * gv[j]); w.y = pk2(ld[j][2] * gv[j], ld[j][3] * gv[j]);
        *(LAS u32x2*)(img + k * TR_PITCH + 8 * (lane & 31)) = w;
    }
}
__device__ __forceinline__ void tr_emit(const TrBlk& B, LAS const unsigned char* img, int wave, int lane) {
    const int i = lane & 15, g = lane >> 4, q = i >> 2, p = i & 3;
#pragma unroll
    for (int kg = 0; kg < 4; ++kg) {
        const int kb = 8 * (4 * kg + g);
        const s16x4 lo = __builtin_bit_cast(s16x4, __builtin_amdgcn_ds_read_tr16_b64_v4i16((LAS s16x4*)(img + (kb + q) * TR_PITCH + (16 * wave + 4 * p) * 2)));
        const s16x4 hi = __builtin_bit_cast(s16x4, __builtin_amdgcn_ds_read_tr16_b64_v4i16((LAS s16x4*)(img + (kb + 4 + q) * TR_PITCH + (16 * wave + 4 * p) * 2)));
        if (!B.fp8) {
            v4u o; o.x = (unsigned)(unsigned short)lo[0] | ((unsigned)(unsigned short)lo[1] << 16); o.y = (unsigned)(unsigned short)lo[2] | ((unsigned)(unsigned short)lo[3] << 16);
            o.z = (unsigned)(unsigned short)hi[0] | ((unsigned)(unsigned short)hi[1] << 16); o.w = (unsigned)(unsigned short)hi[2] | ((unsigned)(unsigned short)hi[3] << 16);
            *(GAS v4u*)(B.dst + (size_t)(16 * wave + i) * B.ldb + kb * 2) = o;
        } else {
            unsigned w0 = 0u, w1 = 0u;
            w0 = __builtin_amdgcn_cvt_pk_fp8_f32(bf2f((unsigned short)lo[0]), bf2f((unsigned short)lo[1]), w0, false);
            w0 = __builtin_amdgcn_cvt_pk_fp8_f32(bf2f((unsigned short)lo[2]), bf2f((unsigned short)lo[3]), w0, true);
            w1 = __builtin_amdgcn_cvt_pk_fp8_f32(bf2f((unsigned short)hi[0]), bf2f((unsigned short)hi[1]), w1, false);
            w1 = __builtin_amdgcn_cvt_pk_fp8_f32(bf2f((unsigned short)hi[2]), bf2f((unsigned short)hi[3]), w1, true);
            *(GAS u32x2*)(B.dst + (size_t)(16 * wave + i) * B.ldb + kb) = (u32x2){w0, w1};
        }
    }
}

struct Ptrs {
    const float *x, *ln_mix, *ln_ffn, *ret_w_in, *ret_w_o, *kv_norm, *w_kv, *diff_w_q, *lq1, *lk1, *lq2, *lk2, *subln, *diff_w_o, *ffn_w_gu, *ffn_w_down, *router, *moe_w_gu, *moe_w_down, *final_norm;
    float* out; unsigned char* ws;
};

__device__ __forceinline__ void p0_prologue(const Ptrs& P, LAS unsigned char* lds, int vcu, int G, float lambda_init) {
    PHASE_IDS();
    unsigned char* ws = P.ws;
    const int gw = vcu * NWAVES + wave, NGW = G * NWAVES;
    {
        constexpr int B_IN = (D / 128) * (RIN / 128), B_RO = (RVD / 128) * (D / 128), B_GU = (D / 128) * (2 * FF / 128), B_DN = (FF / 128) * (D / 128), B_KV = (D / 128) * (2048 / 128), B_Q = (D / 128) * (D / 128), B_DO = B_Q;
        constexpr int NBLK = B_IN + B_RO + B_GU + B_DN + B_KV + B_Q + B_DO;
        auto decode = [&](int it) -> TrBlk {
            const float* W; const float* gain = nullptr; int K, N, gmask = 0, F = 0, row_off = 0, fp8 = 0; float gscale = 1.f; unsigned char* WT; int r = it;
            if (r < B_IN) { W = P.ret_w_in; K = D; N = RIN; gain = P.ln_mix; gmask = 1023; WT = ws + WS_W_IN; }
            else if ((r -= B_IN) < B_RO) { W = P.ret_w_o; K = RVD; N = D; WT = ws + WS_W_RO; }
            else if ((r -= B_RO) < B_GU) { W = P.ffn_w_gu; K = D; N = 2 * FF; gain = P.ln_ffn; gmask = 1023; F = FF; WT = ws + WS_W_GU; }
            else if ((r -= B_GU) < B_DN) { W = P.ffn_w_down; K = FF; N = D; WT = ws + WS_W_DN; }
            else if ((r -= B_DN) < B_KV) { W = P.w_kv; K = D; N = 2048; gain = P.kv_norm; gmask = 1023; WT = ws + WS_W_KVQ; }
            else if ((r -= B_KV) < B_Q) { W = P.diff_w_q; K = D; N = D; gain = P.ln_mix + D; gmask = 1023; row_off = 2048; WT = ws + WS_W_KVQ; }
            else if ((r -= B_Q) < B_DO) { W = P.diff_w_o; K = D; N = D; gain = P.subln; gmask = 127; gscale = 1.0f - lambda_init; WT = ws + WS_W_DO; }
            else { W = P.diff_w_o; K = D; N = D; WT = ws + WS_W_DO; }
            const int nblk = N / 128, kb = r / nblk, nb = r % nblk, k0 = 128 * kb, n0 = 128 * nb;
            int drow = n0;
            if (F > 0) { const int up = n0 >= F ? 1 : 0; const int f = n0 - up * F; drow = 256 * (f >> 7) + 128 * up; }
            TrBlk B; B.src = W + (size_t)k0 * N + n0; B.gain = gain; B.N = N; B.gmask = gmask; B.k0 = k0; B.ldb = fp8 ? K : K * 2; B.fp8 = fp8; B.gscale = gscale;
            B.dst = WT + ((size_t)(row_off + drow) * K + k0) * (fp8 ? 1 : 2);
            return B;
        };
#define LDS_BAR() do { asm volatile("s_waitcnt lgkmcnt(0)" ::: "memory"); __builtin_amdgcn_s_barrier(); asm volatile("" ::: "memory"); } while (0)
        LAS unsigned char* img0 = lds; LAS unsigned char* img1 = lds + 128 * TR_PITCH;
        f32x4 ldA[8], ldB[8]; float gvA[8], gvB[8];
        int it = vcu;
        TrBlk bA = decode(it < NBLK ? it : 0), bB = decode(it + G < NBLK ? it + G : 0);
        if (it < NBLK) tr_load(bA, ldA, gvA, wave, lane);
        if (it + G < NBLK) tr_load(bB, ldB, gvB, wave, lane);
        for (; it < NBLK; it += 2 * G) {
            tr_commit(ldA, gvA, img0, wave, lane);
            LDS_BAR();
            const TrBlk cA = bA; const int n2 = it + 2 * G;
            bA = decode(n2 < NBLK ? n2 : 0);
            if (n2 < NBLK) tr_load(bA, ldA, gvA, wave, lane);
            tr_emit(cA, img0, wave, lane);
            if (it + G < NBLK) {
                tr_commit(ldB, gvB, img1, wave, lane);
                LDS_BAR();
                const TrBlk cB = bB; const int n3 = it + 3 * G;
                bB = decode(n3 < NBLK ? n3 : 0);
                if (n3 < NBLK) tr_load(bB, ldB, gvB, wave, lane);
                tr_emit(cB, img1, wave, lane);
            }
        }
        LDS_BAR();
#undef LDS_BAR
    }
    {
        const int gt = gw * 64 + lane, NT = NGW * 64;
        float* rc = (float*)(ws + WS_RCOS); float* rs = (float*)(ws + WS_RSIN);
        for (int i = gt; i < SEQ * 128; i += NT) {
            const int pos = i >> 7, f = i & 127;
            const float inv = exp2f(-(float)f * (13.287712379549449f / 128.0f));
            const double rev = (double)((float)pos * inv) * 0.15915494309189535;
            const float fr = (float)(rev - floor(rev));
            rc[i] = __builtin_amdgcn_cosf(fr); rs[i] = __builtin_amdgcn_sinf(fr);
        }
        float* dc = (float*)(ws + WS_DCOS); float* ds = (float*)(ws + WS_DSIN);
        for (int i = gt; i < SEQ * 8; i += NT) {
            const int pos = i >> 3, f = i & 7;
            const float inv = exp2f(-(float)f * (18.931568569324174f / 8.0f));
            const double rev = (double)((float)pos * inv) * 0.15915494309189535;
            const float fr = (float)(rev - floor(rev));
            dc[i] = __builtin_amdgcn_cosf(fr); ds[i] = __builtin_amdgcn_sinf(fr);
        }
        float* rwt = (float*)(ws + WS_RWT);
        for (int i = gt; i < NE * D; i += NT) { const int e = i >> 10, k = i & 1023; rwt[i] = P.router[k * NE + e] * P.ln_ffn[D + k]; }
    }
    {
        bf16* xb = (bf16*)(ws + WS_XB); float* ssp = (float*)(ws + WS_SSP);
        f32x4 nv[4];
        if (gw < M) { const GAS f32x4* xr = (const GAS f32x4*)(P.x + (size_t)gw * D) + lane;
#pragma unroll
            for (int j = 0; j < 4; ++j) nv[j] = xr[64 * j]; }
        for (int m = gw; m < M; m += NGW) {
            f32x4 v[4]; float s = 0.f;
#pragma unroll
            for (int j = 0; j < 4; ++j) { v[j] = nv[j]; s += (v[j].x * v[j].x + v[j].y * v[j].y) + (v[j].z * v[j].z + v[j].w * v[j].w); }
            if (m + NGW < M) { const GAS f32x4* xr = (const GAS f32x4*)(P.x + (size_t)(m + NGW) * D) + lane;
#pragma unroll
                for (int j = 0; j < 4; ++j) nv[j] = xr[64 * j]; }
            s = wave_sum(s);
            GAS unsigned long long* o8 = (GAS unsigned long long*)(xb + (size_t)m * D) + lane;
#pragma unroll
            for (int j = 0; j < 4; ++j) o8[64 * j] = (unsigned long long)pk2(v[j].x, v[j].y) | ((unsigned long long)pk2(v[j].z, v[j].w) << 32);
            if (lane < 16) ssp[(size_t)m * 16 + lane] = lane == 0 ? s : 0.f;
        }
    }
}

constexpr int CV_BLKS_GU = NE * (D / 128) * (2 * EF / 128), CV_BLKS_DN = NE * (EF / 128) * (D / 128), CV_BLKS = CV_BLKS_GU + CV_BLKS_DN;
constexpr int CV_PITCH = 272, CV_IMG = 32 * CV_PITCH;
struct CvMini { const float* src; unsigned char* dst; int N, ldb, kg; };
__device__ __forceinline__ CvMini cv_decode(const Ptrs& P, int blk, int qk) {
    CvMini m;
    if (blk < CV_BLKS_GU) {
        const int e = blk / 448, r = blk % 448, kb = r / 56, nb = r % 56, k0 = 128 * kb + 32 * qk, n0 = 128 * nb;
        const int up = n0 >= EF ? 1 : 0, f = n0 - up * EF, drow = 256 * (f >> 7) + 128 * up;
        m.src = P.moe_w_gu + (size_t)e * D * 2 * EF + (size_t)k0 * (2 * EF) + n0; m.kg = k0; m.N = 2 * EF;
        m.dst = P.ws + WS_W_MGU + (size_t)e * 2 * EF * D + (size_t)drow * D + k0; m.ldb = D;
    } else {
        const int b2 = blk - CV_BLKS_GU, e = b2 / 224, r = b2 % 224, kb = r / 8, nb = r % 8, k0 = 128 * kb + 32 * qk, n0 = 128 * nb;
        m.src = P.moe_w_down + (size_t)e * EF * D + (size_t)k0 * D + n0; m.kg = -1; m.N = D;
        m.dst = P.ws + WS_W_MDN + (size_t)e * D * EF + (size_t)n0 * EF + k0; m.ldb = EF;
    }
    return m;
}
__device__ __forceinline__ void cv_load(const CvMini& m, f32x4 (&v)[2], int tid) {
#pragma unroll
    for (int j = 0; j < 2; ++j) { const int row = (tid >> 5) + 16 * j; v[j] = __builtin_nontemporal_load((const f32x4*)(m.src + (size_t)row * m.N + 4 * (tid & 31))); }
}
__device__ __forceinline__ void cv_commit(const f32x4 (&v)[2], int kg, LAS const float* gtab, LAS unsigned char* img, int tid) {
#pragma unroll
    for (int j = 0; j < 2; ++j) { const int row = (tid >> 5) + 16 * j;
        const float gn = kg >= 0 ? gtab[kg + row] : MOE_WDN_SCALE;
        u32x2 w; w.x = pk2(v[j][0] * gn, v[j][1] * gn); w.y = pk2(v[j][2] * gn, v[j][3] * gn);
        *(LAS u32x2*)(img + row * CV_PITCH + 8 * (tid & 31)) = w; }
}
__device__ __forceinline__ void cv_emit(unsigned char* dst, int ldb, LAS const unsigned char* img, int wave, int lane) {
    const int i = lane & 15, g4 = lane >> 4, q = i >> 2, p = i & 3;
    const s16x4 lo = __builtin_bit_cast(s16x4, __builtin_amdgcn_ds_read_tr16_b64_v4i16((LAS s16x4*)(img + (8 * g4 + q) * CV_PITCH + (16 * wave + 4 * p) * 2)));
    const s16x4 hi = __builtin_bit_cast(s16x4, __builtin_amdgcn_ds_read_tr16_b64_v4i16((LAS s16x4*)(img + (8 * g4 + 4 + q) * CV_PITCH + (16 * wave + 4 * p) * 2)));
    unsigned w0, w1; asm volatile("" : "=v"(w0), "=v"(w1));
    w0 = __builtin_amdgcn_cvt_pk_fp8_f32(bf2f((unsigned short)lo[0]), bf2f((unsigned short)lo[1]), w0, false); w0 = __builtin_amdgcn_cvt_pk_fp8_f32(bf2f((unsigned short)lo[2]), bf2f((unsigned short)lo[3]), w0, true);
    w1 = __builtin_amdgcn_cvt_pk_fp8_f32(bf2f((unsigned short)hi[0]), bf2f((unsigned short)hi[1]), w1, false); w1 = __builtin_amdgcn_cvt_pk_fp8_f32(bf2f((unsigned short)hi[2]), bf2f((unsigned short)hi[3]), w1, true);
    *(GAS u32x2*)(dst + (size_t)(16 * wave + i) * ldb + 8 * g4) = (u32x2){w0, w1};
}

namespace ret {
typedef short v4i16_t __attribute__((ext_vector_type(4)));
__device__ __forceinline__ s16x4 trld(LAS const unsigned char* p) { return __builtin_bit_cast(s16x4, __builtin_amdgcn_ds_read_tr16_b64_v4i16((LAS v4i16_t*)p)); }
__device__ __forceinline__ bf16x8 cat8(s16x4 lo, s16x4 hi) { return (bf16x8){lo[0], lo[1], lo[2], lo[3], hi[0], hi[1], hi[2], hi[3]}; }
constexpr int QSTR = 528, SSTR = 144;
constexpr int LQ = 0, LK = LQ + 64 * QSTR, LV = LK + 64 * 512, LVD = LV + 4096, LS = LVD + 4096, LST = LS + 64 * SSTR, LEND = LST + 256 * 64;
static_assert(LEND + 2 * 32 * 272 + 4096 <= RING_BYTES && (LK % 16) == 0 && (LV % 16) == 0 && (LS % 16) == 0 && (LST % 16) == 0, "retention LDS map");

__device__ __forceinline__ void scores_phase(const bf16* proj, bf16* sbuf, LAS unsigned char* lds, int vcu, int G) {
    PHASE_IDS();
    const int i = lane & 15, g = lane >> 4;
    const int srow = tid >> 5, sc16 = tid & 31;
    constexpr int SQ = 0, SK = 64 * QSTR;
    for (int u = vcu; u < 1024; u += G) {
        const int bh = u >> 6, c = u & 63, b = bh >> 2, h = bh & 3;
        const size_t R0 = (size_t)b * SEQ + c * 64;
        const float lg = log2f(1.0f - exp2f(-5.0f - (float)h));
        const bf16* gq = proj + (R0 + srow) * RIN + h * 256 + sc16 * 8;
        v4u tq[4], tk[4];
#pragma unroll
        for (int k = 0; k < 4; ++k) { tq[k] = *(const v4u*)(gq + (size_t)(16 * k) * RIN); tk[k] = *(const v4u*)(gq + 1024 + (size_t)(16 * k) * RIN); }
#pragma unroll
        for (int k = 0; k < 4; ++k) { *(LAS v4u*)(lds + SQ + (srow + 16 * k) * QSTR + sc16 * 16) = tq[k]; *(LAS v4u*)(lds + SK + (srow + 16 * k) * QSTR + sc16 * 16) = tk[k]; }
        WG_BAR();
#pragma unroll
        for (int tt = 0; tt < 2; ++tt) {
            const int ti = 2 * wave + tt, tn = ti >> 2, tm = ti & 3;
            f32x4 acc = (f32x4){0.f, 0.f, 0.f, 0.f};
            if (tm <= tn) {
#pragma unroll
                for (int s = 0; s < 8; ++s) {
                    const bf16x8 a = *(const LAS bf16x8*)(lds + SK + (16 * tm + i) * QSTR + (32 * s + 8 * g) * 2), bq = *(const LAS bf16x8*)(lds + SQ + (16 * tn + i) * QSTR + (32 * s + 8 * g) * 2);
                    acc = __builtin_amdgcn_mfma_f32_16x16x32_bf16(a, bq, acc, 0, 0, 0);
                }
            }
            const int n = 16 * tn + i, m0 = 16 * tm + 4 * g;
            float v[4];
#pragma unroll
            for (int r = 0; r < 4; ++r) { const int dm = n - (m0 + r); v[r] = dm >= 0 ? acc[r] * exp2f((float)dm * lg) : 0.f; }
            u32x2 w; w.x = pk2(v[0], v[1]); w.y = pk2(v[2], v[3]);
            *(u32x2*)(sbuf + (size_t)u * 4096 + n * 64 + m0) = w;
        }
        WG_BAR();
    }
}

__device__ __forceinline__ void scan_phase(const Ptrs& P, const bf16* proj, const bf16* sbuf, bf16* oret, LAS unsigned char* lds, int vcu, int G) {
    PHASE_IDS();
    int cvp = 0;
    struct CvSet { f32x4 a[2], b[2]; unsigned char* d0; unsigned char* d1; int l0, l1, k0, k1; bool have; };
    CvSet cs0, cs1; cs0.have = false; cs1.have = false; cs0.d0 = cs0.d1 = cs1.d0 = cs1.d1 = nullptr; cs0.l0 = cs0.l1 = cs1.l0 = cs1.l1 = 0; cs0.k0 = cs0.k1 = cs1.k0 = cs1.k1 = -1;
    LAS float* gtab = (LAS float*)(lds + LEND + 2 * CV_IMG);
    for (int k = tid; k < D; k += NTHREADS) gtab[k] = P.ln_ffn[D + k] * MOE_WGU_SCALE;
    WG_BAR();
#define SCAN_LBAR() do { asm volatile("s_waitcnt lgkmcnt(0)" ::: "memory"); __builtin_amdgcn_s_barrier(); asm volatile("" ::: "memory"); } while (0)
    LAS unsigned char* cimg0 = lds + LEND; LAS unsigned char* cimg1 = lds + LEND + CV_IMG;
    const int i = lane & 15, g = lane >> 4, q = i >> 2, p = i & 3;
    const int nt = wave >> 1, vt = wave & 1;
    for (int u = vcu; u < 256; u += G) {
        const int bh = u >> 4, vs = u & 15, b = bh >> 2, h = bh & 3;
        const float lg = log2f(1.0f - exp2f(-5.0f - (float)h));
        const float cdec = exp2f(64.0f * lg);
        const float qdl = exp2f((float)(16 * nt + i + 1) * lg);
        const float kd = exp2f((float)(63 - (tid >> 2)) * lg);
        const int qrow = tid >> 5, qc16 = tid & 31;
        const char* uq = (const char*)(proj + (size_t)b * SEQ * RIN + h * 256);
        const unsigned qoff = (unsigned)(qrow * RIN + qc16 * 8) * 2u;
        const int kx = (qrow & 3) | (((qrow >> 3) & 1) << 2);
        const int lq_off = LQ + qrow * QSTR + qc16 * 16;
        const int lk_off = LK + qrow * 512 + (((qc16 >> 1) ^ kx) << 5) + (qc16 & 1) * 16;
        const int vrow = tid >> 2, vc16 = tid & 3;
        const char* uv = (const char*)(proj + (size_t)b * SEQ * RIN + 2048 + h * 512 + vs * 32);
        const unsigned voff = (unsigned)(vrow * RIN + vc16 * 8) * 2u;
        const int lv_off = vrow * 64 + ((vc16 * 16) ^ (((vrow >> 3) & 1) << 5));
        const int srow = tid >> 3, sc16 = tid & 7;
        const char* us = (const char*)(sbuf + (size_t)(bh * 64) * 4096);
        const unsigned soff = (unsigned)tid * 16u;
        const int ls_off = LS + srow * SSTR + sc16 * 16;
        f32x4 st[2][2];
#pragma unroll
        for (int a = 0; a < 2; ++a)
#pragma unroll
            for (int c2 = 0; c2 < 2; ++c2) st[a][c2] = (f32x4){0.f, 0.f, 0.f, 0.f};
        { LAS v4u* z = (LAS v4u*)(lds + LST) + tid * 2; z[0] = (v4u){0u, 0u, 0u, 0u}; z[1] = (v4u){0u, 0u, 0u, 0u}; }
        v4u pq[4], pk[4], pv, ps;
#pragma unroll
        for (int k = 0; k < 4; ++k) { pq[k] = *(const v4u*)(uq + (size_t)(16 * k) * RIN * 2 + qoff); pk[k] = *(const v4u*)(uq + (size_t)(16 * k) * RIN * 2 + 2048 + qoff); }
        pv = (tid < 256) ? *(const v4u*)(uv + voff) : (v4u){0u, 0u, 0u, 0u};
        ps = *(const v4u*)(us + soff);
        auto scan_step = [&](const int c, CvSet& CS) __attribute__((always_inline)) {
#pragma unroll
            for (int k = 0; k < 4; ++k) { *(LAS v4u*)(lds + lq_off + 16 * k * QSTR) = pq[k]; *(LAS v4u*)(lds + lk_off + 16 * k * 512) = pk[k]; }
            if (tid < 256) {
                *(LAS v4u*)(lds + LV + lv_off) = pv;
                v4u d; d.x = pk2(bflo(pv.x) * kd, bfhi(pv.x) * kd); d.y = pk2(bflo(pv.y) * kd, bfhi(pv.y) * kd); d.z = pk2(bflo(pv.z) * kd, bfhi(pv.z) * kd); d.w = pk2(bflo(pv.w) * kd, bfhi(pv.w) * kd);
                *(LAS v4u*)(lds + LVD + lv_off) = d;
            }
            *(LAS v4u*)(lds + ls_off) = ps;
            unsigned char* ed0 = CS.d0; unsigned char* ed1 = CS.d1; const int el0 = CS.l0, el1 = CS.l1; const bool cv_emit_now = CS.have;
            if (CS.have) { cv_commit(CS.a, CS.k0, gtab, cimg0, tid); cv_commit(CS.b, CS.k1, gtab, cimg1, tid); }
            SCAN_LBAR();
            if (c + 1 < 64) {
                const size_t adv = (size_t)(c + 1) * 64 * RIN * 2;
#pragma unroll
                for (int k = 0; k < 4; ++k) { pq[k] = *(const v4u*)(uq + adv + (size_t)(16 * k) * RIN * 2 + qoff); pk[k] = *(const v4u*)(uq + adv + (size_t)(16 * k) * RIN * 2 + 2048 + qoff); }
                if (tid < 256) pv = *(const v4u*)(uv + adv + voff);
                ps = *(const v4u*)(us + (size_t)(c + 1) * 8192 + soff);
            }
            {
                const int blk = vcu + (cvp >> 1) * G;
                CS.have = blk < CV_BLKS;
                if (CS.have) { const CvMini m0 = cv_decode(P, blk, 2 * (cvp & 1)), m1 = cv_decode(P, blk, 2 * (cvp & 1) + 1);
                    cv_load(m0, CS.a, tid); cv_load(m1, CS.b, tid); CS.d0 = m0.dst; CS.l0 = m0.ldb; CS.k0 = m0.kg; CS.d1 = m1.dst; CS.l1 = m1.ldb; CS.k1 = m1.kg; ++cvp; }
            }
            f32x4 a1 = (f32x4){0.f, 0.f, 0.f, 0.f}, a2 = (f32x4){0.f, 0.f, 0.f, 0.f}, a3 = (f32x4){0.f, 0.f, 0.f, 0.f};
#pragma unroll
            for (int s = 0; s < 2; ++s) {
                const bf16x8 a = *(const LAS bf16x8*)(lds + LS + (16 * nt + i) * SSTR + (32 * s + 8 * g) * 2);
                const int r0 = 32 * s + 8 * g + q, r1 = r0 + 4, cb = (16 * vt + 4 * p) * 2;
                const s16x4 lo = trld(lds + LV + r0 * 64 + (cb ^ (((r0 >> 3) & 1) << 5))), hi = trld(lds + LV + r1 * 64 + (cb ^ (((r1 >> 3) & 1) << 5)));
                a1 = __builtin_amdgcn_mfma_f32_16x16x32_bf16(cat8(lo, hi), a, a1, 0, 0, 0);
            }
#pragma unroll
            for (int s = 0; s < 8; ++s) {
                const bf16x8 a = *(const LAS bf16x8*)(lds + LQ + (16 * nt + i) * QSTR + (32 * s + 8 * g) * 2);
                const int r0 = 32 * s + 8 * g + q, r1 = r0 + 4, cb = (16 * vt + 4 * p) * 2;
                const s16x4 lo = trld(lds + LST + r0 * 64 + (cb ^ (((r0 >> 3) & 1) << 5))), hi = trld(lds + LST + r1 * 64 + (cb ^ (((r1 >> 3) & 1) << 5)));
                if (s & 1) a3 = __builtin_amdgcn_mfma_f32_16x16x32_bf16(cat8(lo, hi), a, a3, 0, 0, 0);
                else a2 = __builtin_amdgcn_mfma_f32_16x16x32_bf16(cat8(lo, hi), a, a2, 0, 0, 0);
            }
#pragma unroll
            for (int dt = 0; dt < 2; ++dt)
#pragma unroll
                for (int vv = 0; vv < 2; ++vv) st[dt][vv] = st[dt][vv] * cdec;
#pragma unroll
            for (int s = 0; s < 2; ++s) {
                const int r0 = 32 * s + 8 * g + q, r1 = r0 + 4;
                const int x0 = (r0 & 3) | (((r0 >> 3) & 1) << 2), x1 = (r1 & 3) | (((r1 >> 3) & 1) << 2);
                bf16x8 ka[2], vb[2];
#pragma unroll
                for (int dt = 0; dt < 2; ++dt) {
                    const int slot = 2 * wave + dt;
                    ka[dt] = cat8(trld(lds + LK + r0 * 512 + ((slot ^ x0) << 5) + 8 * p), trld(lds + LK + r1 * 512 + ((slot ^ x1) << 5) + 8 * p));
                }
#pragma unroll
                for (int vv = 0; vv < 2; ++vv) {
                    const int cb = (16 * vv + 4 * p) * 2;
                    vb[vv] = cat8(trld(lds + LVD + r0 * 64 + (cb ^ (((r0 >> 3) & 1) << 5))), trld(lds + LVD + r1 * 64 + (cb ^ (((r1 >> 3) & 1) << 5))));
                }
#pragma unroll
                for (int dt = 0; dt < 2; ++dt)
#pragma unroll
                    for (int vv = 0; vv < 2; ++vv) st[dt][vv] = __builtin_amdgcn_mfma_f32_16x16x32_bf16(ka[dt], vb[vv], st[dt][vv], 0, 0, 0);
            }
            {
                char* uo = (char*)(oret + ((size_t)b * SEQ + c * 64) * RVD + h * 512 + vs * 32);
                const unsigned ooff = (unsigned)((16 * nt + i) * RVD + 16 * vt + 4 * g) * 2u;
                float ov_[4];
#pragma unroll
                for (int r = 0; r < 4; ++r) ov_[r] = a1[r] + qdl * (a2[r] + a3[r]);
                u32x2 w_; w_.x = pk2(ov_[0], ov_[1]); w_.y = pk2(ov_[2], ov_[3]);
                *(u32x2*)(uo + ooff) = w_;
            }
            if (cv_emit_now) { cv_emit(ed0, el0, cimg0, wave, lane); cv_emit(ed1, el1, cimg1, wave, lane); }
            SCAN_LBAR();
#pragma unroll
            for (int dt = 0; dt < 2; ++dt)
#pragma unroll
                for (int vv = 0; vv < 2; ++vv)
#pragma unroll
                    for (int r = 0; r < 4; ++r) {
                        const int d = 32 * wave + 16 * dt + 4 * g + r, cb = (16 * vv + i) * 2;
                        *(LAS bf16*)(lds + LST + d * 64 + (cb ^ (((d >> 3) & 1) << 5))) = (bf16)f2bf(st[dt][vv][r]);
                    }
        };
        for (int c = 0; c < 64; c += 2) { scan_step(c, cs0); scan_step(c + 1, cs1); }
        WG_BAR();
    }
    for (;;) {
        bool any = false;
#pragma unroll
        for (int k = 0; k < 2; ++k) {
            CvSet& CS = k ? cs1 : cs0;
            unsigned char* ed0 = CS.d0; unsigned char* ed1 = CS.d1; const int el0 = CS.l0, el1 = CS.l1; const bool emit_now = CS.have;
            if (CS.have) { cv_commit(CS.a, CS.k0, gtab, cimg0, tid); cv_commit(CS.b, CS.k1, gtab, cimg1, tid); }
            WG_BAR();
            const int blk = vcu + (cvp >> 1) * G;
            CS.have = blk < CV_BLKS;
            if (CS.have) { const CvMini m0 = cv_decode(P, blk, 2 * (cvp & 1)), m1 = cv_decode(P, blk, 2 * (cvp & 1) + 1);
                cv_load(m0, CS.a, tid); cv_load(m1, CS.b, tid); CS.d0 = m0.dst; CS.l0 = m0.ldb; CS.k0 = m0.kg; CS.d1 = m1.dst; CS.l1 = m1.ldb; CS.k1 = m1.kg; ++cvp; }
            if (emit_now) { cv_emit(ed0, el0, cimg0, wave, lane); cv_emit(ed1, el1, cimg1, wave, lane); }
            WG_BAR();
            any = any || emit_now || CS.have;
        }
        if (!any) break;
    }
#undef SCAN_LBAR
}

__device__ __forceinline__ void norm_gate_phase(const bf16* oret, const bf16* proj, bf16* ro, int vcu, int G) {
    PHASE_IDS();
    const int gw = vcu * NWAVES + wave, NGW = G * NWAVES;
    for (int row = gw; row < M; row += NGW) {
        v4u ov[4], gv[4];
#pragma unroll
        for (int h = 0; h < 4; ++h) {
            ov[h] = *(const v4u*)(oret + (size_t)row * RVD + h * 512 + lane * 8);
            gv[h] = *(const v4u*)(proj + (size_t)row * RIN + 4096 + h * 512 + lane * 8);
        }
        float o[4][8], mu[4], rstd[4];
#pragma unroll
        for (int h = 0; h < 4; ++h) {
            o[h][0] = bflo(ov[h].x); o[h][1] = bfhi(ov[h].x); o[h][2] = bflo(ov[h].y); o[h][3] = bfhi(ov[h].y); o[h][4] = bflo(ov[h].z); o[h][5] = bfhi(ov[h].z); o[h][6] = bflo(ov[h].w); o[h][7] = bfhi(ov[h].w);
            float s = 0.f;
#pragma unroll
            for (int j = 0; j < 8; ++j) s += o[h][j];
            mu[h] = s;
        }
#pragma unroll
        for (int h = 0; h < 4; ++h) mu[h] = wave_sum(mu[h]) * (1.0f / 512.0f);
#pragma unroll
        for (int h = 0; h < 4; ++h) {
            float s2 = 0.f;
#pragma unroll
            for (int j = 0; j < 8; ++j) { o[h][j] -= mu[h]; s2 += o[h][j] * o[h][j]; }
            rstd[h] = s2;
        }
#pragma unroll
        for (int h = 0; h < 4; ++h) rstd[h] = __builtin_amdgcn_rsqf(wave_sum(rstd[h]) * (1.0f / 512.0f) + EPS);
#pragma unroll
        for (int h = 0; h < 4; ++h) {
            const float gg[8] = {bflo(gv[h].x), bfhi(gv[h].x), bflo(gv[h].y), bfhi(gv[h].y), bflo(gv[h].z), bfhi(gv[h].z), bflo(gv[h].w), bfhi(gv[h].w)};
            float y[8];
#pragma unroll
            for (int j = 0; j < 8; ++j) y[j] = o[h][j] * rstd[h] * silu_f(gg[j]);
            v4u w; w.x = pk2(y[0], y[1]); w.y = pk2(y[2], y[3]); w.z = pk2(y[4], y[5]); w.w = pk2(y[6], y[7]);
            *(v4u*)(ro + (size_t)row * RVD + h * 512 + lane * 8) = w;
        }
    }
}
}

namespace dat {
constexpr int LK0 = 0  , LV0 = 32768  , LWS = 81920  , LCB = 0  , CSTR = 132;
__device__ __forceinline__ int crow(int r, int hi) { return (r & 3) + 8 * (r >> 2) + 4 * hi; }
__device__ __forceinline__ float half_swap_max(float m) { auto rr = __builtin_amdgcn_permlane32_swap(__float_as_uint(m), __float_as_uint(m), false, false); return fmaxf(__uint_as_float(rr[0]), __uint_as_float(rr[1])); }
__device__ __forceinline__ float half_swap_sum(float m) { auto rr = __builtin_amdgcn_permlane32_swap(__float_as_uint(m), __float_as_uint(m), false, false); return __uint_as_float(rr[0]) + __uint_as_float(rr[1]); }
typedef float f32x2_t __attribute__((ext_vector_type(2))); typedef __bf16 bf16x2_t __attribute__((ext_vector_type(2)));
__device__ __forceinline__ unsigned cvtpk(float lo, float hi) { f32x2_t v = {lo, hi}; bf16x2_t b2 = __builtin_convertvector(v, bf16x2_t); return __builtin_bit_cast(unsigned, b2); }
__device__ __forceinline__ float max3f(float a, float b, float c) { float r; asm("v_max3_f32 %0, %1, %2, %3" : "=v"(r) : "v"(a), "v"(b), "v"(c)); return r; }
__device__ __forceinline__ float fadd_s(float a, float b) { float r; asm("v_add_f32_e32 %0, %1, %2" : "=v"(r) : "v"(a), "v"(b)); return r; }

#define DAT_SBAR() __builtin_amdgcn_sched_barrier(0)
#define DAT_PIN(x) asm volatile("" : "+v"(x))
__device__ __forceinline__ void attn_unit(int b, int h, int qb, const bf16* kvq, bf16* ao, LAS unsigned char* lds, float lam, int wave, int lane, int tid) {
    const int r32 = lane & 31, hi = lane >> 5, comp = wave >> 2, w4 = wave & 3;
    const size_t rowbase = (size_t)b * SEQ;
    const int q0 = qb * 128;
    const int NT = 2 * qb + 2, ntw = 2 * qb + 1 + (w4 >> 1);
    const bf16* Kh = kvq + rowbase * KVQ_N + h * 128;
    const bf16* Vh = kvq + rowbase * KVQ_N + 1024 + h * 128;
    const bf16* Qw = kvq + (rowbase + q0 + w4 * 32) * KVQ_N + 2048 + h * 128 + comp * 64;
    LAS float* wsf = (LAS float*)(lds + LWS) + wave * 64;
    const int pkey = 4 * wave + (lane >> 4), pc = lane & 15;
    const unsigned kvoff = (unsigned)(pkey * KVQ_N + ((pc ^ (pkey & 15)) << 3)) * 2u;
    const unsigned vvoff = (unsigned)(pkey * KVQ_N + ((pc ^ ((pkey & 3) << 2)) << 3)) * 2u;
    const int koff0 = r32 * 256 + (((comp * 8 + hi) ^ (r32 & 15)) << 4);
    const int voff0 = (4 * hi + ((lane & 15) >> 2)) * 256 + ((((lane & 15) >> 2) << 6) | ((4 * ((lane >> 4) & 1) + (lane & 3)) << 3));
#define koffd(d) (koff0 ^ ((d) << 5))
#define voffd(d) (voff0 ^ ((d) << 6))
    const unsigned ldsb = (unsigned)(size_t)lds;
#define DAT_GLDS(base, voff, dst) do { unsigned keep_; asm volatile("s_mov_b32 %0, m0\n\ts_mov_b32 m0, %3\n\ts_nop 0\n\tglobal_load_lds_dwordx4 %1, %2\n\ts_mov_b32 m0, %0" : "=&s"(keep_) : "v"(voff), "s"(base), "s"(dst) : "memory"); } while (0)
#define DAT_DMA(t, kslot, vslot) do { const bf16* kb0_ = Kh + (size_t)(t) * 64 * KVQ_N; const bf16* vb0_ = Vh + (size_t)(t) * 64 * KVQ_N; \
        const unsigned kd_ = (unsigned)__builtin_amdgcn_readfirstlane(ldsb + LK0 + (kslot) * 16384 + wave * 1024), vd_ = (unsigned)__builtin_amdgcn_readfirstlane(ldsb + LV0 + (vslot) * 16384 + wave * 1024); \
        DAT_GLDS(kb0_, kvoff, kd_); DAT_GLDS(kb0_ + (size_t)32 * KVQ_N, kvoff, kd_ + 8192u); DAT_GLDS(vb0_, vvoff, vd_); DAT_GLDS(vb0_ + (size_t)32 * KVQ_N, vvoff, vd_ + 8192u); } while (0)
    DAT_DMA(0, 0, 0);
    bf16x8 qr[4];
#pragma unroll
    for (int d0 = 0; d0 < 4; ++d0) qr[d0] = *(const bf16x8*)(Qw + (size_t)r32 * KVQ_N + d0 * 16 + hi * 8);
    asm volatile("" : "+v"(qr[0]), "+v"(qr[1]), "+v"(qr[2]), "+v"(qr[3]));
    f32x16 o[4];
#pragma unroll
    for (int d = 0; d < 4; ++d)
#pragma unroll
        for (int r = 0; r < 16; ++r) o[d][r] = 0.f;
    float mrun = 0.f, lrun = 0.f;
    f32x16 negm;
#pragma unroll
    for (int r = 0; r < 16; ++r) negm[r] = 0.f;
    f32x16 C0, C1;
    v4u pw[4];
    int vsl_prev = 0, vsl_cur = 0;
    bool resc = false;
#define DAT_DECIDE(FIRST) do { \
        float ra_ = max3f(C0[0], C0[1], C1[0]), rb_ = max3f(C0[2], C0[3], C1[1]); ra_ = max3f(ra_, C1[2], C1[3]); \
        _Pragma("unroll") for (int r = 4; r < 16; r += 4) { ra_ = max3f(ra_, C0[r], C0[r + 1]); rb_ = max3f(rb_, C0[r + 2], C0[r + 3]); ra_ = max3f(ra_, C1[r], C1[r + 1]); rb_ = max3f(rb_, C1[r + 2], C1[r + 3]); } \
        const float rm_ = half_swap_max(max3f(ra_, rb_, rb_)); \
        if ((FIRST) || __any(rm_ > 8.0f)) { \
            const float dl_ = (FIRST) ? rm_ : fmaxf(rm_, 0.f); const float f_ = fast_exp2(-dl_); \
            lrun *= f_; mrun += dl_; if (hi == 0) wsf[r32] = f_; \
            _Pragma("unroll") for (int r = 0; r < 16; ++r) { C0[r] -= dl_; C1[r] -= dl_; negm[r] = -mrun; } \
            resc = !(FIRST); } } while (0)
#define DAT_RESC() do { if (resc) { asm volatile("s_waitcnt lgkmcnt(0)" ::: "memory"); \
        _Pragma("unroll") for (int r = 0; r < 16; ++r) { const float fr_ = wsf[crow(r, hi)]; _Pragma("unroll") for (int d = 0; d < 4; ++d) o[d][r] *= fr_; } resc = false; } } while (0)
#define DAT_VRD(dst_lo, dst_hi, j) do { dst_lo = ret::trld(Vb_ + voffd((j) >> 2) + ((j) & 3) * 4096); dst_hi = ret::trld(Vb_ + voffd((j) >> 2) + ((j) & 3) * 4096 + 2048); } while (0)
#define DAT_QK(t_, DO_, tn_) do { LAS const unsigned char* Kb_ = lds + LK0 + ((t_) & 1) * 16384; \
        const bf16* kb0_ = Kh + (size_t)(tn_) * 64 * KVQ_N; const bf16* vb0_ = Vh + (size_t)(tn_) * 64 * KVQ_N; const unsigned kd_ = (unsigned)__builtin_amdgcn_readfirstlane(ldsb + LK0 + ((tn_) & 1) * 16384 + wave * 1024), vd_ = (unsigned)__builtin_amdgcn_readfirstlane(ldsb + LV0 + ((tn_) % 3) * 16384 + wave * 1024); \
        bf16x8 ka_ = *(const LAS bf16x8*)(Kb_ + koffd(0)), kb_ = *(const LAS bf16x8*)(Kb_ + koffd(0) + 8192), kc_ = *(const LAS bf16x8*)(Kb_ + koffd(1)), kd2_ = *(const LAS bf16x8*)(Kb_ + koffd(1) + 8192); \
        DAT_SBAR(); \
        C0 = __builtin_amdgcn_mfma_f32_32x32x16_bf16(ka_, qr[0], negm, 0, 0, 0); C1 = __builtin_amdgcn_mfma_f32_32x32x16_bf16(kb_, qr[0], negm, 0, 0, 0); \
        ka_ = *(const LAS bf16x8*)(Kb_ + koffd(2)); kb_ = *(const LAS bf16x8*)(Kb_ + koffd(2) + 8192); if (DO_) DAT_GLDS(kb0_, kvoff, kd_); DAT_SBAR(); \
        C0 = __builtin_amdgcn_mfma_f32_32x32x16_bf16(kc_, qr[1], C0, 0, 0, 0); C1 = __builtin_amdgcn_mfma_f32_32x32x16_bf16(kd2_, qr[1], C1, 0, 0, 0); \
        kc_ = *(const LAS bf16x8*)(Kb_ + koffd(3)); kd2_ = *(const LAS bf16x8*)(Kb_ + koffd(3) + 8192); if (DO_) DAT_GLDS(kb0_ + (size_t)32 * KVQ_N, kvoff, kd_ + 8192u); DAT_SBAR(); \
        C0 = __builtin_amdgcn_mfma_f32_32x32x16_bf16(ka_, qr[2], C0, 0, 0, 0); C1 = __builtin_amdgcn_mfma_f32_32x32x16_bf16(kb_, qr[2], C1, 0, 0, 0); \
        if (DO_) DAT_GLDS(vb0_, vvoff, vd_); DAT_SBAR(); \
        C0 = __builtin_amdgcn_mfma_f32_32x32x16_bf16(kc_, qr[3], C0, 0, 0, 0); C1 = __builtin_amdgcn_mfma_f32_32x32x16_bf16(kd2_, qr[3], C1, 0, 0, 0); \
        if (DO_) DAT_GLDS(vb0_ + (size_t)32 * KVQ_N, vvoff, vd_ + 8192u); DAT_SBAR(); \
        asm volatile("s_nop 15\n\ts_nop 7" : "+v"(C0), "+v"(C1)); } while (0)
    {
        WG_BAR();
        DAT_QK(0, true, 1);
        DAT_DECIDE(true);
        float s0_ = 0.f, s1_ = 0.f;
#pragma unroll
        for (int j = 0; j < 16; ++j) {
            const float e0_ = fast_exp2(j < 8 ? C0[2 * (j & 7)] : C1[2 * (j & 7)]), e1_ = fast_exp2(j < 8 ? C0[2 * (j & 7) + 1] : C1[2 * (j & 7) + 1]);
            s0_ += e0_; s1_ += e1_; pw[j >> 2][j & 3] = cvtpk(e0_, e1_);
        }
        lrun += s0_ + s1_;
        vsl_prev = 0; vsl_cur = 16384;
    }
#define DAT_STEADY(t_, PWa, PWb) do { \
        WG_BAR(); \
        const bool dma_ = ((t_) + 1 < NT); \
        LAS const unsigned char* Vb_ = lds + LV0 + vsl_prev; \
        s16x4 vl_[4], vh_[4]; \
        _Pragma("unroll") for (int j = 0; j < 4; ++j) DAT_VRD(vl_[j], vh_[j], j); \
        DAT_QK(t_, dma_, (t_) + 1); \
        DAT_DECIDE(false); \
        const bf16x8 pa_[4] = {__builtin_bit_cast(bf16x8, PWa[0]), __builtin_bit_cast(bf16x8, PWa[1]), __builtin_bit_cast(bf16x8, PWa[2]), __builtin_bit_cast(bf16x8, PWa[3])}; \
        float ssum_ = 0.f; \
        DAT_SBAR(); \
        _Pragma("unroll") for (int j = 0; j < 16; ++j) { \
            o[j >> 2] = __builtin_amdgcn_mfma_f32_32x32x16_bf16(pa_[j & 3], ret::cat8(vl_[j & 3], vh_[j & 3]), o[j >> 2], 0, 0, 0); \
            if (j + 4 < 16) DAT_VRD(vl_[j & 3], vh_[j & 3], j + 4); \
            { const float e0_ = fast_exp2(j < 8 ? C0[2 * (j & 7)] : C1[2 * (j & 7)]), e1_ = fast_exp2(j < 8 ? C0[2 * (j & 7) + 1] : C1[2 * (j & 7) + 1]); \
              ssum_ += e0_; ssum_ += e1_; PWb[j >> 2][j & 3] = cvtpk(e0_, e1_); } \
            DAT_PIN(ssum_); DAT_SBAR(); \
        } \
        DAT_RESC(); \
        lrun += ssum_; \
        vsl_prev = vsl_cur; vsl_cur = (vsl_cur == 32768) ? 0 : vsl_cur + 16384; \
    } while (0)
    v4u pq_[4];
    int t = 1;
    for (; t + 1 < ntw; t += 2) { DAT_STEADY(t, pw, pq_); DAT_STEADY(t + 1, pq_, pw); }
    for (; t <= NT; ++t) {
        if (t < ntw) { DAT_STEADY(t, pw, pq_); pw[0] = pq_[0]; pw[1] = pq_[1]; pw[2] = pq_[2]; pw[3] = pq_[3]; }
        else {
            WG_BAR();
            const bool dma_ = (t + 1 < NT);
            LAS const unsigned char* Vb_ = lds + LV0 + vsl_prev;
            if (dma_) { const int tn_ = t + 1; DAT_DMA(tn_, tn_ & 1, tn_ % 3); }
            if (t == ntw) {
            const bf16x8 pa_[4] = {__builtin_bit_cast(bf16x8, pw[0]), __builtin_bit_cast(bf16x8, pw[1]), __builtin_bit_cast(bf16x8, pw[2]), __builtin_bit_cast(bf16x8, pw[3])};
#pragma unroll
            for (int d = 0; d < 4; ++d)
#pragma unroll
                for (int ks = 0; ks < 4; ++ks) {
                    const s16x4 lo_ = ret::trld(Vb_ + voffd(d) + ks * 4096), hh_ = ret::trld(Vb_ + voffd(d) + ks * 4096 + 2048);
                    o[d] = __builtin_amdgcn_mfma_f32_32x32x16_bf16(pa_[ks], ret::cat8(lo_, hh_), o[d], 0, 0, 0);
                }
            }
            vsl_prev = vsl_cur; vsl_cur = (vsl_cur == 32768) ? 0 : vsl_cur + 16384;
        }
    }
#undef DAT_STEADY
#undef DAT_QK
#undef DAT_VRD
#undef DAT_RESC
#undef DAT_DECIDE
#undef DAT_DMA
#undef DAT_GLDS
#undef koffd
#undef voffd
    {
        const float lt = half_swap_sum(lrun);
        if (hi == 0) wsf[r32] = (comp ? lam : 1.0f) * fast_rcp(lt);
        asm volatile("s_waitcnt lgkmcnt(0)" ::: "memory");
#pragma unroll
        for (int r = 0; r < 16; ++r) { const float fr_ = wsf[crow(r, hi)];
#pragma unroll
            for (int d = 0; d < 4; ++d) o[d][r] *= fr_; }
    }
    WG_BAR();
    LAS float* cb = (LAS float*)(lds + LCB);
    if (comp == 1) {
#pragma unroll
        for (int d = 0; d < 4; ++d)
#pragma unroll
            for (int r = 0; r < 16; ++r) cb[(w4 * 32 + crow(r, hi)) * CSTR + d * 32 + r32] = o[d][r];
    }
    WG_BAR();
    if (comp == 0) {
#pragma unroll
        for (int d = 0; d < 4; ++d)
#pragma unroll
            for (int r = 0; r < 16; ++r) { LAS float* pc = cb + (w4 * 32 + crow(r, hi)) * CSTR + d * 32 + r32; *pc = o[d][r] - *pc; }
    }
    WG_BAR();
    {
        const int row = tid >> 2, part = tid & 3;
        const LAS f32x4* src = (const LAS f32x4*)(cb + row * CSTR + part * 32);
        f32x4 v[8]; float ss = 0.f;
#pragma unroll
        for (int j = 0; j < 8; ++j) { v[j] = src[j]; ss += (v[j][0] * v[j][0] + v[j][1] * v[j][1]) + (v[j][2] * v[j][2] + v[j][3] * v[j][3]); }
        ss += SWZ_XOR(ss, 1); ss += SWZ_XOR(ss, 2);
        const float rstd = __builtin_amdgcn_rsqf(ss * (1.0f / 128.0f) + EPS);
        bf16* dst = ao + (rowbase + q0 + row) * D + h * 128 + part * 32;
#pragma unroll
        for (int j = 0; j < 4; ++j) {
            v4u w; w.x = pk2(v[2 * j][0] * rstd, v[2 * j][1] * rstd); w.y = pk2(v[2 * j][2] * rstd, v[2 * j][3] * rstd);
            w.z = pk2(v[2 * j + 1][0] * rstd, v[2 * j + 1][1] * rstd); w.w = pk2(v[2 * j + 1][2] * rstd, v[2 * j + 1][3] * rstd);
            *(v4u*)(dst + 8 * j) = w;
        }
    }
    WG_BAR();
}

__device__ __forceinline__ void attn_phase(const bf16* kvq, bf16* ao, LAS unsigned char* lds, const float* lq1, const float* lk1, const float* lq2, const float* lk2, float lambda_init, int vcu, int G) {
    PHASE_IDS();
    const float lam = __expf(wave_sum(lq1[lane] * lk1[lane])) - __expf(wave_sum(lq2[lane] * lk2[lane])) + lambda_init;
    const int nun = (G == 256) ? 4 : (1024 - vcu + G - 1) / G;
#pragma unroll 1
    for (int i = 0; i < nun; ++i) {
        int bh, qb;
        if (G == 256) { const int x = vcu >> 5, w = vcu & 31, j = (w + 16) & 31; bh = 4 * x + i; qb = (i == 0) ? w : (i == 1) ? 31 - w : (i == 2) ? j : 31 - j; }
        else { const int u = vcu + i * G; bh = u >> 5; qb = u & 31; }
        attn_unit(bh >> 3, bh & 7, qb, kvq, ao, lds, lam, wave, lane, tid);
    }
}
}

__device__ __forceinline__ void route_a(const bf16* xb, const float* rwt, int* tope, float* topw, int* topr, float* tokr, int* cnt, unsigned char* xn8, LAS unsigned char* lds, int vcu, int G) {
    PHASE_IDS();
    LAS f32x4* rw = (LAS f32x4*)lds;
    LAS int* sel = (LAS int*)(lds + 32768);
    for (int k = tid; k < NE * D / 4; k += NTHREADS) { const int e = k >> 8, c4 = k & 255; rw[((e * 2 + (c4 >> 7)) * 2 + (c4 & 1)) * 64 + ((c4 >> 1) & 63)] = ((const f32x4*)rwt)[k]; }
    WG_BAR();
    for (int tb = vcu; tb < M / 64; tb += G) {
        v4u nv[2];
        { const v4u* xr = (const v4u*)(xb + (size_t)(tb * 64 + wave * 8) * D) + lane;
          nv[0] = xr[0]; nv[1] = xr[64]; }
        for (int tk = 0; tk < 8; ++tk) {
            const int tl = wave * 8 + tk, row = tb * 64 + tl;
            f32x4 v[2][2]; float ss = 0.f;
#pragma unroll
            for (int j = 0; j < 2; ++j) {
                v[j][0] = (f32x4){bflo(nv[j].x), bfhi(nv[j].x), bflo(nv[j].y), bfhi(nv[j].y)}; v[j][1] = (f32x4){bflo(nv[j].z), bfhi(nv[j].z), bflo(nv[j].w), bfhi(nv[j].w)};
#pragma unroll
                for (int h = 0; h < 2; ++h) ss += (v[j][h][0] * v[j][h][0] + v[j][h][1] * v[j][h][1]) + (v[j][h][2] * v[j][h][2] + v[j][h][3] * v[j][h][3]);
            }
            if (tk + 1 < 8) { const v4u* xr = (const v4u*)(xb + (size_t)(row + 1) * D) + lane; nv[0] = xr[0]; nv[1] = xr[64]; }
            ss = wave_sum(ss);
            const float r = __builtin_amdgcn_rsqf(ss * (1.0f / 1024.0f) + EPS);
#pragma unroll
            for (int j = 0; j < 2; ++j) {
                u32x2 w = {0u, 0u};
                w.x = __builtin_amdgcn_cvt_pk_fp8_f32(v[j][0][0] * r, v[j][0][1] * r, w.x, false); w.x = __builtin_amdgcn_cvt_pk_fp8_f32(v[j][0][2] * r, v[j][0][3] * r, w.x, true);
                w.y = __builtin_amdgcn_cvt_pk_fp8_f32(v[j][1][0] * r, v[j][1][1] * r, w.y, false); w.y = __builtin_amdgcn_cvt_pk_fp8_f32(v[j][1][2] * r, v[j][1][3] * r, w.y, true);
                ((u32x2*)(xn8 + (size_t)row * D))[lane + 64 * j] = w;
            }
            float lg[NE];
#pragma unroll
            for (int e = 0; e < NE; ++e) {
                float a = 0.f;
#pragma unroll
                for (int j = 0; j < 2; ++j)
#pragma unroll
                    for (int h = 0; h < 2; ++h) { const f32x4 w = rw[((e * 2 + j) * 2 + h) * 64 + lane]; a += (v[j][h][0] * w[0] + v[j][h][1] * w[1]) + (v[j][h][2] * w[2] + v[j][h][3] * w[3]); }
                lg[e] = wave_sum(a) * r;
            }
            int e1 = 0; float v1 = lg[0];
#pragma unroll
            for (int e = 1; e < NE; ++e) if (lg[e] > v1) { v1 = lg[e]; e1 = e; }
            int e2 = -1; float v2 = -3.0e38f;
#pragma unroll
            for (int e = 0; e < NE; ++e) if (e != e1 && lg[e] > v2) { v2 = lg[e]; e2 = e; }
            const float w1 = fast_rcp(1.0f + __expf(v2 - v1)), w2 = 1.0f - w1;
            if (lane == 0) { tope[row * 2] = e1; tope[row * 2 + 1] = e2; topw[row * 2] = w1; topw[row * 2 + 1] = w2; tokr[row] = r; sel[tl * 2] = e1; sel[tl * 2 + 1] = e2; }
        }
        WG_BAR();
        if (tid < NE) {
            int c = 0;
            for (int k = 0; k < 128; ++k) if (sel[k] == tid) { topr[(tb * 64) * 2 + k] = c; ++c; }
            cnt[tb * NE + tid] = c;
        }
        WG_BAR();
    }
}
__device__ __forceinline__ void route_b(const unsigned char* xn8, const int* tope, const float* topw, const int* topr, const float* tokr, const int* cnt, unsigned char* xg, int* rowinfo, float* rowgate, float* rowr,
                                        LAS unsigned char* lds, LAS int* ldsctl, int vcu, int G) {
    PHASE_IDS();
    LAS int* ct = (LAS int*)lds;
    LAS int* tot = (LAS int*)(lds + 8192);
    for (int k = tid; k < 256 * NE; k += NTHREADS) ct[k] = cnt[k];
    WG_BAR();
    if (tid < NE) { int run = 0; for (int tb = 0; tb < 256; ++tb) { const int c = ct[tb * NE + tid]; ct[tb * NE + tid] = run; run += c; } tot[tid] = run; }
    WG_BAR();
    if (tid == 0) {
        int ts = 0;
        for (int e = 0; e < NE; ++e) { ldsctl[16 + e] = ts; tot[8 + e] = ts * 256; ts += (tot[e] + 255) >> 8; }
        ldsctl[24] = ts; ldsctl[25] = ts;
    }
    WG_BAR();
    for (int tb = vcu; tb < M / 64; tb += G) {
        int mypos = 0;
        {
            const int idx = wave * 16 + (lane & 15), tl = idx >> 1, slot = idx & 1, row = tb * 64 + tl;
            const int e = tope[row * 2 + slot];
            mypos = tot[8 + e] + ct[tb * NE + e] + topr[row * 2 + slot];
            if (lane < 16) { rowinfo[mypos] = slot * M + row; rowgate[mypos] = topw[row * 2 + slot]; rowr[mypos] = tokr[row]; }
        }
        v4u rowsv[8];
#pragma unroll
        for (int k = 0; k < 8; ++k) rowsv[k] = *((const v4u*)(xn8 + (size_t)(tb * 64 + wave * 8 + k) * D) + lane);
#pragma unroll
        for (int k = 0; k < 16; ++k) { const int pos = __builtin_amdgcn_readlane(mypos, k); *((v4u*)(xg + (size_t)pos * D) + lane) = rowsv[k >> 1]; }
    }
    for (int e = vcu; e < NE; e += G) {
        const int beg = tot[8 + e] + tot[e], end = tot[8 + e] + (((tot[e] + 255) >> 8) << 8);
        for (int pos = beg + wave; pos < end; pos += NWAVES) {
            *((v4u*)(xg + (size_t)pos * D) + lane) = (v4u){0u, 0u, 0u, 0u};
            if (lane == 0) { rowinfo[pos] = -1; rowgate[pos] = 0.f; rowr[pos] = 0.f; }
        }
    }
}
__device__ __forceinline__ void final_phase(const bf16* xb, const bf16* y, const float* fn, float* out, int vcu, int G) {
    PHASE_IDS();
    const int gw = vcu * NWAVES + wave, NGW = G * NWAVES;
    f32x4 gn[4];
#pragma unroll
    for (int j = 0; j < 4; ++j) gn[j] = ((const f32x4*)fn)[lane + 64 * j];
    for (int m0 = gw; m0 < M; m0 += 2 * NGW) {
        f32x4 v[2][4]; float ss[2]; bool ok[2];
#pragma unroll
        for (int k = 0; k < 2; ++k) {
            const int m = m0 + k * NGW; ok[k] = m < M; ss[k] = 0.f;
            if (ok[k]) {
                const u32x2* xr = (const u32x2*)(xb + (size_t)m * D) + lane;
                const u32x2* y0 = (const u32x2*)(y + (size_t)m * D) + lane;
                const u32x2* y1 = (const u32x2*)(y + (size_t)(M + m) * D) + lane;
#pragma unroll
                for (int j = 0; j < 4; ++j) {
                    const u32x2 a = y0[64 * j], b2 = y1[64 * j], x0 = xr[64 * j];
                    v[k][j] = (f32x4){bflo(x0.x) + (bflo(a.x) + bflo(b2.x)), bfhi(x0.x) + (bfhi(a.x) + bfhi(b2.x)), bflo(x0.y) + (bflo(a.y) + bflo(b2.y)), bfhi(x0.y) + (bfhi(a.y) + bfhi(b2.y))};
                    ss[k] += (v[k][j][0] * v[k][j][0] + v[k][j][1] * v[k][j][1]) + (v[k][j][2] * v[k][j][2] + v[k][j][3] * v[k][j][3]);
                }
            }
        }
#pragma unroll
        for (int k = 0; k < 2; ++k) ss[k] = wave_sum(ss[k]);
#pragma unroll
        for (int k = 0; k < 2; ++k) if (ok[k]) {
            const float r = __builtin_amdgcn_rsqf(ss[k] * (1.0f / 1024.0f) + EPS);
            f32x4* orow = (f32x4*)(out + (size_t)(m0 + k * NGW) * D) + lane;
#pragma unroll
            for (int j = 0; j < 4; ++j) orow[64 * j] = v[k][j] * r * gn[j];
        }
    }
}
struct Args { Ptrs p; };
static_assert(sizeof(Args) == 22 * 8, "Args has no padding");

__global__ void __launch_bounds__(NTHREADS, 2) yoco_fwd(Args args) {
    extern __shared__ __attribute__((aligned(16))) unsigned char lds_raw[];
    LAS unsigned char* lds = (LAS unsigned char*)lds_raw;
    const Ptrs& P = args.p;
    unsigned char* ws = P.ws;

    const int G = gridDim.x; const int bx = blockIdx.x;
    const int vcu = (G % 8 == 0) ? (bx % 8) * (G / 8) + bx / 8 : bx;
    LAS int* ldsctl = (LAS int*)(lds + LDSCTL_OFF);
    for (int k = threadIdx.x; k < (LDS_BYTES - LDSCTL_OFF) / 4; k += NTHREADS) ldsctl[k] = 0;
    __syncthreads();
    XcdBarrier bar = xcd_barrier_post((unsigned*)(ws + WS_CTL) + CW_BAR, (volatile LAS unsigned*)ldsctl);

    bf16* XB = (bf16*)(ws + WS_XB); float* SSP = (float*)(ws + WS_SSP);
    bf16* PROJ = (bf16*)(ws + WS_PROJ); bf16* KVQ = (bf16*)(ws + WS_KVQ);

    const float lambda_init = 0.8f - 0.6f * 0.7408182206817179f;

    p0_prologue(P, lds, vcu, G, lambda_init);
    xcd_barrier(bar);

    {
        pg8::Gemm g{XB, (const bf16*)(ws + WS_W_IN), M, RIN, D}; pg8::StaticOrder S; S.init(M, RIN, G, bx);
        pg8::EpiInProj E{PROJ, SSP, (const float*)(ws + WS_RCOS), (const float*)(ws + WS_RSIN)};
        pg8::gemm_phase<pg8::EpiInProj, pg8::StaticOrder, true, true>(lds, g, S, E);
    }
    xcd_barrier(bar);
    ret::scores_phase(PROJ, (bf16*)(ws + WS_S), lds, vcu, G);
    xcd_barrier(bar);
    ret::scan_phase(P, PROJ, (const bf16*)(ws + WS_S), (bf16*)(ws + WS_ORET), lds, vcu, G);
    xcd_barrier(bar);
    ret::norm_gate_phase((const bf16*)(ws + WS_ORET), PROJ, (bf16*)(ws + WS_RO), vcu, G);
    xcd_barrier(bar);
    {
        pg8::Gemm g{(const bf16*)(ws + WS_RO), (const bf16*)(ws + WS_W_RO), M, D, RVD}; pg8::StaticOrder S; S.init(M, D, G, bx);
        pg8::EpiResid<false> E{XB, XB, SSP};
        pg8::gemm_phase<pg8::EpiResid<false>, pg8::StaticOrder, true, true>(lds, g, S, E);
    }
    xcd_barrier(bar);
    {
        pg8::Gemm g{XB, (const bf16*)(ws + WS_W_GU), M, 2 * FF, D}; pg8::StaticOrder S; S.init(M, 2 * FF, G, bx);
        pg8::EpiSwiGLU<false> E{ws + WS_H, FF * 2, SSP, 1.0f, 1.0f};
        pg8::gemm_phase<pg8::EpiSwiGLU<false>, pg8::StaticOrder, true, true>(lds, g, S, E);
    }
    xcd_barrier(bar);
    {
        pg8::Gemm g{(const bf16*)(ws + WS_H), (const bf16*)(ws + WS_W_DN), M, D, FF}; pg8::StaticOrder S; S.init(M, D, G, bx);
        pg8::EpiResid<false> E{XB, XB, SSP};
        pg8::gemm_phase<pg8::EpiResid<false>, pg8::StaticOrder, true, true>(lds, g, S, E);
    }
    xcd_barrier(bar);
    {
        pg8::Gemm g{XB, (const bf16*)(ws + WS_W_KVQ), M, KVQ_N, D}; pg8::StaticOrder S; S.init(M, KVQ_N, G, bx);
        pg8::EpiKVQ E{KVQ, SSP, (const float*)(ws + WS_DCOS), (const float*)(ws + WS_DSIN), 0.125f * LOG2E};
        pg8::gemm_phase<pg8::EpiKVQ, pg8::StaticOrder, true, true>(lds, g, S, E);
    }
    xcd_barrier(bar);
    dat::attn_phase(KVQ, (bf16*)(ws + WS_AO), lds, P.lq1, P.lk1, P.lq2, P.lk2, lambda_init, vcu, G);
    xcd_barrier(bar);
    {
        pg8::Gemm g{(const bf16*)(ws + WS_AO), (const bf16*)(ws + WS_W_DO), M, D, D}; pg8::StaticOrder S; S.init(M, D, G, bx);
        pg8::EpiResid<false> E{XB, XB, SSP};
        pg8::gemm_phase<pg8::EpiResid<false>, pg8::StaticOrder, true, true>(lds, g, S, E);
    }
    xcd_barrier(bar);
    route_a(XB, (const float*)(ws + WS_RWT), (int*)(ws + WS_TOPE), (float*)(ws + WS_TOPW), (int*)(ws + WS_TOPR), (float*)(ws + WS_TOKR), (int*)(ws + WS_CNT), ws + WS_XN8, lds, vcu, G);
    xcd_barrier(bar);
    route_b(ws + WS_XN8, (const int*)(ws + WS_TOPE), (const float*)(ws + WS_TOPW), (const int*)(ws + WS_TOPR), (const float*)(ws + WS_TOKR), (const int*)(ws + WS_CNT), ws + WS_XG,
            (int*)(ws + WS_ROWINFO), (float*)(ws + WS_ROWGATE), (float*)(ws + WS_ROWR), lds, ldsctl, vcu, G);
    xcd_barrier(bar);
    {
        pg8::MoeOrder S; S.nM = __builtin_amdgcn_readfirstlane(((volatile LAS int*)ldsctl)[24]); S.nN = 2 * EF / 256; S.nwg = S.nM * S.nN; S.G = G; S.c = bx;
#pragma unroll
        for (int k = 0; k < 9; ++k) S.ts[k] = __builtin_amdgcn_readfirstlane(((volatile LAS int*)ldsctl)[16 + k]);
        pg8::Gemm g{(const bf16*)(ws + WS_XG), (const bf16*)(ws + WS_W_MGU), XG_ROWS, 2 * EF, D / 2};
        pg8::EpiSwiGLU<true> E{ws + WS_HM, EF, nullptr, 1.0f / MOE_WGU_SCALE, MOE_H_SCALE};
        pg8::gemm_phase<pg8::EpiSwiGLU<true>, pg8::MoeOrder, true, true, true>(lds, g, S, E);
    }
    xcd_barrier(bar);
    {
        pg8::MoeOrder S; S.nM = __builtin_amdgcn_readfirstlane(((volatile LAS int*)ldsctl)[24]); S.nN = D / 256; S.nwg = S.nM * S.nN; S.G = G; S.c = bx;
#pragma unroll
        for (int k = 0; k < 9; ++k) S.ts[k] = __builtin_amdgcn_readfirstlane(((volatile LAS int*)ldsctl)[16 + k]);
        pg8::Gemm g{(const bf16*)(ws + WS_HM), (const bf16*)(ws + WS_W_MDN), XG_ROWS, D, EF / 2};
        pg8::EpiMoeDown E{(bf16*)(ws + WS_Y), (const int*)(ws + WS_ROWINFO), (const float*)(ws + WS_ROWGATE), 1.0f / (MOE_WDN_SCALE * MOE_H_SCALE)};
        pg8::gemm_phase<pg8::EpiMoeDown, pg8::MoeOrder, true, true, true>(lds, g, S, E);
    }
    xcd_barrier(bar);
    final_phase(XB, (const bf16*)(ws + WS_Y), P.final_norm, P.out, vcu, G);
}

extern "C" void kernel_launch(void* const* d_in, const int* in_sizes, int n_in, void* d_out, int out_size, void* d_ws, size_t ws_size, hipStream_t stream) {
    static int grid = 0;
    if (grid == 0) {
        if (n_in != 20 || in_sizes[0] != M * D || out_size != M * D || ws_size < WS_END) { fprintf(stderr, "kernel_launch: unexpected shapes (n_in %d, in0 %d, out %d, ws %zu)\n", n_in, n_in > 0 ? in_sizes[0] : -1, out_size, ws_size); grid = -1; return; }
        int dev = 0, cus = 0, per_cu = 0;
        if (hipGetDevice(&dev) != hipSuccess || hipDeviceGetAttribute(&cus, hipDeviceAttributeMultiprocessorCount, dev) != hipSuccess) { grid = -1; return; }
        if (hipFuncSetAttribute((const void*)yoco_fwd, hipFuncAttributeMaxDynamicSharedMemorySize, LDS_BYTES) != hipSuccess) { fprintf(stderr, "kernel_launch: hipFuncSetAttribute failed\n"); grid = -1; return; }
        if (hipOccupancyMaxActiveBlocksPerMultiprocessor(&per_cu, (const void*)yoco_fwd, NTHREADS, LDS_BYTES) != hipSuccess || per_cu < 1) { fprintf(stderr, "kernel_launch: occupancy query reports %d\n", per_cu); }
        (void)hipGetLastError();
        grid = cus;
    }
    if (grid < 0) return;
    (void)hipMemsetAsync((char*)d_ws + WS_CTL, 0, CTL_ZERO_BYTES, stream);
    Args a{};
    const float** pp = (const float**)&a.p;
    for (int i = 0; i < 20; ++i) pp[i] = (const float*)d_in[i];
    a.p.out = (float*)d_out; a.p.ws = (unsigned char*)d_ws;
    hipLaunchKernelGGL(yoco_fwd, dim3(grid), dim3(NTHREADS), LDS_BYTES, stream, a);
}
```

```cpp
#include <hip/hip_runtime.h>
#include <hip/hip_bf16.h>
#include <cstdio>
#include <cstdint>
#include <cmath>
namespace pg8 {
#define PG8_LAS __attribute__((address_space(3)))
typedef unsigned short bf16_t;
typedef short bf16x8 __attribute__((ext_vector_type(8)));
typedef float f32x4 __attribute__((ext_vector_type(4)));
typedef unsigned u32x4 __attribute__((ext_vector_type(4)));
constexpr int BM = 256, BK = 64, HALF = 128, HTB = HALF * BK * 2  , STAGE_BYTES = 8 * HTB, NXCD = 8, WGM = 8;

__host__ __device__ __forceinline__ int lds_byte(int r, int c) { const int st = (r >> 4) * 2 + (c >> 5), rr = r & 15, cc = c & 31, ob = rr * 64 + cc * 2; return st * 1024 + (ob ^ (((ob >> 9) & 1) << 5)); }
__host__ __device__ __forceinline__ void stage_rc(int b, int& R, int& C) { const int st = b / 1024, sb = b % 1024, swz = sb ^ (((sb >> 9) & 1) << 5); R = (st >> 1) * 16 + swz / 64; C = (st & 1) * 32 + (swz % 64) / 2; }
__host__ __device__ __forceinline__ int perm32(int rho) { const int n = rho >> 4, i = rho & 15; return 8 * (i >> 2) + 4 * n + (i & 3); }

struct Unit { int pm, pn, aux; };
struct Gemm { const bf16_t* A; const bf16_t* Bt; int M, N, K; };

struct StaticOrder {
    int nM, nN, nwg, G, c;
    __host__ __device__ void init(int M, int N, int G_, int c_) { nM = M / BM; nN = N / BM; nwg = nM * nN; G = G_; c = c_; }
    __host__ __device__ bool next(int i, Unit& u) const {
        const long L = (long)i * G + c; if (L >= nwg) return false;
        int wgid = (int)L; { const int q = nwg / NXCD, r = nwg % NXCD, xcd = wgid % NXCD, off = wgid / NXCD; wgid = (xcd < r ? xcd * (q + 1) : r * (q + 1) + (xcd - r) * q) + off; }
        const int nig = WGM * nN, gid = wgid / nig, fm = gid * WGM, gsz = (nM - fm) < WGM ? (nM - fm) : WGM;
        u.pm = fm + ((wgid % nig) % gsz); u.pn = (wgid % nig) / gsz; u.aux = u.pn; return true;
    }
    __device__ __forceinline__ void a_ready(const Unit&) const {}
    __device__ __forceinline__ void done(const Unit&) const {}
};

__device__ __forceinline__ unsigned cvt_pk_bf16(float lo, float hi) { unsigned r; asm volatile("v_cvt_pk_bf16_f32 %0, %1, %2" : "=v"(r) : "v"(lo), "v"(hi)); return r; }
typedef float f32x2 __attribute__((ext_vector_type(2)));
typedef int i32x4 __attribute__((ext_vector_type(4)));
typedef int i32x8 __attribute__((ext_vector_type(8)));
__device__ __forceinline__ i32x8 cat8i(bf16x8 a, bf16x8 b) { const i32x4 x = __builtin_bit_cast(i32x4, a), y = __builtin_bit_cast(i32x4, b); return __builtin_shufflevector(x, y, 0, 1, 2, 3, 4, 5, 6, 7); }
template <class Epi, class Sched, bool ALIGN_EPI = false, bool SP2 = false, bool FP8 = false>
__device__ __forceinline__ void gemm_phase(PG8_LAS unsigned char* lds, const Gemm g, const Sched& S, const Epi& E) {
    int tid = threadIdx.x; asm volatile("" : "+v"(tid)); const int wid = __builtin_amdgcn_readfirstlane(tid >> 6), lane = tid & 63, wr = wid >> 2, wc = wid & 3, fr = lane & 15, fq = lane >> 4;
    const int K = g.K, nt = K / BK;
    unsigned voffA[2], voffB[2];
#pragma unroll
    for (int i = 0; i < 2; ++i) { int R, C; stage_rc(tid * 16 + i * 8192, R, C); const int Rb = Epi::PERM ? ((R & ~31) + perm32(R & 31)) : R;
        voffA[i] = (unsigned)(R * K + C) * 2u; voffB[i] = (unsigned)(Rb * K + C) * 2u; }
    const size_t kstep = (size_t)(BK * 2);
    const size_t hstep = (size_t)HALF * K * 2;
    const size_t tstep = 2 * hstep;
    const unsigned ldsw = (unsigned)wid * 1024u;
    const int aoff = lds_byte(wr * 64 + fr, fq * 8), boff = lds_byte(wc * 32 + fr, fq * 8);
#define PG8_SA(b, h) (((b) * 2 + (h)) * HTB)
#define PG8_SB(b, h) ((4 + (b) * 2 + (h)) * HTB)
#define PG8_STAGE(bufoff, gbase, voff) do { _Pragma("unroll") for (int _i = 0; _i < 2; ++_i) \
        __builtin_amdgcn_global_load_lds((const unsigned*)((const char*)(gbase) + (voff)[_i]), (PG8_LAS unsigned*)(lds + (bufoff) + ldsw + _i * 8192), 16, 0, 0); } while (0)
#define PG8_LDA(dst, b, h) do { _Pragma("unroll") for (int m = 0; m < 4; ++m) _Pragma("unroll") for (int k = 0; k < 2; ++k) dst[m][k] = *(const PG8_LAS bf16x8*)(lds + PG8_SA(b, h) + aoff + m * 2048 + k * 1024); } while (0)
#define PG8_LDB(dst, b, h) do { _Pragma("unroll") for (int n = 0; n < 2; ++n) _Pragma("unroll") for (int k = 0; k < 2; ++k) dst[n][k] = *(const PG8_LAS bf16x8*)(lds + PG8_SB(b, h) + boff + n * 2048 + k * 1024); } while (0)
#define PG8_MMA(ai, bj, At, Bt) do { __builtin_amdgcn_s_setprio(1); \
        if constexpr (FP8) { _Pragma("unroll") for (int m = 0; m < 4; ++m) _Pragma("unroll") for (int n = 0; n < 2; ++n) \
            asm volatile("v_mfma_scale_f32_16x16x128_f8f6f4 %0, %1, %2, %0, %3, %3 op_sel_hi:[0,0,0]" : "+v"(acc[ai][bj][m][n]) : "v"(cat8i(Bt[n][0], Bt[n][1])), "v"(cat8i(At[m][0], At[m][1])), "v"(fp8_unit_scale)); } \
        else { _Pragma("unroll") for (int m = 0; m < 4; ++m) _Pragma("unroll") for (int n = 0; n < 2; ++n) _Pragma("unroll") for (int k = 0; k < 2; ++k) \
            acc[ai][bj][m][n] = __builtin_amdgcn_mfma_f32_16x16x32_bf16(Bt[n][k], At[m][k], acc[ai][bj][m][n], 0, 0, 0); } \
        __builtin_amdgcn_s_setprio(0); } while (0)
#define PG8_WAIT_V(n) asm volatile("s_waitcnt vmcnt(" #n ")" ::: "memory")
#define PG8_WAIT_L(n) asm volatile("s_waitcnt lgkmcnt(" #n ")" ::: "memory")
#define PG8_BAR __builtin_amdgcn_s_barrier()
#define PG8_SCHED __builtin_amdgcn_sched_barrier(0)
    const int fp8_unit_scale = 0x7f7f7f7f; (void)fp8_unit_scale;
    Unit cur, nxt; int ui = 0;
    if (!S.next(0, cur)) return;
    f32x4 acc[2][2][4][2];
#pragma unroll
    for (int a = 0; a < 2; ++a)
#pragma unroll
        for (int b = 0; b < 2; ++b)
#pragma unroll
            for (int m = 0; m < 4; ++m)
#pragma unroll
                for (int n = 0; n < 2; ++n) acc[a][b][m][n] = (f32x4){0.f, 0.f, 0.f, 0.f};
    bf16x8 At[4][2], B0[2][2], B1[2][2];
    const char* cA = (const char*)g.A + (size_t)cur.pm * tstep; const char* cB = (const char*)g.Bt + (size_t)cur.pn * tstep;
    S.a_ready(cur);
    if constexpr (SP2) {
        PG8_STAGE(PG8_SB(0, 0), cB, voffB); PG8_STAGE(PG8_SB(0, 1), cB + hstep, voffB); PG8_STAGE(PG8_SA(0, 0), cA, voffA); PG8_STAGE(PG8_SA(0, 1), cA + hstep, voffA);
        if (wr == 1) PG8_BAR;
        PG8_WAIT_V(2); PG8_BAR;
        PG8_STAGE(PG8_SB(1, 0), cB + kstep, voffB); PG8_STAGE(PG8_SA(1, 0), cA + kstep, voffA); PG8_STAGE(PG8_SB(1, 1), cB + hstep + kstep, voffB);
        PG8_WAIT_V(6); PG8_BAR;
    } else {
        PG8_STAGE(PG8_SB(0, 0), cB, voffB); PG8_STAGE(PG8_SA(0, 0), cA, voffA); PG8_STAGE(PG8_SB(0, 1), cB + hstep, voffB); PG8_STAGE(PG8_SA(0, 1), cA + hstep, voffA);
        if (wr == 1) PG8_BAR;
        PG8_WAIT_V(4); PG8_BAR;
        PG8_STAGE(PG8_SB(1, 0), cB + kstep, voffB); PG8_STAGE(PG8_SA(1, 0), cA + kstep, voffA); PG8_STAGE(PG8_SB(1, 1), cB + hstep + kstep, voffB);
        PG8_WAIT_V(6); PG8_BAR;
    }
    for (;;) {
        const bool has_next = S.next(ui + 1, nxt);
        const char* nA = has_next ? (const char*)g.A + (size_t)nxt.pm * tstep : cA; const char* nB = has_next ? (const char*)g.Bt + (size_t)nxt.pn * tstep : cB;
        for (int t = 0; t < nt; t += 2) {
            const bool last = (t == nt - 2);
            const char* a1 = cA + (size_t)(t + 1) * kstep;
            const char* a2 = last ? nA : cA + (size_t)(t + 2) * kstep; const char* b2 = last ? nB : cB + (size_t)(t + 2) * kstep;
            const char* a3 = a2 + kstep; const char* b3 = b2 + kstep;
            if (last && has_next) S.a_ready(nxt);
            if constexpr (SP2) {
            PG8_LDB(B0, 0, 0); PG8_LDB(B1, 0, 1); PG8_SCHED; PG8_LDA(At, 0, 0); PG8_STAGE(PG8_SA(1, 1), a1 + hstep, voffA);
            PG8_WAIT_V(8); PG8_WAIT_L(0); PG8_BAR; PG8_MMA(0, 0, At, B0); PG8_MMA(0, 1, At, B1); PG8_BAR; PG8_SCHED;
            PG8_LDA(At, 0, 1); PG8_STAGE(PG8_SB(0, 0), b2, voffB); PG8_STAGE(PG8_SB(0, 1), b2 + hstep, voffB); PG8_STAGE(PG8_SA(0, 0), a2, voffA);
            PG8_WAIT_V(8); PG8_WAIT_L(0); PG8_BAR; PG8_MMA(1, 0, At, B0); PG8_MMA(1, 1, At, B1); PG8_BAR; PG8_SCHED;
            PG8_LDB(B0, 1, 0); PG8_LDB(B1, 1, 1); PG8_SCHED; PG8_LDA(At, 1, 0); PG8_STAGE(PG8_SA(0, 1), a2 + hstep, voffA);
            PG8_WAIT_V(8); PG8_WAIT_L(0); PG8_BAR; PG8_MMA(0, 0, At, B0); PG8_MMA(0, 1, At, B1); PG8_BAR; PG8_SCHED;
            PG8_LDA(At, 1, 1); PG8_STAGE(PG8_SB(1, 0), b3, voffB); PG8_STAGE(PG8_SB(1, 1), b3 + hstep, voffB); PG8_STAGE(PG8_SA(1, 0), a3, voffA);
            PG8_WAIT_V(8); PG8_WAIT_L(0); PG8_BAR; PG8_MMA(1, 0, At, B0); PG8_MMA(1, 1, At, B1); PG8_BAR; PG8_SCHED;
            } else {
            PG8_LDB(B0, 0, 0); PG8_SCHED; PG8_LDA(At, 0, 0); PG8_STAGE(PG8_SA(1, 1), a1 + hstep, voffA);
            PG8_WAIT_L(8); PG8_BAR; PG8_WAIT_L(0); PG8_MMA(0, 0, At, B0); PG8_BAR; PG8_SCHED;
            PG8_LDB(B1, 0, 1); PG8_STAGE(PG8_SB(0, 0), b2, voffB);
            PG8_BAR; PG8_WAIT_L(0); PG8_MMA(0, 1, At, B1); PG8_BAR;
            PG8_LDA(At, 0, 1); PG8_STAGE(PG8_SA(0, 0), a2, voffA);
            PG8_BAR; PG8_WAIT_L(0); PG8_MMA(1, 0, At, B0); PG8_BAR; PG8_SCHED;
            PG8_STAGE(PG8_SB(0, 1), b2 + hstep, voffB);
            PG8_WAIT_V(6); PG8_BAR; PG8_MMA(1, 1, At, B1); PG8_BAR;
            PG8_LDB(B0, 1, 0); PG8_SCHED; PG8_LDA(At, 1, 0); PG8_STAGE(PG8_SA(0, 1), a2 + hstep, voffA);
            PG8_WAIT_L(8); PG8_BAR; PG8_WAIT_L(0); PG8_MMA(0, 0, At, B0); PG8_BAR; PG8_SCHED;
            PG8_LDB(B1, 1, 1); PG8_STAGE(PG8_SB(1, 0), b3, voffB);
            PG8_BAR; PG8_WAIT_L(0); PG8_MMA(0, 1, At, B1); PG8_BAR;
            PG8_LDA(At, 1, 1); PG8_STAGE(PG8_SA(1, 0), a3, voffA);
            PG8_BAR; PG8_WAIT_L(0); PG8_MMA(1, 0, At, B0); PG8_BAR; PG8_SCHED;
            PG8_STAGE(PG8_SB(1, 1), b3 + hstep, voffB);
            PG8_WAIT_V(6); PG8_BAR; PG8_MMA(1, 1, At, B1); PG8_BAR;
            }
        }
        if constexpr (ALIGN_EPI) { if (wr == 0) PG8_BAR; }
        if constexpr (FP8) asm volatile("s_nop 15\n\ts_nop 15" ::: "memory");
        if constexpr (!Epi::AFTER_DRAIN) { E(acc, cur, wr, wc, fr, fq); S.done(cur); }
        if (!has_next) break;
#pragma unroll
        for (int a = 0; a < 2; ++a)
#pragma unroll
            for (int b = 0; b < 2; ++b)
#pragma unroll
                for (int m = 0; m < 4; ++m)
#pragma unroll
                    for (int n = 0; n < 2; ++n) acc[a][b][m][n] = (f32x4){0.f, 0.f, 0.f, 0.f};
        cur = nxt; cA = nA; cB = nB; ++ui;
        if constexpr (ALIGN_EPI) { if (wr == 1) PG8_BAR; }
    }
    PG8_WAIT_V(0);
    if constexpr (!ALIGN_EPI) { if (wr == 0) PG8_BAR; }
    PG8_BAR;
    if constexpr (Epi::AFTER_DRAIN) { E.fused(acc, cur, wr, wc, fr, fq, lds, wid, lane); S.done(cur); }
#undef PG8_SA
#undef PG8_SB
#undef PG8_STAGE
#undef PG8_LDA
#undef PG8_LDB
#undef PG8_MMA
#undef PG8_WAIT_V
#undef PG8_WAIT_L
#undef PG8_BAR
#undef PG8_SCHED
}
}
#define GAS __attribute__((address_space(1)))
#define LAS __attribute__((address_space(3)))
typedef unsigned short bf16;
typedef unsigned v4u __attribute__((ext_vector_type(4)));
typedef float f32x4 __attribute__((ext_vector_type(4)));
typedef short bf16x8 __attribute__((ext_vector_type(8)));
typedef GAS unsigned gu32;
typedef GAS unsigned long long gu64;
#define RLX_AGENT __ATOMIC_RELAXED, __HIP_MEMORY_SCOPE_AGENT
#define LDS_WAIT() asm volatile("s_waitcnt lgkmcnt(0)" ::: "memory")
#define VM_WAIT() asm volatile("s_waitcnt vmcnt(0)" ::: "memory")
__device__ __forceinline__ unsigned long long rt() { return __builtin_amdgcn_s_memrealtime(); }
__device__ __forceinline__ unsigned f2bf(float f) { unsigned u = __builtin_bit_cast(unsigned, f); return (u + 0x7fffu + ((u >> 16) & 1u)) >> 16; }
__device__ __forceinline__ unsigned pk2(float lo, float hi) { unsigned r; asm("v_cvt_pk_bf16_f32 %0, %1, %2" : "=v"(r) : "v"(lo), "v"(hi)); return r; }

#define XB_TMO      128
#define XB_XCNT(j)  (256  + 64 * (j))
#define XB_XSUB(j)  (1280 + 64 * (j))
#define XB_XGEN(j)  (2304 + 64 * (j))
#define XB_TOP      3328
#define XB_TOPGEN   3392
#define XCD_BAR_WORDS 3456
#define XB_SPIN_CAP (1u << 18)

__device__ __forceinline__ unsigned xb_ld(unsigned* p)              { return __hip_atomic_load(p, __ATOMIC_RELAXED, __HIP_MEMORY_SCOPE_AGENT); }
__device__ __forceinline__ unsigned xb_add(unsigned* p, unsigned v) { return __hip_atomic_fetch_add(p, v, __ATOMIC_RELAXED, __HIP_MEMORY_SCOPE_AGENT); }
__device__ __forceinline__ unsigned xb_xcc_id() { return (unsigned)__builtin_amdgcn_s_getreg((3 << 11) | 20) & 0xFu; }
#define XB_SPIN(cond, bar) do { unsigned _sp = 0; while (cond) { __builtin_amdgcn_s_sleep(1); \
    if ((++_sp & 255u) == 0u) { if (xb_ld(&(bar)[XB_TMO])) break; if (_sp > XB_SPIN_CAP) { atomicAdd(&(bar)[XB_TMO], 1u); break; } } } } while (0)

struct XcdBarrier {
    unsigned* bar; unsigned x;
    volatile LAS unsigned* st;
};

__device__ __forceinline__ XcdBarrier xcd_barrier_post(unsigned* bar, volatile LAS unsigned* st) {
    XcdBarrier b; b.bar = bar; b.x = xb_xcc_id(); b.st = st;
    if (threadIdx.x == 0) (void)xb_add(&bar[XB_XCNT(b.x)], 1u);
    return b;
}
__device__ __forceinline__ void xcd_barrier_complete(unsigned* bar, unsigned x, unsigned& nloc, unsigned& nx) {
    const unsigned G = gridDim.x * gridDim.y * gridDim.z;
    unsigned sum, cnt, mine, sp = 0u;
    for (;;) {
        sum = 0u; cnt = 0u; mine = 0u;
#pragma unroll
        for (unsigned j = 0; j < 16; ++j) { const unsigned c = xb_ld(&bar[XB_XCNT(j)]); sum += c; cnt += (c > 0u) ? 1u : 0u; mine = (j == x) ? c : mine; }
        if (sum == G) break;
        __builtin_amdgcn_s_sleep(1);
        if ((++sp & 255u) == 0u) { if (xb_ld(&bar[XB_TMO])) break; if (sp > XB_SPIN_CAP) { atomicAdd(&bar[XB_TMO], 1u); break; } }
    }
    nloc = mine > 0u ? mine : 1u; nx = cnt > 0u ? cnt : 1u;
}

__device__ __forceinline__ void xcd_barrier(const XcdBarrier& b) {
    asm volatile("s_waitcnt vmcnt(0)" ::: "memory");
    __syncthreads();
    if (threadIdx.x == 0) {
        unsigned* bar = b.bar;
        __builtin_amdgcn_s_waitcnt(0);
        unsigned nloc = b.st[0], nx = b.st[1];
        if (nloc == 0u) { xcd_barrier_complete(bar, b.x, nloc, nx); b.st[0] = nloc; b.st[1] = nx; }
        const unsigned old = xb_add(&bar[XB_XSUB(b.x)], 1u);
        const unsigned gen = old / nloc;
        if (old + 1u == (gen + 1u) * nloc) {
            __builtin_amdgcn_fence(__ATOMIC_RELEASE, "agent");
            asm volatile("s_waitcnt vmcnt(0)" ::: "memory");
            const unsigned og = xb_add(&bar[XB_TOP], 1u);
            const unsigned tg = og / nx;
            if (og + 1u == (tg + 1u) * nx) xb_add(&bar[XB_TOPGEN], 1u);
            else XB_SPIN(xb_ld(&bar[XB_TOPGEN]) == tg, bar);
            __builtin_amdgcn_fence(__ATOMIC_ACQUIRE, "agent");
            xb_add(&bar[XB_XGEN(b.x)], 1u);
            asm volatile("s_waitcnt vmcnt(0)" ::: "memory");
        } else {
            XB_SPIN(xb_ld(&bar[XB_XGEN(b.x)]) == gen, bar);
            __builtin_amdgcn_fence(__ATOMIC_ACQUIRE, "agent");
            asm volatile("s_waitcnt vmcnt(0)" ::: "memory");
        }
    }
    __syncthreads();
}

constexpr int BATCH = 4, SEQ = 4096, D = 1024, M = BATCH * SEQ;
constexpr int RIN = 6144, RVD = 2048;
constexpr int FF = 2816, EF = 3584, NE = 8;
constexpr int KVQ_N = 3072;
constexpr float EPS = 1e-6f;
constexpr float LOG2E = 1.4426950408889634f;

typedef short s16x4 __attribute__((ext_vector_type(4)));
typedef float f32x16 __attribute__((ext_vector_type(16)));
typedef unsigned u32x2 __attribute__((ext_vector_type(2)));

__device__ __forceinline__ float bf2f(unsigned short h) { return __uint_as_float(((unsigned)h) << 16); }
__device__ __forceinline__ float bflo(unsigned w) { return __uint_as_float(w << 16); }
__device__ __forceinline__ float bfhi(unsigned w) { return __uint_as_float(w & 0xffff0000u); }
__device__ __forceinline__ float fast_exp2(float x) { return __builtin_amdgcn_exp2f(x); }
__device__ __forceinline__ float fast_rcp(float x) { return __builtin_amdgcn_rcpf(x); }
__device__ __forceinline__ float silu_f(float x) { return x * fast_rcp(1.0f + fast_exp2(-x * LOG2E)); }
#define SWZ_XOR(v, m) __int_as_float(__builtin_amdgcn_ds_swizzle(__float_as_int(v), ((m) << 10) | 0x1f))
__device__ __forceinline__ float xor32_sum(float v) { auto rr = __builtin_amdgcn_permlane32_swap(__float_as_uint(v), __float_as_uint(v), false, false); return __uint_as_float(rr[0]) + __uint_as_float(rr[1]); }
__device__ __forceinline__ float wave_sum(float v) {
    v += SWZ_XOR(v, 1); v += SWZ_XOR(v, 2); v += SWZ_XOR(v, 4); v += SWZ_XOR(v, 8); v += SWZ_XOR(v, 16);
    return xor32_sum(v);
}

namespace pg8 {
__device__ __forceinline__ float rinv_from_ssp(const float* ssp, int row) {
    const f32x4* p = (const f32x4*)(ssp + (size_t)row * 16);
    const f32x4 a = p[0], b = p[1], c = p[2], d = p[3];
    const float s = (((a[0] + a[1]) + (a[2] + a[3])) + ((b[0] + b[1]) + (b[2] + b[3]))) + (((c[0] + c[1]) + (c[2] + c[3])) + ((d[0] + d[1]) + (d[2] + d[3])));
    return __builtin_amdgcn_rsqf(s * (1.0f / 1024.0f) + EPS);
}
__device__ __forceinline__ u32x4 pack8(const f32x4 a, const f32x4 b) {
    u32x4 w; w.x = cvt_pk_bf16(a[0], a[1]); w.y = cvt_pk_bf16(a[2], a[3]); w.z = cvt_pk_bf16(b[0], b[1]); w.w = cvt_pk_bf16(b[2], b[3]); return w;
}
struct EpiInProj {
    static constexpr bool PERM = true, AFTER_DRAIN = false;
    bf16_t* O; const float* ssp; const float* rcos; const float* rsin;
    __device__ __forceinline__ void operator()(const f32x4 (&acc)[2][2][4][2], const Unit& u, int wr, int wc, int fr, int fq) const {
        const int row0 = u.pm * BM + wr * 64 + fr;
        const int cl = wc * 32 + 8 * fq;
        const bool rope = u.pn < 8;
        const float ksc = (u.pn >= 4 && u.pn < 8) ? 0.0625f : 1.0f;
#pragma unroll
        for (int ai = 0; ai < 2; ++ai)
#pragma unroll
            for (int m = 0; m < 4; ++m) {
                const int row = row0 + ai * HALF + m * 16;
                const float r = rinv_from_ssp(ssp, row) * ksc;
                bf16_t* rowp = O + (size_t)row * RIN + u.pn * BM + cl;
                f32x4 a0 = acc[ai][0][m][0] * r, a1 = acc[ai][0][m][1] * r, b0 = acc[ai][1][m][0] * r, b1 = acc[ai][1][m][1] * r;
                if (rope) {
                    const int pos = row & (SEQ - 1);
                    const f32x4 c0 = *(const f32x4*)(rcos + pos * 128 + cl), c1 = *(const f32x4*)(rcos + pos * 128 + cl + 4);
                    const f32x4 s0 = *(const f32x4*)(rsin + pos * 128 + cl), s1 = *(const f32x4*)(rsin + pos * 128 + cl + 4);
                    const f32x4 x0 = a0 * c0 - b0 * s0, x1 = a1 * c1 - b1 * s1, y0 = b0 * c0 + a0 * s0, y1 = b1 * c1 + a1 * s1;
                    a0 = x0; a1 = x1; b0 = y0; b1 = y1;
                }
                *(u32x4*)(rowp) = pack8(a0, a1);
                *(u32x4*)(rowp + HALF) = pack8(b0, b1);
                if (m & 1) asm volatile("" ::: "memory");
            }
    }
};
template <bool FP8OUT> struct EpiSwiGLU {
    static constexpr bool PERM = true, AFTER_DRAIN = false;
    unsigned char* O; int ldb  ; const float* ssp; float cscale, oscale;
    __device__ __forceinline__ void operator()(const f32x4 (&acc)[2][2][4][2], const Unit& u, int wr, int wc, int fr, int fq) const {
        const int row0 = u.pm * BM + wr * 64 + fr;
        const int col = u.aux * HALF + wc * 32 + 8 * fq;
#pragma unroll
        for (int ai = 0; ai < 2; ++ai)
#pragma unroll
            for (int m = 0; m < 4; ++m) {
                const int row = row0 + ai * HALF + m * 16;
                const float r = ssp ? rinv_from_ssp(ssp, row) * cscale : cscale;
                const float k1 = -r * LOG2E, qv = fast_rcp(r * r * oscale), c0 = __builtin_amdgcn_logf(qv);
                f32x4 h0, h1;
#pragma unroll
                for (int j = 0; j < 4; ++j) {
                    h0[j] = (acc[ai][0][m][0][j] * acc[ai][1][m][0][j]) * fast_rcp(qv + fast_exp2(__builtin_fmaf(acc[ai][0][m][0][j], k1, c0)));
                    h1[j] = (acc[ai][0][m][1][j] * acc[ai][1][m][1][j]) * fast_rcp(qv + fast_exp2(__builtin_fmaf(acc[ai][0][m][1][j], k1, c0)));
                }
                if constexpr (FP8OUT) {
                    unsigned w0, w1; asm volatile("" : "=v"(w0), "=v"(w1));
                    w0 = __builtin_amdgcn_cvt_pk_fp8_f32(h0[0], h0[1], w0, false); w0 = __builtin_amdgcn_cvt_pk_fp8_f32(h0[2], h0[3], w0, true);
                    w1 = __builtin_amdgcn_cvt_pk_fp8_f32(h1[0], h1[1], w1, false); w1 = __builtin_amdgcn_cvt_pk_fp8_f32(h1[2], h1[3], w1, true);
                    *(u32x2*)(O + (size_t)row * ldb + col) = (u32x2){w0, w1};
                } else {
                    *(u32x4*)(O + (size_t)row * ldb + col * 2) = pack8(h0, h1);
                }
                if (m & 1) asm volatile("" ::: "memory");
            }
    }
};
template <bool BASE_F32>
struct EpiResid {
    static constexpr bool PERM = true, AFTER_DRAIN = false;
    const void* base; bf16_t* xb; float* ssp;
    __device__ __forceinline__ void operator()(const f32x4 (&acc)[2][2][4][2], const Unit& u, int wr, int wc, int fr, int fq) const {
        const int row0 = u.pm * BM + wr * 64 + fr;
        const int col0 = u.pn * BM + wc * 32 + 8 * fq;
#pragma unroll
        for (int ai = 0; ai < 2; ++ai)
#pragma unroll
            for (int m = 0; m < 4; ++m) {
                const int row = row0 + ai * HALF + m * 16;
                const size_t off = (size_t)row * D + col0;
                float ss = 0.f;
#pragma unroll
                for (int bj = 0; bj < 2; ++bj) {
                    const size_t c = off + bj * HALF;
                    f32x4 v0, v1;
                    if constexpr (BASE_F32) { v0 = *(const f32x4*)((const float*)base + c); v1 = *(const f32x4*)((const float*)base + c + 4); }
                    else { const u32x4 b = *(const u32x4*)((const bf16_t*)base + c); v0 = (f32x4){bflo(b.x), bfhi(b.x), bflo(b.y), bfhi(b.y)}; v1 = (f32x4){bflo(b.z), bfhi(b.z), bflo(b.w), bfhi(b.w)}; }
                    v0 += acc[ai][bj][m][0]; v1 += acc[ai][bj][m][1];
                    *(u32x4*)(xb + c) = pack8(v0, v1);
                    ss += ((v0[0] * v0[0] + v0[1] * v0[1]) + (v0[2] * v0[2] + v0[3] * v0[3])) + ((v1[0] * v1[0] + v1[1] * v1[1]) + (v1[2] * v1[2] + v1[3] * v1[3]));
                }
                ss += SWZ_XOR(ss, 16); ss = xor32_sum(ss);
                if (fq == 0) ssp[(size_t)row * 16 + u.pn * 4 + wc] = ss;
                asm volatile("" ::: "memory");
            }
    }
};
struct EpiKVQ {
    static constexpr bool PERM = true, AFTER_DRAIN = false;
    bf16_t* O; const float* ssp; const float* dcos; const float* dsin; float qscale;
    __device__ __forceinline__ void operator()(const f32x4 (&acc)[2][2][4][2], const Unit& u, int wr, int wc, int fr, int fq) const {
        const int row0 = u.pm * BM + wr * 64 + fr;
        const int cl = wc * 32 + 8 * fq;
        const int kind = u.pn >> 2;
        const bool ropelane = ((wc & 1) == 0) && (fq < 2);
#pragma unroll
        for (int ai = 0; ai < 2; ++ai)
#pragma unroll
            for (int m = 0; m < 4; ++m) {
                const int row = row0 + ai * HALF + m * 16;
                const float r = rinv_from_ssp(ssp, row) * (kind == 2 ? qscale : 1.0f);
                bf16_t* rowp = O + (size_t)row * KVQ_N + u.pn * BM + cl;
                f32x4 c0, c1, s0, s1;
                if (kind != 1) {
                    const int pos = row & (SEQ - 1);
                    c0 = *(const f32x4*)(dcos + pos * 8); c1 = *(const f32x4*)(dcos + pos * 8 + 4);
                    s0 = *(const f32x4*)(dsin + pos * 8); s1 = *(const f32x4*)(dsin + pos * 8 + 4);
                    if (fq != 0) { s0 = -s0; s1 = -s1; }
                }
#pragma unroll
                for (int bj = 0; bj < 2; ++bj) {
                    f32x4 v0 = acc[ai][bj][m][0] * r, v1 = acc[ai][bj][m][1] * r;
                    if (kind != 1) {
                        f32x4 p0, p1;
#pragma unroll
                        for (int j = 0; j < 4; ++j) { p0[j] = SWZ_XOR(v0[j], 16); p1[j] = SWZ_XOR(v1[j], 16); }
                        if (ropelane) { v0 = v0 * c0 - p0 * s0; v1 = v1 * c1 - p1 * s1; }
                    }
                    *(u32x4*)(rowp + bj * HALF) = pack8(v0, v1);
                }
                if (m & 1) asm volatile("" ::: "memory");
            }
    }
};
struct EpiMoeDown {
    static constexpr bool PERM = true, AFTER_DRAIN = false;
    bf16_t* Y; const int* rowinfo; const float* rowgate; float cscale;
    __device__ __forceinline__ void operator()(const f32x4 (&acc)[2][2][4][2], const Unit& u, int wr, int wc, int fr, int fq) const {
        const int row0 = u.pm * BM + wr * 64 + fr;
        const int cl = u.aux * BM + wc * 32 + 8 * fq;
#pragma unroll
        for (int ai = 0; ai < 2; ++ai)
#pragma unroll
            for (int m = 0; m < 4; ++m) {
                const int row = row0 + ai * HALF + m * 16;
                const int info = rowinfo[row];
                if (info >= 0) {
                    const float g = rowgate[row] * cscale;
                    bf16_t* rowp = Y + (size_t)info * D + cl;
                    *(u32x4*)(rowp) = pack8(acc[ai][0][m][0] * g, acc[ai][0][m][1] * g);
                    *(u32x4*)(rowp + HALF) = pack8(acc[ai][1][m][0] * g, acc[ai][1][m][1] * g);
                }
            }
    }
};
struct MoeOrder {
    int nM, nN, nwg, G, c; int ts[9];
    __device__ __forceinline__ bool next(int i, Unit& u) const {
        const long L = (long)i * G + c; if (L >= nwg) return false;
        int wgid = (int)L; { const int q = nwg / NXCD, r = nwg % NXCD, xcd = wgid % NXCD, off = wgid / NXCD; wgid = (xcd < r ? xcd * (q + 1) : r * (q + 1) + (xcd - r) * q) + off; }
        const int nig = WGM * nN, gid = wgid / nig, fm = gid * WGM, gsz = (nM - fm) < WGM ? (nM - fm) : WGM;
        const int pm = fm + ((wgid % nig) % gsz), pnl = (wgid % nig) / gsz;
        int e = 0;
#pragma unroll
        for (int k = 1; k < 8; ++k) e += (pm >= ts[k]) ? 1 : 0;
        u.pm = pm; u.pn = e * nN + pnl; u.aux = pnl; return true;
    }
    __device__ __forceinline__ void a_ready(const Unit&) const {}
    __device__ __forceinline__ void done(const Unit&) const {}
};
}
constexpr size_t MiB = 1u << 20;
constexpr size_t WS_CTL = 0, CTL_ZERO_BYTES = 1 * MiB;
constexpr size_t WS_RCOS = 1 * MiB, WS_RSIN = 3 * MiB;
constexpr size_t WS_DCOS = 5 * MiB, WS_DSIN = 5 * MiB + 256 * 1024;
constexpr size_t WS_SSP = 6 * MiB;
constexpr size_t WS_RWT = 7 * MiB;
constexpr size_t WS_TOPE = 8 * MiB;
constexpr size_t WS_TOPW = 8 * MiB + 128 * 1024;
constexpr size_t WS_TOPR = 8 * MiB + 256 * 1024;
constexpr size_t WS_TOKR = 8 * MiB + 384 * 1024;
constexpr size_t WS_CNT = 8 * MiB + 512 * 1024;
constexpr int XG_ROWS = 2 * M + NE * 256;
constexpr size_t WS_ROWINFO = 9 * MiB;
constexpr size_t WS_ROWGATE = 9 * MiB + 256 * 1024;
constexpr size_t WS_ROWR = 9 * MiB + 512 * 1024;
constexpr size_t WS_S = 10 * MiB;
constexpr size_t WS_W_IN = 20 * MiB, WS_W_RO = 32 * MiB, WS_W_GU = 36 * MiB, WS_W_DN = 47 * MiB, WS_W_KVQ = 53 * MiB, WS_W_DO = 59 * MiB, WS_W_MGU = 61 * MiB, WS_W_MDN = 173 * MiB;
constexpr size_t WS_XM = 232 * MiB;
constexpr size_t WS_XB = 296 * MiB;
constexpr size_t WS_PROJ = 328 * MiB;
constexpr size_t WS_RO = 520 * MiB;
constexpr size_t WS_ORET = 584 * MiB;
constexpr size_t WS_H = 328 * MiB;
constexpr size_t WS_KVQ = 584 * MiB;
constexpr size_t WS_AO = 680 * MiB;
constexpr size_t WS_Y = 712 * MiB;
constexpr size_t WS_HM = 328 * MiB;
constexpr size_t WS_XG = 584 * MiB;
constexpr size_t WS_XN8 = 776 * MiB;
constexpr size_t WS_END = 792 * MiB;
static_assert(WS_W_MDN + (size_t)NE * D * EF * 2 <= WS_XM && WS_HM + (size_t)XG_ROWS * EF * 2 <= WS_KVQ && WS_XG + (size_t)XG_ROWS * D * 2 <= WS_AO && WS_Y + (size_t)2 * M * D * 2 <= WS_END, "d_ws map");
constexpr float MOE_WGU_SCALE = 64.0f, MOE_WDN_SCALE = 128.0f, MOE_H_SCALE = 8.0f;
constexpr int CW_BAR = 4096;

constexpr int RING_BYTES = 131072;
constexpr int LDSCTL_OFF = RING_BYTES;
constexpr int LDS_BYTES = 147456;
constexpr int NWAVES = 8, NTHREADS = 512;

#define WG_BAR() do { asm volatile("s_waitcnt vmcnt(0) lgkmcnt(0)" ::: "memory"); __builtin_amdgcn_s_barrier(); asm volatile("" ::: "memory"); } while (0)

#define PHASE_IDS() int tid = threadIdx.x; asm volatile("" : "+v"(tid)); const int lane = tid & 63; const int wave = __builtin_amdgcn_readfirstlane(tid >> 6); (void)lane; (void)wave
struct TrBlk { const float* src; const float* gain; unsigned char* dst; int N, gmask, k0, ldb, fp8; float gscale; };
constexpr int TR_PITCH = 288;
__device__ __forceinline__ void tr_load(const TrBlk& B, f32x4 (&ld)[8], float (&gv)[8], int wave, int lane) {
#pragma unroll
    for (int j = 0; j < 8; ++j) {
        const int k = 16 * wave + 2 * j + (lane >> 5);
        ld[j] = *(const f32x4*)(B.src + (size_t)k * B.N + 4 * (lane & 31));
        gv[j] = B.gain ? B.gain[(B.k0 + k) & B.gmask] * B.gscale : B.gscale;
    }
}
__device__ __forceinline__ void tr_commit(const f32x4 (&ld)[8], const float (&gv)[8], LAS unsigned char* img, int wave, int lane) {
#pragma unroll
    for (int j = 0; j < 8; ++j) {
        const int k = 16 * wave + 2 * j + (lane >> 5);
        u32x2 w; w.x = pk2(ld[j][0] * gv[j], ld[j][1] * gv[j]); w.y = pk2(ld[j][2] * gv[j], ld[j][3] * gv[j]);
        *(LAS u32x2*)(img + k * TR_PITCH + 8 * (lane & 31)) = w;
    }
}
__device__ __forceinline__ void tr_emit(const TrBlk& B, LAS const unsigned char* img, int wave, int lane) {
    const int i = lane & 15, g = lane >> 4, q = i >> 2, p = i & 3;
#pragma unroll
    for (int kg = 0; kg < 4; ++kg) {
        const int kb = 8 * (4 * kg + g);
        const s16x4 lo = __builtin_bit_cast(s16x4, __builtin_amdgcn_ds_read_tr16_b64_v4i16((LAS s16x4*)(img + (kb + q) * TR_PITCH + (16 * wave + 4 * p) * 2)));
        const s16x4 hi = __builtin_bit_cast(s16x4, __builtin_amdgcn_ds_read_tr16_b64_v4i16((LAS s16x4*)(img + (kb + 4 + q) * TR_PITCH + (16 * wave + 4 * p) * 2)));
        if (!B.fp8) {
            v4u o; o.x = (unsigned)(unsigned short)lo[0] | ((unsigned)(unsigned short)lo[1] << 16); o.y = (unsigned)(unsigned short)lo[2] | ((unsigned)(unsigned short)lo[3] << 16);
            o.z = (unsigned)(unsigned short)hi[0] | ((unsigned)(unsigned short)hi[1] << 16); o.w = (unsigned)(unsigned short)hi[2] | ((unsigned)(unsigned short)hi[3] << 16);
            *(GAS v4u*)(B.dst + (size_t)(16 * wave + i) * B.ldb + kb * 2) = o;
        } else {
            unsigned w0 = 0u, w1 = 0u;
            w0 = __builtin_amdgcn_cvt_pk_fp8_f32(bf2f((unsigned short)lo[0]), bf2f((unsigned short)lo[1]), w0, false);
            w0 = __builtin_amdgcn_cvt_pk_fp8_f32(bf2f((unsigned short)lo[2]), bf2f((unsigned short)lo[3]), w0, true);
            w1 = __builtin_amdgcn_cvt_pk_fp8_f32(bf2f((unsigned short)hi[0]), bf2f((unsigned short)hi[1]), w1, false);
            w1 = __builtin_amdgcn_cvt_pk_fp8_f32(bf2f((unsigned short)hi[2]), bf2f((unsigned short)hi[3]), w1, true);
            *(GAS u32x2*)(B.dst + (size_t)(16 * wave + i) * B.ldb + kb) = (u32x2){w0, w1};
        }
    }
}

struct Ptrs {
    const float *x, *ln_mix, *ln_ffn, *ret_w_in, *ret_w_o, *kv_norm, *w_kv, *diff_w_q, *lq1, *lk1, *lq2, *lk2, *subln, *diff_w_o, *ffn_w_gu, *ffn_w_down, *router, *moe_w_gu, *moe_w_down, *final_norm;
    float* out; unsigned char* ws;
};

__device__ __forceinline__ void p0_prologue(const Ptrs& P, LAS unsigned char* lds, int vcu, int G, float lambda_init) {
    PHASE_IDS();
    unsigned char* ws = P.ws;
    const int gw = vcu * NWAVES + wave, NGW = G * NWAVES;
    {
        constexpr int B_IN = (D / 128) * (RIN / 128), B_RO = (RVD / 128) * (D / 128), B_GU = (D / 128) * (2 * FF / 128), B_DN = (FF / 128) * (D / 128), B_KV = (D / 128) * (2048 / 128), B_Q = (D / 128) * (D / 128), B_DO = B_Q;
        constexpr int NBLK = B_IN + B_RO + B_GU + B_DN + B_KV + B_Q + B_DO;
        auto decode = [&](int it) -> TrBlk {
            const float* W; const float* gain = nullptr; int K, N, gmask = 0, F = 0, row_off = 0, fp8 = 0; float gscale = 1.f; unsigned char* WT; int r = it;
            if (r < B_IN) { W = P.ret_w_in; K = D; N = RIN; gain = P.ln_mix; gmask = 1023; WT = ws + WS_W_IN; }
            else if ((r -= B_IN) < B_RO) { W = P.ret_w_o; K = RVD; N = D; WT = ws + WS_W_RO; }
            else if ((r -= B_RO) < B_GU) { W = P.ffn_w_gu; K = D; N = 2 * FF; gain = P.ln_ffn; gmask = 1023; F = FF; WT = ws + WS_W_GU; }
            else if ((r -= B_GU) < B_DN) { W = P.ffn_w_down; K = FF; N = D; WT = ws + WS_W_DN; }
            else if ((r -= B_DN) < B_KV) { W = P.w_kv; K = D; N = 2048; gain = P.kv_norm; gmask = 1023; WT = ws + WS_W_KVQ; }
            else if ((r -= B_KV) < B_Q) { W = P.diff_w_q; K = D; N = D; gain = P.ln_mix + D; gmask = 1023; row_off = 2048; WT = ws + WS_W_KVQ; }
            else if ((r -= B_Q) < B_DO) { W = P.diff_w_o; K = D; N = D; gain = P.subln; gmask = 127; gscale = 1.0f - lambda_init; WT = ws + WS_W_DO; }
            else { W = P.diff_w_o; K = D; N = D; WT = ws + WS_W_DO; }
            const int nblk = N / 128, kb = r / nblk, nb = r % nblk, k0 = 128 * kb, n0 = 128 * nb;
            int drow = n0;
            if (F > 0) { const int up = n0 >= F ? 1 : 0; const int f = n0 - up * F; drow = 256 * (f >> 7) + 128 * up; }
            TrBlk B; B.src = W + (size_t)k0 * N + n0; B.gain = gain; B.N = N; B.gmask = gmask; B.k0 = k0; B.ldb = fp8 ? K : K * 2; B.fp8 = fp8; B.gscale = gscale;
            B.dst = WT + ((size_t)(row_off + drow) * K + k0) * (fp8 ? 1 : 2);
            return B;
        };
#define LDS_BAR() do { asm volatile("s_waitcnt lgkmcnt(0)" ::: "memory"); __builtin_amdgcn_s_barrier(); asm volatile("" ::: "memory"); } while (0)
        LAS unsigned char* img0 = lds; LAS unsigned char* img1 = lds + 128 * TR_PITCH;
        f32x4 ldA[8], ldB[8]; float gvA[8], gvB[8];
        int it = vcu;
        TrBlk bA = decode(it < NBLK ? it : 0), bB = decode(it + G < NBLK ? it + G : 0);
        if (it < NBLK) tr_load(bA, ldA, gvA, wave, lane);
        if (it + G < NBLK) tr_load(bB, ldB, gvB, wave, lane);
        for (; it < NBLK; it += 2 * G) {
            tr_commit(ldA, gvA, img0, wave, lane);
            LDS_BAR();
            const TrBlk cA = bA; const int n2 = it + 2 * G;
            bA = decode(n2 < NBLK ? n2 : 0);
            if (n2 < NBLK) tr_load(bA, ldA, gvA, wave, lane);
            tr_emit(cA, img0, wave, lane);
            if (it + G < NBLK) {
                tr_commit(ldB, gvB, img1, wave, lane);
                LDS_BAR();
                const TrBlk cB = bB; const int n3 = it + 3 * G;
                bB = decode(n3 < NBLK ? n3 : 0);
                if (n3 < NBLK) tr_load(bB, ldB, gvB, wave, lane);
                tr_emit(cB, img1, wave, lane);
            }
        }
        LDS_BAR();
#undef LDS_BAR
    }
    {
        const int gt = gw * 64 + lane, NT = NGW * 64;
        float* rc = (float*)(ws + WS_RCOS); float* rs = (float*)(ws + WS_RSIN);
        for (int i = gt; i < SEQ * 128; i += NT) {
            const int pos = i >> 7, f = i & 127;
            const float inv = exp2f(-(float)f * (13.287712379549449f / 128.0f));
            const double rev = (double)((float)pos * inv) * 0.15915494309189535;
            const float fr = (float)(rev - floor(rev));
            rc[i] = __builtin_amdgcn_cosf(fr); rs[i] = __builtin_amdgcn_sinf(fr);
        }
        float* dc = (float*)(ws + WS_DCOS); float* ds = (float*)(ws + WS_DSIN);
        for (int i = gt; i < SEQ * 8; i += NT) {
            const int pos = i >> 3, f = i & 7;
            const float inv = exp2f(-(float)f * (18.931568569324174f / 8.0f));
            const double rev = (double)((float)pos * inv) * 0.15915494309189535;
            const float fr = (float)(rev - floor(rev));
            dc[i] = __builtin_amdgcn_cosf(fr); ds[i] = __builtin_amdgcn_sinf(fr);
        }
        float* rwt = (float*)(ws + WS_RWT);
        for (int i = gt; i < NE * D; i += NT) { const int e = i >> 10, k = i & 1023; rwt[i] = P.router[k * NE + e] * P.ln_ffn[D + k]; }
    }
    {
        bf16* xb = (bf16*)(ws + WS_XB); float* ssp = (float*)(ws + WS_SSP);
        f32x4 nv[4];
        if (gw < M) { const GAS f32x4* xr = (const GAS f32x4*)(P.x + (size_t)gw * D) + lane;
#pragma unroll
            for (int j = 0; j < 4; ++j) nv[j] = xr[64 * j]; }
        for (int m = gw; m < M; m += NGW) {
            f32x4 v[4]; float s = 0.f;
#pragma unroll
            for (int j = 0; j < 4; ++j) { v[j] = nv[j]; s += (v[j].x * v[j].x + v[j].y * v[j].y) + (v[j].z * v[j].z + v[j].w * v[j].w); }
            if (m + NGW < M) { const GAS f32x4* xr = (const GAS f32x4*)(P.x + (size_t)(m + NGW) * D) + lane;
#pragma unroll
                for (int j = 0; j < 4; ++j) nv[j] = xr[64 * j]; }
            s = wave_sum(s);
            GAS unsigned long long* o8 = (GAS unsigned long long*)(xb + (size_t)m * D) + lane;
#pragma unroll
            for (int j = 0; j < 4; ++j) o8[64 * j] = (unsigned long long)pk2(v[j].x, v[j].y) | ((unsigned long long)pk2(v[j].z, v[j].w) << 32);
            if (lane < 16) ssp[(size_t)m * 16 + lane] = lane == 0 ? s : 0.f;
        }
    }
}

constexpr int CV_BLKS_GU = NE * (D / 128) * (2 * EF / 128), CV_BLKS_DN = NE * (EF / 128) * (D / 128), CV_BLKS = CV_BLKS_GU + CV_BLKS_DN;
constexpr int CV_PITCH = 272, CV_IMG = 32 * CV_PITCH;
struct CvMini { const float* src; unsigned char* dst; int N, ldb, kg; };
__device__ __forceinline__ CvMini cv_decode(const Ptrs& P, int blk, int qk) {
    CvMini m;
    if (blk < CV_BLKS_GU) {
        const int e = blk / 448, r = blk % 448, kb = r / 56, nb = r % 56, k0 = 128 * kb + 32 * qk, n0 = 128 * nb;
        const int up = n0 >= EF ? 1 : 0, f = n0 - up * EF, drow = 256 * (f >> 7) + 128 * up;
        m.src = P.moe_w_gu + (size_t)e * D * 2 * EF + (size_t)k0 * (2 * EF) + n0; m.kg = k0; m.N = 2 * EF;
        m.dst = P.ws + WS_W_MGU + (size_t)e * 2 * EF * D + (size_t)drow * D + k0; m.ldb = D;
    } else {
        const int b2 = blk - CV_BLKS_GU, e = b2 / 224, r = b2 % 224, kb = r / 8, nb = r % 8, k0 = 128 * kb + 32 * qk, n0 = 128 * nb;
        m.src = P.moe_w_down + (size_t)e * EF * D + (size_t)k0 * D + n0; m.kg = -1; m.N = D;
        m.dst = P.ws + WS_W_MDN + (size_t)e * D * EF + (size_t)n0 * EF + k0; m.ldb = EF;
    }
    return m;
}
__device__ __forceinline__ void cv_load(const CvMini& m, f32x4 (&v)[2], int tid) {
#pragma unroll
    for (int j = 0; j < 2; ++j) { const int row = (tid >> 5) + 16 * j; v[j] = __builtin_nontemporal_load((const f32x4*)(m.src + (size_t)row * m.N + 4 * (tid & 31))); }
}
__device__ __forceinline__ void cv_commit(const f32x4 (&v)[2], int kg, LAS const float* gtab, LAS unsigned char* img, int tid) {
#pragma unroll
    for (int j = 0; j < 2; ++j) { const int row = (tid >> 5) + 16 * j;
        const float gn = kg >= 0 ? gtab[kg + row] : MOE_WDN_SCALE;
        u32x2 w; w.x = pk2(v[j][0] * gn, v[j][1] * gn); w.y = pk2(v[j][2] * gn, v[j][3] * gn);
        *(LAS u32x2*)(img + row * CV_PITCH + 8 * (tid & 31)) = w; }
}
__device__ __forceinline__ void cv_emit(unsigned char* dst, int ldb, LAS const unsigned char* img, int wave, int lane) {
    const int i = lane & 15, g4 = lane >> 4, q = i >> 2, p = i & 3;
    const s16x4 lo = __builtin_bit_cast(s16x4, __builtin_amdgcn_ds_read_tr16_b64_v4i16((LAS s16x4*)(img + (8 * g4 + q) * CV_PITCH + (16 * wave + 4 * p) * 2)));
    const s16x4 hi = __builtin_bit_cast(s16x4, __builtin_amdgcn_ds_read_tr16_b64_v4i16((LAS s16x4*)(img + (8 * g4 + 4 + q) * CV_PITCH + (16 * wave + 4 * p) * 2)));
    unsigned w0, w1; asm volatile("" : "=v"(w0), "=v"(w1));
    w0 = __builtin_amdgcn_cvt_pk_fp8_f32(bf2f((unsigned short)lo[0]), bf2f((unsigned short)lo[1]), w0, false); w0 = __builtin_amdgcn_cvt_pk_fp8_f32(bf2f((unsigned short)lo[2]), bf2f((unsigned short)lo[3]), w0, true);
    w1 = __builtin_amdgcn_cvt_pk_fp8_f32(bf2f((unsigned short)hi[0]), bf2f((unsigned short)hi[1]), w1, false); w1 = __builtin_amdgcn_cvt_pk_fp8_f32(bf2f((unsigned short)hi[2]), bf2f((unsigned short)hi[3]), w1, true);
    *(GAS u32x2*)(dst + (size_t)(16 * wave + i) * ldb + 8 * g4) = (u32x2){w0, w1};
}

namespace ret {
typedef short v4i16_t __attribute__((ext_vector_type(4)));
__device__ __forceinline__ s16x4 trld(LAS const unsigned char* p) { return __builtin_bit_cast(s16x4, __builtin_amdgcn_ds_read_tr16_b64_v4i16((LAS v4i16_t*)p)); }
__device__ __forceinline__ bf16x8 cat8(s16x4 lo, s16x4 hi) { return (bf16x8){lo[0], lo[1], lo[2], lo[3], hi[0], hi[1], hi[2], hi[3]}; }
constexpr int QSTR = 528, SSTR = 144;
constexpr int LQ = 0, LK = LQ + 64 * QSTR, LV = LK + 64 * 512, LVD = LV + 4096, LS = LVD + 4096, LST = LS + 64 * SSTR, LEND = LST + 32 * QSTR;
static_assert(LEND + 2 * 32 * 272 + 4096 <= RING_BYTES && (LK % 16) == 0 && (LV % 16) == 0 && (LS % 16) == 0 && (LST % 16) == 0, "retention LDS map");

__device__ __forceinline__ void scores_phase(const bf16* proj, bf16* sbuf, LAS unsigned char* lds, int vcu, int G) {
    PHASE_IDS();
    const int i = lane & 15, g = lane >> 4;
    const int srow = tid >> 5, sc16 = tid & 31;
    constexpr int SQ = 0, SK = 64 * QSTR;
    for (int u = vcu; u < 1024; u += G) {
        const int bh = u >> 6, c = u & 63, b = bh >> 2, h = bh & 3;
        const size_t R0 = (size_t)b * SEQ + c * 64;
        const float lg = log2f(1.0f - exp2f(-5.0f - (float)h));
        const bf16* gq = proj + (R0 + srow) * RIN + h * 256 + sc16 * 8;
        v4u tq[4], tk[4];
#pragma unroll
        for (int k = 0; k < 4; ++k) { tq[k] = *(const v4u*)(gq + (size_t)(16 * k) * RIN); tk[k] = *(const v4u*)(gq + 1024 + (size_t)(16 * k) * RIN); }
#pragma unroll
        for (int k = 0; k < 4; ++k) { *(LAS v4u*)(lds + SQ + (srow + 16 * k) * QSTR + sc16 * 16) = tq[k]; *(LAS v4u*)(lds + SK + (srow + 16 * k) * QSTR + sc16 * 16) = tk[k]; }
        WG_BAR();
#pragma unroll
        for (int tt = 0; tt < 2; ++tt) {
            const int ti = 2 * wave + tt, tn = ti >> 2, tm = ti & 3;
            f32x4 acc = (f32x4){0.f, 0.f, 0.f, 0.f};
            if (tm <= tn) {
#pragma unroll
                for (int s = 0; s < 8; ++s) {
                    const bf16x8 a = *(const LAS bf16x8*)(lds + SK + (16 * tm + i) * QSTR + (32 * s + 8 * g) * 2), bq = *(const LAS bf16x8*)(lds + SQ + (16 * tn + i) * QSTR + (32 * s + 8 * g) * 2);
                    acc = __builtin_amdgcn_mfma_f32_16x16x32_bf16(a, bq, acc, 0, 0, 0);
                }
            }
            const int n = 16 * tn + i, m0 = 16 * tm + 4 * g;
            float v[4];
#pragma unroll
            for (int r = 0; r < 4; ++r) { const int dm = n - (m0 + r); v[r] = dm >= 0 ? acc[r] * exp2f((float)dm * lg) : 0.f; }
            u32x2 w; w.x = pk2(v[0], v[1]); w.y = pk2(v[2], v[3]);
            *(u32x2*)(sbuf + (size_t)u * 4096 + n * 64 + m0) = w;
        }
        WG_BAR();
    }
}

__device__ __forceinline__ void scan_phase(const Ptrs& P, const bf16* proj, const bf16* sbuf, bf16* oret, LAS unsigned char* lds, int vcu, int G) {
    PHASE_IDS();
    int cvp = 0;
    struct CvSet { f32x4 a[2], b[2]; unsigned char* d0; unsigned char* d1; int l0, l1, k0, k1; bool have; };
    CvSet cs0, cs1; cs0.have = false; cs1.have = false; cs0.d0 = cs0.d1 = cs1.d0 = cs1.d1 = nullptr; cs0.l0 = cs0.l1 = cs1.l0 = cs1.l1 = 0; cs0.k0 = cs0.k1 = cs1.k0 = cs1.k1 = -1;
    LAS float* gtab = (LAS float*)(lds + LEND + 2 * CV_IMG);
    for (int k = tid; k < D; k += NTHREADS) gtab[k] = P.ln_ffn[D + k] * MOE_WGU_SCALE;
    WG_BAR();
#define SCAN_LBAR() do { asm volatile("s_waitcnt lgkmcnt(0)" ::: "memory"); __builtin_amdgcn_s_barrier(); asm volatile("" ::: "memory"); } while (0)
    LAS unsigned char* cimg0 = lds + LEND; LAS unsigned char* cimg1 = lds + LEND + CV_IMG;
    const int i = lane & 15, g = lane >> 4, q = i >> 2, p = i & 3;
    const int nt = wave >> 1, vt = wave & 1;
    for (int u = vcu; u < 256; u += G) {
        const int bh = u >> 4, vs = u & 15, b = bh >> 2, h = bh & 3;
        const float lg = log2f(1.0f - exp2f(-5.0f - (float)h));
        const float cdec = exp2f(64.0f * lg);
        const float qdl = exp2f((float)(16 * nt + i + 1) * lg);
        const float kd = exp2f((float)(63 - (tid >> 2)) * lg);
        const int qrow = tid >> 5, qc16 = tid & 31;
        const char* uq = (const char*)(proj + (size_t)b * SEQ * RIN + h * 256);
        const unsigned qoff = (unsigned)(qrow * RIN + qc16 * 8) * 2u;
        const int kx = (qrow & 3) | (((qrow >> 3) & 1) << 2);
        const int lq_off = LQ + qrow * QSTR + qc16 * 16;
        const int lk_off = LK + qrow * 512 + (((qc16 >> 1) ^ kx) << 5) + (qc16 & 1) * 16;
        const int vrow = tid >> 2, vc16 = tid & 3;
        const char* uv = (const char*)(proj + (size_t)b * SEQ * RIN + 2048 + h * 512 + vs * 32);
        const unsigned voff = (unsigned)(vrow * RIN + vc16 * 8) * 2u;
        const int lv_off = vrow * 64 + ((vc16 * 16) ^ (((vrow >> 3) & 1) << 5));
        const int srow = tid >> 3, sc16 = tid & 7;
        const char* us = (const char*)(sbuf + (size_t)(bh * 64) * 4096);
        const unsigned soff = (unsigned)tid * 16u;
        const int ls_off = LS + srow * SSTR + sc16 * 16;
        f32x4 st[2][2];
#pragma unroll
        for (int a = 0; a < 2; ++a)
#pragma unroll
            for (int c2 = 0; c2 < 2; ++c2) st[a][c2] = (f32x4){0.f, 0.f, 0.f, 0.f};
        for (int k = tid; k < 32 * QSTR / 16; k += NTHREADS) ((LAS v4u*)(lds + LST))[k] = (v4u){0u, 0u, 0u, 0u};
        v4u pq[4], pk[4], pv, ps;
#pragma unroll
        for (int k = 0; k < 4; ++k) { pq[k] = *(const v4u*)(uq + (size_t)(16 * k) * RIN * 2 + qoff); pk[k] = *(const v4u*)(uq + (size_t)(16 * k) * RIN * 2 + 2048 + qoff); }
        pv = (tid < 256) ? *(const v4u*)(uv + voff) : (v4u){0u, 0u, 0u, 0u};
        ps = *(const v4u*)(us + soff);
        auto scan_step = [&](const int c, CvSet& CS) __attribute__((always_inline)) {
#pragma unroll
            for (int k = 0; k < 4; ++k) { *(LAS v4u*)(lds + lq_off + 16 * k * QSTR) = pq[k]; *(LAS v4u*)(lds + lk_off + 16 * k * 512) = pk[k]; }
            if (tid < 256) {
                *(LAS v4u*)(lds + LV + lv_off) = pv;
                v4u d; d.x = pk2(bflo(pv.x) * kd, bfhi(pv.x) * kd); d.y = pk2(bflo(pv.y) * kd, bfhi(pv.y) * kd); d.z = pk2(bflo(pv.z) * kd, bfhi(pv.z) * kd); d.w = pk2(bflo(pv.w) * kd, bfhi(pv.w) * kd);
                *(LAS v4u*)(lds + LVD + lv_off) = d;
            }
            *(LAS v4u*)(lds + ls_off) = ps;
            unsigned char* ed0 = CS.d0; unsigned char* ed1 = CS.d1; const int el0 = CS.l0, el1 = CS.l1; const bool cv_emit_now = CS.have;
            if (CS.have) { cv_commit(CS.a, CS.k0, gtab, cimg0, tid); cv_commit(CS.b, CS.k1, gtab, cimg1, tid); }
            SCAN_LBAR();
            if (c + 1 < 64) {
                const size_t adv = (size_t)(c + 1) * 64 * RIN * 2;
#pragma unroll
                for (int k = 0; k < 4; ++k) { pq[k] = *(const v4u*)(uq + adv + (size_t)(16 * k) * RIN * 2 + qoff); pk[k] = *(const v4u*)(uq + adv + (size_t)(16 * k) * RIN * 2 + 2048 + qoff); }
                if (tid < 256) pv = *(const v4u*)(uv + adv + voff);
                ps = *(const v4u*)(us + (size_t)(c + 1) * 8192 + soff);
            }
            {
                const int blk = vcu + (cvp >> 1) * G;
                CS.have = blk < CV_BLKS;
                if (CS.have) { const CvMini m0 = cv_decode(P, blk, 2 * (cvp & 1)), m1 = cv_decode(P, blk, 2 * (cvp & 1) + 1);
                    cv_load(m0, CS.a, tid); cv_load(m1, CS.b, tid); CS.d0 = m0.dst; CS.l0 = m0.ldb; CS.k0 = m0.kg; CS.d1 = m1.dst; CS.l1 = m1.ldb; CS.k1 = m1.kg; ++cvp; }
            }
            f32x4 a1 = (f32x4){0.f, 0.f, 0.f, 0.f}, a2 = (f32x4){0.f, 0.f, 0.f, 0.f}, a3 = (f32x4){0.f, 0.f, 0.f, 0.f};
#pragma unroll
            for (int s = 0; s < 2; ++s) {
                const bf16x8 a = *(const LAS bf16x8*)(lds + LS + (16 * nt + i) * SSTR + (32 * s + 8 * g) * 2);
                const int r0 = 32 * s + 8 * g + q, r1 = r0 + 4, cb = (16 * vt + 4 * p) * 2;
                const s16x4 lo = trld(lds + LV + r0 * 64 + (cb ^ (((r0 >> 3) & 1) << 5))), hi = trld(lds + LV + r1 * 64 + (cb ^ (((r1 >> 3) & 1) << 5)));
                a1 = __builtin_amdgcn_mfma_f32_16x16x32_bf16(cat8(lo, hi), a, a1, 0, 0, 0);
            }
#pragma unroll
            for (int s = 0; s < 8; ++s) {
                const bf16x8 a = *(const LAS bf16x8*)(lds + LQ + (16 * nt + i) * QSTR + (32 * s + 8 * g) * 2);
                const bf16x8 sf = *(const LAS bf16x8*)(lds + LST + (16 * vt + i) * QSTR + (32 * s + 8 * g) * 2);
                if (s & 1) a3 = __builtin_amdgcn_mfma_f32_16x16x32_bf16(sf, a, a3, 0, 0, 0);
                else a2 = __builtin_amdgcn_mfma_f32_16x16x32_bf16(sf, a, a2, 0, 0, 0);
            }
#pragma unroll
            for (int dt = 0; dt < 2; ++dt)
#pragma unroll
                for (int vv = 0; vv < 2; ++vv) st[dt][vv] = st[dt][vv] * cdec;
#pragma unroll
            for (int s = 0; s < 2; ++s) {
                const int r0 = 32 * s + 8 * g + q, r1 = r0 + 4;
                const int x0 = (r0 & 3) | (((r0 >> 3) & 1) << 2), x1 = (r1 & 3) | (((r1 >> 3) & 1) << 2);
                bf16x8 ka[2], vb[2];
#pragma unroll
                for (int dt = 0; dt < 2; ++dt) {
                    const int slot = 2 * wave + dt;
                    ka[dt] = cat8(trld(lds + LK + r0 * 512 + ((slot ^ x0) << 5) + 8 * p), trld(lds + LK + r1 * 512 + ((slot ^ x1) << 5) + 8 * p));
                }
#pragma unroll
                for (int vv = 0; vv < 2; ++vv) {
                    const int cb = (16 * vv + 4 * p) * 2;
                    vb[vv] = cat8(trld(lds + LVD + r0 * 64 + (cb ^ (((r0 >> 3) & 1) << 5))), trld(lds + LVD + r1 * 64 + (cb ^ (((r1 >> 3) & 1) << 5))));
                }
#pragma unroll
                for (int dt = 0; dt < 2; ++dt)
#pragma unroll
                    for (int vv = 0; vv < 2; ++vv) st[dt][vv] = __builtin_amdgcn_mfma_f32_16x16x32_bf16(ka[dt], vb[vv], st[dt][vv], 0, 0, 0);
            }
            {
                char* uo = (char*)(oret + ((size_t)b * SEQ + c * 64) * RVD + h * 512 + vs * 32);
                const unsigned ooff = (unsigned)((16 * nt + i) * RVD + 16 * vt + 4 * g) * 2u;
                float ov_[4];
#pragma unroll
                for (int r = 0; r < 4; ++r) ov_[r] = a1[r] + qdl * (a2[r] + a3[r]);
                u32x2 w_; w_.x = pk2(ov_[0], ov_[1]); w_.y = pk2(ov_[2], ov_[3]);
                *(u32x2*)(uo + ooff) = w_;
            }
            if (cv_emit_now) { cv_emit(ed0, el0, cimg0, wave, lane); cv_emit(ed1, el1, cimg1, wave, lane); }
            SCAN_LBAR();
#pragma unroll
            for (int dt = 0; dt < 2; ++dt)
#pragma unroll
                for (int vv = 0; vv < 2; ++vv)
                    *(LAS u32x2*)(lds + LST + (16 * vv + i) * QSTR + (32 * wave + 16 * dt + 4 * g) * 2) = (u32x2){pk2(st[dt][vv][0], st[dt][vv][1]), pk2(st[dt][vv][2], st[dt][vv][3])};
        };
        for (int c = 0; c < 64; c += 2) { scan_step(c, cs0); scan_step(c + 1, cs1); }
        WG_BAR();
    }
    for (;;) {
        bool any = false;
#pragma unroll
        for (int k = 0; k < 2; ++k) {
            CvSet& CS = k ? cs1 : cs0;
            unsigned char* ed0 = CS.d0; unsigned char* ed1 = CS.d1; const int el0 = CS.l0, el1 = CS.l1; const bool emit_now = CS.have;
            if (CS.have) { cv_commit(CS.a, CS.k0, gtab, cimg0, tid); cv_commit(CS.b, CS.k1, gtab, cimg1, tid); }
            WG_BAR();
            const int blk = vcu + (cvp >> 1) * G;
            CS.have = blk < CV_BLKS;
            if (CS.have) { const CvMini m0 = cv_decode(P, blk, 2 * (cvp & 1)), m1 = cv_decode(P, blk, 2 * (cvp & 1) + 1);
                cv_load(m0, CS.a, tid); cv_load(m1, CS.b, tid); CS.d0 = m0.dst; CS.l0 = m0.ldb; CS.k0 = m0.kg; CS.d1 = m1.dst; CS.l1 = m1.ldb; CS.k1 = m1.kg; ++cvp; }
            if (emit_now) { cv_emit(ed0, el0, cimg0, wave, lane); cv_emit(ed1, el1, cimg1, wave, lane); }
            WG_BAR();
            any = any || emit_now || CS.have;
        }
        if (!any) break;
    }
#undef SCAN_LBAR
}

__device__ __forceinline__ void norm_gate_phase(const bf16* oret, const bf16* proj, bf16* ro, int vcu, int G) {
    PHASE_IDS();
    const int gw = vcu * NWAVES + wave, NGW = G * NWAVES;
    for (int row = gw; row < M; row += NGW) {
        v4u ov[4], gv[4];
#pragma unroll
        for (int h = 0; h < 4; ++h) {
            ov[h] = *(const v4u*)(oret + (size_t)row * RVD + h * 512 + lane * 8);
            gv[h] = *(const v4u*)(proj + (size_t)row * RIN + 4096 + h * 512 + lane * 8);
        }
        float o[4][8], mu[4], rstd[4];
#pragma unroll
        for (int h = 0; h < 4; ++h) {
            o[h][0] = bflo(ov[h].x); o[h][1] = bfhi(ov[h].x); o[h][2] = bflo(ov[h].y); o[h][3] = bfhi(ov[h].y); o[h][4] = bflo(ov[h].z); o[h][5] = bfhi(ov[h].z); o[h][6] = bflo(ov[h].w); o[h][7] = bfhi(ov[h].w);
            float s = 0.f;
#pragma unroll
            for (int j = 0; j < 8; ++j) s += o[h][j];
            mu[h] = s;
        }
#pragma unroll
        for (int h = 0; h < 4; ++h) mu[h] = wave_sum(mu[h]) * (1.0f / 512.0f);
#pragma unroll
        for (int h = 0; h < 4; ++h) {
            float s2 = 0.f;
#pragma unroll
            for (int j = 0; j < 8; ++j) { o[h][j] -= mu[h]; s2 += o[h][j] * o[h][j]; }
            rstd[h] = s2;
        }
#pragma unroll
        for (int h = 0; h < 4; ++h) rstd[h] = __builtin_amdgcn_rsqf(wave_sum(rstd[h]) * (1.0f / 512.0f) + EPS);
#pragma unroll
        for (int h = 0; h < 4; ++h) {
            const float gg[8] = {bflo(gv[h].x), bfhi(gv[h].x), bflo(gv[h].y), bfhi(gv[h].y), bflo(gv[h].z), bfhi(gv[h].z), bflo(gv[h].w), bfhi(gv[h].w)};
            float y[8];
#pragma unroll
            for (int j = 0; j < 8; ++j) y[j] = o[h][j] * rstd[h] * silu_f(gg[j]);
            v4u w; w.x = pk2(y[0], y[1]); w.y = pk2(y[2], y[3]); w.z = pk2(y[4], y[5]); w.w = pk2(y[6], y[7]);
            *(v4u*)(ro + (size_t)row * RVD + h * 512 + lane * 8) = w;
        }
    }
}
}

namespace dat {
constexpr int LK0 = 0  , LV0 = 32768  , LWS = 81920  , LCB = 0  , CSTR = 132;
__device__ __forceinline__ int crow(int r, int hi) { return (r & 3) + 8 * (r >> 2) + 4 * hi; }
__device__ __forceinline__ float half_swap_max(float m) { auto rr = __builtin_amdgcn_permlane32_swap(__float_as_uint(m), __float_as_uint(m), false, false); return fmaxf(__uint_as_float(rr[0]), __uint_as_float(rr[1])); }
__device__ __forceinline__ float half_swap_sum(float m) { auto rr = __builtin_amdgcn_permlane32_swap(__float_as_uint(m), __float_as_uint(m), false, false); return __uint_as_float(rr[0]) + __uint_as_float(rr[1]); }
typedef float f32x2_t __attribute__((ext_vector_type(2))); typedef __bf16 bf16x2_t __attribute__((ext_vector_type(2)));
__device__ __forceinline__ unsigned cvtpk(float lo, float hi) { f32x2_t v = {lo, hi}; bf16x2_t b2 = __builtin_convertvector(v, bf16x2_t); return __builtin_bit_cast(unsigned, b2); }
__device__ __forceinline__ float max3f(float a, float b, float c) { float r; asm("v_max3_f32 %0, %1, %2, %3" : "=v"(r) : "v"(a), "v"(b), "v"(c)); return r; }
__device__ __forceinline__ float fadd_s(float a, float b) { float r; asm("v_add_f32_e32 %0, %1, %2" : "=v"(r) : "v"(a), "v"(b)); return r; }

#define DAT_SBAR() __builtin_amdgcn_sched_barrier(0)
#define DAT_PIN(x) asm volatile("" : "+v"(x))
__device__ __forceinline__ void attn_unit(int b, int h, int qb, const bf16* kvq, bf16* ao, LAS unsigned char* lds, float lam, int wave, int lane, int tid) {
    const int r32 = lane & 31, hi = lane >> 5, comp = wave >> 2, w4 = wave & 3;
    const size_t rowbase = (size_t)b * SEQ;
    const int q0 = qb * 128;
    const int NT = 2 * qb + 2, ntw = 2 * qb + 1 + (w4 >> 1);
    const bf16* Kh = kvq + rowbase * KVQ_N + h * 128;
    const bf16* Vh = kvq + rowbase * KVQ_N + 1024 + h * 128;
    const bf16* Qw = kvq + (rowbase + q0 + w4 * 32) * KVQ_N + 2048 + h * 128 + comp * 64;
    LAS float* wsf = (LAS float*)(lds + LWS) + wave * 64;
    const int pkey = 4 * wave + (lane >> 4), pc = lane & 15;
    const unsigned kvoff = (unsigned)(pkey * KVQ_N + ((pc ^ (pkey & 15)) << 3)) * 2u;
    const unsigned vvoff = (unsigned)(pkey * KVQ_N + ((pc ^ ((pkey & 3) << 2)) << 3)) * 2u;
    const int koff0 = r32 * 256 + (((comp * 8 + hi) ^ (r32 & 15)) << 4);
    const int voff0 = (4 * hi + ((lane & 15) >> 2)) * 256 + ((((lane & 15) >> 2) << 6) | ((4 * ((lane >> 4) & 1) + (lane & 3)) << 3));
#define koffd(d) (koff0 ^ ((d) << 5))
#define voffd(d) (voff0 ^ ((d) << 6))
    const unsigned ldsb = (unsigned)(size_t)lds;
#define DAT_GLDS(base, voff, dst) do { unsigned keep_; asm volatile("s_mov_b32 %0, m0\n\ts_mov_b32 m0, %3\n\ts_nop 0\n\tglobal_load_lds_dwordx4 %1, %2\n\ts_mov_b32 m0, %0" : "=&s"(keep_) : "v"(voff), "s"(base), "s"(dst) : "memory"); } while (0)
#define DAT_DMA(t, kslot, vslot) do { const bf16* kb0_ = Kh + (size_t)(t) * 64 * KVQ_N; const bf16* vb0_ = Vh + (size_t)(t) * 64 * KVQ_N; \
        const unsigned kd_ = (unsigned)__builtin_amdgcn_readfirstlane(ldsb + LK0 + (kslot) * 16384 + wave * 1024), vd_ = (unsigned)__builtin_amdgcn_readfirstlane(ldsb + LV0 + (vslot) * 16384 + wave * 1024); \
        DAT_GLDS(kb0_, kvoff, kd_); DAT_GLDS(kb0_ + (size_t)32 * KVQ_N, kvoff, kd_ + 8192u); DAT_GLDS(vb0_, vvoff, vd_); DAT_GLDS(vb0_ + (size_t)32 * KVQ_N, vvoff, vd_ + 8192u); } while (0)
    DAT_DMA(0, 0, 0);
    bf16x8 qr[4];
#pragma unroll
    for (int d0 = 0; d0 < 4; ++d0) qr[d0] = *(const bf16x8*)(Qw + (size_t)r32 * KVQ_N + d0 * 16 + hi * 8);
    asm volatile("" : "+v"(qr[0]), "+v"(qr[1]), "+v"(qr[2]), "+v"(qr[3]));
    f32x16 o[4];
#pragma unroll
    for (int d = 0; d < 4; ++d)
#pragma unroll
        for (int r = 0; r < 16; ++r) o[d][r] = 0.f;
    float mrun = 0.f, lrun = 0.f;
    f32x16 negm;
#pragma unroll
    for (int r = 0; r < 16; ++r) negm[r] = 0.f;
    f32x16 C0, C1;
    v4u pw[4];
    int vsl_prev = 0, vsl_cur = 0;
    bool resc = false;
#define DAT_DECIDE(FIRST) do { \
        float ra_ = max3f(C0[0], C0[1], C1[0]), rb_ = max3f(C0[2], C0[3], C1[1]); ra_ = max3f(ra_, C1[2], C1[3]); \
        _Pragma("unroll") for (int r = 4; r < 16; r += 4) { ra_ = max3f(ra_, C0[r], C0[r + 1]); rb_ = max3f(rb_, C0[r + 2], C0[r + 3]); ra_ = max3f(ra_, C1[r], C1[r + 1]); rb_ = max3f(rb_, C1[r + 2], C1[r + 3]); } \
        const float rm_ = half_swap_max(max3f(ra_, rb_, rb_)); \
        if ((FIRST) || __any(rm_ > 8.0f)) { \
            const float dl_ = (FIRST) ? rm_ : fmaxf(rm_, 0.f); const float f_ = fast_exp2(-dl_); \
            lrun *= f_; mrun += dl_; if (hi == 0) wsf[r32] = f_; \
            _Pragma("unroll") for (int r = 0; r < 16; ++r) { C0[r] -= dl_; C1[r] -= dl_; negm[r] = -mrun; } \
            resc = !(FIRST); } } while (0)
#define DAT_RESC() do { if (resc) { asm volatile("s_waitcnt lgkmcnt(0)" ::: "memory"); \
        _Pragma("unroll") for (int r = 0; r < 16; ++r) { const float fr_ = wsf[crow(r, hi)]; _Pragma("unroll") for (int d = 0; d < 4; ++d) o[d][r] *= fr_; } resc = false; } } while (0)
#define DAT_VRD(dst_lo, dst_hi, j) do { dst_lo = ret::trld(Vb_ + voffd((j) >> 2) + ((j) & 3) * 4096); dst_hi = ret::trld(Vb_ + voffd((j) >> 2) + ((j) & 3) * 4096 + 2048); } while (0)
#define DAT_QK(t_, DO_, tn_) do { LAS const unsigned char* Kb_ = lds + LK0 + ((t_) & 1) * 16384; \
        const bf16* kb0_ = Kh + (size_t)(tn_) * 64 * KVQ_N; const bf16* vb0_ = Vh + (size_t)(tn_) * 64 * KVQ_N; const unsigned kd_ = (unsigned)__builtin_amdgcn_readfirstlane(ldsb + LK0 + ((tn_) & 1) * 16384 + wave * 1024), vd_ = (unsigned)__builtin_amdgcn_readfirstlane(ldsb + LV0 + ((tn_) % 3) * 16384 + wave * 1024); \
        bf16x8 ka_ = *(const LAS bf16x8*)(Kb_ + koffd(0)), kb_ = *(const LAS bf16x8*)(Kb_ + koffd(0) + 8192), kc_ = *(const LAS bf16x8*)(Kb_ + koffd(1)), kd2_ = *(const LAS bf16x8*)(Kb_ + koffd(1) + 8192); \
        DAT_SBAR(); \
        C0 = __builtin_amdgcn_mfma_f32_32x32x16_bf16(ka_, qr[0], negm, 0, 0, 0); C1 = __builtin_amdgcn_mfma_f32_32x32x16_bf16(kb_, qr[0], negm, 0, 0, 0); \
        ka_ = *(const LAS bf16x8*)(Kb_ + koffd(2)); kb_ = *(const LAS bf16x8*)(Kb_ + koffd(2) + 8192); if (DO_) DAT_GLDS(kb0_, kvoff, kd_); DAT_SBAR(); \
        C0 = __builtin_amdgcn_mfma_f32_32x32x16_bf16(kc_, qr[1], C0, 0, 0, 0); C1 = __builtin_amdgcn_mfma_f32_32x32x16_bf16(kd2_, qr[1], C1, 0, 0, 0); \
        kc_ = *(const LAS bf16x8*)(Kb_ + koffd(3)); kd2_ = *(const LAS bf16x8*)(Kb_ + koffd(3) + 8192); if (DO_) DAT_GLDS(kb0_ + (size_t)32 * KVQ_N, kvoff, kd_ + 8192u); DAT_SBAR(); \
        C0 = __builtin_amdgcn_mfma_f32_32x32x16_bf16(ka_, qr[2], C0, 0, 0, 0); C1 = __builtin_amdgcn_mfma_f32_32x32x16_bf16(kb_, qr[2], C1, 0, 0, 0); \
        if (DO_) DAT_GLDS(vb0_, vvoff, vd_); DAT_SBAR(); \
        C0 = __builtin_amdgcn_mfma_f32_32x32x16_bf16(kc_, qr[3], C0, 0, 0, 0); C1 = __builtin_amdgcn_mfma_f32_32x32x16_bf16(kd2_, qr[3], C1, 0, 0, 0); \
        if (DO_) DAT_GLDS(vb0_ + (size_t)32 * KVQ_N, vvoff, vd_ + 8192u); DAT_SBAR(); \
        asm volatile("s_nop 15\n\ts_nop 7" : "+v"(C0), "+v"(C1)); } while (0)
    {
        WG_BAR();
        DAT_QK(0, true, 1);
        DAT_DECIDE(true);
        float s0_ = 0.f, s1_ = 0.f;
#pragma unroll
        for (int j = 0; j < 16; ++j) {
            const float e0_ = fast_exp2(j < 8 ? C0[2 * (j & 7)] : C1[2 * (j & 7)]), e1_ = fast_exp2(j < 8 ? C0[2 * (j & 7) + 1] : C1[2 * (j & 7) + 1]);
            s0_ += e0_; s1_ += e1_; pw[j >> 2][j & 3] = cvtpk(e0_, e1_);
        }
        lrun += s0_ + s1_;
        vsl_prev = 0; vsl_cur = 16384;
    }
#define DAT_STEADY(t_, PWa, PWb) do { \
        WG_BAR(); \
        const bool dma_ = ((t_) + 1 < NT); \
        LAS const unsigned char* Vb_ = lds + LV0 + vsl_prev; \
        s16x4 vl_[4], vh_[4]; \
        _Pragma("unroll") for (int j = 0; j < 4; ++j) DAT_VRD(vl_[j], vh_[j], j); \
        DAT_QK(t_, dma_, (t_) + 1); \
        DAT_DECIDE(false); \
        const bf16x8 pa_[4] = {__builtin_bit_cast(bf16x8, PWa[0]), __builtin_bit_cast(bf16x8, PWa[1]), __builtin_bit_cast(bf16x8, PWa[2]), __builtin_bit_cast(bf16x8, PWa[3])}; \
        float ssum_ = 0.f; \
        DAT_SBAR(); \
        _Pragma("unroll") for (int j = 0; j < 16; ++j) { \
            o[j >> 2] = __builtin_amdgcn_mfma_f32_32x32x16_bf16(pa_[j & 3], ret::cat8(vl_[j & 3], vh_[j & 3]), o[j >> 2], 0, 0, 0); \
            if (j + 4 < 16) DAT_VRD(vl_[j & 3], vh_[j & 3], j + 4); \
            { const float e0_ = fast_exp2(j < 8 ? C0[2 * (j & 7)] : C1[2 * (j & 7)]), e1_ = fast_exp2(j < 8 ? C0[2 * (j & 7) + 1] : C1[2 * (j & 7) + 1]); \
              ssum_ += e0_; ssum_ += e1_; PWb[j >> 2][j & 3] = cvtpk(e0_, e1_); } \
            DAT_PIN(ssum_); DAT_SBAR(); \
        } \
        DAT_RESC(); \
        lrun += ssum_; \
        vsl_prev = vsl_cur; vsl_cur = (vsl_cur == 32768) ? 0 : vsl_cur + 16384; \
    } while (0)
    v4u pq_[4];
    int t = 1;
    for (; t + 1 < ntw; t += 2) { DAT_STEADY(t, pw, pq_); DAT_STEADY(t + 1, pq_, pw); }
    for (; t <= NT; ++t) {
        if (t < ntw) { DAT_STEADY(t, pw, pq_); pw[0] = pq_[0]; pw[1] = pq_[1]; pw[2] = pq_[2]; pw[3] = pq_[3]; }
        else {
            WG_BAR();
            const bool dma_ = (t + 1 < NT);
            LAS const unsigned char* Vb_ = lds + LV0 + vsl_prev;
            if (dma_) { const int tn_ = t + 1; DAT_DMA(tn_, tn_ & 1, tn_ % 3); }
            if (t == ntw) {
            const bf16x8 pa_[4] = {__builtin_bit_cast(bf16x8, pw[0]), __builtin_bit_cast(bf16x8, pw[1]), __builtin_bit_cast(bf16x8, pw[2]), __builtin_bit_cast(bf16x8, pw[3])};
#pragma unroll
            for (int d = 0; d < 4; ++d)
#pragma unroll
                for (int ks = 0; ks < 4; ++ks) {
                    const s16x4 lo_ = ret::trld(Vb_ + voffd(d) + ks * 4096), hh_ = ret::trld(Vb_ + voffd(d) + ks * 4096 + 2048);
                    o[d] = __builtin_amdgcn_mfma_f32_32x32x16_bf16(pa_[ks], ret::cat8(lo_, hh_), o[d], 0, 0, 0);
                }
            }
            vsl_prev = vsl_cur; vsl_cur = (vsl_cur == 32768) ? 0 : vsl_cur + 16384;
        }
    }
#undef DAT_STEADY
#undef DAT_QK
#undef DAT_VRD
#undef DAT_RESC
#undef DAT_DECIDE
#undef DAT_DMA
#undef DAT_GLDS
#undef koffd
#undef voffd
    {
        const float lt = half_swap_sum(lrun);
        if (hi == 0) wsf[r32] = (comp ? lam : 1.0f) * fast_rcp(lt);
        asm volatile("s_waitcnt lgkmcnt(0)" ::: "memory");
#pragma unroll
        for (int r = 0; r < 16; ++r) { const float fr_ = wsf[crow(r, hi)];
#pragma unroll
            for (int d = 0; d < 4; ++d) o[d][r] *= fr_; }
    }
    WG_BAR();
    LAS float* cb = (LAS float*)(lds + LCB);
    if (comp == 1) {
#pragma unroll
        for (int d = 0; d < 4; ++d)
#pragma unroll
            for (int r = 0; r < 16; ++r) cb[(w4 * 32 + crow(r, hi)) * CSTR + d * 32 + r32] = o[d][r];
    }
    WG_BAR();
    if (comp == 0) {
#pragma unroll
        for (int d = 0; d < 4; ++d)
#pragma unroll
            for (int r = 0; r < 16; ++r) { LAS float* pc = cb + (w4 * 32 + crow(r, hi)) * CSTR + d * 32 + r32; *pc = o[d][r] - *pc; }
    }
    WG_BAR();
    {
        const int row = tid >> 2, part = tid & 3;
        const LAS f32x4* src = (const LAS f32x4*)(cb + row * CSTR + part * 32);
        f32x4 v[8]; float ss = 0.f;
#pragma unroll
        for (int j = 0; j < 8; ++j) { v[j] = src[j]; ss += (v[j][0] * v[j][0] + v[j][1] * v[j][1]) + (v[j][2] * v[j][2] + v[j][3] * v[j][3]); }
        ss += SWZ_XOR(ss, 1); ss += SWZ_XOR(ss, 2);
        const float rstd = __builtin_amdgcn_rsqf(ss * (1.0f / 128.0f) + EPS);
        bf16* dst = ao + (rowbase + q0 + row) * D + h * 128 + part * 32;
#pragma unroll
        for (int j = 0; j < 4; ++j) {
            v4u w; w.x = pk2(v[2 * j][0] * rstd, v[2 * j][1] * rstd); w.y = pk2(v[2 * j][2] * rstd, v[2 * j][3] * rstd);
            w.z = pk2(v[2 * j + 1][0] * rstd, v[2 * j + 1][1] * rstd); w.w = pk2(v[2 * j + 1][2] * rstd, v[2 * j + 1][3] * rstd);
            *(v4u*)(dst + 8 * j) = w;
        }
    }
    WG_BAR();
}

__device__ __forceinline__ void attn_phase(const bf16* kvq, bf16* ao, LAS unsigned char* lds, const float* lq1, const float* lk1, const float* lq2, const float* lk2, float lambda_init, int vcu, int G) {
    PHASE_IDS();
    const float lam = __expf(wave_sum(lq1[lane] * lk1[lane])) - __expf(wave_sum(lq2[lane] * lk2[lane])) + lambda_init;
    const int nun = (G == 256) ? 4 : (1024 - vcu + G - 1) / G;
#pragma unroll 1
    for (int i = 0; i < nun; ++i) {
        int bh, qb;
        if (G == 256) { const int x = vcu >> 5, w = vcu & 31, j = (w + 16) & 31; bh = 4 * x + i; qb = (i == 0) ? w : (i == 1) ? 31 - w : (i == 2) ? j : 31 - j; }
        else { const int u = vcu + i * G; bh = u >> 5; qb = u & 31; }
        attn_unit(bh >> 3, bh & 7, qb, kvq, ao, lds, lam, wave, lane, tid);
    }
}
}

__device__ __forceinline__ void route_a(const bf16* xb, const float* rwt, int* tope, float* topw, int* topr, float* tokr, int* cnt, unsigned char* xn8, LAS unsigned char* lds, int vcu, int G) {
    PHASE_IDS();
    LAS f32x4* rw = (LAS f32x4*)lds;
    LAS int* sel = (LAS int*)(lds + 32768);
    for (int k = tid; k < NE * D / 4; k += NTHREADS) { const int e = k >> 8, c4 = k & 255; rw[((e * 2 + (c4 >> 7)) * 2 + (c4 & 1)) * 64 + ((c4 >> 1) & 63)] = ((const f32x4*)rwt)[k]; }
    WG_BAR();
    for (int tb = vcu; tb < M / 64; tb += G) {
        v4u nv[2];
        { const v4u* xr = (const v4u*)(xb + (size_t)(tb * 64 + wave * 8) * D) + lane;
          nv[0] = xr[0]; nv[1] = xr[64]; }
        for (int tk = 0; tk < 8; ++tk) {
            const int tl = wave * 8 + tk, row = tb * 64 + tl;
            f32x4 v[2][2]; float ss = 0.f;
#pragma unroll
            for (int j = 0; j < 2; ++j) {
                v[j][0] = (f32x4){bflo(nv[j].x), bfhi(nv[j].x), bflo(nv[j].y), bfhi(nv[j].y)}; v[j][1] = (f32x4){bflo(nv[j].z), bfhi(nv[j].z), bflo(nv[j].w), bfhi(nv[j].w)};
#pragma unroll
                for (int h = 0; h < 2; ++h) ss += (v[j][h][0] * v[j][h][0] + v[j][h][1] * v[j][h][1]) + (v[j][h][2] * v[j][h][2] + v[j][h][3] * v[j][h][3]);
            }
            if (tk + 1 < 8) { const v4u* xr = (const v4u*)(xb + (size_t)(row + 1) * D) + lane; nv[0] = xr[0]; nv[1] = xr[64]; }
            ss = wave_sum(ss);
            const float r = __builtin_amdgcn_rsqf(ss * (1.0f / 1024.0f) + EPS);
#pragma unroll
            for (int j = 0; j < 2; ++j) {
                u32x2 w = {0u, 0u};
                w.x = __builtin_amdgcn_cvt_pk_fp8_f32(v[j][0][0] * r, v[j][0][1] * r, w.x, false); w.x = __builtin_amdgcn_cvt_pk_fp8_f32(v[j][0][2] * r, v[j][0][3] * r, w.x, true);
                w.y = __builtin_amdgcn_cvt_pk_fp8_f32(v[j][1][0] * r, v[j][1][1] * r, w.y, false); w.y = __builtin_amdgcn_cvt_pk_fp8_f32(v[j][1][2] * r, v[j][1][3] * r, w.y, true);
                ((u32x2*)(xn8 + (size_t)row * D))[lane + 64 * j] = w;
            }
            float lg[NE];
#pragma unroll
            for (int e = 0; e < NE; ++e) {
                float a = 0.f;
#pragma unroll
                for (int j = 0; j < 2; ++j)
#pragma unroll
                    for (int h = 0; h < 2; ++h) { const f32x4 w = rw[((e * 2 + j) * 2 + h) * 64 + lane]; a += (v[j][h][0] * w[0] + v[j][h][1] * w[1]) + (v[j][h][2] * w[2] + v[j][h][3] * w[3]); }
                lg[e] = wave_sum(a) * r;
            }
            int e1 = 0; float v1 = lg[0];
#pragma unroll
            for (int e = 1; e < NE; ++e) if (lg[e] > v1) { v1 = lg[e]; e1 = e; }
            int e2 = -1; float v2 = -3.0e38f;
#pragma unroll
            for (int e = 0; e < NE; ++e) if (e != e1 && lg[e] > v2) { v2 = lg[e]; e2 = e; }
            const float w1 = fast_rcp(1.0f + __expf(v2 - v1)), w2 = 1.0f - w1;
            if (lane == 0) { tope[row * 2] = e1; tope[row * 2 + 1] = e2; topw[row * 2] = w1; topw[row * 2 + 1] = w2; tokr[row] = r; sel[tl * 2] = e1; sel[tl * 2 + 1] = e2; }
        }
        WG_BAR();
        if (tid < NE) {
            int c = 0;
            for (int k = 0; k < 128; ++k) if (sel[k] == tid) { topr[(tb * 64) * 2 + k] = c; ++c; }
            cnt[tb * NE + tid] = c;
        }
        WG_BAR();
    }
}
__device__ __forceinline__ void route_b(const unsigned char* xn8, const int* tope, const float* topw, const int* topr, const float* tokr, const int* cnt, unsigned char* xg, int* rowinfo, float* rowgate, float* rowr,
                                        LAS unsigned char* lds, LAS int* ldsctl, int vcu, int G) {
    PHASE_IDS();
    LAS int* ct = (LAS int*)lds;
    LAS int* tot = (LAS int*)(lds + 8192);
    for (int k = tid; k < 256 * NE; k += NTHREADS) ct[k] = cnt[k];
    WG_BAR();
    if (tid < NE) { int run = 0; for (int tb = 0; tb < 256; ++tb) { const int c = ct[tb * NE + tid]; ct[tb * NE + tid] = run; run += c; } tot[tid] = run; }
    WG_BAR();
    if (tid == 0) {
        int ts = 0;
        for (int e = 0; e < NE; ++e) { ldsctl[16 + e] = ts; tot[8 + e] = ts * 256; ts += (tot[e] + 255) >> 8; }
        ldsctl[24] = ts; ldsctl[25] = ts;
    }
    WG_BAR();
    for (int tb = vcu; tb < M / 64; tb += G) {
        int mypos = 0;
        {
            const int idx = wave * 16 + (lane & 15), tl = idx >> 1, slot = idx & 1, row = tb * 64 + tl;
            const int e = tope[row * 2 + slot];
            mypos = tot[8 + e] + ct[tb * NE + e] + topr[row * 2 + slot];
            if (lane < 16) { rowinfo[mypos] = slot * M + row; rowgate[mypos] = topw[row * 2 + slot]; rowr[mypos] = tokr[row]; }
        }
        v4u rowsv[8];
#pragma unroll
        for (int k = 0; k < 8; ++k) rowsv[k] = *((const v4u*)(xn8 + (size_t)(tb * 64 + wave * 8 + k) * D) + lane);
#pragma unroll
        for (int k = 0; k < 16; ++k) { const int pos = __builtin_amdgcn_readlane(mypos, k); *((v4u*)(xg + (size_t)pos * D) + lane) = rowsv[k >> 1]; }
    }
    for (int e = vcu; e < NE; e += G) {
        const int beg = tot[8 + e] + tot[e], end = tot[8 + e] + (((tot[e] + 255) >> 8) << 8);
        for (int pos = beg + wave; pos < end; pos += NWAVES) {
            *((v4u*)(xg + (size_t)pos * D) + lane) = (v4u){0u, 0u, 0u, 0u};
            if (lane == 0) { rowinfo[pos] = -1; rowgate[pos] = 0.f; rowr[pos] = 0.f; }
        }
    }
}
__device__ __forceinline__ void final_phase(const bf16* xb, const bf16* y, const float* fn, float* out, int vcu, int G) {
    PHASE_IDS();
    const int gw = vcu * NWAVES + wave, NGW = G * NWAVES;
    f32x4 gn[4];
#pragma unroll
    for (int j = 0; j < 4; ++j) gn[j] = ((const f32x4*)fn)[lane + 64 * j];
    for (int m0 = gw; m0 < M; m0 += 2 * NGW) {
        f32x4 v[2][4]; float ss[2]; bool ok[2];
#pragma unroll
        for (int k = 0; k < 2; ++k) {
            const int m = m0 + k * NGW; ok[k] = m < M; ss[k] = 0.f;
            if (ok[k]) {
                const u32x2* xr = (const u32x2*)(xb + (size_t)m * D) + lane;
                const u32x2* y0 = (const u32x2*)(y + (size_t)m * D) + lane;
                const u32x2* y1 = (const u32x2*)(y + (size_t)(M + m) * D) + lane;
#pragma unroll
                for (int j = 0; j < 4; ++j) {
                    const u32x2 a = y0[64 * j], b2 = y1[64 * j], x0 = xr[64 * j];
                    v[k][j] = (f32x4){bflo(x0.x) + (bflo(a.x) + bflo(b2.x)), bfhi(x0.x) + (bfhi(a.x) + bfhi(b2.x)), bflo(x0.y) + (bflo(a.y) + bflo(b2.y)), bfhi(x0.y) + (bfhi(a.y) + bfhi(b2.y))};
                    ss[k] += (v[k][j][0] * v[k][j][0] + v[k][j][1] * v[k][j][1]) + (v[k][j][2] * v[k][j][2] + v[k][j][3] * v[k][j][3]);
                }
            }
        }
#pragma unroll
        for (int k = 0; k < 2; ++k) ss[k] = wave_sum(ss[k]);
#pragma unroll
        for (int k = 0; k < 2; ++k) if (ok[k]) {
            const float r = __builtin_amdgcn_rsqf(ss[k] * (1.0f / 1024.0f) + EPS);
            f32x4* orow = (f32x4*)(out + (size_t)(m0 + k * NGW) * D) + lane;
#pragma unroll
            for (int j = 0; j < 4; ++j) orow[64 * j] = v[k][j] * r * gn[j];
        }
    }
}
struct Args { Ptrs p; };
static_assert(sizeof(Args) == 22 * 8, "Args has no padding");

__global__ void __launch_bounds__(NTHREADS, 2) yoco_fwd(Args args) {
    extern __shared__ __attribute__((aligned(16))) unsigned char lds_raw[];
    LAS unsigned char* lds = (LAS unsigned char*)lds_raw;
    const Ptrs& P = args.p;
    unsigned char* ws = P.ws;

    const int G = gridDim.x; const int bx = blockIdx.x;
    const int vcu = (G % 8 == 0) ? (bx % 8) * (G / 8) + bx / 8 : bx;
    LAS int* ldsctl = (LAS int*)(lds + LDSCTL_OFF);
    for (int k = threadIdx.x; k < (LDS_BYTES - LDSCTL_OFF) / 4; k += NTHREADS) ldsctl[k] = 0;
    __syncthreads();
    XcdBarrier bar = xcd_barrier_post((unsigned*)(ws + WS_CTL) + CW_BAR, (volatile LAS unsigned*)ldsctl);

    bf16* XB = (bf16*)(ws + WS_XB); float* SSP = (float*)(ws + WS_SSP);
    bf16* PROJ = (bf16*)(ws + WS_PROJ); bf16* KVQ = (bf16*)(ws + WS_KVQ);

    const float lambda_init = 0.8f - 0.6f * 0.7408182206817179f;

    p0_prologue(P, lds, vcu, G, lambda_init);
    xcd_barrier(bar);

    {
        pg8::Gemm g{XB, (const bf16*)(ws + WS_W_IN), M, RIN, D}; pg8::StaticOrder S; S.init(M, RIN, G, bx);
        pg8::EpiInProj E{PROJ, SSP, (const float*)(ws + WS_RCOS), (const float*)(ws + WS_RSIN)};
        pg8::gemm_phase<pg8::EpiInProj, pg8::StaticOrder, true, true>(lds, g, S, E);
    }
    xcd_barrier(bar);
    ret::scores_phase(PROJ, (bf16*)(ws + WS_S), lds, vcu, G);
    xcd_barrier(bar);
    ret::scan_phase(P, PROJ, (const bf16*)(ws + WS_S), (bf16*)(ws + WS_ORET), lds, vcu, G);
    xcd_barrier(bar);
    ret::norm_gate_phase((const bf16*)(ws + WS_ORET), PROJ, (bf16*)(ws + WS_RO), vcu, G);
    xcd_barrier(bar);
    {
        pg8::Gemm g{(const bf16*)(ws + WS_RO), (const bf16*)(ws + WS_W_RO), M, D, RVD}; pg8::StaticOrder S; S.init(M, D, G, bx);
        pg8::EpiResid<true> E{P.x, XB, SSP};
        pg8::gemm_phase<pg8::EpiResid<true>, pg8::StaticOrder, true, true>(lds, g, S, E);
    }
    xcd_barrier(bar);
    {
        pg8::Gemm g{XB, (const bf16*)(ws + WS_W_GU), M, 2 * FF, D}; pg8::StaticOrder S; S.init(M, 2 * FF, G, bx);
        pg8::EpiSwiGLU<false> E{ws + WS_H, FF * 2, SSP, 1.0f, 1.0f};
        pg8::gemm_phase<pg8::EpiSwiGLU<false>, pg8::StaticOrder, true, true>(lds, g, S, E);
    }
    xcd_barrier(bar);
    {
        pg8::Gemm g{(const bf16*)(ws + WS_H), (const bf16*)(ws + WS_W_DN), M, D, FF}; pg8::StaticOrder S; S.init(M, D, G, bx);
        pg8::EpiResid<false> E{XB, XB, SSP};
        pg8::gemm_phase<pg8::EpiResid<false>, pg8::StaticOrder, true, true>(lds, g, S, E);
    }
    xcd_barrier(bar);
    {
        pg8::Gemm g{XB, (const bf16*)(ws + WS_W_KVQ), M, KVQ_N, D}; pg8::StaticOrder S; S.init(M, KVQ_N, G, bx);
        pg8::EpiKVQ E{KVQ, SSP, (const float*)(ws + WS_DCOS), (const float*)(ws + WS_DSIN), 0.125f * LOG2E};
        pg8::gemm_phase<pg8::EpiKVQ, pg8::StaticOrder, true, true>(lds, g, S, E);
    }
    xcd_barrier(bar);
    dat::attn_phase(KVQ, (bf16*)(ws + WS_AO), lds, P.lq1, P.lk1, P.lq2, P.lk2, lambda_init, vcu, G);
    xcd_barrier(bar);
    {
        pg8::Gemm g{(const bf16*)(ws + WS_AO), (const bf16*)(ws + WS_W_DO), M, D, D}; pg8::StaticOrder S; S.init(M, D, G, bx);
        pg8::EpiResid<false> E{XB, XB, SSP};
        pg8::gemm_phase<pg8::EpiResid<false>, pg8::StaticOrder, true, true>(lds, g, S, E);
    }
    xcd_barrier(bar);
    route_a(XB, (const float*)(ws + WS_RWT), (int*)(ws + WS_TOPE), (float*)(ws + WS_TOPW), (int*)(ws + WS_TOPR), (float*)(ws + WS_TOKR), (int*)(ws + WS_CNT), ws + WS_XN8, lds, vcu, G);
    xcd_barrier(bar);
    route_b(ws + WS_XN8, (const int*)(ws + WS_TOPE), (const float*)(ws + WS_TOPW), (const int*)(ws + WS_TOPR), (const float*)(ws + WS_TOKR), (const int*)(ws + WS_CNT), ws + WS_XG,
            (int*)(ws + WS_ROWINFO), (float*)(ws + WS_ROWGATE), (float*)(ws + WS_ROWR), lds, ldsctl, vcu, G);
    xcd_barrier(bar);
    {
        pg8::MoeOrder S; S.nM = __builtin_amdgcn_readfirstlane(((volatile LAS int*)ldsctl)[24]); S.nN = 2 * EF / 256; S.nwg = S.nM * S.nN; S.G = G; S.c = bx;
#pragma unroll
        for (int k = 0; k < 9; ++k) S.ts[k] = __builtin_amdgcn_readfirstlane(((volatile LAS int*)ldsctl)[16 + k]);
        pg8::Gemm g{(const bf16*)(ws + WS_XG), (const bf16*)(ws + WS_W_MGU), XG_ROWS, 2 * EF, D / 2};
        pg8::EpiSwiGLU<true> E{ws + WS_HM, EF, nullptr, 1.0f / MOE_WGU_SCALE, MOE_H_SCALE};
        pg8::gemm_phase<pg8::EpiSwiGLU<true>, pg8::MoeOrder, true, true, true>(lds, g, S, E);
    }
    xcd_barrier(bar);
    {
        pg8::MoeOrder S; S.nM = __builtin_amdgcn_readfirstlane(((volatile LAS int*)ldsctl)[24]); S.nN = D / 256; S.nwg = S.nM * S.nN; S.G = G; S.c = bx;
#pragma unroll
        for (int k = 0; k < 9; ++k) S.ts[k] = __builtin_amdgcn_readfirstlane(((volatile LAS int*)ldsctl)[16 + k]);
        pg8::Gemm g{(const bf16*)(ws + WS_HM), (const bf16*)(ws + WS_W_MDN), XG_ROWS, D, EF / 2};
        pg8::EpiMoeDown E{(bf16*)(ws + WS_Y), (const int*)(ws + WS_ROWINFO), (const float*)(ws + WS_ROWGATE), 1.0f / (MOE_WDN_SCALE * MOE_H_SCALE)};
        pg8::gemm_phase<pg8::EpiMoeDown, pg8::MoeOrder, true, true, true>(lds, g, S, E);
    }
    xcd_barrier(bar);
    final_phase(XB, (const bf16*)(ws + WS_Y), P.final_norm, P.out, vcu, G);
}

extern "C" void kernel_launch(void* const* d_in, const int* in_sizes, int n_in, void* d_out, int out_size, void* d_ws, size_t ws_size, hipStream_t stream) {
    static int grid = 0;
    if (grid == 0) {
        if (n_in != 20 || in_sizes[0] != M * D || out_size != M * D || ws_size < WS_END) { fprintf(stderr, "kernel_launch: unexpected shapes (n_in %d, in0 %d, out %d, ws %zu)\n", n_in, n_in > 0 ? in_sizes[0] : -1, out_size, ws_size); grid = -1; return; }
        int dev = 0, cus = 0, per_cu = 0;
        if (hipGetDevice(&dev) != hipSuccess || hipDeviceGetAttribute(&cus, hipDeviceAttributeMultiprocessorCount, dev) != hipSuccess) { grid = -1; return; }
        if (hipFuncSetAttribute((const void*)yoco_fwd, hipFuncAttributeMaxDynamicSharedMemorySize, LDS_BYTES) != hipSuccess) { fprintf(stderr, "kernel_launch: hipFuncSetAttribute failed\n"); grid = -1; return; }
        if (hipOccupancyMaxActiveBlocksPerMultiprocessor(&per_cu, (const void*)yoco_fwd, NTHREADS, LDS_BYTES) != hipSuccess || per_cu < 1) { fprintf(stderr, "kernel_launch: occupancy query reports %d\n", per_cu); }
        (void)hipGetLastError();
        grid = cus;
    }
    if (grid < 0) return;
    (void)hipMemsetAsync((char*)d_ws + WS_CTL, 0, CTL_ZERO_BYTES, stream);
    Args a{};
    const float** pp = (const float**)&a.p;
    for (int i = 0; i < 20; ++i) pp[i] = (const float*)d_in[i];
    a.p.out = (float*)d_out; a.p.ws = (unsigned char*)d_ws;
    hipLaunchKernelGGL(yoco_fwd, dim3(grid), dim3(NTHREADS), LDS_BYTES, stream, a);
}
```

```cpp
#include <hip/hip_runtime.h>
#include <hip/hip_bf16.h>
#include <cstdio>
#include <cstdint>
#include <cmath>
namespace pg8 {
#define PG8_LAS __attribute__((address_space(3)))
typedef unsigned short bf16_t;
typedef short bf16x8 __attribute__((ext_vector_type(8)));
typedef float f32x4 __attribute__((ext_vector_type(4)));
typedef unsigned u32x4 __attribute__((ext_vector_type(4)));
constexpr int BM = 256, BK = 64, HALF = 128, HTB = HALF * BK * 2  , STAGE_BYTES = 8 * HTB, NXCD = 8, WGM = 8;

__host__ __device__ __forceinline__ int lds_byte(int r, int c) { const int st = (r >> 4) * 2 + (c >> 5), rr = r & 15, cc = c & 31, ob = rr * 64 + cc * 2; return st * 1024 + (ob ^ (((ob >> 9) & 1) << 5)); }
__host__ __device__ __forceinline__ void stage_rc(int b, int& R, int& C) { const int st = b / 1024, sb = b % 1024, swz = sb ^ (((sb >> 9) & 1) << 5); R = (st >> 1) * 16 + swz / 64; C = (st & 1) * 32 + (swz % 64) / 2; }
__host__ __device__ __forceinline__ int perm32(int rho) { const int n = rho >> 4, i = rho & 15; return 8 * (i >> 2) + 4 * n + (i & 3); }

struct Unit { int pm, pn, aux; };
struct Gemm { const bf16_t* A; const bf16_t* Bt; int M, N, K; };

struct StaticOrder {
    int nM, nN, nwg, G, c;
    __host__ __device__ void init(int M, int N, int G_, int c_) { nM = M / BM; nN = N / BM; nwg = nM * nN; G = G_; c = c_; }
    __host__ __device__ bool next(int i, Unit& u) const {
        const long L = (long)i * G + c; if (L >= nwg) return false;
        int wgid = (int)L; { const int q = nwg / NXCD, r = nwg % NXCD, xcd = wgid % NXCD, off = wgid / NXCD; wgid = (xcd < r ? xcd * (q + 1) : r * (q + 1) + (xcd - r) * q) + off; }
        const int nig = WGM * nN, gid = wgid / nig, fm = gid * WGM, gsz = (nM - fm) < WGM ? (nM - fm) : WGM;
        u.pm = fm + ((wgid % nig) % gsz); u.pn = (wgid % nig) / gsz; u.aux = u.pn; return true;
    }
    __device__ __forceinline__ void a_ready(const Unit&) const {}
    __device__ __forceinline__ void done(const Unit&) const {}
};

__device__ __forceinline__ unsigned cvt_pk_bf16(float lo, float hi) { unsigned r; asm volatile("v_cvt_pk_bf16_f32 %0, %1, %2" : "=v"(r) : "v"(lo), "v"(hi)); return r; }
typedef float f32x2 __attribute__((ext_vector_type(2)));
typedef int i32x4 __attribute__((ext_vector_type(4)));
typedef int i32x8 __attribute__((ext_vector_type(8)));
__device__ __forceinline__ i32x8 cat8i(bf16x8 a, bf16x8 b) { const i32x4 x = __builtin_bit_cast(i32x4, a), y = __builtin_bit_cast(i32x4, b); return __builtin_shufflevector(x, y, 0, 1, 2, 3, 4, 5, 6, 7); }
template <class Epi, class Sched, bool ALIGN_EPI = false, bool SP2 = false, bool FP8 = false>
__device__ __forceinline__ void gemm_phase(PG8_LAS unsigned char* lds, const Gemm g, const Sched& S, const Epi& E) {
    int tid = threadIdx.x; asm volatile("" : "+v"(tid)); const int wid = __builtin_amdgcn_readfirstlane(tid >> 6), lane = tid & 63, wr = wid >> 2, wc = wid & 3, fr = lane & 15, fq = lane >> 4;
    const int K = g.K, nt = K / BK;
    unsigned voffA[2], voffB[2];
#pragma unroll
    for (int i = 0; i < 2; ++i) { int R, C; stage_rc(tid * 16 + i * 8192, R, C); const int Rb = Epi::PERM ? ((R & ~31) + perm32(R & 31)) : R;
        voffA[i] = (unsigned)(R * K + C) * 2u; voffB[i] = (unsigned)(Rb * K + C) * 2u; }
    const size_t kstep = (size_t)(BK * 2);
    const size_t hstep = (size_t)HALF * K * 2;
    const size_t tstep = 2 * hstep;
    const unsigned ldsw = (unsigned)wid * 1024u;
    const int aoff = lds_byte(wr * 64 + fr, fq * 8), boff = lds_byte(wc * 32 + fr, fq * 8);
#define PG8_SA(b, h) (((b) * 2 + (h)) * HTB)
#define PG8_SB(b, h) ((4 + (b) * 2 + (h)) * HTB)
#define PG8_STAGE(bufoff, gbase, voff) do { _Pragma("unroll") for (int _i = 0; _i < 2; ++_i) \
        __builtin_amdgcn_global_load_lds((const unsigned*)((const char*)(gbase) + (voff)[_i]), (PG8_LAS unsigned*)(lds + (bufoff) + ldsw + _i * 8192), 16, 0, 0); } while (0)
#define PG8_LDA(dst, b, h) do { _Pragma("unroll") for (int m = 0; m < 4; ++m) _Pragma("unroll") for (int k = 0; k < 2; ++k) dst[m][k] = *(const PG8_LAS bf16x8*)(lds + PG8_SA(b, h) + aoff + m * 2048 + k * 1024); } while (0)
#define PG8_LDB(dst, b, h) do { _Pragma("unroll") for (int n = 0; n < 2; ++n) _Pragma("unroll") for (int k = 0; k < 2; ++k) dst[n][k] = *(const PG8_LAS bf16x8*)(lds + PG8_SB(b, h) + boff + n * 2048 + k * 1024); } while (0)
#define PG8_MMA(ai, bj, At, Bt) do { __builtin_amdgcn_s_setprio(1); \
        if constexpr (FP8) { _Pragma("unroll") for (int m = 0; m < 4; ++m) _Pragma("unroll") for (int n = 0; n < 2; ++n) \
            asm volatile("v_mfma_scale_f32_16x16x128_f8f6f4 %0, %1, %2, %0, %3, %3 op_sel_hi:[0,0,0]" : "+v"(acc[ai][bj][m][n]) : "v"(cat8i(Bt[n][0], Bt[n][1])), "v"(cat8i(At[m][0], At[m][1])), "v"(fp8_unit_scale)); } \
        else { _Pragma("unroll") for (int m = 0; m < 4; ++m) _Pragma("unroll") for (int n = 0; n < 2; ++n) _Pragma("unroll") for (int k = 0; k < 2; ++k) \
            acc[ai][bj][m][n] = __builtin_amdgcn_mfma_f32_16x16x32_bf16(Bt[n][k], At[m][k], acc[ai][bj][m][n], 0, 0, 0); } \
        __builtin_amdgcn_s_setprio(0); } while (0)
#define PG8_WAIT_V(n) asm volatile("s_waitcnt vmcnt(" #n ")" ::: "memory")
#define PG8_WAIT_L(n) asm volatile("s_waitcnt lgkmcnt(" #n ")" ::: "memory")
#define PG8_BAR __builtin_amdgcn_s_barrier()
#define PG8_SCHED __builtin_amdgcn_sched_barrier(0)
    const int fp8_unit_scale = 0x7f7f7f7f; (void)fp8_unit_scale;
    Unit cur, nxt; int ui = 0;
    if (!S.next(0, cur)) return;
    f32x4 acc[2][2][4][2];
#pragma unroll
    for (int a = 0; a < 2; ++a)
#pragma unroll
        for (int b = 0; b < 2; ++b)
#pragma unroll
            for (int m = 0; m < 4; ++m)
#pragma unroll
                for (int n = 0; n < 2; ++n) acc[a][b][m][n] = (f32x4){0.f, 0.f, 0.f, 0.f};
    bf16x8 At[4][2], B0[2][2], B1[2][2];
    const char* cA = (const char*)g.A + (size_t)cur.pm * tstep; const char* cB = (const char*)g.Bt + (size_t)cur.pn * tstep;
    S.a_ready(cur);
    if constexpr (SP2) {
        PG8_STAGE(PG8_SB(0, 0), cB, voffB); PG8_STAGE(PG8_SB(0, 1), cB + hstep, voffB); PG8_STAGE(PG8_SA(0, 0), cA, voffA); PG8_STAGE(PG8_SA(0, 1), cA + hstep, voffA);
        if (wr == 1) PG8_BAR;
        PG8_WAIT_V(2); PG8_BAR;
        PG8_STAGE(PG8_SB(1, 0), cB + kstep, voffB); PG8_STAGE(PG8_SA(1, 0), cA + kstep, voffA); PG8_STAGE(PG8_SB(1, 1), cB + hstep + kstep, voffB);
        PG8_WAIT_V(6); PG8_BAR;
    } else {
        PG8_STAGE(PG8_SB(0, 0), cB, voffB); PG8_STAGE(PG8_SA(0, 0), cA, voffA); PG8_STAGE(PG8_SB(0, 1), cB + hstep, voffB); PG8_STAGE(PG8_SA(0, 1), cA + hstep, voffA);
        if (wr == 1) PG8_BAR;
        PG8_WAIT_V(4); PG8_BAR;
        PG8_STAGE(PG8_SB(1, 0), cB + kstep, voffB); PG8_STAGE(PG8_SA(1, 0), cA + kstep, voffA); PG8_STAGE(PG8_SB(1, 1), cB + hstep + kstep, voffB);
        PG8_WAIT_V(6); PG8_BAR;
    }
    for (;;) {
        const bool has_next = S.next(ui + 1, nxt);
        const char* nA = has_next ? (const char*)g.A + (size_t)nxt.pm * tstep : cA; const char* nB = has_next ? (const char*)g.Bt + (size_t)nxt.pn * tstep : cB;
        for (int t = 0; t < nt; t += 2) {
            const bool last = (t == nt - 2);
            const char* a1 = cA + (size_t)(t + 1) * kstep;
            const char* a2 = last ? nA : cA + (size_t)(t + 2) * kstep; const char* b2 = last ? nB : cB + (size_t)(t + 2) * kstep;
            const char* a3 = a2 + kstep; const char* b3 = b2 + kstep;
            if (last && has_next) S.a_ready(nxt);
            if constexpr (SP2) {
            PG8_LDB(B0, 0, 0); PG8_LDB(B1, 0, 1); PG8_SCHED; PG8_LDA(At, 0, 0); PG8_STAGE(PG8_SA(1, 1), a1 + hstep, voffA);
            PG8_WAIT_V(8); PG8_WAIT_L(0); PG8_BAR; PG8_MMA(0, 0, At, B0); PG8_MMA(0, 1, At, B1); PG8_BAR; PG8_SCHED;
            PG8_LDA(At, 0, 1); PG8_STAGE(PG8_SB(0, 0), b2, voffB); PG8_STAGE(PG8_SB(0, 1), b2 + hstep, voffB); PG8_STAGE(PG8_SA(0, 0), a2, voffA);
            PG8_WAIT_V(8); PG8_WAIT_L(0); PG8_BAR; PG8_MMA(1, 0, At, B0); PG8_MMA(1, 1, At, B1); PG8_BAR; PG8_SCHED;
            PG8_LDB(B0, 1, 0); PG8_LDB(B1, 1, 1); PG8_SCHED; PG8_LDA(At, 1, 0); PG8_STAGE(PG8_SA(0, 1), a2 + hstep, voffA);
            PG8_WAIT_V(8); PG8_WAIT_L(0); PG8_BAR; PG8_MMA(0, 0, At, B0); PG8_MMA(0, 1, At, B1); PG8_BAR; PG8_SCHED;
            PG8_LDA(At, 1, 1); PG8_STAGE(PG8_SB(1, 0), b3, voffB); PG8_STAGE(PG8_SB(1, 1), b3 + hstep, voffB); PG8_STAGE(PG8_SA(1, 0), a3, voffA);
            PG8_WAIT_V(8); PG8_WAIT_L(0); PG8_BAR; PG8_MMA(1, 0, At, B0); PG8_MMA(1, 1, At, B1); PG8_BAR; PG8_SCHED;
            } else {
            PG8_LDB(B0, 0, 0); PG8_SCHED; PG8_LDA(At, 0, 0); PG8_STAGE(PG8_SA(1, 1), a1 + hstep, voffA);
            PG8_WAIT_L(8); PG8_BAR; PG8_WAIT_L(0); PG8_MMA(0, 0, At, B0); PG8_BAR; PG8_SCHED;
            PG8_LDB(B1, 0, 1); PG8_STAGE(PG8_SB(0, 0), b2, voffB);
            PG8_BAR; PG8_WAIT_L(0); PG8_MMA(0, 1, At, B1); PG8_BAR;
            PG8_LDA(At, 0, 1); PG8_STAGE(PG8_SA(0, 0), a2, voffA);
            PG8_BAR; PG8_WAIT_L(0); PG8_MMA(1, 0, At, B0); PG8_BAR; PG8_SCHED;
            PG8_STAGE(PG8_SB(0, 1), b2 + hstep, voffB);
            PG8_WAIT_V(6); PG8_BAR; PG8_MMA(1, 1, At, B1); PG8_BAR;
            PG8_LDB(B0, 1, 0); PG8_SCHED; PG8_LDA(At, 1, 0); PG8_STAGE(PG8_SA(0, 1), a2 + hstep, voffA);
            PG8_WAIT_L(8); PG8_BAR; PG8_WAIT_L(0); PG8_MMA(0, 0, At, B0); PG8_BAR; PG8_SCHED;
            PG8_LDB(B1, 1, 1); PG8_STAGE(PG8_SB(1, 0), b3, voffB);
            PG8_BAR; PG8_WAIT_L(0); PG8_MMA(0, 1, At, B1); PG8_BAR;
            PG8_LDA(At, 1, 1); PG8_STAGE(PG8_SA(1, 0), a3, voffA);
            PG8_BAR; PG8_WAIT_L(0); PG8_MMA(1, 0, At, B0); PG8_BAR; PG8_SCHED;
            PG8_STAGE(PG8_SB(1, 1), b3 + hstep, voffB);
            PG8_WAIT_V(6); PG8_BAR; PG8_MMA(1, 1, At, B1); PG8_BAR;
            }
        }
        if constexpr (ALIGN_EPI) { if (wr == 0) PG8_BAR; }
        if constexpr (FP8) asm volatile("s_nop 15\n\ts_nop 15" ::: "memory");
        if constexpr (!Epi::AFTER_DRAIN) { E(acc, cur, wr, wc, fr, fq); S.done(cur); }
        if (!has_next) break;
#pragma unroll
        for (int a = 0; a < 2; ++a)
#pragma unroll
            for (int b = 0; b < 2; ++b)
#pragma unroll
                for (int m = 0; m < 4; ++m)
#pragma unroll
                    for (int n = 0; n < 2; ++n) acc[a][b][m][n] = (f32x4){0.f, 0.f, 0.f, 0.f};
        cur = nxt; cA = nA; cB = nB; ++ui;
        if constexpr (ALIGN_EPI) { if (wr == 1) PG8_BAR; }
    }
    PG8_WAIT_V(0);
    if constexpr (!ALIGN_EPI) { if (wr == 0) PG8_BAR; }
    PG8_BAR;
    if constexpr (Epi::AFTER_DRAIN) { E.fused(acc, cur, wr, wc, fr, fq, lds, wid, lane); S.done(cur); }
#undef PG8_SA
#undef PG8_SB
#undef PG8_STAGE
#undef PG8_LDA
#undef PG8_LDB
#undef PG8_MMA
#undef PG8_WAIT_V
#undef PG8_WAIT_L
#undef PG8_BAR
#undef PG8_SCHED
}
}
#define GAS __attribute__((address_space(1)))
#define LAS __attribute__((address_space(3)))
typedef unsigned short bf16;
typedef unsigned v4u __attribute__((ext_vector_type(4)));
typedef float f32x4 __attribute__((ext_vector_type(4)));
typedef short bf16x8 __attribute__((ext_vector_type(8)));
typedef GAS unsigned gu32;
typedef GAS unsigned long long gu64;
#define RLX_AGENT __ATOMIC_RELAXED, __HIP_MEMORY_SCOPE_AGENT
#define LDS_WAIT() asm volatile("s_waitcnt lgkmcnt(0)" ::: "memory")
#define VM_WAIT() asm volatile("s_waitcnt vmcnt(0)" ::: "memory")
__device__ __forceinline__ unsigned long long rt() { return __builtin_amdgcn_s_memrealtime(); }
__device__ __forceinline__ unsigned f2bf(float f) { unsigned u = __builtin_bit_cast(unsigned, f); return (u + 0x7fffu + ((u >> 16) & 1u)) >> 16; }
__device__ __forceinline__ unsigned pk2(float lo, float hi) { unsigned r; asm("v_cvt_pk_bf16_f32 %0, %1, %2" : "=v"(r) : "v"(lo), "v"(hi)); return r; }

#define XB_TMO      128
#define XB_XCNT(j)  (256  + 64 * (j))
#define XB_XSUB(j)  (1280 + 64 * (j))
#define XB_XGEN(j)  (2304 + 64 * (j))
#define XB_TOP      3328
#define XB_TOPGEN   3392
#define XCD_BAR_WORDS 3456
#define XB_SPIN_CAP (1u << 18)

__device__ __forceinline__ unsigned xb_ld(unsigned* p)              { return __hip_atomic_load(p, __ATOMIC_RELAXED, __HIP_MEMORY_SCOPE_AGENT); }
__device__ __forceinline__ unsigned xb_add(unsigned* p, unsigned v) { return __hip_atomic_fetch_add(p, v, __ATOMIC_RELAXED, __HIP_MEMORY_SCOPE_AGENT); }
__device__ __forceinline__ unsigned xb_xcc_id() { return (unsigned)__builtin_amdgcn_s_getreg((3 << 11) | 20) & 0xFu; }
#define XB_SPIN(cond, bar) do { unsigned _sp = 0; while (cond) { __builtin_amdgcn_s_sleep(1); \
    if ((++_sp & 255u) == 0u) { if (xb_ld(&(bar)[XB_TMO])) break; if (_sp > XB_SPIN_CAP) { atomicAdd(&(bar)[XB_TMO], 1u); break; } } } } while (0)

struct XcdBarrier {
    unsigned* bar; unsigned x;
    volatile LAS unsigned* st;
};

__device__ __forceinline__ XcdBarrier xcd_barrier_post(unsigned* bar, volatile LAS unsigned* st) {
    XcdBarrier b; b.bar = bar; b.x = xb_xcc_id(); b.st = st;
    if (threadIdx.x == 0) (void)xb_add(&bar[XB_XCNT(b.x)], 1u);
    return b;
}
__device__ __forceinline__ void xcd_barrier_complete(unsigned* bar, unsigned x, unsigned& nloc, unsigned& nx) {
    const unsigned G = gridDim.x * gridDim.y * gridDim.z;
    unsigned sum, cnt, mine, sp = 0u;
    for (;;) {
        sum = 0u; cnt = 0u; mine = 0u;
#pragma unroll
        for (unsigned j = 0; j < 16; ++j) { const unsigned c = xb_ld(&bar[XB_XCNT(j)]); sum += c; cnt += (c > 0u) ? 1u : 0u; mine = (j == x) ? c : mine; }
        if (sum == G) break;
        __builtin_amdgcn_s_sleep(1);
        if ((++sp & 255u) == 0u) { if (xb_ld(&bar[XB_TMO])) break; if (sp > XB_SPIN_CAP) { atomicAdd(&bar[XB_TMO], 1u); break; } }
    }
    nloc = mine > 0u ? mine : 1u; nx = cnt > 0u ? cnt : 1u;
}

__device__ __forceinline__ void xcd_barrier(const XcdBarrier& b) {
    asm volatile("s_waitcnt vmcnt(0)" ::: "memory");
    __syncthreads();
    if (threadIdx.x == 0) {
        unsigned* bar = b.bar;
        __builtin_amdgcn_s_waitcnt(0);
        unsigned nloc = b.st[0], nx = b.st[1];
        if (nloc == 0u) { xcd_barrier_complete(bar, b.x, nloc, nx); b.st[0] = nloc; b.st[1] = nx; }
        const unsigned old = xb_add(&bar[XB_XSUB(b.x)], 1u);
        const unsigned gen = old / nloc;
        if (old + 1u == (gen + 1u) * nloc) {
            __builtin_amdgcn_fence(__ATOMIC_RELEASE, "agent");
            asm volatile("s_waitcnt vmcnt(0)" ::: "memory");
            const unsigned og = xb_add(&bar[XB_TOP], 1u);
            const unsigned tg = og / nx;
            if (og + 1u == (tg + 1u) * nx) xb_add(&bar[XB_TOPGEN], 1u);
            else XB_SPIN(xb_ld(&bar[XB_TOPGEN]) == tg, bar);
            __builtin_amdgcn_fence(__ATOMIC_ACQUIRE, "agent");
            xb_add(&bar[XB_XGEN(b.x)], 1u);
            asm volatile("s_waitcnt vmcnt(0)" ::: "memory");
        } else {
            XB_SPIN(xb_ld(&bar[XB_XGEN(b.x)]) == gen, bar);
            __builtin_amdgcn_fence(__ATOMIC_ACQUIRE, "agent");
            asm volatile("s_waitcnt vmcnt(0)" ::: "memory");
        }
    }
    __syncthreads();
}

constexpr int BATCH = 4, SEQ = 4096, D = 1024, M = BATCH * SEQ;
constexpr int RIN = 6144, RVD = 2048;
constexpr int FF = 2816, EF = 3584, NE = 8;
constexpr int KVQ_N = 3072;
constexpr float EPS = 1e-6f;
constexpr float LOG2E = 1.4426950408889634f;

typedef short s16x4 __attribute__((ext_vector_type(4)));
typedef float f32x16 __attribute__((ext_vector_type(16)));
typedef unsigned u32x2 __attribute__((ext_vector_type(2)));

__device__ __forceinline__ float bf2f(unsigned short h) { return __uint_as_float(((unsigned)h) << 16); }
__device__ __forceinline__ float bflo(unsigned w) { return __uint_as_float(w << 16); }
__device__ __forceinline__ float bfhi(unsigned w) { return __uint_as_float(w & 0xffff0000u); }
__device__ __forceinline__ float fast_exp2(float x) { return __builtin_amdgcn_exp2f(x); }
__device__ __forceinline__ float fast_rcp(float x) { return __builtin_amdgcn_rcpf(x); }
__device__ __forceinline__ float silu_f(float x) { return x * fast_rcp(1.0f + fast_exp2(-x * LOG2E)); }
#define SWZ_XOR(v, m) __int_as_float(__builtin_amdgcn_ds_swizzle(__float_as_int(v), ((m) << 10) | 0x1f))
__device__ __forceinline__ float xor32_sum(float v) { auto rr = __builtin_amdgcn_permlane32_swap(__float_as_uint(v), __float_as_uint(v), false, false); return __uint_as_float(rr[0]) + __uint_as_float(rr[1]); }
__device__ __forceinline__ float wave_sum(float v) {
    v += SWZ_XOR(v, 1); v += SWZ_XOR(v, 2); v += SWZ_XOR(v, 4); v += SWZ_XOR(v, 8); v += SWZ_XOR(v, 16);
    return xor32_sum(v);
}

namespace pg8 {
__device__ __forceinline__ float rinv_from_ssp(const float* ssp, int row) {
    const f32x4* p = (const f32x4*)(ssp + (size_t)row * 16);
    const f32x4 a = p[0], b = p[1], c = p[2], d = p[3];
    const float s = (((a[0] + a[1]) + (a[2] + a[3])) + ((b[0] + b[1]) + (b[2] + b[3]))) + (((c[0] + c[1]) + (c[2] + c[3])) + ((d[0] + d[1]) + (d[2] + d[3])));
    return __builtin_amdgcn_rsqf(s * (1.0f / 1024.0f) + EPS);
}
__device__ __forceinline__ void rinv8_from_ssp(const float* ssp, int row0, int fq, float (&r)[8]) {
    f32x4 a[8];
#pragma unroll
    for (int x = 0; x < 8; ++x) a[x] = ((const f32x4*)(ssp + (size_t)(row0 + (x >> 2) * HALF + (x & 3) * 16) * 16))[fq];
#pragma unroll
    for (int x = 0; x < 8; ++x) {
        float s = (a[x][0] + a[x][1]) + (a[x][2] + a[x][3]);
        s += SWZ_XOR(s, 16); s = xor32_sum(s);
        r[x] = __builtin_amdgcn_rsqf(s * (1.0f / 1024.0f) + EPS);
    }
}
__device__ __forceinline__ u32x4 pack8(const f32x4 a, const f32x4 b) {
    u32x4 w; w.x = cvt_pk_bf16(a[0], a[1]); w.y = cvt_pk_bf16(a[2], a[3]); w.z = cvt_pk_bf16(b[0], b[1]); w.w = cvt_pk_bf16(b[2], b[3]); return w;
}
struct EpiInProj {
    static constexpr bool PERM = true, AFTER_DRAIN = false;
    bf16_t* O; const float* ssp; const float* rcos; const float* rsin;
    __device__ __forceinline__ void operator()(const f32x4 (&acc)[2][2][4][2], const Unit& u, int wr, int wc, int fr, int fq) const {
        const int row0 = u.pm * BM + wr * 64 + fr;
        const int cl = wc * 32 + 8 * fq;
        const bool rope = u.pn < 8;
        const float ksc = (u.pn >= 4 && u.pn < 8) ? 0.0625f : 1.0f;
        float rv[8]; rinv8_from_ssp(ssp, row0, fq, rv);
#pragma unroll
        for (int ai = 0; ai < 2; ++ai)
#pragma unroll
            for (int m = 0; m < 4; ++m) {
                const int row = row0 + ai * HALF + m * 16;
                const float r = rv[ai * 4 + m] * ksc;
                bf16_t* rowp = O + (size_t)row * RIN + u.pn * BM + cl;
                f32x4 a0 = acc[ai][0][m][0] * r, a1 = acc[ai][0][m][1] * r, b0 = acc[ai][1][m][0] * r, b1 = acc[ai][1][m][1] * r;
                if (rope) {
                    const int pos = row & (SEQ - 1);
                    const f32x4 c0 = *(const f32x4*)(rcos + pos * 128 + cl), c1 = *(const f32x4*)(rcos + pos * 128 + cl + 4);
                    const f32x4 s0 = *(const f32x4*)(rsin + pos * 128 + cl), s1 = *(const f32x4*)(rsin + pos * 128 + cl + 4);
                    const f32x4 x0 = a0 * c0 - b0 * s0, x1 = a1 * c1 - b1 * s1, y0 = b0 * c0 + a0 * s0, y1 = b1 * c1 + a1 * s1;
                    a0 = x0; a1 = x1; b0 = y0; b1 = y1;
                }
                *(u32x4*)(rowp) = pack8(a0, a1);
                *(u32x4*)(rowp + HALF) = pack8(b0, b1);
                if (m & 1) asm volatile("" ::: "memory");
            }
    }
};
template <bool FP8OUT> struct EpiSwiGLU {
    static constexpr bool PERM = true, AFTER_DRAIN = false;
    unsigned char* O; int ldb  ; const float* ssp; float cscale, oscale;
    __device__ __forceinline__ void operator()(const f32x4 (&acc)[2][2][4][2], const Unit& u, int wr, int wc, int fr, int fq) const {
        const int row0 = u.pm * BM + wr * 64 + fr;
        const int col = u.aux * HALF + wc * 32 + 8 * fq;
        float rv[8];
        if (ssp) rinv8_from_ssp(ssp, row0, fq, rv); else {
#pragma unroll
            for (int x = 0; x < 8; ++x) rv[x] = 1.0f; }
#pragma unroll
        for (int ai = 0; ai < 2; ++ai)
#pragma unroll
            for (int m = 0; m < 4; ++m) {
                const int row = row0 + ai * HALF + m * 16;
                const float r = rv[ai * 4 + m] * cscale;
                const float k1 = -r * LOG2E, qv = fast_rcp(r * r * oscale), c0 = __builtin_amdgcn_logf(qv);
                f32x4 h0, h1;
#pragma unroll
                for (int j = 0; j < 4; ++j) {
                    h0[j] = (acc[ai][0][m][0][j] * acc[ai][1][m][0][j]) * fast_rcp(qv + fast_exp2(__builtin_fmaf(acc[ai][0][m][0][j], k1, c0)));
                    h1[j] = (acc[ai][0][m][1][j] * acc[ai][1][m][1][j]) * fast_rcp(qv + fast_exp2(__builtin_fmaf(acc[ai][0][m][1][j], k1, c0)));
                }
                if constexpr (FP8OUT) {
                    unsigned w0, w1; asm volatile("" : "=v"(w0), "=v"(w1));
                    w0 = __builtin_amdgcn_cvt_pk_fp8_f32(h0[0], h0[1], w0, false); w0 = __builtin_amdgcn_cvt_pk_fp8_f32(h0[2], h0[3], w0, true);
                    w1 = __builtin_amdgcn_cvt_pk_fp8_f32(h1[0], h1[1], w1, false); w1 = __builtin_amdgcn_cvt_pk_fp8_f32(h1[2], h1[3], w1, true);
                    *(u32x2*)(O + (size_t)row * ldb + col) = (u32x2){w0, w1};
                } else {
                    *(u32x4*)(O + (size_t)row * ldb + col * 2) = pack8(h0, h1);
                }
                if (m & 1) asm volatile("" ::: "memory");
            }
    }
};
template <bool BASE_F32>
struct EpiResid {
    static constexpr bool PERM = true, AFTER_DRAIN = false;
    const void* base; bf16_t* xb; float* ssp;
    template <int AI0, int NAI>
    __device__ __forceinline__ void part(const f32x4 (&acc)[2][2][4][2], const Unit& u, int row0, int col0, int wc, int fq) const {
        f32x4 bv[NAI * 4][2][2];
#pragma unroll
        for (int x = 0; x < NAI * 4; ++x) {
            const int row = row0 + (AI0 + (x >> 2)) * HALF + (x & 3) * 16;
#pragma unroll
            for (int bj = 0; bj < 2; ++bj) {
                const size_t c = (size_t)row * D + col0 + bj * HALF;
                if constexpr (BASE_F32) { bv[x][bj][0] = *(const f32x4*)((const float*)base + c); bv[x][bj][1] = *(const f32x4*)((const float*)base + c + 4); }
                else { const u32x4 b = *(const u32x4*)((const bf16_t*)base + c); bv[x][bj][0] = __builtin_bit_cast(f32x4, b); }
            }
        }
#pragma unroll
        for (int x = 0; x < NAI * 4; ++x) {
            const int ai = AI0 + (x >> 2), m = x & 3;
            const int row = row0 + ai * HALF + m * 16;
            float ss = 0.f;
#pragma unroll
            for (int bj = 0; bj < 2; ++bj) {
                const size_t c = (size_t)row * D + col0 + bj * HALF;
                f32x4 v0, v1;
                if constexpr (BASE_F32) { v0 = bv[x][bj][0]; v1 = bv[x][bj][1]; }
                else { const u32x4 b = __builtin_bit_cast(u32x4, bv[x][bj][0]); v0 = (f32x4){bflo(b.x), bfhi(b.x), bflo(b.y), bfhi(b.y)}; v1 = (f32x4){bflo(b.z), bfhi(b.z), bflo(b.w), bfhi(b.w)}; }
                v0 += acc[ai][bj][m][0]; v1 += acc[ai][bj][m][1];
                *(u32x4*)(xb + c) = pack8(v0, v1);
                ss += ((v0[0] * v0[0] + v0[1] * v0[1]) + (v0[2] * v0[2] + v0[3] * v0[3])) + ((v1[0] * v1[0] + v1[1] * v1[1]) + (v1[2] * v1[2] + v1[3] * v1[3]));
            }
            ss += SWZ_XOR(ss, 16); ss = xor32_sum(ss);
            if (fq == 0) ssp[(size_t)row * 16 + u.pn * 4 + wc] = ss;
        }
    }
    __device__ __forceinline__ void operator()(const f32x4 (&acc)[2][2][4][2], const Unit& u, int wr, int wc, int fr, int fq) const {
        const int row0 = u.pm * BM + wr * 64 + fr;
        const int col0 = u.pn * BM + wc * 32 + 8 * fq;
        if constexpr (BASE_F32) { part<0, 1>(acc, u, row0, col0, wc, fq); asm volatile("" ::: "memory"); part<1, 1>(acc, u, row0, col0, wc, fq); }
        else part<0, 2>(acc, u, row0, col0, wc, fq);
    }
};
struct EpiKVQ {
    static constexpr bool PERM = true, AFTER_DRAIN = false;
    bf16_t* O; const float* ssp; const float* dcos; const float* dsin; float qscale;
    __device__ __forceinline__ void operator()(const f32x4 (&acc)[2][2][4][2], const Unit& u, int wr, int wc, int fr, int fq) const {
        const int row0 = u.pm * BM + wr * 64 + fr;
        const int cl = wc * 32 + 8 * fq;
        const int kind = u.pn >> 2;
        const bool ropelane = ((wc & 1) == 0) && (fq < 2);
        float rv[8]; rinv8_from_ssp(ssp, row0, fq, rv);
#pragma unroll
        for (int ai = 0; ai < 2; ++ai)
#pragma unroll
            for (int m = 0; m < 4; ++m) {
                const int row = row0 + ai * HALF + m * 16;
                const float r = rv[ai * 4 + m] * (kind == 2 ? qscale : 1.0f);
                bf16_t* rowp = O + (size_t)row * KVQ_N + u.pn * BM + cl;
                f32x4 c0, c1, s0, s1;
                if (kind != 1) {
                    const int pos = row & (SEQ - 1);
                    c0 = *(const f32x4*)(dcos + pos * 8); c1 = *(const f32x4*)(dcos + pos * 8 + 4);
                    s0 = *(const f32x4*)(dsin + pos * 8); s1 = *(const f32x4*)(dsin + pos * 8 + 4);
                    if (fq != 0) { s0 = -s0; s1 = -s1; }
                }
#pragma unroll
                for (int bj = 0; bj < 2; ++bj) {
                    f32x4 v0 = acc[ai][bj][m][0] * r, v1 = acc[ai][bj][m][1] * r;
                    if (kind != 1) {
                        f32x4 p0, p1;
#pragma unroll
                        for (int j = 0; j < 4; ++j) { p0[j] = SWZ_XOR(v0[j], 16); p1[j] = SWZ_XOR(v1[j], 16); }
                        if (ropelane) { v0 = v0 * c0 - p0 * s0; v1 = v1 * c1 - p1 * s1; }
                    }
                    *(u32x4*)(rowp + bj * HALF) = pack8(v0, v1);
                }
                if (m & 1) asm volatile("" ::: "memory");
            }
    }
};
struct EpiMoeDown {
    static constexpr bool PERM = true, AFTER_DRAIN = false;
    bf16_t* Y; const int* rowinfo; const float* rowgate; float cscale;
    __device__ __forceinline__ void operator()(const f32x4 (&acc)[2][2][4][2], const Unit& u, int wr, int wc, int fr, int fq) const {
        const int row0 = u.pm * BM + wr * 64 + fr;
        const int cl = u.aux * BM + wc * 32 + 8 * fq;
#pragma unroll
        for (int ai = 0; ai < 2; ++ai)
#pragma unroll
            for (int m = 0; m < 4; ++m) {
                const int row = row0 + ai * HALF + m * 16;
                const int info = rowinfo[row];
                if (info >= 0) {
                    const float g = rowgate[row] * cscale;
                    bf16_t* rowp = Y + (size_t)info * D + cl;
                    *(u32x4*)(rowp) = pack8(acc[ai][0][m][0] * g, acc[ai][0][m][1] * g);
                    *(u32x4*)(rowp + HALF) = pack8(acc[ai][1][m][0] * g, acc[ai][1][m][1] * g);
                }
            }
    }
};
struct MoeOrder {
    int nM, nN, nwg, G, c; int ts[9];
    __device__ __forceinline__ bool next(int i, Unit& u) const {
        const long L = (long)i * G + c; if (L >= nwg) return false;
        int wgid = (int)L; { const int q = nwg / NXCD, r = nwg % NXCD, xcd = wgid % NXCD, off = wgid / NXCD; wgid = (xcd < r ? xcd * (q + 1) : r * (q + 1) + (xcd - r) * q) + off; }
        const int nig = WGM * nN, gid = wgid / nig, fm = gid * WGM, gsz = (nM - fm) < WGM ? (nM - fm) : WGM;
        const int pm = fm + ((wgid % nig) % gsz), pnl = (wgid % nig) / gsz;
        int e = 0;
#pragma unroll
        for (int k = 1; k < 8; ++k) e += (pm >= ts[k]) ? 1 : 0;
        u.pm = pm; u.pn = e * nN + pnl; u.aux = pnl; return true;
    }
    __device__ __forceinline__ void a_ready(const Unit&) const {}
    __device__ __forceinline__ void done(const Unit&) const {}
};
}
constexpr size_t MiB = 1u << 20;
constexpr size_t WS_CTL = 0, CTL_ZERO_BYTES = 1 * MiB;
constexpr size_t WS_RCOS = 1 * MiB, WS_RSIN = 3 * MiB;
constexpr size_t WS_DCOS = 5 * MiB, WS_DSIN = 5 * MiB + 256 * 1024;
constexpr size_t WS_SSP = 6 * MiB;
constexpr size_t WS_RWT = 7 * MiB;
constexpr size_t WS_TOPE = 8 * MiB;
constexpr size_t WS_TOPW = 8 * MiB + 128 * 1024;
constexpr size_t WS_TOPR = 8 * MiB + 256 * 1024;
constexpr size_t WS_TOKR = 8 * MiB + 384 * 1024;
constexpr size_t WS_CNT = 8 * MiB + 512 * 1024;
constexpr int XG_ROWS = 2 * M + NE * 256;
constexpr size_t WS_ROWINFO = 9 * MiB;
constexpr size_t WS_ROWGATE = 9 * MiB + 256 * 1024;
constexpr size_t WS_ROWR = 9 * MiB + 512 * 1024;
constexpr size_t WS_S = 10 * MiB;
constexpr size_t WS_W_IN = 20 * MiB, WS_W_RO = 32 * MiB, WS_W_GU = 36 * MiB, WS_W_DN = 47 * MiB, WS_W_KVQ = 53 * MiB, WS_W_DO = 59 * MiB, WS_W_MGU = 61 * MiB, WS_W_MDN = 173 * MiB;
constexpr size_t WS_XM = 232 * MiB;
constexpr size_t WS_XB = 296 * MiB;
constexpr size_t WS_PROJ = 328 * MiB;
constexpr size_t WS_RO = 520 * MiB;
constexpr size_t WS_ORET = 584 * MiB;
constexpr size_t WS_H = 328 * MiB;
constexpr size_t WS_KVQ = 584 * MiB;
constexpr size_t WS_AO = 680 * MiB;
constexpr size_t WS_Y = 712 * MiB;
constexpr size_t WS_HM = 328 * MiB;
constexpr size_t WS_XG = 584 * MiB;
constexpr size_t WS_XN8 = 776 * MiB;
constexpr size_t WS_END = 792 * MiB;
static_assert(WS_W_MDN + (size_t)NE * D * EF * 2 <= WS_XM && WS_HM + (size_t)XG_ROWS * EF * 2 <= WS_KVQ && WS_XG + (size_t)XG_ROWS * D * 2 <= WS_AO && WS_Y + (size_t)2 * M * D * 2 <= WS_END, "d_ws map");
constexpr float MOE_WGU_SCALE = 64.0f, MOE_WDN_SCALE = 128.0f, MOE_H_SCALE = 8.0f;
constexpr int CW_BAR = 4096;

constexpr int RING_BYTES = 131072;
constexpr int LDSCTL_OFF = RING_BYTES;
constexpr int LDS_BYTES = 147456;
constexpr int NWAVES = 8, NTHREADS = 512;

#define WG_BAR() do { asm volatile("s_waitcnt vmcnt(0) lgkmcnt(0)" ::: "memory"); __builtin_amdgcn_s_barrier(); asm volatile("" ::: "memory"); } while (0)

#define PHASE_IDS() int tid = threadIdx.x; asm volatile("" : "+v"(tid)); const int lane = tid & 63; const int wave = __builtin_amdgcn_readfirstlane(tid >> 6); (void)lane; (void)wave
struct TrBlk { const float* src; const float* gain; unsigned char* dst; int N, gmask, k0, ldb, fp8; float gscale; };
constexpr int TR_PITCH = 288;
__device__ __forceinline__ void tr_load(const TrBlk& B, f32x4 (&ld)[8], float (&gv)[8], int wave, int lane) {
#pragma unroll
    for (int j = 0; j < 8; ++j) {
        const int k = 16 * wave + 2 * j + (lane >> 5);
        ld[j] = *(const f32x4*)(B.src + (size_t)k * B.N + 4 * (lane & 31));
        gv[j] = B.gain ? B.gain[(B.k0 + k) & B.gmask] * B.gscale : B.gscale;
    }
}
__device__ __forceinline__ void tr_commit(const f32x4 (&ld)[8], const float (&gv)[8], LAS unsigned char* img, int wave, int lane) {
#pragma unroll
    for (int j = 0; j < 8; ++j) {
        const int k = 16 * wave + 2 * j + (lane >> 5);
        u32x2 w; w.x = pk2(ld[j][0] * gv[j], ld[j][1] * gv[j]); w.y = pk2(ld[j][2] * gv[j], ld[j][3] * gv[j]);
        *(LAS u32x2*)(img + k * TR_PITCH + 8 * (lane & 31)) = w;
    }
}
__device__ __forceinline__ void tr_emit(const TrBlk& B, LAS const unsigned char* img, int wave, int lane) {
    const int i = lane & 15, g = lane >> 4, q = i >> 2, p = i & 3;
#pragma unroll
    for (int kg = 0; kg < 4; ++kg) {
        const int kb = 8 * (4 * kg + g);
        const s16x4 lo = __builtin_bit_cast(s16x4, __builtin_amdgcn_ds_read_tr16_b64_v4i16((LAS s16x4*)(img + (kb + q) * TR_PITCH + (16 * wave + 4 * p) * 2)));
        const s16x4 hi = __builtin_bit_cast(s16x4, __builtin_amdgcn_ds_read_tr16_b64_v4i16((LAS s16x4*)(img + (kb + 4 + q) * TR_PITCH + (16 * wave + 4 * p) * 2)));
        if (!B.fp8) {
            v4u o; o.x = (unsigned)(unsigned short)lo[0] | ((unsigned)(unsigned short)lo[1] << 16); o.y = (unsigned)(unsigned short)lo[2] | ((unsigned)(unsigned short)lo[3] << 16);
            o.z = (unsigned)(unsigned short)hi[0] | ((unsigned)(unsigned short)hi[1] << 16); o.w = (unsigned)(unsigned short)hi[2] | ((unsigned)(unsigned short)hi[3] << 16);
            *(GAS v4u*)(B.dst + (size_t)(16 * wave + i) * B.ldb + kb * 2) = o;
        } else {
            unsigned w0 = 0u, w1 = 0u;
            w0 = __builtin_amdgcn_cvt_pk_fp8_f32(bf2f((unsigned short)lo[0]), bf2f((unsigned short)lo[1]), w0, false);
            w0 = __builtin_amdgcn_cvt_pk_fp8_f32(bf2f((unsigned short)lo[2]), bf2f((unsigned short)lo[3]), w0, true);
            w1 = __builtin_amdgcn_cvt_pk_fp8_f32(bf2f((unsigned short)hi[0]), bf2f((unsigned short)hi[1]), w1, false);
            w1 = __builtin_amdgcn_cvt_pk_fp8_f32(bf2f((unsigned short)hi[2]), bf2f((unsigned short)hi[3]), w1, true);
            *(GAS u32x2*)(B.dst + (size_t)(16 * wave + i) * B.ldb + kb) = (u32x2){w0, w1};
        }
    }
}

struct Ptrs {
    const float *x, *ln_mix, *ln_ffn, *ret_w_in, *ret_w_o, *kv_norm, *w_kv, *diff_w_q, *lq1, *lk1, *lq2, *lk2, *subln, *diff_w_o, *ffn_w_gu, *ffn_w_down, *router, *moe_w_gu, *moe_w_down, *final_norm;
    float* out; unsigned char* ws;
};

__device__ __forceinline__ void p0_prologue(const Ptrs& P, LAS unsigned char* lds, int vcu, int G, float lambda_init) {
    PHASE_IDS();
    unsigned char* ws = P.ws;
    const int gw = vcu * NWAVES + wave, NGW = G * NWAVES;
    {
        constexpr int B_IN = (D / 128) * (RIN / 128), B_RO = (RVD / 128) * (D / 128), B_GU = (D / 128) * (2 * FF / 128), B_DN = (FF / 128) * (D / 128), B_KV = (D / 128) * (2048 / 128), B_Q = (D / 128) * (D / 128), B_DO = B_Q;
        constexpr int NBLK = B_IN + B_RO + B_GU + B_DN + B_KV + B_Q + B_DO;
        auto decode = [&](int it) -> TrBlk {
            const float* W; const float* gain = nullptr; int K, N, gmask = 0, F = 0, row_off = 0, fp8 = 0; float gscale = 1.f; unsigned char* WT; int r = it;
            if (r < B_IN) { W = P.ret_w_in; K = D; N = RIN; gain = P.ln_mix; gmask = 1023; WT = ws + WS_W_IN; }
            else if ((r -= B_IN) < B_RO) { W = P.ret_w_o; K = RVD; N = D; WT = ws + WS_W_RO; }
            else if ((r -= B_RO) < B_GU) { W = P.ffn_w_gu; K = D; N = 2 * FF; gain = P.ln_ffn; gmask = 1023; F = FF; WT = ws + WS_W_GU; }
            else if ((r -= B_GU) < B_DN) { W = P.ffn_w_down; K = FF; N = D; WT = ws + WS_W_DN; }
            else if ((r -= B_DN) < B_KV) { W = P.w_kv; K = D; N = 2048; gain = P.kv_norm; gmask = 1023; WT = ws + WS_W_KVQ; }
            else if ((r -= B_KV) < B_Q) { W = P.diff_w_q; K = D; N = D; gain = P.ln_mix + D; gmask = 1023; row_off = 2048; WT = ws + WS_W_KVQ; }
            else if ((r -= B_Q) < B_DO) { W = P.diff_w_o; K = D; N = D; gain = P.subln; gmask = 127; gscale = 1.0f - lambda_init; WT = ws + WS_W_DO; }
            else { W = P.diff_w_o; K = D; N = D; WT = ws + WS_W_DO; }
            const int nblk = N / 128, kb = r / nblk, nb = r % nblk, k0 = 128 * kb, n0 = 128 * nb;
            int drow = n0;
            if (F > 0) { const int up = n0 >= F ? 1 : 0; const int f = n0 - up * F; drow = 256 * (f >> 7) + 128 * up; }
            TrBlk B; B.src = W + (size_t)k0 * N + n0; B.gain = gain; B.N = N; B.gmask = gmask; B.k0 = k0; B.ldb = fp8 ? K : K * 2; B.fp8 = fp8; B.gscale = gscale;
            B.dst = WT + ((size_t)(row_off + drow) * K + k0) * (fp8 ? 1 : 2);
            return B;
        };
#define LDS_BAR() do { asm volatile("s_waitcnt lgkmcnt(0)" ::: "memory"); __builtin_amdgcn_s_barrier(); asm volatile("" ::: "memory"); } while (0)
        LAS unsigned char* img0 = lds; LAS unsigned char* img1 = lds + 128 * TR_PITCH;
        f32x4 ldA[8], ldB[8]; float gvA[8], gvB[8];
        int it = vcu;
        TrBlk bA = decode(it < NBLK ? it : 0), bB = decode(it + G < NBLK ? it + G : 0);
        if (it < NBLK) tr_load(bA, ldA, gvA, wave, lane);
        if (it + G < NBLK) tr_load(bB, ldB, gvB, wave, lane);
        for (; it < NBLK; it += 2 * G) {
            tr_commit(ldA, gvA, img0, wave, lane);
            LDS_BAR();
            const TrBlk cA = bA; const int n2 = it + 2 * G;
            bA = decode(n2 < NBLK ? n2 : 0);
            if (n2 < NBLK) tr_load(bA, ldA, gvA, wave, lane);
            tr_emit(cA, img0, wave, lane);
            if (it + G < NBLK) {
                tr_commit(ldB, gvB, img1, wave, lane);
                LDS_BAR();
                const TrBlk cB = bB; const int n3 = it + 3 * G;
                bB = decode(n3 < NBLK ? n3 : 0);
                if (n3 < NBLK) tr_load(bB, ldB, gvB, wave, lane);
                tr_emit(cB, img1, wave, lane);
            }
        }
        LDS_BAR();
#undef LDS_BAR
    }
    {
        const int gt = gw * 64 + lane, NT = NGW * 64;
        float* rc = (float*)(ws + WS_RCOS); float* rs = (float*)(ws + WS_RSIN);
        for (int i = gt; i < SEQ * 128; i += NT) {
            const int pos = i >> 7, f = i & 127;
            const float inv = exp2f(-(float)f * (13.287712379549449f / 128.0f));
            const double rev = (double)((float)pos * inv) * 0.15915494309189535;
            const float fr = (float)(rev - floor(rev));
            rc[i] = __builtin_amdgcn_cosf(fr); rs[i] = __builtin_amdgcn_sinf(fr);
        }
        float* dc = (float*)(ws + WS_DCOS); float* ds = (float*)(ws + WS_DSIN);
        for (int i = gt; i < SEQ * 8; i += NT) {
            const int pos = i >> 3, f = i & 7;
            const float inv = exp2f(-(float)f * (18.931568569324174f / 8.0f));
            const double rev = (double)((float)pos * inv) * 0.15915494309189535;
            const float fr = (float)(rev - floor(rev));
            dc[i] = __builtin_amdgcn_cosf(fr); ds[i] = __builtin_amdgcn_sinf(fr);
        }
        float* rwt = (float*)(ws + WS_RWT);
        for (int i = gt; i < NE * D; i += NT) { const int e = i >> 10, k = i & 1023; rwt[i] = P.router[k * NE + e] * P.ln_ffn[D + k]; }
    }
    {
        bf16* xb = (bf16*)(ws + WS_XB); float* ssp = (float*)(ws + WS_SSP);
        f32x4 nv[4];
        if (gw < M) { const GAS f32x4* xr = (const GAS f32x4*)(P.x + (size_t)gw * D) + lane;
#pragma unroll
            for (int j = 0; j < 4; ++j) nv[j] = xr[64 * j]; }
        for (int m = gw; m < M; m += NGW) {
            f32x4 v[4]; float s = 0.f;
#pragma unroll
            for (int j = 0; j < 4; ++j) { v[j] = nv[j]; s += (v[j].x * v[j].x + v[j].y * v[j].y) + (v[j].z * v[j].z + v[j].w * v[j].w); }
            if (m + NGW < M) { const GAS f32x4* xr = (const GAS f32x4*)(P.x + (size_t)(m + NGW) * D) + lane;
#pragma unroll
                for (int j = 0; j < 4; ++j) nv[j] = xr[64 * j]; }
            s = wave_sum(s);
            GAS unsigned long long* o8 = (GAS unsigned long long*)(xb + (size_t)m * D) + lane;
#pragma unroll
            for (int j = 0; j < 4; ++j) o8[64 * j] = (unsigned long long)pk2(v[j].x, v[j].y) | ((unsigned long long)pk2(v[j].z, v[j].w) << 32);
            if (lane < 16) ssp[(size_t)m * 16 + lane] = lane == 0 ? s : 0.f;
        }
    }
}

constexpr int CV_BLKS_GU = NE * (D / 128) * (2 * EF / 128), CV_BLKS_DN = NE * (EF / 128) * (D / 128), CV_BLKS = CV_BLKS_GU + CV_BLKS_DN;
constexpr int CV_PITCH = 272, CV_IMG = 32 * CV_PITCH;
struct CvMini { const float* src; unsigned char* dst; int N, ldb, kg; };
__device__ __forceinline__ CvMini cv_decode(const Ptrs& P, int blk, int qk) {
    CvMini m;
    if (blk < CV_BLKS_GU) {
        const int e = blk / 448, r = blk % 448, kb = r / 56, nb = r % 56, k0 = 128 * kb + 32 * qk, n0 = 128 * nb;
        const int up = n0 >= EF ? 1 : 0, f = n0 - up * EF, drow = 256 * (f >> 7) + 128 * up;
        m.src = P.moe_w_gu + (size_t)e * D * 2 * EF + (size_t)k0 * (2 * EF) + n0; m.kg = k0; m.N = 2 * EF;
        m.dst = P.ws + WS_W_MGU + (size_t)e * 2 * EF * D + (size_t)drow * D + k0; m.ldb = D;
    } else {
        const int b2 = blk - CV_BLKS_GU, e = b2 / 224, r = b2 % 224, kb = r / 8, nb = r % 8, k0 = 128 * kb + 32 * qk, n0 = 128 * nb;
        m.src = P.moe_w_down + (size_t)e * EF * D + (size_t)k0 * D + n0; m.kg = -1; m.N = D;
        m.dst = P.ws + WS_W_MDN + (size_t)e * D * EF + (size_t)n0 * EF + k0; m.ldb = EF;
    }
    return m;
}
__device__ __forceinline__ void cv_load(const CvMini& m, f32x4 (&v)[2], int tid) {
#pragma unroll
    for (int j = 0; j < 2; ++j) { const int row = (tid >> 5) + 16 * j; v[j] = __builtin_nontemporal_load((const f32x4*)(m.src + (size_t)row * m.N + 4 * (tid & 31))); }
}
__device__ __forceinline__ void cv_commit(const f32x4 (&v)[2], int kg, LAS const float* gtab, LAS unsigned char* img, int tid) {
#pragma unroll
    for (int j = 0; j < 2; ++j) { const int row = (tid >> 5) + 16 * j;
        const float gn = kg >= 0 ? gtab[kg + row] : MOE_WDN_SCALE;
        u32x2 w; w.x = pk2(v[j][0] * gn, v[j][1] * gn); w.y = pk2(v[j][2] * gn, v[j][3] * gn);
        *(LAS u32x2*)(img + row * CV_PITCH + 8 * (tid & 31)) = w; }
}
__device__ __forceinline__ void cv_emit(unsigned char* dst, int ldb, LAS const unsigned char* img, int wave, int lane) {
    const int i = lane & 15, g4 = lane >> 4, q = i >> 2, p = i & 3;
    const s16x4 lo = __builtin_bit_cast(s16x4, __builtin_amdgcn_ds_read_tr16_b64_v4i16((LAS s16x4*)(img + (8 * g4 + q) * CV_PITCH + (16 * wave + 4 * p) * 2)));
    const s16x4 hi = __builtin_bit_cast(s16x4, __builtin_amdgcn_ds_read_tr16_b64_v4i16((LAS s16x4*)(img + (8 * g4 + 4 + q) * CV_PITCH + (16 * wave + 4 * p) * 2)));
    unsigned w0, w1; asm volatile("" : "=v"(w0), "=v"(w1));
    w0 = __builtin_amdgcn_cvt_pk_fp8_f32(bf2f((unsigned short)lo[0]), bf2f((unsigned short)lo[1]), w0, false); w0 = __builtin_amdgcn_cvt_pk_fp8_f32(bf2f((unsigned short)lo[2]), bf2f((unsigned short)lo[3]), w0, true);
    w1 = __builtin_amdgcn_cvt_pk_fp8_f32(bf2f((unsigned short)hi[0]), bf2f((unsigned short)hi[1]), w1, false); w1 = __builtin_amdgcn_cvt_pk_fp8_f32(bf2f((unsigned short)hi[2]), bf2f((unsigned short)hi[3]), w1, true);
    *(GAS u32x2*)(dst + (size_t)(16 * wave + i) * ldb + 8 * g4) = (u32x2){w0, w1};
}

namespace ret {
typedef short v4i16_t __attribute__((ext_vector_type(4)));
__device__ __forceinline__ s16x4 trld(LAS const unsigned char* p) { return __builtin_bit_cast(s16x4, __builtin_amdgcn_ds_read_tr16_b64_v4i16((LAS v4i16_t*)p)); }
__device__ __forceinline__ bf16x8 cat8(s16x4 lo, s16x4 hi) { return (bf16x8){lo[0], lo[1], lo[2], lo[3], hi[0], hi[1], hi[2], hi[3]}; }
constexpr int QSTR = 528, SSTR = 144;
constexpr int LQ = 0, LK = LQ + 64 * QSTR, LV = LK + 64 * 512, LVD = LV + 4096, LS = LVD + 4096, LST = LS + 64 * SSTR, LEND = LST + 32 * QSTR;
static_assert(LEND + 2 * 32 * 272 + 4096 <= RING_BYTES && (LK % 16) == 0 && (LV % 16) == 0 && (LS % 16) == 0 && (LST % 16) == 0, "retention LDS map");

__device__ __forceinline__ void scores_phase(const bf16* proj, bf16* sbuf, LAS unsigned char* lds, int vcu, int G) {
    PHASE_IDS();
    const int i = lane & 15, g = lane >> 4;
    const int srow = tid >> 5, sc16 = tid & 31;
    constexpr int SQ = 0, SK = 64 * QSTR;
    for (int u = vcu; u < 1024; u += G) {
        const int bh = u >> 6, c = u & 63, b = bh >> 2, h = bh & 3;
        const size_t R0 = (size_t)b * SEQ + c * 64;
        const float lg = log2f(1.0f - exp2f(-5.0f - (float)h));
        const bf16* gq = proj + (R0 + srow) * RIN + h * 256 + sc16 * 8;
        v4u tq[4], tk[4];
#pragma unroll
        for (int k = 0; k < 4; ++k) { tq[k] = *(const v4u*)(gq + (size_t)(16 * k) * RIN); tk[k] = *(const v4u*)(gq + 1024 + (size_t)(16 * k) * RIN); }
#pragma unroll
        for (int k = 0; k < 4; ++k) { *(LAS v4u*)(lds + SQ + (srow + 16 * k) * QSTR + sc16 * 16) = tq[k]; *(LAS v4u*)(lds + SK + (srow + 16 * k) * QSTR + sc16 * 16) = tk[k]; }
        WG_BAR();
#pragma unroll
        for (int tt = 0; tt < 2; ++tt) {
            const int ti = 2 * wave + tt, tn = ti >> 2, tm = ti & 3;
            f32x4 acc = (f32x4){0.f, 0.f, 0.f, 0.f};
            if (tm <= tn) {
#pragma unroll
                for (int s = 0; s < 8; ++s) {
                    const bf16x8 a = *(const LAS bf16x8*)(lds + SK + (16 * tm + i) * QSTR + (32 * s + 8 * g) * 2), bq = *(const LAS bf16x8*)(lds + SQ + (16 * tn + i) * QSTR + (32 * s + 8 * g) * 2);
                    acc = __builtin_amdgcn_mfma_f32_16x16x32_bf16(a, bq, acc, 0, 0, 0);
                }
            }
            const int n = 16 * tn + i, m0 = 16 * tm + 4 * g;
            float v[4];
#pragma unroll
            for (int r = 0; r < 4; ++r) { const int dm = n - (m0 + r); v[r] = dm >= 0 ? acc[r] * exp2f((float)dm * lg) : 0.f; }
            u32x2 w; w.x = pk2(v[0], v[1]); w.y = pk2(v[2], v[3]);
            *(u32x2*)(sbuf + (size_t)u * 4096 + n * 64 + m0) = w;
        }
        WG_BAR();
    }
}

__device__ __forceinline__ void scan_phase(const Ptrs& P, const bf16* proj, const bf16* sbuf, bf16* oret, LAS unsigned char* lds, int vcu, int G) {
    PHASE_IDS();
    int cvp = 0;
    struct CvSet { f32x4 a[2], b[2]; unsigned char* d0; unsigned char* d1; int l0, l1, k0, k1; bool have; };
    CvSet cs0, cs1; cs0.have = false; cs1.have = false; cs0.d0 = cs0.d1 = cs1.d0 = cs1.d1 = nullptr; cs0.l0 = cs0.l1 = cs1.l0 = cs1.l1 = 0; cs0.k0 = cs0.k1 = cs1.k0 = cs1.k1 = -1;
    LAS float* gtab = (LAS float*)(lds + LEND + 2 * CV_IMG);
    for (int k = tid; k < D; k += NTHREADS) gtab[k] = P.ln_ffn[D + k] * MOE_WGU_SCALE;
    WG_BAR();
#define SCAN_LBAR() do { asm volatile("s_waitcnt lgkmcnt(0)" ::: "memory"); __builtin_amdgcn_s_barrier(); asm volatile("" ::: "memory"); } while (0)
    LAS unsigned char* cimg0 = lds + LEND; LAS unsigned char* cimg1 = lds + LEND + CV_IMG;
    const int i = lane & 15, g = lane >> 4, q = i >> 2, p = i & 3;
    const int nt = wave >> 1, vt = wave & 1;
    for (int u = vcu; u < 256; u += G) {
        const int bh = u >> 4, vs = u & 15, b = bh >> 2, h = bh & 3;
        const float lg = log2f(1.0f - exp2f(-5.0f - (float)h));
        const float cdec = exp2f(64.0f * lg);
        const float qdl = exp2f((float)(16 * nt + i + 1) * lg);
        const float kd = exp2f((float)(63 - (tid >> 2)) * lg);
        const int qrow = tid >> 5, qc16 = tid & 31;
        const char* uq = (const char*)(proj + (size_t)b * SEQ * RIN + h * 256);
        const unsigned qoff = (unsigned)(qrow * RIN + qc16 * 8) * 2u;
        const int kx = (qrow & 3) | (((qrow >> 3) & 1) << 2);
        const int lq_off = LQ + qrow * QSTR + qc16 * 16;
        const int lk_off = LK + qrow * 512 + (((qc16 >> 1) ^ kx) << 5) + (qc16 & 1) * 16;
        const int vrow = tid >> 2, vc16 = tid & 3;
        const char* uv = (const char*)(proj + (size_t)b * SEQ * RIN + 2048 + h * 512 + vs * 32);
        const unsigned voff = (unsigned)(vrow * RIN + vc16 * 8) * 2u;
        const int lv_off = vrow * 64 + ((vc16 * 16) ^ (((vrow >> 3) & 1) << 5));
        const int srow = tid >> 3, sc16 = tid & 7;
        const char* us = (const char*)(sbuf + (size_t)(bh * 64) * 4096);
        const unsigned soff = (unsigned)tid * 16u;
        const int ls_off = LS + srow * SSTR + sc16 * 16;
        f32x4 st[2][2];
#pragma unroll
        for (int a = 0; a < 2; ++a)
#pragma unroll
            for (int c2 = 0; c2 < 2; ++c2) st[a][c2] = (f32x4){0.f, 0.f, 0.f, 0.f};
        for (int k = tid; k < 32 * QSTR / 16; k += NTHREADS) ((LAS v4u*)(lds + LST))[k] = (v4u){0u, 0u, 0u, 0u};
        v4u pq[4], pk[4], pv, ps;
#pragma unroll
        for (int k = 0; k < 4; ++k) { pq[k] = *(const v4u*)(uq + (size_t)(16 * k) * RIN * 2 + qoff); pk[k] = *(const v4u*)(uq + (size_t)(16 * k) * RIN * 2 + 2048 + qoff); }
        pv = (tid < 256) ? *(const v4u*)(uv + voff) : (v4u){0u, 0u, 0u, 0u};
        ps = *(const v4u*)(us + soff);
        auto scan_step = [&](const int c, CvSet& CS) __attribute__((always_inline)) {
#pragma unroll
            for (int k = 0; k < 4; ++k) { *(LAS v4u*)(lds + lq_off + 16 * k * QSTR) = pq[k]; *(LAS v4u*)(lds + lk_off + 16 * k * 512) = pk[k]; }
            if (tid < 256) {
                *(LAS v4u*)(lds + LV + lv_off) = pv;
                v4u d; d.x = pk2(bflo(pv.x) * kd, bfhi(pv.x) * kd); d.y = pk2(bflo(pv.y) * kd, bfhi(pv.y) * kd); d.z = pk2(bflo(pv.z) * kd, bfhi(pv.z) * kd); d.w = pk2(bflo(pv.w) * kd, bfhi(pv.w) * kd);
                *(LAS v4u*)(lds + LVD + lv_off) = d;
            }
            *(LAS v4u*)(lds + ls_off) = ps;
            unsigned char* ed0 = CS.d0; unsigned char* ed1 = CS.d1; const int el0 = CS.l0, el1 = CS.l1; const bool cv_emit_now = CS.have;
            if (CS.have) { cv_commit(CS.a, CS.k0, gtab, cimg0, tid); cv_commit(CS.b, CS.k1, gtab, cimg1, tid); }
            SCAN_LBAR();
            if (c + 1 < 64) {
                const size_t adv = (size_t)(c + 1) * 64 * RIN * 2;
#pragma unroll
                for (int k = 0; k < 4; ++k) { pq[k] = *(const v4u*)(uq + adv + (size_t)(16 * k) * RIN * 2 + qoff); pk[k] = *(const v4u*)(uq + adv + (size_t)(16 * k) * RIN * 2 + 2048 + qoff); }
                if (tid < 256) pv = *(const v4u*)(uv + adv + voff);
                ps = *(const v4u*)(us + (size_t)(c + 1) * 8192 + soff);
            }
            {
                const int blk = vcu + (cvp >> 1) * G;
                CS.have = blk < CV_BLKS;
                if (CS.have) { const CvMini m0 = cv_decode(P, blk, 2 * (cvp & 1)), m1 = cv_decode(P, blk, 2 * (cvp & 1) + 1);
                    cv_load(m0, CS.a, tid); cv_load(m1, CS.b, tid); CS.d0 = m0.dst; CS.l0 = m0.ldb; CS.k0 = m0.kg; CS.d1 = m1.dst; CS.l1 = m1.ldb; CS.k1 = m1.kg; ++cvp; }
            }
            f32x4 a1 = (f32x4){0.f, 0.f, 0.f, 0.f}, a2 = (f32x4){0.f, 0.f, 0.f, 0.f}, a3 = (f32x4){0.f, 0.f, 0.f, 0.f};
#pragma unroll
            for (int s = 0; s < 2; ++s) {
                const bf16x8 a = *(const LAS bf16x8*)(lds + LS + (16 * nt + i) * SSTR + (32 * s + 8 * g) * 2);
                const int r0 = 32 * s + 8 * g + q, r1 = r0 + 4, cb = (16 * vt + 4 * p) * 2;
                const s16x4 lo = trld(lds + LV + r0 * 64 + (cb ^ (((r0 >> 3) & 1) << 5))), hi = trld(lds + LV + r1 * 64 + (cb ^ (((r1 >> 3) & 1) << 5)));
                a1 = __builtin_amdgcn_mfma_f32_16x16x32_bf16(cat8(lo, hi), a, a1, 0, 0, 0);
            }
#pragma unroll
            for (int s = 0; s < 8; ++s) {
                const bf16x8 a = *(const LAS bf16x8*)(lds + LQ + (16 * nt + i) * QSTR + (32 * s + 8 * g) * 2);
                const bf16x8 sf = *(const LAS bf16x8*)(lds + LST + (16 * vt + i) * QSTR + (32 * s + 8 * g) * 2);
                if (s & 1) a3 = __builtin_amdgcn_mfma_f32_16x16x32_bf16(sf, a, a3, 0, 0, 0);
                else a2 = __builtin_amdgcn_mfma_f32_16x16x32_bf16(sf, a, a2, 0, 0, 0);
            }
#pragma unroll
            for (int dt = 0; dt < 2; ++dt)
#pragma unroll
                for (int vv = 0; vv < 2; ++vv) st[dt][vv] = st[dt][vv] * cdec;
#pragma unroll
            for (int s = 0; s < 2; ++s) {
                const int r0 = 32 * s + 8 * g + q, r1 = r0 + 4;
                const int x0 = (r0 & 3) | (((r0 >> 3) & 1) << 2), x1 = (r1 & 3) | (((r1 >> 3) & 1) << 2);
                bf16x8 ka[2], vb[2];
#pragma unroll
                for (int dt = 0; dt < 2; ++dt) {
                    const int slot = 2 * wave + dt;
                    ka[dt] = cat8(trld(lds + LK + r0 * 512 + ((slot ^ x0) << 5) + 8 * p), trld(lds + LK + r1 * 512 + ((slot ^ x1) << 5) + 8 * p));
                }
#pragma unroll
                for (int vv = 0; vv < 2; ++vv) {
                    const int cb = (16 * vv + 4 * p) * 2;
                    vb[vv] = cat8(trld(lds + LVD + r0 * 64 + (cb ^ (((r0 >> 3) & 1) << 5))), trld(lds + LVD + r1 * 64 + (cb ^ (((r1 >> 3) & 1) << 5))));
                }
#pragma unroll
                for (int dt = 0; dt < 2; ++dt)
#pragma unroll
                    for (int vv = 0; vv < 2; ++vv) st[dt][vv] = __builtin_amdgcn_mfma_f32_16x16x32_bf16(ka[dt], vb[vv], st[dt][vv], 0, 0, 0);
            }
            {
                char* uo = (char*)(oret + ((size_t)b * SEQ + c * 64) * RVD + h * 512 + vs * 32);
                const unsigned ooff = (unsigned)((16 * nt + i) * RVD + 16 * vt + 4 * g) * 2u;
                float ov_[4];
#pragma unroll
                for (int r = 0; r < 4; ++r) ov_[r] = a1[r] + qdl * (a2[r] + a3[r]);
                u32x2 w_; w_.x = pk2(ov_[0], ov_[1]); w_.y = pk2(ov_[2], ov_[3]);
                *(u32x2*)(uo + ooff) = w_;
            }
            if (cv_emit_now) { cv_emit(ed0, el0, cimg0, wave, lane); cv_emit(ed1, el1, cimg1, wave, lane); }
            SCAN_LBAR();
#pragma unroll
            for (int dt = 0; dt < 2; ++dt)
#pragma unroll
                for (int vv = 0; vv < 2; ++vv)
                    *(LAS u32x2*)(lds + LST + (16 * vv + i) * QSTR + (32 * wave + 16 * dt + 4 * g) * 2) = (u32x2){pk2(st[dt][vv][0], st[dt][vv][1]), pk2(st[dt][vv][2], st[dt][vv][3])};
        };
        for (int c = 0; c < 64; c += 2) { scan_step(c, cs0); scan_step(c + 1, cs1); }
        WG_BAR();
    }
    for (;;) {
        bool any = false;
#pragma unroll
        for (int k = 0; k < 2; ++k) {
            CvSet& CS = k ? cs1 : cs0;
            unsigned char* ed0 = CS.d0; unsigned char* ed1 = CS.d1; const int el0 = CS.l0, el1 = CS.l1; const bool emit_now = CS.have;
            if (CS.have) { cv_commit(CS.a, CS.k0, gtab, cimg0, tid); cv_commit(CS.b, CS.k1, gtab, cimg1, tid); }
            WG_BAR();
            const int blk = vcu + (cvp >> 1) * G;
            CS.have = blk < CV_BLKS;
            if (CS.have) { const CvMini m0 = cv_decode(P, blk, 2 * (cvp & 1)), m1 = cv_decode(P, blk, 2 * (cvp & 1) + 1);
                cv_load(m0, CS.a, tid); cv_load(m1, CS.b, tid); CS.d0 = m0.dst; CS.l0 = m0.ldb; CS.k0 = m0.kg; CS.d1 = m1.dst; CS.l1 = m1.ldb; CS.k1 = m1.kg; ++cvp; }
            if (emit_now) { cv_emit(ed0, el0, cimg0, wave, lane); cv_emit(ed1, el1, cimg1, wave, lane); }
            WG_BAR();
            any = any || emit_now || CS.have;
        }
        if (!any) break;
    }
#undef SCAN_LBAR
}

__device__ __forceinline__ void norm_gate_phase(const bf16* oret, const bf16* proj, bf16* ro, int vcu, int G) {
    PHASE_IDS();
    const int gw = vcu * NWAVES + wave, NGW = G * NWAVES;
    for (int row = gw; row < M; row += NGW) {
        v4u ov[4], gv[4];
#pragma unroll
        for (int h = 0; h < 4; ++h) {
            ov[h] = *(const v4u*)(oret + (size_t)row * RVD + h * 512 + lane * 8);
            gv[h] = *(const v4u*)(proj + (size_t)row * RIN + 4096 + h * 512 + lane * 8);
        }
        float o[4][8], mu[4], rstd[4];
#pragma unroll
        for (int h = 0; h < 4; ++h) {
            o[h][0] = bflo(ov[h].x); o[h][1] = bfhi(ov[h].x); o[h][2] = bflo(ov[h].y); o[h][3] = bfhi(ov[h].y); o[h][4] = bflo(ov[h].z); o[h][5] = bfhi(ov[h].z); o[h][6] = bflo(ov[h].w); o[h][7] = bfhi(ov[h].w);
            float s = 0.f;
#pragma unroll
            for (int j = 0; j < 8; ++j) s += o[h][j];
            mu[h] = s;
        }
#pragma unroll
        for (int h = 0; h < 4; ++h) mu[h] = wave_sum(mu[h]) * (1.0f / 512.0f);
#pragma unroll
        for (int h = 0; h < 4; ++h) {
            float s2 = 0.f;
#pragma unroll
            for (int j = 0; j < 8; ++j) { o[h][j] -= mu[h]; s2 += o[h][j] * o[h][j]; }
            rstd[h] = s2;
        }
#pragma unroll
        for (int h = 0; h < 4; ++h) rstd[h] = __builtin_amdgcn_rsqf(wave_sum(rstd[h]) * (1.0f / 512.0f) + EPS);
#pragma unroll
        for (int h = 0; h < 4; ++h) {
            const float gg[8] = {bflo(gv[h].x), bfhi(gv[h].x), bflo(gv[h].y), bfhi(gv[h].y), bflo(gv[h].z), bfhi(gv[h].z), bflo(gv[h].w), bfhi(gv[h].w)};
            float y[8];
#pragma unroll
            for (int j = 0; j < 8; ++j) y[j] = o[h][j] * rstd[h] * silu_f(gg[j]);
            v4u w; w.x = pk2(y[0], y[1]); w.y = pk2(y[2], y[3]); w.z = pk2(y[4], y[5]); w.w = pk2(y[6], y[7]);
            *(v4u*)(ro + (size_t)row * RVD + h * 512 + lane * 8) = w;
        }
    }
}
}

namespace dat {
constexpr int LK0 = 0  , LV0 = 32768  , LWS = 81920  , LCB = 0  , CSTR = 132;
__device__ __forceinline__ int crow(int r, int hi) { return (r & 3) + 8 * (r >> 2) + 4 * hi; }
__device__ __forceinline__ float half_swap_max(float m) { auto rr = __builtin_amdgcn_permlane32_swap(__float_as_uint(m), __float_as_uint(m), false, false); return fmaxf(__uint_as_float(rr[0]), __uint_as_float(rr[1])); }
__device__ __forceinline__ float half_swap_sum(float m) { auto rr = __builtin_amdgcn_permlane32_swap(__float_as_uint(m), __float_as_uint(m), false, false); return __uint_as_float(rr[0]) + __uint_as_float(rr[1]); }
typedef float f32x2_t __attribute__((ext_vector_type(2))); typedef __bf16 bf16x2_t __attribute__((ext_vector_type(2)));
__device__ __forceinline__ unsigned cvtpk(float lo, float hi) { f32x2_t v = {lo, hi}; bf16x2_t b2 = __builtin_convertvector(v, bf16x2_t); return __builtin_bit_cast(unsigned, b2); }
__device__ __forceinline__ float max3f(float a, float b, float c) { float r; asm("v_max3_f32 %0, %1, %2, %3" : "=v"(r) : "v"(a), "v"(b), "v"(c)); return r; }
__device__ __forceinline__ float fadd_s(float a, float b) { float r; asm("v_add_f32_e32 %0, %1, %2" : "=v"(r) : "v"(a), "v"(b)); return r; }

#define DAT_SBAR() __builtin_amdgcn_sched_barrier(0)
#define DAT_PIN(x) asm volatile("" : "+v"(x))
__device__ __forceinline__ void attn_unit(int b, int h, int qb, const bf16* kvq, bf16* ao, LAS unsigned char* lds, float lam, int wave, int lane, int tid) {
    const int r32 = lane & 31, hi = lane >> 5, comp = wave >> 2, w4 = wave & 3;
    const size_t rowbase = (size_t)b * SEQ;
    const int q0 = qb * 128;
    const int NT = 2 * qb + 2, ntw = 2 * qb + 1 + (w4 >> 1);
    const bf16* Kh = kvq + rowbase * KVQ_N + h * 128;
    const bf16* Vh = kvq + rowbase * KVQ_N + 1024 + h * 128;
    const bf16* Qw = kvq + (rowbase + q0 + w4 * 32) * KVQ_N + 2048 + h * 128 + comp * 64;
    LAS float* wsf = (LAS float*)(lds + LWS) + wave * 64;
    const int pkey = 4 * wave + (lane >> 4), pc = lane & 15;
    const unsigned kvoff = (unsigned)(pkey * KVQ_N + ((pc ^ (pkey & 15)) << 3)) * 2u;
    const unsigned vvoff = (unsigned)(pkey * KVQ_N + ((pc ^ ((pkey & 3) << 2)) << 3)) * 2u;
    const int koff0 = r32 * 256 + (((comp * 8 + hi) ^ (r32 & 15)) << 4);
    const int voff0 = (4 * hi + ((lane & 15) >> 2)) * 256 + ((((lane & 15) >> 2) << 6) | ((4 * ((lane >> 4) & 1) + (lane & 3)) << 3));
#define koffd(d) (koff0 ^ ((d) << 5))
#define voffd(d) (voff0 ^ ((d) << 6))
    const unsigned ldsb = (unsigned)(size_t)lds;
#define DAT_GLDS(base, voff, dst) do { unsigned keep_; asm volatile("s_mov_b32 %0, m0\n\ts_mov_b32 m0, %3\n\ts_nop 0\n\tglobal_load_lds_dwordx4 %1, %2\n\ts_mov_b32 m0, %0" : "=&s"(keep_) : "v"(voff), "s"(base), "s"(dst) : "memory"); } while (0)
#define DAT_DMA(t, kslot, vslot) do { const bf16* kb0_ = Kh + (size_t)(t) * 64 * KVQ_N; const bf16* vb0_ = Vh + (size_t)(t) * 64 * KVQ_N; \
        const unsigned kd_ = (unsigned)__builtin_amdgcn_readfirstlane(ldsb + LK0 + (kslot) * 16384 + wave * 1024), vd_ = (unsigned)__builtin_amdgcn_readfirstlane(ldsb + LV0 + (vslot) * 16384 + wave * 1024); \
        DAT_GLDS(kb0_, kvoff, kd_); DAT_GLDS(kb0_ + (size_t)32 * KVQ_N, kvoff, kd_ + 8192u); DAT_GLDS(vb0_, vvoff, vd_); DAT_GLDS(vb0_ + (size_t)32 * KVQ_N, vvoff, vd_ + 8192u); } while (0)
    DAT_DMA(0, 0, 0);
    bf16x8 qr[4];
#pragma unroll
    for (int d0 = 0; d0 < 4; ++d0) qr[d0] = *(const bf16x8*)(Qw + (size_t)r32 * KVQ_N + d0 * 16 + hi * 8);
    asm volatile("" : "+v"(qr[0]), "+v"(qr[1]), "+v"(qr[2]), "+v"(qr[3]));
    f32x16 o[4];
#pragma unroll
    for (int d = 0; d < 4; ++d)
#pragma unroll
        for (int r = 0; r < 16; ++r) o[d][r] = 0.f;
    float mrun = 0.f, lrun = 0.f;
    f32x16 negm;
#pragma unroll
    for (int r = 0; r < 16; ++r) negm[r] = 0.f;
    f32x16 C0, C1;
    v4u pw[4];
    int vsl_prev = 0, vsl_cur = 0;
    bool resc = false;
#define DAT_DECIDE(FIRST) do { \
        float ra_ = max3f(C0[0], C0[1], C1[0]), rb_ = max3f(C0[2], C0[3], C1[1]); ra_ = max3f(ra_, C1[2], C1[3]); \
        _Pragma("unroll") for (int r = 4; r < 16; r += 4) { ra_ = max3f(ra_, C0[r], C0[r + 1]); rb_ = max3f(rb_, C0[r + 2], C0[r + 3]); ra_ = max3f(ra_, C1[r], C1[r + 1]); rb_ = max3f(rb_, C1[r + 2], C1[r + 3]); } \
        const float rm_ = half_swap_max(max3f(ra_, rb_, rb_)); \
        if ((FIRST) || __any(rm_ > 8.0f)) { \
            const float dl_ = (FIRST) ? rm_ : fmaxf(rm_, 0.f); const float f_ = fast_exp2(-dl_); \
            lrun *= f_; mrun += dl_; if (hi == 0) wsf[r32] = f_; \
            _Pragma("unroll") for (int r = 0; r < 16; ++r) { C0[r] -= dl_; C1[r] -= dl_; negm[r] = -mrun; } \
            resc = !(FIRST); } } while (0)
#define DAT_RESC() do { if (resc) { asm volatile("s_waitcnt lgkmcnt(0)" ::: "memory"); \
        _Pragma("unroll") for (int r = 0; r < 16; ++r) { const float fr_ = wsf[crow(r, hi)]; _Pragma("unroll") for (int d = 0; d < 4; ++d) o[d][r] *= fr_; } resc = false; } } while (0)
#define DAT_VRD(dst_lo, dst_hi, j) do { dst_lo = ret::trld(Vb_ + voffd((j) >> 2) + ((j) & 3) * 4096); dst_hi = ret::trld(Vb_ + voffd((j) >> 2) + ((j) & 3) * 4096 + 2048); } while (0)
#define DAT_QK(t_, DO_, tn_) do { LAS const unsigned char* Kb_ = lds + LK0 + ((t_) & 1) * 16384; \
        const bf16* kb0_ = Kh + (size_t)(tn_) * 64 * KVQ_N; const bf16* vb0_ = Vh + (size_t)(tn_) * 64 * KVQ_N; const unsigned kd_ = (unsigned)__builtin_amdgcn_readfirstlane(ldsb + LK0 + ((tn_) & 1) * 16384 + wave * 1024), vd_ = (unsigned)__builtin_amdgcn_readfirstlane(ldsb + LV0 + ((tn_) % 3) * 16384 + wave * 1024); \
        bf16x8 ka_ = *(const LAS bf16x8*)(Kb_ + koffd(0)), kb_ = *(const LAS bf16x8*)(Kb_ + koffd(0) + 8192), kc_ = *(const LAS bf16x8*)(Kb_ + koffd(1)), kd2_ = *(const LAS bf16x8*)(Kb_ + koffd(1) + 8192); \
        DAT_SBAR(); \
        C0 = __builtin_amdgcn_mfma_f32_32x32x16_bf16(ka_, qr[0], negm, 0, 0, 0); C1 = __builtin_amdgcn_mfma_f32_32x32x16_bf16(kb_, qr[0], negm, 0, 0, 0); \
        ka_ = *(const LAS bf16x8*)(Kb_ + koffd(2)); kb_ = *(const LAS bf16x8*)(Kb_ + koffd(2) + 8192); if (DO_) DAT_GLDS(kb0_, kvoff, kd_); DAT_SBAR(); \
        C0 = __builtin_amdgcn_mfma_f32_32x32x16_bf16(kc_, qr[1], C0, 0, 0, 0); C1 = __builtin_amdgcn_mfma_f32_32x32x16_bf16(kd2_, qr[1], C1, 0, 0, 0); \
        kc_ = *(const LAS bf16x8*)(Kb_ + koffd(3)); kd2_ = *(const LAS bf16x8*)(Kb_ + koffd(3) + 8192); if (DO_) DAT_GLDS(kb0_ + (size_t)32 * KVQ_N, kvoff, kd_ + 8192u); DAT_SBAR(); \
        C0 = __builtin_amdgcn_mfma_f32_32x32x16_bf16(ka_, qr[2], C0, 0, 0, 0); C1 = __builtin_amdgcn_mfma_f32_32x32x16_bf16(kb_, qr[2], C1, 0, 0, 0); \
        if (DO_) DAT_GLDS(vb0_, vvoff, vd_); DAT_SBAR(); \
        C0 = __builtin_amdgcn_mfma_f32_32x32x16_bf16(kc_, qr[3], C0, 0, 0, 0); C1 = __builtin_amdgcn_mfma_f32_32x32x16_bf16(kd2_, qr[3], C1, 0, 0, 0); \
        if (DO_) DAT_GLDS(vb0_ + (size_t)32 * KVQ_N, vvoff, vd_ + 8192u); DAT_SBAR(); \
        asm volatile("s_nop 15\n\ts_nop 7" : "+v"(C0), "+v"(C1)); } while (0)
    {
        WG_BAR();
        DAT_QK(0, true, 1);
        DAT_DECIDE(true);
        float s0_ = 0.f, s1_ = 0.f;
#pragma unroll
        for (int j = 0; j < 16; ++j) {
            const float e0_ = fast_exp2(j < 8 ? C0[2 * (j & 7)] : C1[2 * (j & 7)]), e1_ = fast_exp2(j < 8 ? C0[2 * (j & 7) + 1] : C1[2 * (j & 7) + 1]);
            s0_ += e0_; s1_ += e1_; pw[j >> 2][j & 3] = cvtpk(e0_, e1_);
        }
        lrun += s0_ + s1_;
        vsl_prev = 0; vsl_cur = 16384;
    }
#define DAT_STEADY(t_, PWa, PWb) do { \
        WG_BAR(); \
        const bool dma_ = ((t_) + 1 < NT); \
        LAS const unsigned char* Vb_ = lds + LV0 + vsl_prev; \
        s16x4 vl_[4], vh_[4]; \
        _Pragma("unroll") for (int j = 0; j < 4; ++j) DAT_VRD(vl_[j], vh_[j], j); \
        DAT_QK(t_, dma_, (t_) + 1); \
        DAT_DECIDE(false); \
        const bf16x8 pa_[4] = {__builtin_bit_cast(bf16x8, PWa[0]), __builtin_bit_cast(bf16x8, PWa[1]), __builtin_bit_cast(bf16x8, PWa[2]), __builtin_bit_cast(bf16x8, PWa[3])}; \
        float ssum_ = 0.f; \
        DAT_SBAR(); \
        _Pragma("unroll") for (int j = 0; j < 16; ++j) { \
            o[j >> 2] = __builtin_amdgcn_mfma_f32_32x32x16_bf16(pa_[j & 3], ret::cat8(vl_[j & 3], vh_[j & 3]), o[j >> 2], 0, 0, 0); \
            if (j + 4 < 16) DAT_VRD(vl_[j & 3], vh_[j & 3], j + 4); \
            { const float e0_ = fast_exp2(j < 8 ? C0[2 * (j & 7)] : C1[2 * (j & 7)]), e1_ = fast_exp2(j < 8 ? C0[2 * (j & 7) + 1] : C1[2 * (j & 7) + 1]); \
              ssum_ += e0_; ssum_ += e1_; PWb[j >> 2][j & 3] = cvtpk(e0_, e1_); } \
            DAT_PIN(ssum_); DAT_SBAR(); \
        } \
        DAT_RESC(); \
        lrun += ssum_; \
        vsl_prev = vsl_cur; vsl_cur = (vsl_cur == 32768) ? 0 : vsl_cur + 16384; \
    } while (0)
    v4u pq_[4];
    int t = 1;
    for (; t + 1 < ntw; t += 2) { DAT_STEADY(t, pw, pq_); DAT_STEADY(t + 1, pq_, pw); }
    for (; t <= NT; ++t) {
        if (t < ntw) { DAT_STEADY(t, pw, pq_); pw[0] = pq_[0]; pw[1] = pq_[1]; pw[2] = pq_[2]; pw[3] = pq_[3]; }
        else {
            WG_BAR();
            const bool dma_ = (t + 1 < NT);
            LAS const unsigned char* Vb_ = lds + LV0 + vsl_prev;
            if (dma_) { const int tn_ = t + 1; DAT_DMA(tn_, tn_ & 1, tn_ % 3); }
            if (t == ntw) {
            const bf16x8 pa_[4] = {__builtin_bit_cast(bf16x8, pw[0]), __builtin_bit_cast(bf16x8, pw[1]), __builtin_bit_cast(bf16x8, pw[2]), __builtin_bit_cast(bf16x8, pw[3])};
#pragma unroll
            for (int d = 0; d < 4; ++d)
#pragma unroll
                for (int ks = 0; ks < 4; ++ks) {
                    const s16x4 lo_ = ret::trld(Vb_ + voffd(d) + ks * 4096), hh_ = ret::trld(Vb_ + voffd(d) + ks * 4096 + 2048);
                    o[d] = __builtin_amdgcn_mfma_f32_32x32x16_bf16(pa_[ks], ret::cat8(lo_, hh_), o[d], 0, 0, 0);
                }
            }
            vsl_prev = vsl_cur; vsl_cur = (vsl_cur == 32768) ? 0 : vsl_cur + 16384;
        }
    }
#undef DAT_STEADY
#undef DAT_QK
#undef DAT_VRD
#undef DAT_RESC
#undef DAT_DECIDE
#undef DAT_DMA
#undef DAT_GLDS
#undef koffd
#undef voffd
    {
        const float lt = half_swap_sum(lrun);
        if (hi == 0) wsf[r32] = (comp ? lam : 1.0f) * fast_rcp(lt);
        asm volatile("s_waitcnt lgkmcnt(0)" ::: "memory");
#pragma unroll
        for (int r = 0; r < 16; ++r) { const float fr_ = wsf[crow(r, hi)];
#pragma unroll
            for (int d = 0; d < 4; ++d) o[d][r] *= fr_; }
    }
    WG_BAR();
    LAS float* cb = (LAS float*)(lds + LCB);
    if (comp == 1) {
#pragma unroll
        for (int d = 0; d < 4; ++d)
#pragma unroll
            for (int r = 0; r < 16; ++r) cb[(w4 * 32 + crow(r, hi)) * CSTR + d * 32 + r32] = o[d][r];
    }
    WG_BAR();
    if (comp == 0) {
#pragma unroll
        for (int d = 0; d < 4; ++d)
#pragma unroll
            for (int r = 0; r < 16; ++r) { LAS float* pc = cb + (w4 * 32 + crow(r, hi)) * CSTR + d * 32 + r32; *pc = o[d][r] - *pc; }
    }
    WG_BAR();
    {
        const int row = tid >> 2, part = tid & 3;
        const LAS f32x4* src = (const LAS f32x4*)(cb + row * CSTR + part * 32);
        f32x4 v[8]; float ss = 0.f;
#pragma unroll
        for (int j = 0; j < 8; ++j) { v[j] = src[j]; ss += (v[j][0] * v[j][0] + v[j][1] * v[j][1]) + (v[j][2] * v[j][2] + v[j][3] * v[j][3]); }
        ss += SWZ_XOR(ss, 1); ss += SWZ_XOR(ss, 2);
        const float rstd = __builtin_amdgcn_rsqf(ss * (1.0f / 128.0f) + EPS);
        bf16* dst = ao + (rowbase + q0 + row) * D + h * 128 + part * 32;
#pragma unroll
        for (int j = 0; j < 4; ++j) {
            v4u w; w.x = pk2(v[2 * j][0] * rstd, v[2 * j][1] * rstd); w.y = pk2(v[2 * j][2] * rstd, v[2 * j][3] * rstd);
            w.z = pk2(v[2 * j + 1][0] * rstd, v[2 * j + 1][1] * rstd); w.w = pk2(v[2 * j + 1][2] * rstd, v[2 * j + 1][3] * rstd);
            *(v4u*)(dst + 8 * j) = w;
        }
    }
    WG_BAR();
}

__device__ __forceinline__ void attn_phase(const bf16* kvq, bf16* ao, LAS unsigned char* lds, const float* lq1, const float* lk1, const float* lq2, const float* lk2, float lambda_init, int vcu, int G) {
    PHASE_IDS();
    const float lam = __expf(wave_sum(lq1[lane] * lk1[lane])) - __expf(wave_sum(lq2[lane] * lk2[lane])) + lambda_init;
    const int nun = (G == 256) ? 4 : (1024 - vcu + G - 1) / G;
#pragma unroll 1
    for (int i = 0; i < nun; ++i) {
        int bh, qb;
        if (G == 256) { const int x = vcu >> 5, w = vcu & 31, j = (w + 16) & 31; bh = 4 * x + i; qb = (i == 0) ? w : (i == 1) ? 31 - w : (i == 2) ? j : 31 - j; }
        else { const int u = vcu + i * G; bh = u >> 5; qb = u & 31; }
        attn_unit(bh >> 3, bh & 7, qb, kvq, ao, lds, lam, wave, lane, tid);
    }
}
}

__device__ __forceinline__ void route_a(const bf16* xb, const float* rwt, int* tope, float* topw, int* topr, float* tokr, int* cnt, unsigned char* xn8, LAS unsigned char* lds, int vcu, int G) {
    PHASE_IDS();
    LAS f32x4* rw = (LAS f32x4*)lds;
    LAS int* sel = (LAS int*)(lds + 32768);
    for (int k = tid; k < NE * D / 4; k += NTHREADS) { const int e = k >> 8, c4 = k & 255; rw[((e * 2 + (c4 >> 7)) * 2 + (c4 & 1)) * 64 + ((c4 >> 1) & 63)] = ((const f32x4*)rwt)[k]; }
    WG_BAR();
    for (int tb = vcu; tb < M / 64; tb += G) {
        v4u nv[2];
        { const v4u* xr = (const v4u*)(xb + (size_t)(tb * 64 + wave * 8) * D) + lane;
          nv[0] = xr[0]; nv[1] = xr[64]; }
        for (int tk = 0; tk < 8; ++tk) {
            const int tl = wave * 8 + tk, row = tb * 64 + tl;
            f32x4 v[2][2]; float ss = 0.f;
#pragma unroll
            for (int j = 0; j < 2; ++j) {
                v[j][0] = (f32x4){bflo(nv[j].x), bfhi(nv[j].x), bflo(nv[j].y), bfhi(nv[j].y)}; v[j][1] = (f32x4){bflo(nv[j].z), bfhi(nv[j].z), bflo(nv[j].w), bfhi(nv[j].w)};
#pragma unroll
                for (int h = 0; h < 2; ++h) ss += (v[j][h][0] * v[j][h][0] + v[j][h][1] * v[j][h][1]) + (v[j][h][2] * v[j][h][2] + v[j][h][3] * v[j][h][3]);
            }
            if (tk + 1 < 8) { const v4u* xr = (const v4u*)(xb + (size_t)(row + 1) * D) + lane; nv[0] = xr[0]; nv[1] = xr[64]; }
            ss = wave_sum(ss);
            const float r = __builtin_amdgcn_rsqf(ss * (1.0f / 1024.0f) + EPS);
#pragma unroll
            for (int j = 0; j < 2; ++j) {
                u32x2 w = {0u, 0u};
                w.x = __builtin_amdgcn_cvt_pk_fp8_f32(v[j][0][0] * r, v[j][0][1] * r, w.x, false); w.x = __builtin_amdgcn_cvt_pk_fp8_f32(v[j][0][2] * r, v[j][0][3] * r, w.x, true);
                w.y = __builtin_amdgcn_cvt_pk_fp8_f32(v[j][1][0] * r, v[j][1][1] * r, w.y, false); w.y = __builtin_amdgcn_cvt_pk_fp8_f32(v[j][1][2] * r, v[j][1][3] * r, w.y, true);
                ((u32x2*)(xn8 + (size_t)row * D))[lane + 64 * j] = w;
            }
            float lg[NE];
#pragma unroll
            for (int e = 0; e < NE; ++e) {
                float a = 0.f;
#pragma unroll
                for (int j = 0; j < 2; ++j)
#pragma unroll
                    for (int h = 0; h < 2; ++h) { const f32x4 w = rw[((e * 2 + j) * 2 + h) * 64 + lane]; a += (v[j][h][0] * w[0] + v[j][h][1] * w[1]) + (v[j][h][2] * w[2] + v[j][h][3] * w[3]); }
                lg[e] = wave_sum(a) * r;
            }
            int e1 = 0; float v1 = lg[0];
#pragma unroll
            for (int e = 1; e < NE; ++e) if (lg[e] > v1) { v1 = lg[e]; e1 = e; }
            int e2 = -1; float v2 = -3.0e38f;
#pragma unroll
            for (int e = 0; e < NE; ++e) if (e != e1 && lg[e] > v2) { v2 = lg[e]; e2 = e; }
            const float w1 = fast_rcp(1.0f + __expf(v2 - v1)), w2 = 1.0f - w1;
            if (lane == 0) { tope[row * 2] = e1; tope[row * 2 + 1] = e2; topw[row * 2] = w1; topw[row * 2 + 1] = w2; tokr[row] = r; sel[tl * 2] = e1; sel[tl * 2 + 1] = e2; }
        }
        WG_BAR();
        if (tid < NE) {
            int c = 0;
            for (int k = 0; k < 128; ++k) if (sel[k] == tid) { topr[(tb * 64) * 2 + k] = c; ++c; }
            cnt[tb * NE + tid] = c;
        }
        WG_BAR();
    }
}
__device__ __forceinline__ void route_b(const unsigned char* xn8, const int* tope, const float* topw, const int* topr, const float* tokr, const int* cnt, unsigned char* xg, int* rowinfo, float* rowgate, float* rowr,
                                        LAS unsigned char* lds, LAS int* ldsctl, int vcu, int G) {
    PHASE_IDS();
    LAS int* ct = (LAS int*)lds;
    LAS int* tot = (LAS int*)(lds + 8192);
    for (int k = tid; k < 256 * NE; k += NTHREADS) ct[k] = cnt[k];
    WG_BAR();
    if (tid < NE) { int run = 0; for (int tb = 0; tb < 256; ++tb) { const int c = ct[tb * NE + tid]; ct[tb * NE + tid] = run; run += c; } tot[tid] = run; }
    WG_BAR();
    if (tid == 0) {
        int ts = 0;
        for (int e = 0; e < NE; ++e) { ldsctl[16 + e] = ts; tot[8 + e] = ts * 256; ts += (tot[e] + 255) >> 8; }
        ldsctl[24] = ts; ldsctl[25] = ts;
    }
    WG_BAR();
    for (int tb = vcu; tb < M / 64; tb += G) {
        int mypos = 0;
        {
            const int idx = wave * 16 + (lane & 15), tl = idx >> 1, slot = idx & 1, row = tb * 64 + tl;
            const int e = tope[row * 2 + slot];
            mypos = tot[8 + e] + ct[tb * NE + e] + topr[row * 2 + slot];
            if (lane < 16) { rowinfo[mypos] = slot * M + row; rowgate[mypos] = topw[row * 2 + slot]; rowr[mypos] = tokr[row]; }
        }
        v4u rowsv[8];
#pragma unroll
        for (int k = 0; k < 8; ++k) rowsv[k] = *((const v4u*)(xn8 + (size_t)(tb * 64 + wave * 8 + k) * D) + lane);
#pragma unroll
        for (int k = 0; k < 16; ++k) { const int pos = __builtin_amdgcn_readlane(mypos, k); *((v4u*)(xg + (size_t)pos * D) + lane) = rowsv[k >> 1]; }
    }
    for (int e = vcu; e < NE; e += G) {
        const int beg = tot[8 + e] + tot[e], end = tot[8 + e] + (((tot[e] + 255) >> 8) << 8);
        for (int pos = beg + wave; pos < end; pos += NWAVES) {
            *((v4u*)(xg + (size_t)pos * D) + lane) = (v4u){0u, 0u, 0u, 0u};
            if (lane == 0) { rowinfo[pos] = -1; rowgate[pos] = 0.f; rowr[pos] = 0.f; }
        }
    }
}
__device__ __forceinline__ void final_phase(const bf16* xb, const bf16* y, const float* fn, float* out, int vcu, int G) {
    PHASE_IDS();
    const int gw = vcu * NWAVES + wave, NGW = G * NWAVES;
    f32x4 gn[4];
#pragma unroll
    for (int j = 0; j < 4; ++j) gn[j] = ((const f32x4*)fn)[lane + 64 * j];
    for (int m0 = gw; m0 < M; m0 += 2 * NGW) {
        f32x4 v[2][4]; float ss[2]; bool ok[2];
#pragma unroll
        for (int k = 0; k < 2; ++k) {
            const int m = m0 + k * NGW; ok[k] = m < M; ss[k] = 0.f;
            if (ok[k]) {
                const u32x2* xr = (const u32x2*)(xb + (size_t)m * D) + lane;
                const u32x2* y0 = (const u32x2*)(y + (size_t)m * D) + lane;
                const u32x2* y1 = (const u32x2*)(y + (size_t)(M + m) * D) + lane;
#pragma unroll
                for (int j = 0; j < 4; ++j) {
                    const u32x2 a = y0[64 * j], b2 = y1[64 * j], x0 = xr[64 * j];
                    v[k][j] = (f32x4){bflo(x0.x) + (bflo(a.x) + bflo(b2.x)), bfhi(x0.x) + (bfhi(a.x) + bfhi(b2.x)), bflo(x0.y) + (bflo(a.y) + bflo(b2.y)), bfhi(x0.y) + (bfhi(a.y) + bfhi(b2.y))};
                    ss[k] += (v[k][j][0] * v[k][j][0] + v[k][j][1] * v[k][j][1]) + (v[k][j][2] * v[k][j][2] + v[k][j][3] * v[k][j][3]);
                }
            }
        }
#pragma unroll
        for (int k = 0; k < 2; ++k) ss[k] = wave_sum(ss[k]);
#pragma unroll
        for (int k = 0; k < 2; ++k) if (ok[k]) {
            const float r = __builtin_amdgcn_rsqf(ss[k] * (1.0f / 1024.0f) + EPS);
            f32x4* orow = (f32x4*)(out + (size_t)(m0 + k * NGW) * D) + lane;
#pragma unroll
            for (int j = 0; j < 4; ++j) orow[64 * j] = v[k][j] * r * gn[j];
        }
    }
}
struct Args { Ptrs p; };
static_assert(sizeof(Args) == 22 * 8, "Args has no padding");

__global__ void __launch_bounds__(NTHREADS, 2) yoco_fwd(Args args) {
    extern __shared__ __attribute__((aligned(16))) unsigned char lds_raw[];
    LAS unsigned char* lds = (LAS unsigned char*)lds_raw;
    const Ptrs& P = args.p;
    unsigned char* ws = P.ws;

    const int G = gridDim.x; const int bx = blockIdx.x;
    const int vcu = (G % 8 == 0) ? (bx % 8) * (G / 8) + bx / 8 : bx;
    LAS int* ldsctl = (LAS int*)(lds + LDSCTL_OFF);
    for (int k = threadIdx.x; k < (LDS_BYTES - LDSCTL_OFF) / 4; k += NTHREADS) ldsctl[k] = 0;
    __syncthreads();
    XcdBarrier bar = xcd_barrier_post((unsigned*)(ws + WS_CTL) + CW_BAR, (volatile LAS unsigned*)ldsctl);

    bf16* XB = (bf16*)(ws + WS_XB); float* SSP = (float*)(ws + WS_SSP);
    bf16* PROJ = (bf16*)(ws + WS_PROJ); bf16* KVQ = (bf16*)(ws + WS_KVQ);

    const float lambda_init = 0.8f - 0.6f * 0.7408182206817179f;

    p0_prologue(P, lds, vcu, G, lambda_init);
    xcd_barrier(bar);

    {
        pg8::Gemm g{XB, (const bf16*)(ws + WS_W_IN), M, RIN, D}; pg8::StaticOrder S; S.init(M, RIN, G, bx);
        pg8::EpiInProj E{PROJ, SSP, (const float*)(ws + WS_RCOS), (const float*)(ws + WS_RSIN)};
        pg8::gemm_phase<pg8::EpiInProj, pg8::StaticOrder, true, true>(lds, g, S, E);
    }
    xcd_barrier(bar);
    ret::scores_phase(PROJ, (bf16*)(ws + WS_S), lds, vcu, G);
    xcd_barrier(bar);
    ret::scan_phase(P, PROJ, (const bf16*)(ws + WS_S), (bf16*)(ws + WS_ORET), lds, vcu, G);
    xcd_barrier(bar);
    ret::norm_gate_phase((const bf16*)(ws + WS_ORET), PROJ, (bf16*)(ws + WS_RO), vcu, G);
    xcd_barrier(bar);
    {
        pg8::Gemm g{(const bf16*)(ws + WS_RO), (const bf16*)(ws + WS_W_RO), M, D, RVD}; pg8::StaticOrder S; S.init(M, D, G, bx);
        pg8::EpiResid<true> E{P.x, XB, SSP};
        pg8::gemm_phase<pg8::EpiResid<true>, pg8::StaticOrder, true, true>(lds, g, S, E);
    }
    xcd_barrier(bar);
    {
        pg8::Gemm g{XB, (const bf16*)(ws + WS_W_GU), M, 2 * FF, D}; pg8::StaticOrder S; S.init(M, 2 * FF, G, bx);
        pg8::EpiSwiGLU<false> E{ws + WS_H, FF * 2, SSP, 1.0f, 1.0f};
        pg8::gemm_phase<pg8::EpiSwiGLU<false>, pg8::StaticOrder, true, true>(lds, g, S, E);
    }
    xcd_barrier(bar);
    {
        pg8::Gemm g{(const bf16*)(ws + WS_H), (const bf16*)(ws + WS_W_DN), M, D, FF}; pg8::StaticOrder S; S.init(M, D, G, bx);
        pg8::EpiResid<false> E{XB, XB, SSP};
        pg8::gemm_phase<pg8::EpiResid<false>, pg8::StaticOrder, true, true>(lds, g, S, E);
    }
    xcd_barrier(bar);
    {
        pg8::Gemm g{XB, (const bf16*)(ws + WS_W_KVQ), M, KVQ_N, D}; pg8::StaticOrder S; S.init(M, KVQ_N, G, bx);
        pg8::EpiKVQ E{KVQ, SSP, (const float*)(ws + WS_DCOS), (const float*)(ws + WS_DSIN), 0.125f * LOG2E};
        pg8::gemm_phase<pg8::EpiKVQ, pg8::StaticOrder, true, true>(lds, g, S, E);
    }
    xcd_barrier(bar);
    dat::attn_phase(KVQ, (bf16*)(ws + WS_AO), lds, P.lq1, P.lk1, P.lq2, P.lk2, lambda_init, vcu, G);
    xcd_barrier(bar);
    {
        pg8::Gemm g{(const bf16*)(ws + WS_AO), (const bf16*)(ws + WS_W_DO), M, D, D}; pg8::StaticOrder S; S.init(M, D, G, bx);
        pg8::EpiResid<false> E{XB, XB, SSP};
        pg8::gemm_phase<pg8::EpiResid<false>, pg8::StaticOrder, true, true>(lds, g, S, E);
    }
    xcd_barrier(bar);
    route_a(XB, (const float*)(ws + WS_RWT), (int*)(ws + WS_TOPE), (float*)(ws + WS_TOPW), (int*)(ws + WS_TOPR), (float*)(ws + WS_TOKR), (int*)(ws + WS_CNT), ws + WS_XN8, lds, vcu, G);
    xcd_barrier(bar);
    route_b(ws + WS_XN8, (const int*)(ws + WS_TOPE), (const float*)(ws + WS_TOPW), (const int*)(ws + WS_TOPR), (const float*)(ws + WS_TOKR), (const int*)(ws + WS_CNT), ws + WS_XG,
            (int*)(ws + WS_ROWINFO), (float*)(ws + WS_ROWGATE), (float*)(ws + WS_ROWR), lds, ldsctl, vcu, G);
    xcd_barrier(bar);
    {
        pg8::MoeOrder S; S.nM = __builtin_amdgcn_readfirstlane(((volatile LAS int*)ldsctl)[24]); S.nN = 2 * EF / 256; S.nwg = S.nM * S.nN; S.G = G; S.c = bx;
#pragma unroll
        for (int k = 0; k < 9; ++k) S.ts[k] = __builtin_amdgcn_readfirstlane(((volatile LAS int*)ldsctl)[16 + k]);
        pg8::Gemm g{(const bf16*)(ws + WS_XG), (const bf16*)(ws + WS_W_MGU), XG_ROWS, 2 * EF, D / 2};
        pg8::EpiSwiGLU<true> E{ws + WS_HM, EF, nullptr, 1.0f / MOE_WGU_SCALE, MOE_H_SCALE};
        pg8::gemm_phase<pg8::EpiSwiGLU<true>, pg8::MoeOrder, true, true, true>(lds, g, S, E);
    }
    xcd_barrier(bar);
    {
        pg8::MoeOrder S; S.nM = __builtin_amdgcn_readfirstlane(((volatile LAS int*)ldsctl)[24]); S.nN = D / 256; S.nwg = S.nM * S.nN; S.G = G; S.c = bx;
#pragma unroll
        for (int k = 0; k < 9; ++k) S.ts[k] = __builtin_amdgcn_readfirstlane(((volatile LAS int*)ldsctl)[16 + k]);
        pg8::Gemm g{(const bf16*)(ws + WS_HM), (const bf16*)(ws + WS_W_MDN), XG_ROWS, D, EF / 2};
        pg8::EpiMoeDown E{(bf16*)(ws + WS_Y), (const int*)(ws + WS_ROWINFO), (const float*)(ws + WS_ROWGATE), 1.0f / (MOE_WDN_SCALE * MOE_H_SCALE)};
        pg8::gemm_phase<pg8::EpiMoeDown, pg8::MoeOrder, true, true, true>(lds, g, S, E);
    }
    xcd_barrier(bar);
    final_phase(XB, (const bf16*)(ws + WS_Y), P.final_norm, P.out, vcu, G);
}

extern "C" void kernel_launch(void* const* d_in, const int* in_sizes, int n_in, void* d_out, int out_size, void* d_ws, size_t ws_size, hipStream_t stream) {
    static int grid = 0;
    if (grid == 0) {
        if (n_in != 20 || in_sizes[0] != M * D || out_size != M * D || ws_size < WS_END) { fprintf(stderr, "kernel_launch: unexpected shapes (n_in %d, in0 %d, out %d, ws %zu)\n", n_in, n_in > 0 ? in_sizes[0] : -1, out_size, ws_size); grid = -1; return; }
        int dev = 0, cus = 0, per_cu = 0;
        if (hipGetDevice(&dev) != hipSuccess || hipDeviceGetAttribute(&cus, hipDeviceAttributeMultiprocessorCount, dev) != hipSuccess) { grid = -1; return; }
        if (hipFuncSetAttribute((const void*)yoco_fwd, hipFuncAttributeMaxDynamicSharedMemorySize, LDS_BYTES) != hipSuccess) { fprintf(stderr, "kernel_launch: hipFuncSetAttribute failed\n"); grid = -1; return; }
        if (hipOccupancyMaxActiveBlocksPerMultiprocessor(&per_cu, (const void*)yoco_fwd, NTHREADS, LDS_BYTES) != hipSuccess || per_cu < 1) { fprintf(stderr, "kernel_launch: occupancy query reports %d\n", per_cu); }
        (void)hipGetLastError();
        grid = cus;
    }
    if (grid < 0) return;
    (void)hipMemsetAsync((char*)d_ws + WS_CTL, 0, CTL_ZERO_BYTES, stream);
    Args a{};
    const float** pp = (const float**)&a.p;
    for (int i = 0; i < 20; ++i) pp[i] = (const float*)d_in[i];
    a.p.out = (float*)d_out; a.p.ws = (unsigned char*)d_ws;
    hipLaunchKernelGGL(yoco_fwd, dim3(grid), dim3(NTHREADS), LDS_BYTES, stream, a);
}
```

```cpp
#include <hip/hip_runtime.h>
#include <hip/hip_bf16.h>
#include <cstdio>
#include <cstdint>
#include <cmath>
namespace pg8 {
#define PG8_LAS __attribute__((address_space(3)))
typedef unsigned short bf16_t;
typedef short bf16x8 __attribute__((ext_vector_type(8)));
typedef float f32x4 __attribute__((ext_vector_type(4)));
typedef unsigned u32x4 __attribute__((ext_vector_type(4)));
constexpr int BM = 256, BK = 64, HALF = 128, HTB = HALF * BK * 2  , STAGE_BYTES = 8 * HTB, NXCD = 8, WGM = 8;

__host__ __device__ __forceinline__ int lds_byte(int r, int c) { const int st = (r >> 4) * 2 + (c >> 5), rr = r & 15, cc = c & 31, ob = rr * 64 + cc * 2; return st * 1024 + (ob ^ (((ob >> 9) & 1) << 5)); }
__host__ __device__ __forceinline__ void stage_rc(int b, int& R, int& C) { const int st = b / 1024, sb = b % 1024, swz = sb ^ (((sb >> 9) & 1) << 5); R = (st >> 1) * 16 + swz / 64; C = (st & 1) * 32 + (swz % 64) / 2; }
__host__ __device__ __forceinline__ int perm32(int rho) { const int n = rho >> 4, i = rho & 15; return 8 * (i >> 2) + 4 * n + (i & 3); }

struct Unit { int pm, pn, aux; };
struct Gemm { const bf16_t* A; const bf16_t* Bt; int M, N, K; };

struct StaticOrder {
    int nM, nN, nwg, G, c;
    __host__ __device__ void init(int M, int N, int G_, int c_) { nM = M / BM; nN = N / BM; nwg = nM * nN; G = G_; c = c_; }
    __host__ __device__ bool next(int i, Unit& u) const {
        const long L = (long)i * G + c; if (L >= nwg) return false;
        int wgid = (int)L; { const int q = nwg / NXCD, r = nwg % NXCD, xcd = wgid % NXCD, off = wgid / NXCD; wgid = (xcd < r ? xcd * (q + 1) : r * (q + 1) + (xcd - r) * q) + off; }
        const int nig = WGM * nN, gid = wgid / nig, fm = gid * WGM, gsz = (nM - fm) < WGM ? (nM - fm) : WGM;
        u.pm = fm + ((wgid % nig) % gsz); u.pn = (wgid % nig) / gsz; u.aux = u.pn; return true;
    }
    __device__ __forceinline__ void a_ready(const Unit&) const {}
    __device__ __forceinline__ void done(const Unit&) const {}
};

__device__ __forceinline__ unsigned cvt_pk_bf16(float lo, float hi) { unsigned r; asm volatile("v_cvt_pk_bf16_f32 %0, %1, %2" : "=v"(r) : "v"(lo), "v"(hi)); return r; }
typedef float f32x2 __attribute__((ext_vector_type(2)));
typedef int i32x4 __attribute__((ext_vector_type(4)));
typedef int i32x8 __attribute__((ext_vector_type(8)));
__device__ __forceinline__ i32x8 cat8i(bf16x8 a, bf16x8 b) { const i32x4 x = __builtin_bit_cast(i32x4, a), y = __builtin_bit_cast(i32x4, b); return __builtin_shufflevector(x, y, 0, 1, 2, 3, 4, 5, 6, 7); }
template <class Epi, class Sched, bool ALIGN_EPI = false, bool SP2 = false, bool FP8 = false>
__device__ __forceinline__ void gemm_phase(PG8_LAS unsigned char* lds, const Gemm g, const Sched& S, const Epi& E) {
    int tid = threadIdx.x; asm volatile("" : "+v"(tid)); const int wid = __builtin_amdgcn_readfirstlane(tid >> 6), lane = tid & 63, wr = wid >> 2, wc = wid & 3, fr = lane & 15, fq = lane >> 4;
    const int K = g.K, nt = K / BK;
    unsigned voffA[2], voffB[2];
#pragma unroll
    for (int i = 0; i < 2; ++i) { int R, C; stage_rc(tid * 16 + i * 8192, R, C); const int Rb = Epi::PERM ? ((R & ~31) + perm32(R & 31)) : R;
        voffA[i] = (unsigned)(R * K + C) * 2u; voffB[i] = (unsigned)(Rb * K + C) * 2u; }
    const size_t kstep = (size_t)(BK * 2);
    const size_t hstep = (size_t)HALF * K * 2;
    const size_t tstep = 2 * hstep;
    const unsigned ldsw = (unsigned)wid * 1024u;
    const int aoff = lds_byte(wr * 64 + fr, fq * 8), boff = lds_byte(wc * 32 + fr, fq * 8);
#define PG8_SA(b, h) (((b) * 2 + (h)) * HTB)
#define PG8_SB(b, h) ((4 + (b) * 2 + (h)) * HTB)
#define PG8_STAGE(bufoff, gbase, voff) do { _Pragma("unroll") for (int _i = 0; _i < 2; ++_i) \
        __builtin_amdgcn_global_load_lds((const unsigned*)((const char*)(gbase) + (voff)[_i]), (PG8_LAS unsigned*)(lds + (bufoff) + ldsw + _i * 8192), 16, 0, 0); } while (0)
#define PG8_LDA(dst, b, h) do { _Pragma("unroll") for (int m = 0; m < 4; ++m) _Pragma("unroll") for (int k = 0; k < 2; ++k) dst[m][k] = *(const PG8_LAS bf16x8*)(lds + PG8_SA(b, h) + aoff + m * 2048 + k * 1024); } while (0)
#define PG8_LDB(dst, b, h) do { _Pragma("unroll") for (int n = 0; n < 2; ++n) _Pragma("unroll") for (int k = 0; k < 2; ++k) dst[n][k] = *(const PG8_LAS bf16x8*)(lds + PG8_SB(b, h) + boff + n * 2048 + k * 1024); } while (0)
#define PG8_MMA(ai, bj, At, Bt) do { __builtin_amdgcn_s_setprio(1); \
        if constexpr (FP8) { _Pragma("unroll") for (int m = 0; m < 4; ++m) _Pragma("unroll") for (int n = 0; n < 2; ++n) \
            asm volatile("v_mfma_scale_f32_16x16x128_f8f6f4 %0, %1, %2, %0, %3, %3 op_sel_hi:[0,0,0]" : "+v"(acc[ai][bj][m][n]) : "v"(cat8i(Bt[n][0], Bt[n][1])), "v"(cat8i(At[m][0], At[m][1])), "v"(fp8_unit_scale)); } \
        else { _Pragma("unroll") for (int m = 0; m < 4; ++m) _Pragma("unroll") for (int n = 0; n < 2; ++n) _Pragma("unroll") for (int k = 0; k < 2; ++k) \
            acc[ai][bj][m][n] = __builtin_amdgcn_mfma_f32_16x16x32_bf16(Bt[n][k], At[m][k], acc[ai][bj][m][n], 0, 0, 0); } \
        __builtin_amdgcn_s_setprio(0); } while (0)
#define PG8_WAIT_V(n) asm volatile("s_waitcnt vmcnt(" #n ")" ::: "memory")
#define PG8_WAIT_L(n) asm volatile("s_waitcnt lgkmcnt(" #n ")" ::: "memory")
#define PG8_BAR __builtin_amdgcn_s_barrier()
#define PG8_SCHED __builtin_amdgcn_sched_barrier(0)
    const int fp8_unit_scale = 0x7f7f7f7f; (void)fp8_unit_scale;
    Unit cur, nxt; int ui = 0;
    if (!S.next(0, cur)) return;
    f32x4 acc[2][2][4][2];
#pragma unroll
    for (int a = 0; a < 2; ++a)
#pragma unroll
        for (int b = 0; b < 2; ++b)
#pragma unroll
            for (int m = 0; m < 4; ++m)
#pragma unroll
                for (int n = 0; n < 2; ++n) acc[a][b][m][n] = (f32x4){0.f, 0.f, 0.f, 0.f};
    bf16x8 At[4][2], B0[2][2], B1[2][2];
    const char* cA = (const char*)g.A + (size_t)cur.pm * tstep; const char* cB = (const char*)g.Bt + (size_t)cur.pn * tstep;
    S.a_ready(cur);
    if constexpr (SP2) {
        PG8_STAGE(PG8_SB(0, 0), cB, voffB); PG8_STAGE(PG8_SB(0, 1), cB + hstep, voffB); PG8_STAGE(PG8_SA(0, 0), cA, voffA); PG8_STAGE(PG8_SA(0, 1), cA + hstep, voffA);
        if (wr == 1) PG8_BAR;
        PG8_WAIT_V(2); PG8_BAR;
        PG8_STAGE(PG8_SB(1, 0), cB + kstep, voffB); PG8_STAGE(PG8_SA(1, 0), cA + kstep, voffA); PG8_STAGE(PG8_SB(1, 1), cB + hstep + kstep, voffB);
        PG8_WAIT_V(6); PG8_BAR;
    } else {
        PG8_STAGE(PG8_SB(0, 0), cB, voffB); PG8_STAGE(PG8_SA(0, 0), cA, voffA); PG8_STAGE(PG8_SB(0, 1), cB + hstep, voffB); PG8_STAGE(PG8_SA(0, 1), cA + hstep, voffA);
        if (wr == 1) PG8_BAR;
        PG8_WAIT_V(4); PG8_BAR;
        PG8_STAGE(PG8_SB(1, 0), cB + kstep, voffB); PG8_STAGE(PG8_SA(1, 0), cA + kstep, voffA); PG8_STAGE(PG8_SB(1, 1), cB + hstep + kstep, voffB);
        PG8_WAIT_V(6); PG8_BAR;
    }
    for (;;) {
        const bool has_next = S.next(ui + 1, nxt);
        const char* nA = has_next ? (const char*)g.A + (size_t)nxt.pm * tstep : cA; const char* nB = has_next ? (const char*)g.Bt + (size_t)nxt.pn * tstep : cB;
        for (int t = 0; t < nt; t += 2) {
            const bool last = (t == nt - 2);
            const char* a1 = cA + (size_t)(t + 1) * kstep;
            const char* a2 = last ? nA : cA + (size_t)(t + 2) * kstep; const char* b2 = last ? nB : cB + (size_t)(t + 2) * kstep;
            const char* a3 = a2 + kstep; const char* b3 = b2 + kstep;
            if (last && has_next) S.a_ready(nxt);
            if constexpr (SP2) {
            PG8_LDB(B0, 0, 0); PG8_LDB(B1, 0, 1); PG8_SCHED; PG8_LDA(At, 0, 0); PG8_STAGE(PG8_SA(1, 1), a1 + hstep, voffA);
            PG8_WAIT_V(8); PG8_WAIT_L(0); PG8_BAR; PG8_MMA(0, 0, At, B0); PG8_MMA(0, 1, At, B1); PG8_BAR; PG8_SCHED;
            PG8_LDA(At, 0, 1); PG8_STAGE(PG8_SB(0, 0), b2, voffB); PG8_STAGE(PG8_SB(0, 1), b2 + hstep, voffB); PG8_STAGE(PG8_SA(0, 0), a2, voffA);
            PG8_WAIT_V(8); PG8_WAIT_L(0); PG8_BAR; PG8_MMA(1, 0, At, B0); PG8_MMA(1, 1, At, B1); PG8_BAR; PG8_SCHED;
            PG8_LDB(B0, 1, 0); PG8_LDB(B1, 1, 1); PG8_SCHED; PG8_LDA(At, 1, 0); PG8_STAGE(PG8_SA(0, 1), a2 + hstep, voffA);
            PG8_WAIT_V(8); PG8_WAIT_L(0); PG8_BAR; PG8_MMA(0, 0, At, B0); PG8_MMA(0, 1, At, B1); PG8_BAR; PG8_SCHED;
            PG8_LDA(At, 1, 1); PG8_STAGE(PG8_SB(1, 0), b3, voffB); PG8_STAGE(PG8_SB(1, 1), b3 + hstep, voffB); PG8_STAGE(PG8_SA(1, 0), a3, voffA);
            PG8_WAIT_V(8); PG8_WAIT_L(0); PG8_BAR; PG8_MMA(1, 0, At, B0); PG8_MMA(1, 1, At, B1); PG8_BAR; PG8_SCHED;
            } else {
            PG8_LDB(B0, 0, 0); PG8_SCHED; PG8_LDA(At, 0, 0); PG8_STAGE(PG8_SA(1, 1), a1 + hstep, voffA);
            PG8_WAIT_L(8); PG8_BAR; PG8_WAIT_L(0); PG8_MMA(0, 0, At, B0); PG8_BAR; PG8_SCHED;
            PG8_LDB(B1, 0, 1); PG8_STAGE(PG8_SB(0, 0), b2, voffB);
            PG8_BAR; PG8_WAIT_L(0); PG8_MMA(0, 1, At, B1); PG8_BAR;
            PG8_LDA(At, 0, 1); PG8_STAGE(PG8_SA(0, 0), a2, voffA);
            PG8_BAR; PG8_WAIT_L(0); PG8_MMA(1, 0, At, B0); PG8_BAR; PG8_SCHED;
            PG8_STAGE(PG8_SB(0, 1), b2 + hstep, voffB);
            PG8_WAIT_V(6); PG8_BAR; PG8_MMA(1, 1, At, B1); PG8_BAR;
            PG8_LDB(B0, 1, 0); PG8_SCHED; PG8_LDA(At, 1, 0); PG8_STAGE(PG8_SA(0, 1), a2 + hstep, voffA);
            PG8_WAIT_L(8); PG8_BAR; PG8_WAIT_L(0); PG8_MMA(0, 0, At, B0); PG8_BAR; PG8_SCHED;
            PG8_LDB(B1, 1, 1); PG8_STAGE(PG8_SB(1, 0), b3, voffB);
            PG8_BAR; PG8_WAIT_L(0); PG8_MMA(0, 1, At, B1); PG8_BAR;
            PG8_LDA(At, 1, 1); PG8_STAGE(PG8_SA(1, 0), a3, voffA);
            PG8_BAR; PG8_WAIT_L(0); PG8_MMA(1, 0, At, B0); PG8_BAR; PG8_SCHED;
            PG8_STAGE(PG8_SB(1, 1), b3 + hstep, voffB);
            PG8_WAIT_V(6); PG8_BAR; PG8_MMA(1, 1, At, B1); PG8_BAR;
            }
        }
        if constexpr (ALIGN_EPI) { if (wr == 0) PG8_BAR; }
        if constexpr (FP8) asm volatile("s_nop 15\n\ts_nop 15" ::: "memory");
        if constexpr (!Epi::AFTER_DRAIN) { E(acc, cur, wr, wc, fr, fq); S.done(cur); }
        if (!has_next) break;
#pragma unroll
        for (int a = 0; a < 2; ++a)
#pragma unroll
            for (int b = 0; b < 2; ++b)
#pragma unroll
                for (int m = 0; m < 4; ++m)
#pragma unroll
                    for (int n = 0; n < 2; ++n) acc[a][b][m][n] = (f32x4){0.f, 0.f, 0.f, 0.f};
        cur = nxt; cA = nA; cB = nB; ++ui;
        if constexpr (ALIGN_EPI) { if (wr == 1) PG8_BAR; }
    }
    PG8_WAIT_V(0);
    if constexpr (!ALIGN_EPI) { if (wr == 0) PG8_BAR; }
    PG8_BAR;
    if constexpr (Epi::AFTER_DRAIN) { E.fused(acc, cur, wr, wc, fr, fq, lds, wid, lane); S.done(cur); }
#undef PG8_SA
#undef PG8_SB
#undef PG8_STAGE
#undef PG8_LDA
#undef PG8_LDB
#undef PG8_MMA
#undef PG8_WAIT_V
#undef PG8_WAIT_L
#undef PG8_BAR
#undef PG8_SCHED
}
}
#define GAS __attribute__((address_space(1)))
#define LAS __attribute__((address_space(3)))
typedef unsigned short bf16;
typedef unsigned v4u __attribute__((ext_vector_type(4)));
typedef float f32x4 __attribute__((ext_vector_type(4)));
typedef short bf16x8 __attribute__((ext_vector_type(8)));
typedef GAS unsigned gu32;
typedef GAS unsigned long long gu64;
#define RLX_AGENT __ATOMIC_RELAXED, __HIP_MEMORY_SCOPE_AGENT
#define LDS_WAIT() asm volatile("s_waitcnt lgkmcnt(0)" ::: "memory")
#define VM_WAIT() asm volatile("s_waitcnt vmcnt(0)" ::: "memory")
__device__ __forceinline__ unsigned long long rt() { return __builtin_amdgcn_s_memrealtime(); }
__device__ __forceinline__ unsigned f2bf(float f) { unsigned u = __builtin_bit_cast(unsigned, f); return (u + 0x7fffu + ((u >> 16) & 1u)) >> 16; }
__device__ __forceinline__ unsigned pk2(float lo, float hi) { unsigned r; asm("v_cvt_pk_bf16_f32 %0, %1, %2" : "=v"(r) : "v"(lo), "v"(hi)); return r; }

#define XB_TMO      128
#define XB_XCNT(j)  (256  + 64 * (j))
#define XB_XSUB(j)  (1280 + 64 * (j))
#define XB_XGEN(j)  (2304 + 64 * (j))
#define XB_TOP      3328
#define XB_TOPGEN   3392
#define XCD_BAR_WORDS 3456
#define XB_SPIN_CAP (1u << 18)

__device__ __forceinline__ unsigned xb_ld(unsigned* p)              { return __hip_atomic_load(p, __ATOMIC_RELAXED, __HIP_MEMORY_SCOPE_AGENT); }
__device__ __forceinline__ unsigned xb_add(unsigned* p, unsigned v) { return __hip_atomic_fetch_add(p, v, __ATOMIC_RELAXED, __HIP_MEMORY_SCOPE_AGENT); }
__device__ __forceinline__ unsigned xb_xcc_id() { return (unsigned)__builtin_amdgcn_s_getreg((3 << 11) | 20) & 0xFu; }
#define XB_SPIN(cond, bar) do { unsigned _sp = 0; while (cond) { __builtin_amdgcn_s_sleep(1); \
    if ((++_sp & 255u) == 0u) { if (xb_ld(&(bar)[XB_TMO])) break; if (_sp > XB_SPIN_CAP) { atomicAdd(&(bar)[XB_TMO], 1u); break; } } } } while (0)

struct XcdBarrier {
    unsigned* bar; unsigned x;
    volatile LAS unsigned* st;
};

__device__ __forceinline__ XcdBarrier xcd_barrier_post(unsigned* bar, volatile LAS unsigned* st) {
    XcdBarrier b; b.bar = bar; b.x = xb_xcc_id(); b.st = st;
    if (threadIdx.x == 0) (void)xb_add(&bar[XB_XCNT(b.x)], 1u);
    return b;
}
__device__ __forceinline__ void xcd_barrier_complete(unsigned* bar, unsigned x, unsigned& nloc, unsigned& nx) {
    const unsigned G = gridDim.x * gridDim.y * gridDim.z;
    unsigned sum, cnt, mine, sp = 0u;
    for (;;) {
        sum = 0u; cnt = 0u; mine = 0u;
#pragma unroll
        for (unsigned j = 0; j < 16; ++j) { const unsigned c = xb_ld(&bar[XB_XCNT(j)]); sum += c; cnt += (c > 0u) ? 1u : 0u; mine = (j == x) ? c : mine; }
        if (sum == G) break;
        __builtin_amdgcn_s_sleep(1);
        if ((++sp & 255u) == 0u) { if (xb_ld(&bar[XB_TMO])) break; if (sp > XB_SPIN_CAP) { atomicAdd(&bar[XB_TMO], 1u); break; } }
    }
    nloc = mine > 0u ? mine : 1u; nx = cnt > 0u ? cnt : 1u;
}

__device__ __forceinline__ void xcd_barrier(const XcdBarrier& b) {
    asm volatile("s_waitcnt vmcnt(0)" ::: "memory");
    __syncthreads();
    if (threadIdx.x == 0) {
        unsigned* bar = b.bar;
        __builtin_amdgcn_s_waitcnt(0);
        unsigned nloc = b.st[0], nx = b.st[1];
        if (nloc == 0u) { xcd_barrier_complete(bar, b.x, nloc, nx); b.st[0] = nloc; b.st[1] = nx; }
        const unsigned old = xb_add(&bar[XB_XSUB(b.x)], 1u);
        const unsigned gen = old / nloc;
        if (old + 1u == (gen + 1u) * nloc) {
            __builtin_amdgcn_fence(__ATOMIC_RELEASE, "agent");
            asm volatile("s_waitcnt vmcnt(0)" ::: "memory");
            const unsigned og = xb_add(&bar[XB_TOP], 1u);
            const unsigned tg = og / nx;
            if (og + 1u == (tg + 1u) * nx) xb_add(&bar[XB_TOPGEN], 1u);
            else XB_SPIN(xb_ld(&bar[XB_TOPGEN]) == tg, bar);
            __builtin_amdgcn_fence(__ATOMIC_ACQUIRE, "agent");
            xb_add(&bar[XB_XGEN(b.x)], 1u);
            asm volatile("s_waitcnt vmcnt(0)" ::: "memory");
        } else {
            XB_SPIN(xb_ld(&bar[XB_XGEN(b.x)]) == gen, bar);
            __builtin_amdgcn_fence(__ATOMIC_ACQUIRE, "agent");
            asm volatile("s_waitcnt vmcnt(0)" ::: "memory");
        }
    }
    __syncthreads();
}

constexpr int BATCH = 4, SEQ = 4096, D = 1024, M = BATCH * SEQ;
constexpr int RIN = 6144, RVD = 2048;
constexpr int FF = 2816, EF = 3584, NE = 8;
constexpr int KVQ_N = 3072;
constexpr float EPS = 1e-6f;
constexpr float LOG2E = 1.4426950408889634f;

typedef short s16x4 __attribute__((ext_vector_type(4)));
typedef float f32x16 __attribute__((ext_vector_type(16)));
typedef unsigned u32x2 __attribute__((ext_vector_type(2)));

__device__ __forceinline__ float bf2f(unsigned short h) { return __uint_as_float(((unsigned)h) << 16); }
__device__ __forceinline__ float bflo(unsigned w) { return __uint_as_float(w << 16); }
__device__ __forceinline__ float bfhi(unsigned w) { return __uint_as_float(w & 0xffff0000u); }
__device__ __forceinline__ float fast_exp2(float x) { return __builtin_amdgcn_exp2f(x); }
__device__ __forceinline__ float fast_rcp(float x) { return __builtin_amdgcn_rcpf(x); }
__device__ __forceinline__ float silu_f(float x) { return x * fast_rcp(1.0f + fast_exp2(-x * LOG2E)); }
#define SWZ_XOR(v, m) __int_as_float(__builtin_amdgcn_ds_swizzle(__float_as_int(v), ((m) << 10) | 0x1f))
__device__ __forceinline__ float xor32_sum(float v) { auto rr = __builtin_amdgcn_permlane32_swap(__float_as_uint(v), __float_as_uint(v), false, false); return __uint_as_float(rr[0]) + __uint_as_float(rr[1]); }
__device__ __forceinline__ float wave_sum(float v) {
    v += SWZ_XOR(v, 1); v += SWZ_XOR(v, 2); v += SWZ_XOR(v, 4); v += SWZ_XOR(v, 8); v += SWZ_XOR(v, 16);
    return xor32_sum(v);
}

namespace pg8 {
__device__ __forceinline__ float rinv_from_ssp(const float* ssp, int row) {
    const f32x4* p = (const f32x4*)(ssp + (size_t)row * 16);
    const f32x4 a = p[0], b = p[1], c = p[2], d = p[3];
    const float s = (((a[0] + a[1]) + (a[2] + a[3])) + ((b[0] + b[1]) + (b[2] + b[3]))) + (((c[0] + c[1]) + (c[2] + c[3])) + ((d[0] + d[1]) + (d[2] + d[3])));
    return __builtin_amdgcn_rsqf(s * (1.0f / 1024.0f) + EPS);
}
__device__ __forceinline__ void rinv8_from_ssp(const float* ssp, int row0, int fq, float (&r)[8]) {
    f32x4 a[8];
#pragma unroll
    for (int x = 0; x < 8; ++x) a[x] = ((const f32x4*)(ssp + (size_t)(row0 + (x >> 2) * HALF + (x & 3) * 16) * 16))[fq];
#pragma unroll
    for (int x = 0; x < 8; ++x) {
        float s = (a[x][0] + a[x][1]) + (a[x][2] + a[x][3]);
        s += SWZ_XOR(s, 16); s = xor32_sum(s);
        r[x] = __builtin_amdgcn_rsqf(s * (1.0f / 1024.0f) + EPS);
    }
}
__device__ __forceinline__ u32x4 pack8(const f32x4 a, const f32x4 b) {
    u32x4 w; w.x = cvt_pk_bf16(a[0], a[1]); w.y = cvt_pk_bf16(a[2], a[3]); w.z = cvt_pk_bf16(b[0], b[1]); w.w = cvt_pk_bf16(b[2], b[3]); return w;
}
struct EpiInProj {
    static constexpr bool PERM = true, AFTER_DRAIN = false;
    bf16_t* O; const float* ssp; const float* rcos; const float* rsin;
    __device__ __forceinline__ void operator()(const f32x4 (&acc)[2][2][4][2], const Unit& u, int wr, int wc, int fr, int fq) const {
        const int row0 = u.pm * BM + wr * 64 + fr;
        const int cl = wc * 32 + 8 * fq;
        const bool rope = u.pn < 8;
        const float ksc = (u.pn >= 4 && u.pn < 8) ? 0.0625f : 1.0f;
        float rv[8]; rinv8_from_ssp(ssp, row0, fq, rv);
#pragma unroll
        for (int ai = 0; ai < 2; ++ai)
#pragma unroll
            for (int m = 0; m < 4; ++m) {
                const int row = row0 + ai * HALF + m * 16;
                const float r = rv[ai * 4 + m] * ksc;
                bf16_t* rowp = O + (size_t)row * RIN + u.pn * BM + cl;
                f32x4 a0 = acc[ai][0][m][0] * r, a1 = acc[ai][0][m][1] * r, b0 = acc[ai][1][m][0] * r, b1 = acc[ai][1][m][1] * r;
                if (rope) {
                    const int pos = row & (SEQ - 1);
                    const f32x4 c0 = *(const f32x4*)(rcos + pos * 128 + cl), c1 = *(const f32x4*)(rcos + pos * 128 + cl + 4);
                    const f32x4 s0 = *(const f32x4*)(rsin + pos * 128 + cl), s1 = *(const f32x4*)(rsin + pos * 128 + cl + 4);
                    const f32x4 x0 = a0 * c0 - b0 * s0, x1 = a1 * c1 - b1 * s1, y0 = b0 * c0 + a0 * s0, y1 = b1 * c1 + a1 * s1;
                    a0 = x0; a1 = x1; b0 = y0; b1 = y1;
                }
                *(u32x4*)(rowp) = pack8(a0, a1);
                *(u32x4*)(rowp + HALF) = pack8(b0, b1);
                if (m & 1) asm volatile("" ::: "memory");
            }
    }
};
template <bool FP8OUT> struct EpiSwiGLU {
    static constexpr bool PERM = true, AFTER_DRAIN = false;
    unsigned char* O; int ldb  ; const float* ssp; float cscale, oscale;
    __device__ __forceinline__ void operator()(const f32x4 (&acc)[2][2][4][2], const Unit& u, int wr, int wc, int fr, int fq) const {
        const int row0 = u.pm * BM + wr * 64 + fr;
        const int col = u.aux * HALF + wc * 32 + 8 * fq;
        float rv[8];
        if (ssp) rinv8_from_ssp(ssp, row0, fq, rv); else {
#pragma unroll
            for (int x = 0; x < 8; ++x) rv[x] = 1.0f; }
#pragma unroll
        for (int ai = 0; ai < 2; ++ai)
#pragma unroll
            for (int m = 0; m < 4; ++m) {
                const int row = row0 + ai * HALF + m * 16;
                const float r = rv[ai * 4 + m] * cscale;
                const float k1 = -r * LOG2E, qv = fast_rcp(r * r * oscale), c0 = __builtin_amdgcn_logf(qv);
                f32x4 h0, h1;
#pragma unroll
                for (int j = 0; j < 4; ++j) {
                    h0[j] = (acc[ai][0][m][0][j] * acc[ai][1][m][0][j]) * fast_rcp(qv + fast_exp2(__builtin_fmaf(acc[ai][0][m][0][j], k1, c0)));
                    h1[j] = (acc[ai][0][m][1][j] * acc[ai][1][m][1][j]) * fast_rcp(qv + fast_exp2(__builtin_fmaf(acc[ai][0][m][1][j], k1, c0)));
                }
                if constexpr (FP8OUT) {
                    unsigned w0, w1; asm volatile("" : "=v"(w0), "=v"(w1));
                    w0 = __builtin_amdgcn_cvt_pk_fp8_f32(h0[0], h0[1], w0, false); w0 = __builtin_amdgcn_cvt_pk_fp8_f32(h0[2], h0[3], w0, true);
                    w1 = __builtin_amdgcn_cvt_pk_fp8_f32(h1[0], h1[1], w1, false); w1 = __builtin_amdgcn_cvt_pk_fp8_f32(h1[2], h1[3], w1, true);
                    *(u32x2*)(O + (size_t)row * ldb + col) = (u32x2){w0, w1};
                } else {
                    *(u32x4*)(O + (size_t)row * ldb + col * 2) = pack8(h0, h1);
                }
                if (m & 1) asm volatile("" ::: "memory");
            }
    }
};
template <bool BASE_F32>
struct EpiResid {
    static constexpr bool PERM = true, AFTER_DRAIN = false;
    const void* base; bf16_t* xb; float* ssp;
    template <int AI0, int NAI>
    __device__ __forceinline__ void part(const f32x4 (&acc)[2][2][4][2], const Unit& u, int row0, int col0, int wc, int fq) const {
        f32x4 bv[NAI * 4][2][2];
#pragma unroll
        for (int x = 0; x < NAI * 4; ++x) {
            const int row = row0 + (AI0 + (x >> 2)) * HALF + (x & 3) * 16;
#pragma unroll
            for (int bj = 0; bj < 2; ++bj) {
                const size_t c = (size_t)row * D + col0 + bj * HALF;
                if constexpr (BASE_F32) { bv[x][bj][0] = *(const f32x4*)((const float*)base + c); bv[x][bj][1] = *(const f32x4*)((const float*)base + c + 4); }
                else { const u32x4 b = *(const u32x4*)((const bf16_t*)base + c); bv[x][bj][0] = __builtin_bit_cast(f32x4, b); }
            }
        }
#pragma unroll
        for (int x = 0; x < NAI * 4; ++x) {
            const int ai = AI0 + (x >> 2), m = x & 3;
            const int row = row0 + ai * HALF + m * 16;
            float ss = 0.f;
#pragma unroll
            for (int bj = 0; bj < 2; ++bj) {
                const size_t c = (size_t)row * D + col0 + bj * HALF;
                f32x4 v0, v1;
                if constexpr (BASE_F32) { v0 = bv[x][bj][0]; v1 = bv[x][bj][1]; }
                else { const u32x4 b = __builtin_bit_cast(u32x4, bv[x][bj][0]); v0 = (f32x4){bflo(b.x), bfhi(b.x), bflo(b.y), bfhi(b.y)}; v1 = (f32x4){bflo(b.z), bfhi(b.z), bflo(b.w), bfhi(b.w)}; }
                v0 += acc[ai][bj][m][0]; v1 += acc[ai][bj][m][1];
                *(u32x4*)(xb + c) = pack8(v0, v1);
                ss += ((v0[0] * v0[0] + v0[1] * v0[1]) + (v0[2] * v0[2] + v0[3] * v0[3])) + ((v1[0] * v1[0] + v1[1] * v1[1]) + (v1[2] * v1[2] + v1[3] * v1[3]));
            }
            ss += SWZ_XOR(ss, 16); ss = xor32_sum(ss);
            if (fq == 0) ssp[(size_t)row * 16 + u.pn * 4 + wc] = ss;
        }
    }
    __device__ __forceinline__ void operator()(const f32x4 (&acc)[2][2][4][2], const Unit& u, int wr, int wc, int fr, int fq) const {
        const int row0 = u.pm * BM + wr * 64 + fr;
        const int col0 = u.pn * BM + wc * 32 + 8 * fq;
        if constexpr (BASE_F32) { part<0, 1>(acc, u, row0, col0, wc, fq); asm volatile("" ::: "memory"); part<1, 1>(acc, u, row0, col0, wc, fq); }
        else part<0, 2>(acc, u, row0, col0, wc, fq);
    }
};
struct EpiKVQ {
    static constexpr bool PERM = true, AFTER_DRAIN = false;
    bf16_t* O; const float* ssp; const float* dcos; const float* dsin; float qscale;
    __device__ __forceinline__ void operator()(const f32x4 (&acc)[2][2][4][2], const Unit& u, int wr, int wc, int fr, int fq) const {
        const int row0 = u.pm * BM + wr * 64 + fr;
        const int cl = wc * 32 + 8 * fq;
        const int kind = u.pn >> 2;
        const bool ropelane = ((wc & 1) == 0) && (fq < 2);
        float rv[8]; rinv8_from_ssp(ssp, row0, fq, rv);
#pragma unroll
        for (int ai = 0; ai < 2; ++ai)
#pragma unroll
            for (int m = 0; m < 4; ++m) {
                const int row = row0 + ai * HALF + m * 16;
                const float r = rv[ai * 4 + m] * (kind == 2 ? qscale : 1.0f);
                bf16_t* rowp = O + (size_t)row * KVQ_N + u.pn * BM + cl;
                f32x4 c0, c1, s0, s1;
                if (kind != 1) {
                    const int pos = row & (SEQ - 1);
                    c0 = *(const f32x4*)(dcos + pos * 8); c1 = *(const f32x4*)(dcos + pos * 8 + 4);
                    s0 = *(const f32x4*)(dsin + pos * 8); s1 = *(const f32x4*)(dsin + pos * 8 + 4);
                    if (fq != 0) { s0 = -s0; s1 = -s1; }
                }
#pragma unroll
                for (int bj = 0; bj < 2; ++bj) {
                    f32x4 v0 = acc[ai][bj][m][0] * r, v1 = acc[ai][bj][m][1] * r;
                    if (kind != 1) {
                        f32x4 p0, p1;
#pragma unroll
                        for (int j = 0; j < 4; ++j) { p0[j] = SWZ_XOR(v0[j], 16); p1[j] = SWZ_XOR(v1[j], 16); }
                        if (ropelane) { v0 = v0 * c0 - p0 * s0; v1 = v1 * c1 - p1 * s1; }
                    }
                    *(u32x4*)(rowp + bj * HALF) = pack8(v0, v1);
                }
                if (m & 1) asm volatile("" ::: "memory");
            }
    }
};
struct EpiMoeDown {
    static constexpr bool PERM = true, AFTER_DRAIN = false;
    bf16_t* Y; const int* rowinfo; const float* rowgate; float cscale;
    __device__ __forceinline__ void operator()(const f32x4 (&acc)[2][2][4][2], const Unit& u, int wr, int wc, int fr, int fq) const {
        const int row0 = u.pm * BM + wr * 64 + fr;
        const int cl = u.aux * BM + wc * 32 + 8 * fq;
        int inf[8]; float gt[8];
#pragma unroll
        for (int x = 0; x < 8; ++x) { const int row = row0 + (x >> 2) * HALF + (x & 3) * 16; inf[x] = rowinfo[row]; gt[x] = rowgate[row]; }
#pragma unroll
        for (int ai = 0; ai < 2; ++ai)
#pragma unroll
            for (int m = 0; m < 4; ++m) {
                const int info = inf[ai * 4 + m];
                if (info >= 0) {
                    const float g = gt[ai * 4 + m] * cscale;
                    bf16_t* rowp = Y + (size_t)info * D + cl;
                    *(u32x4*)(rowp) = pack8(acc[ai][0][m][0] * g, acc[ai][0][m][1] * g);
                    *(u32x4*)(rowp + HALF) = pack8(acc[ai][1][m][0] * g, acc[ai][1][m][1] * g);
                }
            }
    }
};
struct MoeOrder {
    int nM, nN, nwg, G, c; int ts[9];
    __device__ __forceinline__ bool next(int i, Unit& u) const {
        const long L = (long)i * G + c; if (L >= nwg) return false;
        int wgid = (int)L; { const int q = nwg / NXCD, r = nwg % NXCD, xcd = wgid % NXCD, off = wgid / NXCD; wgid = (xcd < r ? xcd * (q + 1) : r * (q + 1) + (xcd - r) * q) + off; }
        const int nig = WGM * nN, gid = wgid / nig, fm = gid * WGM, gsz = (nM - fm) < WGM ? (nM - fm) : WGM;
        const int pm = fm + ((wgid % nig) % gsz), pnl = (wgid % nig) / gsz;
        int e = 0;
#pragma unroll
        for (int k = 1; k < 8; ++k) e += (pm >= ts[k]) ? 1 : 0;
        u.pm = pm; u.pn = e * nN + pnl; u.aux = pnl; return true;
    }
    __device__ __forceinline__ void a_ready(const Unit&) const {}
    __device__ __forceinline__ void done(const Unit&) const {}
};
}
constexpr size_t MiB = 1u << 20;
constexpr size_t WS_CTL = 0, CTL_ZERO_BYTES = 1 * MiB;
constexpr size_t WS_RCOS = 1 * MiB, WS_RSIN = 3 * MiB;
constexpr size_t WS_DCOS = 5 * MiB, WS_DSIN = 5 * MiB + 256 * 1024;
constexpr size_t WS_SSP = 6 * MiB;
constexpr size_t WS_RWT = 7 * MiB;
constexpr size_t WS_TOPE = 8 * MiB;
constexpr size_t WS_TOPW = 8 * MiB + 128 * 1024;
constexpr size_t WS_TOPR = 8 * MiB + 256 * 1024;
constexpr size_t WS_TOKR = 8 * MiB + 384 * 1024;
constexpr size_t WS_CNT = 8 * MiB + 512 * 1024;
constexpr int XG_ROWS = 2 * M + NE * 256;
constexpr size_t WS_ROWINFO = 9 * MiB;
constexpr size_t WS_ROWGATE = 9 * MiB + 256 * 1024;
constexpr size_t WS_ROWR = 9 * MiB + 512 * 1024;
constexpr size_t WS_S = 10 * MiB;
constexpr size_t WS_W_IN = 20 * MiB, WS_W_RO = 32 * MiB, WS_W_GU = 36 * MiB, WS_W_DN = 47 * MiB, WS_W_KVQ = 53 * MiB, WS_W_DO = 59 * MiB, WS_W_MGU = 61 * MiB, WS_W_MDN = 173 * MiB;
constexpr size_t WS_XM = 232 * MiB;
constexpr size_t WS_XB = 296 * MiB;
constexpr size_t WS_PROJ = 328 * MiB;
constexpr size_t WS_RO = 520 * MiB;
constexpr size_t WS_ORET = 584 * MiB;
constexpr size_t WS_H = 328 * MiB;
constexpr size_t WS_KVQ = 584 * MiB;
constexpr size_t WS_AO = 680 * MiB;
constexpr size_t WS_Y = 712 * MiB;
constexpr size_t WS_HM = 328 * MiB;
constexpr size_t WS_XG = 584 * MiB;
constexpr size_t WS_XN8 = 776 * MiB;
constexpr size_t WS_END = 792 * MiB;
static_assert(WS_W_MDN + (size_t)NE * D * EF * 2 <= WS_XM && WS_HM + (size_t)XG_ROWS * EF * 2 <= WS_KVQ && WS_XG + (size_t)XG_ROWS * D * 2 <= WS_AO && WS_Y + (size_t)2 * M * D * 2 <= WS_END, "d_ws map");
constexpr float MOE_WGU_SCALE = 64.0f, MOE_WDN_SCALE = 128.0f, MOE_H_SCALE = 8.0f;
constexpr int CW_BAR = 4096;

constexpr int RING_BYTES = 131072;
constexpr int LDSCTL_OFF = RING_BYTES;
constexpr int LDS_BYTES = 147456;
constexpr int NWAVES = 8, NTHREADS = 512;

#define WG_BAR() do { asm volatile("s_waitcnt vmcnt(0) lgkmcnt(0)" ::: "memory"); __builtin_amdgcn_s_barrier(); asm volatile("" ::: "memory"); } while (0)

#define PHASE_IDS() int tid = threadIdx.x; asm volatile("" : "+v"(tid)); const int lane = tid & 63; const int wave = __builtin_amdgcn_readfirstlane(tid >> 6); (void)lane; (void)wave
struct TrBlk { const float* src; const float* gain; unsigned char* dst; int N, gmask, k0, ldb, fp8; float gscale; };
constexpr int TR_PITCH = 288;
__device__ __forceinline__ void tr_load(const TrBlk& B, f32x4 (&ld)[8], float (&gv)[8], int wave, int lane) {
#pragma unroll
    for (int j = 0; j < 8; ++j) {
        const int k = 16 * wave + 2 * j + (lane >> 5);
        ld[j] = *(const f32x4*)(B.src + (size_t)k * B.N + 4 * (lane & 31));
        gv[j] = B.gain ? B.gain[(B.k0 + k) & B.gmask] * B.gscale : B.gscale;
    }
}
__device__ __forceinline__ void tr_commit(const f32x4 (&ld)[8], const float (&gv)[8], LAS unsigned char* img, int wave, int lane) {
#pragma unroll
    for (int j = 0; j < 8; ++j) {
        const int k = 16 * wave + 2 * j + (lane >> 5);
        u32x2 w; w.x = pk2(ld[j][0] * gv[j], ld[j][1] * gv[j]); w.y = pk2(ld[j][2] * gv[j], ld[j][3] * gv[j]);
        *(LAS u32x2*)(img + k * TR_PITCH + 8 * (lane & 31)) = w;
    }
}
__device__ __forceinline__ void tr_emit(const TrBlk& B, LAS const unsigned char* img, int wave, int lane) {
    const int i = lane & 15, g = lane >> 4, q = i >> 2, p = i & 3;
#pragma unroll
    for (int kg = 0; kg < 4; ++kg) {
        const int kb = 8 * (4 * kg + g);
        const s16x4 lo = __builtin_bit_cast(s16x4, __builtin_amdgcn_ds_read_tr16_b64_v4i16((LAS s16x4*)(img + (kb + q) * TR_PITCH + (16 * wave + 4 * p) * 2)));
        const s16x4 hi = __builtin_bit_cast(s16x4, __builtin_amdgcn_ds_read_tr16_b64_v4i16((LAS s16x4*)(img + (kb + 4 + q) * TR_PITCH + (16 * wave + 4 * p) * 2)));
        if (!B.fp8) {
            v4u o; o.x = (unsigned)(unsigned short)lo[0] | ((unsigned)(unsigned short)lo[1] << 16); o.y = (unsigned)(unsigned short)lo[2] | ((unsigned)(unsigned short)lo[3] << 16);
            o.z = (unsigned)(unsigned short)hi[0] | ((unsigned)(unsigned short)hi[1] << 16); o.w = (unsigned)(unsigned short)hi[2] | ((unsigned)(unsigned short)hi[3] << 16);
            *(GAS v4u*)(B.dst + (size_t)(16 * wave + i) * B.ldb + kb * 2) = o;
        } else {
            unsigned w0 = 0u, w1 = 0u;
            w0 = __builtin_amdgcn_cvt_pk_fp8_f32(bf2f((unsigned short)lo[0]), bf2f((unsigned short)lo[1]), w0, false);
            w0 = __builtin_amdgcn_cvt_pk_fp8_f32(bf2f((unsigned short)lo[2]), bf2f((unsigned short)lo[3]), w0, true);
            w1 = __builtin_amdgcn_cvt_pk_fp8_f32(bf2f((unsigned short)hi[0]), bf2f((unsigned short)hi[1]), w1, false);
            w1 = __builtin_amdgcn_cvt_pk_fp8_f32(bf2f((unsigned short)hi[2]), bf2f((unsigned short)hi[3]), w1, true);
            *(GAS u32x2*)(B.dst + (size_t)(16 * wave + i) * B.ldb + kb) = (u32x2){w0, w1};
        }
    }
}

struct Ptrs {
    const float *x, *ln_mix, *ln_ffn, *ret_w_in, *ret_w_o, *kv_norm, *w_kv, *diff_w_q, *lq1, *lk1, *lq2, *lk2, *subln, *diff_w_o, *ffn_w_gu, *ffn_w_down, *router, *moe_w_gu, *moe_w_down, *final_norm;
    float* out; unsigned char* ws;
};

__device__ __forceinline__ void p0_prologue(const Ptrs& P, LAS unsigned char* lds, int vcu, int G, float lambda_init) {
    PHASE_IDS();
    unsigned char* ws = P.ws;
    const int gw = vcu * NWAVES + wave, NGW = G * NWAVES;
    {
        constexpr int B_IN = (D / 128) * (RIN / 128), B_RO = (RVD / 128) * (D / 128), B_GU = (D / 128) * (2 * FF / 128), B_DN = (FF / 128) * (D / 128), B_KV = (D / 128) * (2048 / 128), B_Q = (D / 128) * (D / 128), B_DO = B_Q;
        constexpr int NBLK = B_IN + B_RO + B_GU + B_DN + B_KV + B_Q + B_DO;
        auto decode = [&](int it) -> TrBlk {
            const float* W; const float* gain = nullptr; int K, N, gmask = 0, F = 0, row_off = 0, fp8 = 0; float gscale = 1.f; unsigned char* WT; int r = it;
            if (r < B_IN) { W = P.ret_w_in; K = D; N = RIN; gain = P.ln_mix; gmask = 1023; WT = ws + WS_W_IN; }
            else if ((r -= B_IN) < B_RO) { W = P.ret_w_o; K = RVD; N = D; WT = ws + WS_W_RO; }
            else if ((r -= B_RO) < B_GU) { W = P.ffn_w_gu; K = D; N = 2 * FF; gain = P.ln_ffn; gmask = 1023; F = FF; WT = ws + WS_W_GU; }
            else if ((r -= B_GU) < B_DN) { W = P.ffn_w_down; K = FF; N = D; WT = ws + WS_W_DN; }
            else if ((r -= B_DN) < B_KV) { W = P.w_kv; K = D; N = 2048; gain = P.kv_norm; gmask = 1023; WT = ws + WS_W_KVQ; }
            else if ((r -= B_KV) < B_Q) { W = P.diff_w_q; K = D; N = D; gain = P.ln_mix + D; gmask = 1023; row_off = 2048; WT = ws + WS_W_KVQ; }
            else if ((r -= B_Q) < B_DO) { W = P.diff_w_o; K = D; N = D; gain = P.subln; gmask = 127; gscale = 1.0f - lambda_init; WT = ws + WS_W_DO; }
            else { W = P.diff_w_o; K = D; N = D; WT = ws + WS_W_DO; }
            const int nblk = N / 128, kb = r / nblk, nb = r % nblk, k0 = 128 * kb, n0 = 128 * nb;
            int drow = n0;
            if (F > 0) { const int up = n0 >= F ? 1 : 0; const int f = n0 - up * F; drow = 256 * (f >> 7) + 128 * up; }
            TrBlk B; B.src = W + (size_t)k0 * N + n0; B.gain = gain; B.N = N; B.gmask = gmask; B.k0 = k0; B.ldb = fp8 ? K : K * 2; B.fp8 = fp8; B.gscale = gscale;
            B.dst = WT + ((size_t)(row_off + drow) * K + k0) * (fp8 ? 1 : 2);
            return B;
        };
#define LDS_BAR() do { asm volatile("s_waitcnt lgkmcnt(0)" ::: "memory"); __builtin_amdgcn_s_barrier(); asm volatile("" ::: "memory"); } while (0)
        LAS unsigned char* img0 = lds; LAS unsigned char* img1 = lds + 128 * TR_PITCH;
        f32x4 ldA[8], ldB[8]; float gvA[8], gvB[8];
        int it = vcu;
        TrBlk bA = decode(it < NBLK ? it : 0), bB = decode(it + G < NBLK ? it + G : 0);
        if (it < NBLK) tr_load(bA, ldA, gvA, wave, lane);
        if (it + G < NBLK) tr_load(bB, ldB, gvB, wave, lane);
        for (; it < NBLK; it += 2 * G) {
            tr_commit(ldA, gvA, img0, wave, lane);
            LDS_BAR();
            const TrBlk cA = bA; const int n2 = it + 2 * G;
            bA = decode(n2 < NBLK ? n2 : 0);
            if (n2 < NBLK) tr_load(bA, ldA, gvA, wave, lane);
            tr_emit(cA, img0, wave, lane);
            if (it + G < NBLK) {
                tr_commit(ldB, gvB, img1, wave, lane);
                LDS_BAR();
                const TrBlk cB = bB; const int n3 = it + 3 * G;
                bB = decode(n3 < NBLK ? n3 : 0);
                if (n3 < NBLK) tr_load(bB, ldB, gvB, wave, lane);
                tr_emit(cB, img1, wave, lane);
            }
        }
        LDS_BAR();
#undef LDS_BAR
    }
    {
        const int gt = gw * 64 + lane, NT = NGW * 64;
        float* rc = (float*)(ws + WS_RCOS); float* rs = (float*)(ws + WS_RSIN);
        for (int i = gt; i < SEQ * 128; i += NT) {
            const int pos = i >> 7, f = i & 127;
            const float inv = exp2f(-(float)f * (13.287712379549449f / 128.0f));
            const double rev = (double)((float)pos * inv) * 0.15915494309189535;
            const float fr = (float)(rev - floor(rev));
            rc[i] = __builtin_amdgcn_cosf(fr); rs[i] = __builtin_amdgcn_sinf(fr);
        }
        float* dc = (float*)(ws + WS_DCOS); float* ds = (float*)(ws + WS_DSIN);
        for (int i = gt; i < SEQ * 8; i += NT) {
            const int pos = i >> 3, f = i & 7;
            const float inv = exp2f(-(float)f * (18.931568569324174f / 8.0f));
            const double rev = (double)((float)pos * inv) * 0.15915494309189535;
            const float fr = (float)(rev - floor(rev));
            dc[i] = __builtin_amdgcn_cosf(fr); ds[i] = __builtin_amdgcn_sinf(fr);
        }
        float* rwt = (float*)(ws + WS_RWT);
        for (int i = gt; i < NE * D; i += NT) { const int e = i >> 10, k = i & 1023; rwt[i] = P.router[k * NE + e] * P.ln_ffn[D + k]; }
    }
    {
        bf16* xb = (bf16*)(ws + WS_XB); float* ssp = (float*)(ws + WS_SSP);
        f32x4 nv[4];
        if (gw < M) { const GAS f32x4* xr = (const GAS f32x4*)(P.x + (size_t)gw * D) + lane;
#pragma unroll
            for (int j = 0; j < 4; ++j) nv[j] = xr[64 * j]; }
        for (int m = gw; m < M; m += NGW) {
            f32x4 v[4]; float s = 0.f;
#pragma unroll
            for (int j = 0; j < 4; ++j) { v[j] = nv[j]; s += (v[j].x * v[j].x + v[j].y * v[j].y) + (v[j].z * v[j].z + v[j].w * v[j].w); }
            if (m + NGW < M) { const GAS f32x4* xr = (const GAS f32x4*)(P.x + (size_t)(m + NGW) * D) + lane;
#pragma unroll
                for (int j = 0; j < 4; ++j) nv[j] = xr[64 * j]; }
            s = wave_sum(s);
            GAS unsigned long long* o8 = (GAS unsigned long long*)(xb + (size_t)m * D) + lane;
#pragma unroll
            for (int j = 0; j < 4; ++j) o8[64 * j] = (unsigned long long)pk2(v[j].x, v[j].y) | ((unsigned long long)pk2(v[j].z, v[j].w) << 32);
            if (lane < 16) ssp[(size_t)m * 16 + lane] = lane == 0 ? s : 0.f;
        }
    }
}

constexpr int CV_BLKS_GU = NE * (D / 128) * (2 * EF / 128), CV_BLKS_DN = NE * (EF / 128) * (D / 128), CV_BLKS = CV_BLKS_GU + CV_BLKS_DN;
constexpr int CV_PITCH = 272, CV_IMG = 32 * CV_PITCH;
struct CvMini { const float* src; unsigned char* dst; int N, ldb, kg; };
__device__ __forceinline__ CvMini cv_decode(const Ptrs& P, int blk, int qk) {
    CvMini m;
    if (blk < CV_BLKS_GU) {
        const int e = blk / 448, r = blk % 448, kb = r / 56, nb = r % 56, k0 = 128 * kb + 32 * qk, n0 = 128 * nb;
        const int up = n0 >= EF ? 1 : 0, f = n0 - up * EF, drow = 256 * (f >> 7) + 128 * up;
        m.src = P.moe_w_gu + (size_t)e * D * 2 * EF + (size_t)k0 * (2 * EF) + n0; m.kg = k0; m.N = 2 * EF;
        m.dst = P.ws + WS_W_MGU + (size_t)e * 2 * EF * D + (size_t)drow * D + k0; m.ldb = D;
    } else {
        const int b2 = blk - CV_BLKS_GU, e = b2 / 224, r = b2 % 224, kb = r / 8, nb = r % 8, k0 = 128 * kb + 32 * qk, n0 = 128 * nb;
        m.src = P.moe_w_down + (size_t)e * EF * D + (size_t)k0 * D + n0; m.kg = -1; m.N = D;
        m.dst = P.ws + WS_W_MDN + (size_t)e * D * EF + (size_t)n0 * EF + k0; m.ldb = EF;
    }
    return m;
}
__device__ __forceinline__ void cv_load(const CvMini& m, f32x4 (&v)[2], int tid) {
#pragma unroll
    for (int j = 0; j < 2; ++j) { const int row = (tid >> 5) + 16 * j; v[j] = __builtin_nontemporal_load((const f32x4*)(m.src + (size_t)row * m.N + 4 * (tid & 31))); }
}
__device__ __forceinline__ void cv_commit(const f32x4 (&v)[2], int kg, LAS const float* gtab, LAS unsigned char* img, int tid) {
#pragma unroll
    for (int j = 0; j < 2; ++j) { const int row = (tid >> 5) + 16 * j;
        const float gn = kg >= 0 ? gtab[kg + row] : MOE_WDN_SCALE;
        u32x2 w; w.x = pk2(v[j][0] * gn, v[j][1] * gn); w.y = pk2(v[j][2] * gn, v[j][3] * gn);
        *(LAS u32x2*)(img + row * CV_PITCH + 8 * (tid & 31)) = w; }
}
__device__ __forceinline__ void cv_emit(unsigned char* dst, int ldb, LAS const unsigned char* img, int wave, int lane) {
    const int i = lane & 15, g4 = lane >> 4, q = i >> 2, p = i & 3;
    const s16x4 lo = __builtin_bit_cast(s16x4, __builtin_amdgcn_ds_read_tr16_b64_v4i16((LAS s16x4*)(img + (8 * g4 + q) * CV_PITCH + (16 * wave + 4 * p) * 2)));
    const s16x4 hi = __builtin_bit_cast(s16x4, __builtin_amdgcn_ds_read_tr16_b64_v4i16((LAS s16x4*)(img + (8 * g4 + 4 + q) * CV_PITCH + (16 * wave + 4 * p) * 2)));
    unsigned w0, w1; asm volatile("" : "=v"(w0), "=v"(w1));
    w0 = __builtin_amdgcn_cvt_pk_fp8_f32(bf2f((unsigned short)lo[0]), bf2f((unsigned short)lo[1]), w0, false); w0 = __builtin_amdgcn_cvt_pk_fp8_f32(bf2f((unsigned short)lo[2]), bf2f((unsigned short)lo[3]), w0, true);
    w1 = __builtin_amdgcn_cvt_pk_fp8_f32(bf2f((unsigned short)hi[0]), bf2f((unsigned short)hi[1]), w1, false); w1 = __builtin_amdgcn_cvt_pk_fp8_f32(bf2f((unsigned short)hi[2]), bf2f((unsigned short)hi[3]), w1, true);
    *(GAS u32x2*)(dst + (size_t)(16 * wave + i) * ldb + 8 * g4) = (u32x2){w0, w1};
}

namespace ret {
typedef short v4i16_t __attribute__((ext_vector_type(4)));
__device__ __forceinline__ s16x4 trld(LAS const unsigned char* p) { return __builtin_bit_cast(s16x4, __builtin_amdgcn_ds_read_tr16_b64_v4i16((LAS v4i16_t*)p)); }
__device__ __forceinline__ bf16x8 cat8(s16x4 lo, s16x4 hi) { return (bf16x8){lo[0], lo[1], lo[2], lo[3], hi[0], hi[1], hi[2], hi[3]}; }
constexpr int QSTR = 528, SSTR = 144;
constexpr int LQ = 0, LK = LQ + 64 * QSTR, LV = LK + 64 * 512, LVD = LV + 4096, LS = LVD + 4096, LST = LS + 64 * SSTR, LEND = LST + 32 * QSTR;
static_assert(LEND + 2 * 32 * 272 + 4096 <= RING_BYTES && (LK % 16) == 0 && (LV % 16) == 0 && (LS % 16) == 0 && (LST % 16) == 0, "retention LDS map");

__device__ __forceinline__ void scores_phase(const bf16* proj, bf16* sbuf, LAS unsigned char* lds, int vcu, int G) {
    PHASE_IDS();
    const int i = lane & 15, g = lane >> 4;
    const int srow = tid >> 5, sc16 = tid & 31;
    constexpr int SQ = 0, SK = 64 * QSTR;
    for (int u = vcu; u < 1024; u += G) {
        const int bh = u >> 6, c = u & 63, b = bh >> 2, h = bh & 3;
        const size_t R0 = (size_t)b * SEQ + c * 64;
        const float lg = log2f(1.0f - exp2f(-5.0f - (float)h));
        const bf16* gq = proj + (R0 + srow) * RIN + h * 256 + sc16 * 8;
        v4u tq[4], tk[4];
#pragma unroll
        for (int k = 0; k < 4; ++k) { tq[k] = *(const v4u*)(gq + (size_t)(16 * k) * RIN); tk[k] = *(const v4u*)(gq + 1024 + (size_t)(16 * k) * RIN); }
#pragma unroll
        for (int k = 0; k < 4; ++k) { *(LAS v4u*)(lds + SQ + (srow + 16 * k) * QSTR + sc16 * 16) = tq[k]; *(LAS v4u*)(lds + SK + (srow + 16 * k) * QSTR + sc16 * 16) = tk[k]; }
        WG_BAR();
#pragma unroll
        for (int tt = 0; tt < 2; ++tt) {
            const int ti = 2 * wave + tt, tn = ti >> 2, tm = ti & 3;
            f32x4 acc = (f32x4){0.f, 0.f, 0.f, 0.f};
            if (tm <= tn) {
#pragma unroll
                for (int s = 0; s < 8; ++s) {
                    const bf16x8 a = *(const LAS bf16x8*)(lds + SK + (16 * tm + i) * QSTR + (32 * s + 8 * g) * 2), bq = *(const LAS bf16x8*)(lds + SQ + (16 * tn + i) * QSTR + (32 * s + 8 * g) * 2);
                    acc = __builtin_amdgcn_mfma_f32_16x16x32_bf16(a, bq, acc, 0, 0, 0);
                }
            }
            const int n = 16 * tn + i, m0 = 16 * tm + 4 * g;
            float v[4];
#pragma unroll
            for (int r = 0; r < 4; ++r) { const int dm = n - (m0 + r); v[r] = dm >= 0 ? acc[r] * exp2f((float)dm * lg) : 0.f; }
            u32x2 w; w.x = pk2(v[0], v[1]); w.y = pk2(v[2], v[3]);
            *(u32x2*)(sbuf + (size_t)u * 4096 + n * 64 + m0) = w;
        }
        WG_BAR();
    }
}

__device__ __forceinline__ void scan_phase(const Ptrs& P, const bf16* proj, const bf16* sbuf, bf16* oret, LAS unsigned char* lds, int vcu, int G) {
    PHASE_IDS();
    int cvp = 0;
    struct CvSet { f32x4 a[2], b[2]; unsigned char* d0; unsigned char* d1; int l0, l1, k0, k1; bool have; };
    CvSet cs0, cs1; cs0.have = false; cs1.have = false; cs0.d0 = cs0.d1 = cs1.d0 = cs1.d1 = nullptr; cs0.l0 = cs0.l1 = cs1.l0 = cs1.l1 = 0; cs0.k0 = cs0.k1 = cs1.k0 = cs1.k1 = -1;
    LAS float* gtab = (LAS float*)(lds + LEND + 2 * CV_IMG);
    for (int k = tid; k < D; k += NTHREADS) gtab[k] = P.ln_ffn[D + k] * MOE_WGU_SCALE;
    WG_BAR();
#define SCAN_LBAR() do { asm volatile("s_waitcnt lgkmcnt(0)" ::: "memory"); __builtin_amdgcn_s_barrier(); asm volatile("" ::: "memory"); } while (0)
    LAS unsigned char* cimg0 = lds + LEND; LAS unsigned char* cimg1 = lds + LEND + CV_IMG;
    const int i = lane & 15, g = lane >> 4, q = i >> 2, p = i & 3;
    const int nt = wave >> 1, vt = wave & 1;
    for (int u = vcu; u < 256; u += G) {
        const int bh = u >> 4, vs = u & 15, b = bh >> 2, h = bh & 3;
        const float lg = log2f(1.0f - exp2f(-5.0f - (float)h));
        const float cdec = exp2f(64.0f * lg);
        const float qdl = exp2f((float)(16 * nt + i + 1) * lg);
        const float kd = exp2f((float)(63 - (tid >> 2)) * lg);
        const int qrow = tid >> 5, qc16 = tid & 31;
        const char* uq = (const char*)(proj + (size_t)b * SEQ * RIN + h * 256);
        const unsigned qoff = (unsigned)(qrow * RIN + qc16 * 8) * 2u;
        const int kx = (qrow & 3) | (((qrow >> 3) & 1) << 2);
        const int lq_off = LQ + qrow * QSTR + qc16 * 16;
        const int lk_off = LK + qrow * 512 + (((qc16 >> 1) ^ kx) << 5) + (qc16 & 1) * 16;
        const int vrow = tid >> 2, vc16 = tid & 3;
        const char* uv = (const char*)(proj + (size_t)b * SEQ * RIN + 2048 + h * 512 + vs * 32);
        const unsigned voff = (unsigned)(vrow * RIN + vc16 * 8) * 2u;
        const int lv_off = vrow * 64 + ((vc16 * 16) ^ (((vrow >> 3) & 1) << 5));
        const int srow = tid >> 3, sc16 = tid & 7;
        const char* us = (const char*)(sbuf + (size_t)(bh * 64) * 4096);
        const unsigned soff = (unsigned)tid * 16u;
        const int ls_off = LS + srow * SSTR + sc16 * 16;
        f32x4 st[2][2];
#pragma unroll
        for (int a = 0; a < 2; ++a)
#pragma unroll
            for (int c2 = 0; c2 < 2; ++c2) st[a][c2] = (f32x4){0.f, 0.f, 0.f, 0.f};
        for (int k = tid; k < 32 * QSTR / 16; k += NTHREADS) ((LAS v4u*)(lds + LST))[k] = (v4u){0u, 0u, 0u, 0u};
        v4u pq[4], pk[4], pv, ps;
#pragma unroll
        for (int k = 0; k < 4; ++k) { pq[k] = *(const v4u*)(uq + (size_t)(16 * k) * RIN * 2 + qoff); pk[k] = *(const v4u*)(uq + (size_t)(16 * k) * RIN * 2 + 2048 + qoff); }
        pv = (tid < 256) ? *(const v4u*)(uv + voff) : (v4u){0u, 0u, 0u, 0u};
        ps = *(const v4u*)(us + soff);
        auto scan_step = [&](const int c, CvSet& CS) __attribute__((always_inline)) {
#pragma unroll
            for (int k = 0; k < 4; ++k) { *(LAS v4u*)(lds + lq_off + 16 * k * QSTR) = pq[k]; *(LAS v4u*)(lds + lk_off + 16 * k * 512) = pk[k]; }
            if (tid < 256) {
                *(LAS v4u*)(lds + LV + lv_off) = pv;
                v4u d; d.x = pk2(bflo(pv.x) * kd, bfhi(pv.x) * kd); d.y = pk2(bflo(pv.y) * kd, bfhi(pv.y) * kd); d.z = pk2(bflo(pv.z) * kd, bfhi(pv.z) * kd); d.w = pk2(bflo(pv.w) * kd, bfhi(pv.w) * kd);
                *(LAS v4u*)(lds + LVD + lv_off) = d;
            }
            *(LAS v4u*)(lds + ls_off) = ps;
            unsigned char* ed0 = CS.d0; unsigned char* ed1 = CS.d1; const int el0 = CS.l0, el1 = CS.l1; const bool cv_emit_now = CS.have;
            if (CS.have) { cv_commit(CS.a, CS.k0, gtab, cimg0, tid); cv_commit(CS.b, CS.k1, gtab, cimg1, tid); }
            SCAN_LBAR();
            if (c + 1 < 64) {
                const size_t adv = (size_t)(c + 1) * 64 * RIN * 2;
#pragma unroll
                for (int k = 0; k < 4; ++k) { pq[k] = *(const v4u*)(uq + adv + (size_t)(16 * k) * RIN * 2 + qoff); pk[k] = *(const v4u*)(uq + adv + (size_t)(16 * k) * RIN * 2 + 2048 + qoff); }
                if (tid < 256) pv = *(const v4u*)(uv + adv + voff);
                ps = *(const v4u*)(us + (size_t)(c + 1) * 8192 + soff);
            }
            {
                const int blk = vcu + (cvp >> 1) * G;
                CS.have = blk < CV_BLKS;
                if (CS.have) { const CvMini m0 = cv_decode(P, blk, 2 * (cvp & 1)), m1 = cv_decode(P, blk, 2 * (cvp & 1) + 1);
                    cv_load(m0, CS.a, tid); cv_load(m1, CS.b, tid); CS.d0 = m0.dst; CS.l0 = m0.ldb; CS.k0 = m0.kg; CS.d1 = m1.dst; CS.l1 = m1.ldb; CS.k1 = m1.kg; ++cvp; }
            }
            f32x4 a1 = (f32x4){0.f, 0.f, 0.f, 0.f}, a2 = (f32x4){0.f, 0.f, 0.f, 0.f}, a3 = (f32x4){0.f, 0.f, 0.f, 0.f};
#pragma unroll
            for (int s = 0; s < 2; ++s) {
                const bf16x8 a = *(const LAS bf16x8*)(lds + LS + (16 * nt + i) * SSTR + (32 * s + 8 * g) * 2);
                const int r0 = 32 * s + 8 * g + q, r1 = r0 + 4, cb = (16 * vt + 4 * p) * 2;
                const s16x4 lo = trld(lds + LV + r0 * 64 + (cb ^ (((r0 >> 3) & 1) << 5))), hi = trld(lds + LV + r1 * 64 + (cb ^ (((r1 >> 3) & 1) << 5)));
                a1 = __builtin_amdgcn_mfma_f32_16x16x32_bf16(cat8(lo, hi), a, a1, 0, 0, 0);
            }
#pragma unroll
            for (int s = 0; s < 8; ++s) {
                const bf16x8 a = *(const LAS bf16x8*)(lds + LQ + (16 * nt + i) * QSTR + (32 * s + 8 * g) * 2);
                const bf16x8 sf = *(const LAS bf16x8*)(lds + LST + (16 * vt + i) * QSTR + (32 * s + 8 * g) * 2);
                if (s & 1) a3 = __builtin_amdgcn_mfma_f32_16x16x32_bf16(sf, a, a3, 0, 0, 0);
                else a2 = __builtin_amdgcn_mfma_f32_16x16x32_bf16(sf, a, a2, 0, 0, 0);
            }
#pragma unroll
            for (int dt = 0; dt < 2; ++dt)
#pragma unroll
                for (int vv = 0; vv < 2; ++vv) st[dt][vv] = st[dt][vv] * cdec;
#pragma unroll
            for (int s = 0; s < 2; ++s) {
                const int r0 = 32 * s + 8 * g + q, r1 = r0 + 4;
                const int x0 = (r0 & 3) | (((r0 >> 3) & 1) << 2), x1 = (r1 & 3) | (((r1 >> 3) & 1) << 2);
                bf16x8 ka[2], vb[2];
#pragma unroll
                for (int dt = 0; dt < 2; ++dt) {
                    const int slot = 2 * wave + dt;
                    ka[dt] = cat8(trld(lds + LK + r0 * 512 + ((slot ^ x0) << 5) + 8 * p), trld(lds + LK + r1 * 512 + ((slot ^ x1) << 5) + 8 * p));
                }
#pragma unroll
                for (int vv = 0; vv < 2; ++vv) {
                    const int cb = (16 * vv + 4 * p) * 2;
                    vb[vv] = cat8(trld(lds + LVD + r0 * 64 + (cb ^ (((r0 >> 3) & 1) << 5))), trld(lds + LVD + r1 * 64 + (cb ^ (((r1 >> 3) & 1) << 5))));
                }
#pragma unroll
                for (int dt = 0; dt < 2; ++dt)
#pragma unroll
                    for (int vv = 0; vv < 2; ++vv) st[dt][vv] = __builtin_amdgcn_mfma_f32_16x16x32_bf16(ka[dt], vb[vv], st[dt][vv], 0, 0, 0);
            }
            {
                char* uo = (char*)(oret + ((size_t)b * SEQ + c * 64) * RVD + h * 512 + vs * 32);
                const unsigned ooff = (unsigned)((16 * nt + i) * RVD + 16 * vt + 4 * g) * 2u;
                float ov_[4];
#pragma unroll
                for (int r = 0; r < 4; ++r) ov_[r] = a1[r] + qdl * (a2[r] + a3[r]);
                u32x2 w_; w_.x = pk2(ov_[0], ov_[1]); w_.y = pk2(ov_[2], ov_[3]);
                *(u32x2*)(uo + ooff) = w_;
            }
            if (cv_emit_now) { cv_emit(ed0, el0, cimg0, wave, lane); cv_emit(ed1, el1, cimg1, wave, lane); }
            SCAN_LBAR();
#pragma unroll
            for (int dt = 0; dt < 2; ++dt)
#pragma unroll
                for (int vv = 0; vv < 2; ++vv)
                    *(LAS u32x2*)(lds + LST + (16 * vv + i) * QSTR + (32 * wave + 16 * dt + 4 * g) * 2) = (u32x2){pk2(st[dt][vv][0], st[dt][vv][1]), pk2(st[dt][vv][2], st[dt][vv][3])};
        };
        for (int c = 0; c < 64; c += 2) { scan_step(c, cs0); scan_step(c + 1, cs1); }
        WG_BAR();
    }
    for (;;) {
        bool any = false;
#pragma unroll
        for (int k = 0; k < 2; ++k) {
            CvSet& CS = k ? cs1 : cs0;
            unsigned char* ed0 = CS.d0; unsigned char* ed1 = CS.d1; const int el0 = CS.l0, el1 = CS.l1; const bool emit_now = CS.have;
            if (CS.have) { cv_commit(CS.a, CS.k0, gtab, cimg0, tid); cv_commit(CS.b, CS.k1, gtab, cimg1, tid); }
            WG_BAR();
            const int blk = vcu + (cvp >> 1) * G;
            CS.have = blk < CV_BLKS;
            if (CS.have) { const CvMini m0 = cv_decode(P, blk, 2 * (cvp & 1)), m1 = cv_decode(P, blk, 2 * (cvp & 1) + 1);
                cv_load(m0, CS.a, tid); cv_load(m1, CS.b, tid); CS.d0 = m0.dst; CS.l0 = m0.ldb; CS.k0 = m0.kg; CS.d1 = m1.dst; CS.l1 = m1.ldb; CS.k1 = m1.kg; ++cvp; }
            if (emit_now) { cv_emit(ed0, el0, cimg0, wave, lane); cv_emit(ed1, el1, cimg1, wave, lane); }
            WG_BAR();
            any = any || emit_now || CS.have;
        }
        if (!any) break;
    }
#undef SCAN_LBAR
}

__device__ __forceinline__ void norm_gate_phase(const bf16* oret, const bf16* proj, bf16* ro, int vcu, int G) {
    PHASE_IDS();
    const int gw = vcu * NWAVES + wave, NGW = G * NWAVES;
    for (int row = gw; row < M; row += NGW) {
        v4u ov[4], gv[4];
#pragma unroll
        for (int h = 0; h < 4; ++h) {
            ov[h] = *(const v4u*)(oret + (size_t)row * RVD + h * 512 + lane * 8);
            gv[h] = *(const v4u*)(proj + (size_t)row * RIN + 4096 + h * 512 + lane * 8);
        }
        float o[4][8], mu[4], rstd[4];
#pragma unroll
        for (int h = 0; h < 4; ++h) {
            o[h][0] = bflo(ov[h].x); o[h][1] = bfhi(ov[h].x); o[h][2] = bflo(ov[h].y); o[h][3] = bfhi(ov[h].y); o[h][4] = bflo(ov[h].z); o[h][5] = bfhi(ov[h].z); o[h][6] = bflo(ov[h].w); o[h][7] = bfhi(ov[h].w);
            float s = 0.f;
#pragma unroll
            for (int j = 0; j < 8; ++j) s += o[h][j];
            mu[h] = s;
        }
#pragma unroll
        for (int h = 0; h < 4; ++h) mu[h] = wave_sum(mu[h]) * (1.0f / 512.0f);
#pragma unroll
        for (int h = 0; h < 4; ++h) {
            float s2 = 0.f;
#pragma unroll
            for (int j = 0; j < 8; ++j) { o[h][j] -= mu[h]; s2 += o[h][j] * o[h][j]; }
            rstd[h] = s2;
        }
#pragma unroll
        for (int h = 0; h < 4; ++h) rstd[h] = __builtin_amdgcn_rsqf(wave_sum(rstd[h]) * (1.0f / 512.0f) + EPS);
#pragma unroll
        for (int h = 0; h < 4; ++h) {
            const float gg[8] = {bflo(gv[h].x), bfhi(gv[h].x), bflo(gv[h].y), bfhi(gv[h].y), bflo(gv[h].z), bfhi(gv[h].z), bflo(gv[h].w), bfhi(gv[h].w)};
            float y[8];
#pragma unroll
            for (int j = 0; j < 8; ++j) y[j] = o[h][j] * rstd[h] * silu_f(gg[j]);
            v4u w; w.x = pk2(y[0], y[1]); w.y = pk2(y[2], y[3]); w.z = pk2(y[4], y[5]); w.w = pk2(y[6], y[7]);
            *(v4u*)(ro + (size_t)row * RVD + h * 512 + lane * 8) = w;
        }
    }
}
}

namespace dat {
constexpr int LK0 = 0  , LV0 = 32768  , LWS = 81920  , LCB = 0  , CSTR = 132;
__device__ __forceinline__ int crow(int r, int hi) { return (r & 3) + 8 * (r >> 2) + 4 * hi; }
__device__ __forceinline__ float half_swap_max(float m) { auto rr = __builtin_amdgcn_permlane32_swap(__float_as_uint(m), __float_as_uint(m), false, false); return fmaxf(__uint_as_float(rr[0]), __uint_as_float(rr[1])); }
__device__ __forceinline__ float half_swap_sum(float m) { auto rr = __builtin_amdgcn_permlane32_swap(__float_as_uint(m), __float_as_uint(m), false, false); return __uint_as_float(rr[0]) + __uint_as_float(rr[1]); }
typedef float f32x2_t __attribute__((ext_vector_type(2))); typedef __bf16 bf16x2_t __attribute__((ext_vector_type(2)));
__device__ __forceinline__ unsigned cvtpk(float lo, float hi) { f32x2_t v = {lo, hi}; bf16x2_t b2 = __builtin_convertvector(v, bf16x2_t); return __builtin_bit_cast(unsigned, b2); }
__device__ __forceinline__ float max3f(float a, float b, float c) { float r; asm("v_max3_f32 %0, %1, %2, %3" : "=v"(r) : "v"(a), "v"(b), "v"(c)); return r; }
__device__ __forceinline__ float fadd_s(float a, float b) { float r; asm("v_add_f32_e32 %0, %1, %2" : "=v"(r) : "v"(a), "v"(b)); return r; }

#define DAT_SBAR() __builtin_amdgcn_sched_barrier(0)
#define DAT_PIN(x) asm volatile("" : "+v"(x))
__device__ __forceinline__ void attn_unit(int b, int h, int qb, const bf16* kvq, bf16* ao, LAS unsigned char* lds, float lam, int wave, int lane, int tid) {
    const int r32 = lane & 31, hi = lane >> 5, comp = wave >> 2, w4 = wave & 3;
    const size_t rowbase = (size_t)b * SEQ;
    const int q0 = qb * 128;
    const int NT = 2 * qb + 2, ntw = 2 * qb + 1 + (w4 >> 1);
    const bf16* Kh = kvq + rowbase * KVQ_N + h * 128;
    const bf16* Vh = kvq + rowbase * KVQ_N + 1024 + h * 128;
    const bf16* Qw = kvq + (rowbase + q0 + w4 * 32) * KVQ_N + 2048 + h * 128 + comp * 64;
    LAS float* wsf = (LAS float*)(lds + LWS) + wave * 64;
    const int pkey = 4 * wave + (lane >> 4), pc = lane & 15;
    const unsigned kvoff = (unsigned)(pkey * KVQ_N + ((pc ^ (pkey & 15)) << 3)) * 2u;
    const unsigned vvoff = (unsigned)(pkey * KVQ_N + ((pc ^ ((pkey & 3) << 2)) << 3)) * 2u;
    const int koff0 = r32 * 256 + (((comp * 8 + hi) ^ (r32 & 15)) << 4);
    const int voff0 = (4 * hi + ((lane & 15) >> 2)) * 256 + ((((lane & 15) >> 2) << 6) | ((4 * ((lane >> 4) & 1) + (lane & 3)) << 3));
#define koffd(d) (koff0 ^ ((d) << 5))
#define voffd(d) (voff0 ^ ((d) << 6))
    const unsigned ldsb = (unsigned)(size_t)lds;
#define DAT_GLDS(base, voff, dst) do { unsigned keep_; asm volatile("s_mov_b32 %0, m0\n\ts_mov_b32 m0, %3\n\ts_nop 0\n\tglobal_load_lds_dwordx4 %1, %2\n\ts_mov_b32 m0, %0" : "=&s"(keep_) : "v"(voff), "s"(base), "s"(dst) : "memory"); } while (0)
#define DAT_DMA(t, kslot, vslot) do { const bf16* kb0_ = Kh + (size_t)(t) * 64 * KVQ_N; const bf16* vb0_ = Vh + (size_t)(t) * 64 * KVQ_N; \
        const unsigned kd_ = (unsigned)__builtin_amdgcn_readfirstlane(ldsb + LK0 + (kslot) * 16384 + wave * 1024), vd_ = (unsigned)__builtin_amdgcn_readfirstlane(ldsb + LV0 + (vslot) * 16384 + wave * 1024); \
        DAT_GLDS(kb0_, kvoff, kd_); DAT_GLDS(kb0_ + (size_t)32 * KVQ_N, kvoff, kd_ + 8192u); DAT_GLDS(vb0_, vvoff, vd_); DAT_GLDS(vb0_ + (size_t)32 * KVQ_N, vvoff, vd_ + 8192u); } while (0)
    DAT_DMA(0, 0, 0);
    bf16x8 qr[4];
#pragma unroll
    for (int d0 = 0; d0 < 4; ++d0) qr[d0] = *(const bf16x8*)(Qw + (size_t)r32 * KVQ_N + d0 * 16 + hi * 8);
    asm volatile("" : "+v"(qr[0]), "+v"(qr[1]), "+v"(qr[2]), "+v"(qr[3]));
    f32x16 o[4];
#pragma unroll
    for (int d = 0; d < 4; ++d)
#pragma unroll
        for (int r = 0; r < 16; ++r) o[d][r] = 0.f;
    float mrun = 0.f, lrun = 0.f;
    f32x16 negm;
#pragma unroll
    for (int r = 0; r < 16; ++r) negm[r] = 0.f;
    f32x16 C0, C1;
    v4u pw[4];
    int vsl_prev = 0, vsl_cur = 0;
    bool resc = false;
#define DAT_DECIDE(FIRST) do { \
        float ra_ = max3f(C0[0], C0[1], C1[0]), rb_ = max3f(C0[2], C0[3], C1[1]); ra_ = max3f(ra_, C1[2], C1[3]); \
        _Pragma("unroll") for (int r = 4; r < 16; r += 4) { ra_ = max3f(ra_, C0[r], C0[r + 1]); rb_ = max3f(rb_, C0[r + 2], C0[r + 3]); ra_ = max3f(ra_, C1[r], C1[r + 1]); rb_ = max3f(rb_, C1[r + 2], C1[r + 3]); } \
        const float rm_ = half_swap_max(max3f(ra_, rb_, rb_)); \
        if ((FIRST) || __any(rm_ > 8.0f)) { \
            const float dl_ = (FIRST) ? rm_ : fmaxf(rm_, 0.f); const float f_ = fast_exp2(-dl_); \
            lrun *= f_; mrun += dl_; if (hi == 0) wsf[r32] = f_; \
            _Pragma("unroll") for (int r = 0; r < 16; ++r) { C0[r] -= dl_; C1[r] -= dl_; negm[r] = -mrun; } \
            resc = !(FIRST); } } while (0)
#define DAT_RESC() do { if (resc) { asm volatile("s_waitcnt lgkmcnt(0)" ::: "memory"); \
        _Pragma("unroll") for (int r = 0; r < 16; ++r) { const float fr_ = wsf[crow(r, hi)]; _Pragma("unroll") for (int d = 0; d < 4; ++d) o[d][r] *= fr_; } resc = false; } } while (0)
#define DAT_VRD(dst_lo, dst_hi, j) do { dst_lo = ret::trld(Vb_ + voffd((j) >> 2) + ((j) & 3) * 4096); dst_hi = ret::trld(Vb_ + voffd((j) >> 2) + ((j) & 3) * 4096 + 2048); } while (0)
#define DAT_QK(t_, DO_, tn_) do { LAS const unsigned char* Kb_ = lds + LK0 + ((t_) & 1) * 16384; \
        const bf16* kb0_ = Kh + (size_t)(tn_) * 64 * KVQ_N; const bf16* vb0_ = Vh + (size_t)(tn_) * 64 * KVQ_N; const unsigned kd_ = (unsigned)__builtin_amdgcn_readfirstlane(ldsb + LK0 + ((tn_) & 1) * 16384 + wave * 1024), vd_ = (unsigned)__builtin_amdgcn_readfirstlane(ldsb + LV0 + ((tn_) % 3) * 16384 + wave * 1024); \
        bf16x8 ka_ = *(const LAS bf16x8*)(Kb_ + koffd(0)), kb_ = *(const LAS bf16x8*)(Kb_ + koffd(0) + 8192), kc_ = *(const LAS bf16x8*)(Kb_ + koffd(1)), kd2_ = *(const LAS bf16x8*)(Kb_ + koffd(1) + 8192); \
        DAT_SBAR(); \
        C0 = __builtin_amdgcn_mfma_f32_32x32x16_bf16(ka_, qr[0], negm, 0, 0, 0); C1 = __builtin_amdgcn_mfma_f32_32x32x16_bf16(kb_, qr[0], negm, 0, 0, 0); \
        ka_ = *(const LAS bf16x8*)(Kb_ + koffd(2)); kb_ = *(const LAS bf16x8*)(Kb_ + koffd(2) + 8192); if (DO_) DAT_GLDS(kb0_, kvoff, kd_); DAT_SBAR(); \
        C0 = __builtin_amdgcn_mfma_f32_32x32x16_bf16(kc_, qr[1], C0, 0, 0, 0); C1 = __builtin_amdgcn_mfma_f32_32x32x16_bf16(kd2_, qr[1], C1, 0, 0, 0); \
        kc_ = *(const LAS bf16x8*)(Kb_ + koffd(3)); kd2_ = *(const LAS bf16x8*)(Kb_ + koffd(3) + 8192); if (DO_) DAT_GLDS(kb0_ + (size_t)32 * KVQ_N, kvoff, kd_ + 8192u); DAT_SBAR(); \
        C0 = __builtin_amdgcn_mfma_f32_32x32x16_bf16(ka_, qr[2], C0, 0, 0, 0); C1 = __builtin_amdgcn_mfma_f32_32x32x16_bf16(kb_, qr[2], C1, 0, 0, 0); \
        if (DO_) DAT_GLDS(vb0_, vvoff, vd_); DAT_SBAR(); \
        C0 = __builtin_amdgcn_mfma_f32_32x32x16_bf16(kc_, qr[3], C0, 0, 0, 0); C1 = __builtin_amdgcn_mfma_f32_32x32x16_bf16(kd2_, qr[3], C1, 0, 0, 0); \
        if (DO_) DAT_GLDS(vb0_ + (size_t)32 * KVQ_N, vvoff, vd_ + 8192u); DAT_SBAR(); \
        asm volatile("s_nop 15\n\ts_nop 7" : "+v"(C0), "+v"(C1)); } while (0)
    {
        WG_BAR();
        DAT_QK(0, true, 1);
        DAT_DECIDE(true);
        float s0_ = 0.f, s1_ = 0.f;
#pragma unroll
        for (int j = 0; j < 16; ++j) {
            const float e0_ = fast_exp2(j < 8 ? C0[2 * (j & 7)] : C1[2 * (j & 7)]), e1_ = fast_exp2(j < 8 ? C0[2 * (j & 7) + 1] : C1[2 * (j & 7) + 1]);
            s0_ += e0_; s1_ += e1_; pw[j >> 2][j & 3] = cvtpk(e0_, e1_);
        }
        lrun += s0_ + s1_;
        vsl_prev = 0; vsl_cur = 16384;
    }
#define DAT_STEADY(t_, PWa, PWb) do { \
        WG_BAR(); \
        const bool dma_ = ((t_) + 1 < NT); \
        LAS const unsigned char* Vb_ = lds + LV0 + vsl_prev; \
        s16x4 vl_[4], vh_[4]; \
        _Pragma("unroll") for (int j = 0; j < 4; ++j) DAT_VRD(vl_[j], vh_[j], j); \
        DAT_QK(t_, dma_, (t_) + 1); \
        DAT_DECIDE(false); \
        const bf16x8 pa_[4] = {__builtin_bit_cast(bf16x8, PWa[0]), __builtin_bit_cast(bf16x8, PWa[1]), __builtin_bit_cast(bf16x8, PWa[2]), __builtin_bit_cast(bf16x8, PWa[3])}; \
        float ssum_ = 0.f; \
        DAT_SBAR(); \
        _Pragma("unroll") for (int j = 0; j < 16; ++j) { \
            o[j >> 2] = __builtin_amdgcn_mfma_f32_32x32x16_bf16(pa_[j & 3], ret::cat8(vl_[j & 3], vh_[j & 3]), o[j >> 2], 0, 0, 0); \
            if (j + 4 < 16) DAT_VRD(vl_[j & 3], vh_[j & 3], j + 4); \
            { const float e0_ = fast_exp2(j < 8 ? C0[2 * (j & 7)] : C1[2 * (j & 7)]), e1_ = fast_exp2(j < 8 ? C0[2 * (j & 7) + 1] : C1[2 * (j & 7) + 1]); \
              ssum_ += e0_; ssum_ += e1_; PWb[j >> 2][j & 3] = cvtpk(e0_, e1_); } \
            DAT_PIN(ssum_); DAT_SBAR(); \
        } \
        DAT_RESC(); \
        lrun += ssum_; \
        vsl_prev = vsl_cur; vsl_cur = (vsl_cur == 32768) ? 0 : vsl_cur + 16384; \
    } while (0)
    v4u pq_[4];
    int t = 1;
    for (; t + 1 < ntw; t += 2) { DAT_STEADY(t, pw, pq_); DAT_STEADY(t + 1, pq_, pw); }
    for (; t <= NT; ++t) {
        if (t < ntw) { DAT_STEADY(t, pw, pq_); pw[0] = pq_[0]; pw[1] = pq_[1]; pw[2] = pq_[2]; pw[3] = pq_[3]; }
        else {
            WG_BAR();
            const bool dma_ = (t + 1 < NT);
            LAS const unsigned char* Vb_ = lds + LV0 + vsl_prev;
            if (dma_) { const int tn_ = t + 1; DAT_DMA(tn_, tn_ & 1, tn_ % 3); }
            if (t == ntw) {
            const bf16x8 pa_[4] = {__builtin_bit_cast(bf16x8, pw[0]), __builtin_bit_cast(bf16x8, pw[1]), __builtin_bit_cast(bf16x8, pw[2]), __builtin_bit_cast(bf16x8, pw[3])};
#pragma unroll
            for (int d = 0; d < 4; ++d)
#pragma unroll
                for (int ks = 0; ks < 4; ++ks) {
                    const s16x4 lo_ = ret::trld(Vb_ + voffd(d) + ks * 4096), hh_ = ret::trld(Vb_ + voffd(d) + ks * 4096 + 2048);
                    o[d] = __builtin_amdgcn_mfma_f32_32x32x16_bf16(pa_[ks], ret::cat8(lo_, hh_), o[d], 0, 0, 0);
                }
            }
            vsl_prev = vsl_cur; vsl_cur = (vsl_cur == 32768) ? 0 : vsl_cur + 16384;
        }
    }
#undef DAT_STEADY
#undef DAT_QK
#undef DAT_VRD
#undef DAT_RESC
#undef DAT_DECIDE
#undef DAT_DMA
#undef DAT_GLDS
#undef koffd
#undef voffd
    {
        const float lt = half_swap_sum(lrun);
        if (hi == 0) wsf[r32] = (comp ? lam : 1.0f) * fast_rcp(lt);
        asm volatile("s_waitcnt lgkmcnt(0)" ::: "memory");
#pragma unroll
        for (int r = 0; r < 16; ++r) { const float fr_ = wsf[crow(r, hi)];
#pragma unroll
            for (int d = 0; d < 4; ++d) o[d][r] *= fr_; }
    }
    WG_BAR();
    LAS float* cb = (LAS float*)(lds + LCB);
    if (comp == 1) {
#pragma unroll
        for (int d = 0; d < 4; ++d)
#pragma unroll
            for (int r = 0; r < 16; ++r) cb[(w4 * 32 + crow(r, hi)) * CSTR + d * 32 + r32] = o[d][r];
    }
    WG_BAR();
    if (comp == 0) {
#pragma unroll
        for (int d = 0; d < 4; ++d)
#pragma unroll
            for (int r = 0; r < 16; ++r) { LAS float* pc = cb + (w4 * 32 + crow(r, hi)) * CSTR + d * 32 + r32; *pc = o[d][r] - *pc; }
    }
    WG_BAR();
    {
        const int row = tid >> 2, part = tid & 3;
        const LAS f32x4* src = (const LAS f32x4*)(cb + row * CSTR + part * 32);
        f32x4 v[8]; float ss = 0.f;
#pragma unroll
        for (int j = 0; j < 8; ++j) { v[j] = src[j]; ss += (v[j][0] * v[j][0] + v[j][1] * v[j][1]) + (v[j][2] * v[j][2] + v[j][3] * v[j][3]); }
        ss += SWZ_XOR(ss, 1); ss += SWZ_XOR(ss, 2);
        const float rstd = __builtin_amdgcn_rsqf(ss * (1.0f / 128.0f) + EPS);
        bf16* dst = ao + (rowbase + q0 + row) * D + h * 128 + part * 32;
#pragma unroll
        for (int j = 0; j < 4; ++j) {
            v4u w; w.x = pk2(v[2 * j][0] * rstd, v[2 * j][1] * rstd); w.y = pk2(v[2 * j][2] * rstd, v[2 * j][3] * rstd);
            w.z = pk2(v[2 * j + 1][0] * rstd, v[2 * j + 1][1] * rstd); w.w = pk2(v[2 * j + 1][2] * rstd, v[2 * j + 1][3] * rstd);
            *(v4u*)(dst + 8 * j) = w;
        }
    }
    WG_BAR();
}

__device__ __forceinline__ void attn_phase(const bf16* kvq, bf16* ao, LAS unsigned char* lds, const float* lq1, const float* lk1, const float* lq2, const float* lk2, float lambda_init, int vcu, int G) {
    PHASE_IDS();
    const float lam = __expf(wave_sum(lq1[lane] * lk1[lane])) - __expf(wave_sum(lq2[lane] * lk2[lane])) + lambda_init;
    const int nun = (G == 256) ? 4 : (1024 - vcu + G - 1) / G;
#pragma unroll 1
    for (int i = 0; i < nun; ++i) {
        int bh, qb;
        if (G == 256) { const int x = vcu >> 5, w = vcu & 31, j = (w + 16) & 31; bh = 4 * x + i; qb = (i == 0) ? w : (i == 1) ? 31 - w : (i == 2) ? j : 31 - j; }
        else { const int u = vcu + i * G; bh = u >> 5; qb = u & 31; }
        attn_unit(bh >> 3, bh & 7, qb, kvq, ao, lds, lam, wave, lane, tid);
    }
}
}

__device__ __forceinline__ void route_a(const bf16* xb, const float* rwt, int* tope, float* topw, int* topr, float* tokr, int* cnt, unsigned char* xn8, LAS unsigned char* lds, int vcu, int G) {
    PHASE_IDS();
    LAS f32x4* rw = (LAS f32x4*)lds;
    LAS int* sel = (LAS int*)(lds + 32768);
    for (int k = tid; k < NE * D / 4; k += NTHREADS) { const int e = k >> 8, c4 = k & 255; rw[((e * 2 + (c4 >> 7)) * 2 + (c4 & 1)) * 64 + ((c4 >> 1) & 63)] = ((const f32x4*)rwt)[k]; }
    WG_BAR();
    for (int tb = vcu; tb < M / 64; tb += G) {
        v4u nv[2];
        { const v4u* xr = (const v4u*)(xb + (size_t)(tb * 64 + wave * 8) * D) + lane;
          nv[0] = xr[0]; nv[1] = xr[64]; }
        for (int tk = 0; tk < 8; ++tk) {
            const int tl = wave * 8 + tk, row = tb * 64 + tl;
            f32x4 v[2][2]; float ss = 0.f;
#pragma unroll
            for (int j = 0; j < 2; ++j) {
                v[j][0] = (f32x4){bflo(nv[j].x), bfhi(nv[j].x), bflo(nv[j].y), bfhi(nv[j].y)}; v[j][1] = (f32x4){bflo(nv[j].z), bfhi(nv[j].z), bflo(nv[j].w), bfhi(nv[j].w)};
#pragma unroll
                for (int h = 0; h < 2; ++h) ss += (v[j][h][0] * v[j][h][0] + v[j][h][1] * v[j][h][1]) + (v[j][h][2] * v[j][h][2] + v[j][h][3] * v[j][h][3]);
            }
            if (tk + 1 < 8) { const v4u* xr = (const v4u*)(xb + (size_t)(row + 1) * D) + lane; nv[0] = xr[0]; nv[1] = xr[64]; }
            ss = wave_sum(ss);
            const float r = __builtin_amdgcn_rsqf(ss * (1.0f / 1024.0f) + EPS);
#pragma unroll
            for (int j = 0; j < 2; ++j) {
                u32x2 w = {0u, 0u};
                w.x = __builtin_amdgcn_cvt_pk_fp8_f32(v[j][0][0] * r, v[j][0][1] * r, w.x, false); w.x = __builtin_amdgcn_cvt_pk_fp8_f32(v[j][0][2] * r, v[j][0][3] * r, w.x, true);
                w.y = __builtin_amdgcn_cvt_pk_fp8_f32(v[j][1][0] * r, v[j][1][1] * r, w.y, false); w.y = __builtin_amdgcn_cvt_pk_fp8_f32(v[j][1][2] * r, v[j][1][3] * r, w.y, true);
                ((u32x2*)(xn8 + (size_t)row * D))[lane + 64 * j] = w;
            }
            float lg[NE];
#pragma unroll
            for (int e = 0; e < NE; ++e) {
                float a = 0.f;
#pragma unroll
                for (int j = 0; j < 2; ++j)
#pragma unroll
                    for (int h = 0; h < 2; ++h) { const f32x4 w = rw[((e * 2 + j) * 2 + h) * 64 + lane]; a += (v[j][h][0] * w[0] + v[j][h][1] * w[1]) + (v[j][h][2] * w[2] + v[j][h][3] * w[3]); }
                lg[e] = wave_sum(a) * r;
            }
            int e1 = 0; float v1 = lg[0];
#pragma unroll
            for (int e = 1; e < NE; ++e) if (lg[e] > v1) { v1 = lg[e]; e1 = e; }
            int e2 = -1; float v2 = -3.0e38f;
#pragma unroll
            for (int e = 0; e < NE; ++e) if (e != e1 && lg[e] > v2) { v2 = lg[e]; e2 = e; }
            const float w1 = fast_rcp(1.0f + __expf(v2 - v1)), w2 = 1.0f - w1;
            if (lane == 0) { tope[row * 2] = e1; tope[row * 2 + 1] = e2; topw[row * 2] = w1; topw[row * 2 + 1] = w2; tokr[row] = r; sel[tl * 2] = e1; sel[tl * 2 + 1] = e2; }
        }
        WG_BAR();
        if (tid < NE) {
            int c = 0;
            for (int k = 0; k < 128; ++k) if (sel[k] == tid) { topr[(tb * 64) * 2 + k] = c; ++c; }
            cnt[tb * NE + tid] = c;
        }
        WG_BAR();
    }
}
__device__ __forceinline__ void route_b(const unsigned char* xn8, const int* tope, const float* topw, const int* topr, const float* tokr, const int* cnt, unsigned char* xg, int* rowinfo, float* rowgate, float* rowr,
                                        LAS unsigned char* lds, LAS int* ldsctl, int vcu, int G) {
    PHASE_IDS();
    LAS int* ct = (LAS int*)lds;
    LAS int* tot = (LAS int*)(lds + 8192);
    for (int k = tid; k < 256 * NE; k += NTHREADS) ct[k] = cnt[k];
    WG_BAR();
    if (tid < NE) { int run = 0; for (int tb = 0; tb < 256; ++tb) { const int c = ct[tb * NE + tid]; ct[tb * NE + tid] = run; run += c; } tot[tid] = run; }
    WG_BAR();
    if (tid == 0) {
        int ts = 0;
        for (int e = 0; e < NE; ++e) { ldsctl[16 + e] = ts; tot[8 + e] = ts * 256; ts += (tot[e] + 255) >> 8; }
        ldsctl[24] = ts; ldsctl[25] = ts;
    }
    WG_BAR();
    for (int tb = vcu; tb < M / 64; tb += G) {
        int mypos = 0;
        {
            const int idx = wave * 16 + (lane & 15), tl = idx >> 1, slot = idx & 1, row = tb * 64 + tl;
            const int e = tope[row * 2 + slot];
            mypos = tot[8 + e] + ct[tb * NE + e] + topr[row * 2 + slot];
            if (lane < 16) { rowinfo[mypos] = slot * M + row; rowgate[mypos] = topw[row * 2 + slot]; rowr[mypos] = tokr[row]; }
        }
        v4u rowsv[8];
#pragma unroll
        for (int k = 0; k < 8; ++k) rowsv[k] = *((const v4u*)(xn8 + (size_t)(tb * 64 + wave * 8 + k) * D) + lane);
#pragma unroll
        for (int k = 0; k < 16; ++k) { const int pos = __builtin_amdgcn_readlane(mypos, k); *((v4u*)(xg + (size_t)pos * D) + lane) = rowsv[k >> 1]; }
    }
    for (int e = vcu; e < NE; e += G) {
        const int beg = tot[8 + e] + tot[e], end = tot[8 + e] + (((tot[e] + 255) >> 8) << 8);
        for (int pos = beg + wave; pos < end; pos += NWAVES) {
            *((v4u*)(xg + (size_t)pos * D) + lane) = (v4u){0u, 0u, 0u, 0u};
            if (lane == 0) { rowinfo[pos] = -1; rowgate[pos] = 0.f; rowr[pos] = 0.f; }
        }
    }
}
__device__ __forceinline__ void final_phase(const bf16* xb, const bf16* y, const float* fn, float* out, int vcu, int G) {
    PHASE_IDS();
    const int gw = vcu * NWAVES + wave, NGW = G * NWAVES;
    f32x4 gn[4];
#pragma unroll
    for (int j = 0; j < 4; ++j) gn[j] = ((const f32x4*)fn)[lane + 64 * j];
    for (int m0 = gw; m0 < M; m0 += 2 * NGW) {
        f32x4 v[2][4]; float ss[2]; bool ok[2];
#pragma unroll
        for (int k = 0; k < 2; ++k) {
            const int m = m0 + k * NGW; ok[k] = m < M; ss[k] = 0.f;
            if (ok[k]) {
                const u32x2* xr = (const u32x2*)(xb + (size_t)m * D) + lane;
                const u32x2* y0 = (const u32x2*)(y + (size_t)m * D) + lane;
                const u32x2* y1 = (const u32x2*)(y + (size_t)(M + m) * D) + lane;
#pragma unroll
                for (int j = 0; j < 4; ++j) {
                    const u32x2 a = y0[64 * j], b2 = y1[64 * j], x0 = xr[64 * j];
                    v[k][j] = (f32x4){bflo(x0.x) + (bflo(a.x) + bflo(b2.x)), bfhi(x0.x) + (bfhi(a.x) + bfhi(b2.x)), bflo(x0.y) + (bflo(a.y) + bflo(b2.y)), bfhi(x0.y) + (bfhi(a.y) + bfhi(b2.y))};
                    ss[k] += (v[k][j][0] * v[k][j][0] + v[k][j][1] * v[k][j][1]) + (v[k][j][2] * v[k][j][2] + v[k][j][3] * v[k][j][3]);
                }
            }
        }
#pragma unroll
        for (int k = 0; k < 2; ++k) ss[k] = wave_sum(ss[k]);
#pragma unroll
        for (int k = 0; k < 2; ++k) if (ok[k]) {
            const float r = __builtin_amdgcn_rsqf(ss[k] * (1.0f / 1024.0f) + EPS);
            f32x4* orow = (f32x4*)(out + (size_t)(m0 + k * NGW) * D) + lane;
#pragma unroll
            for (int j = 0; j < 4; ++j) orow[64 * j] = v[k][j] * r * gn[j];
        }
    }
}
struct Args { Ptrs p; };
static_assert(sizeof(Args) == 22 * 8, "Args has no padding");

__global__ void __launch_bounds__(NTHREADS, 2) yoco_fwd(Args args) {
    extern __shared__ __attribute__((aligned(16))) unsigned char lds_raw[];
    LAS unsigned char* lds = (LAS unsigned char*)lds_raw;
    const Ptrs& P = args.p;
    unsigned char* ws = P.ws;

    const int G = gridDim.x; const int bx = blockIdx.x;
    const int vcu = (G % 8 == 0) ? (bx % 8) * (G / 8) + bx / 8 : bx;
    LAS int* ldsctl = (LAS int*)(lds + LDSCTL_OFF);
    for (int k = threadIdx.x; k < (LDS_BYTES - LDSCTL_OFF) / 4; k += NTHREADS) ldsctl[k] = 0;
    __syncthreads();
    XcdBarrier bar = xcd_barrier_post((unsigned*)(ws + WS_CTL) + CW_BAR, (volatile LAS unsigned*)ldsctl);

    bf16* XB = (bf16*)(ws + WS_XB); float* SSP = (float*)(ws + WS_SSP);
    bf16* PROJ = (bf16*)(ws + WS_PROJ); bf16* KVQ = (bf16*)(ws + WS_KVQ);

    const float lambda_init = 0.8f - 0.6f * 0.7408182206817179f;

    p0_prologue(P, lds, vcu, G, lambda_init);
    xcd_barrier(bar);

    {
        pg8::Gemm g{XB, (const bf16*)(ws + WS_W_IN), M, RIN, D}; pg8::StaticOrder S; S.init(M, RIN, G, bx);
        pg8::EpiInProj E{PROJ, SSP, (const float*)(ws + WS_RCOS), (const float*)(ws + WS_RSIN)};
        pg8::gemm_phase<pg8::EpiInProj, pg8::StaticOrder, true, true>(lds, g, S, E);
    }
    xcd_barrier(bar);
    ret::scores_phase(PROJ, (bf16*)(ws + WS_S), lds, vcu, G);
    xcd_barrier(bar);
    ret::scan_phase(P, PROJ, (const bf16*)(ws + WS_S), (bf16*)(ws + WS_ORET), lds, vcu, G);
    xcd_barrier(bar);
    ret::norm_gate_phase((const bf16*)(ws + WS_ORET), PROJ, (bf16*)(ws + WS_RO), vcu, G);
    xcd_barrier(bar);
    {
        pg8::Gemm g{(const bf16*)(ws + WS_RO), (const bf16*)(ws + WS_W_RO), M, D, RVD}; pg8::StaticOrder S; S.init(M, D, G, bx);
        pg8::EpiResid<true> E{P.x, XB, SSP};
        pg8::gemm_phase<pg8::EpiResid<true>, pg8::StaticOrder, true, true>(lds, g, S, E);
    }
    xcd_barrier(bar);
    {
        pg8::Gemm g{XB, (const bf16*)(ws + WS_W_GU), M, 2 * FF, D}; pg8::StaticOrder S; S.init(M, 2 * FF, G, bx);
        pg8::EpiSwiGLU<false> E{ws + WS_H, FF * 2, SSP, 1.0f, 1.0f};
        pg8::gemm_phase<pg8::EpiSwiGLU<false>, pg8::StaticOrder, true, true>(lds, g, S, E);
    }
    xcd_barrier(bar);
    {
        pg8::Gemm g{(const bf16*)(ws + WS_H), (const bf16*)(ws + WS_W_DN), M, D, FF}; pg8::StaticOrder S; S.init(M, D, G, bx);
        pg8::EpiResid<false> E{XB, XB, SSP};
        pg8::gemm_phase<pg8::EpiResid<false>, pg8::StaticOrder, true, true>(lds, g, S, E);
    }
    xcd_barrier(bar);
    {
        pg8::Gemm g{XB, (const bf16*)(ws + WS_W_KVQ), M, KVQ_N, D}; pg8::StaticOrder S; S.init(M, KVQ_N, G, bx);
        pg8::EpiKVQ E{KVQ, SSP, (const float*)(ws + WS_DCOS), (const float*)(ws + WS_DSIN), 0.125f * LOG2E};
        pg8::gemm_phase<pg8::EpiKVQ, pg8::StaticOrder, true, true>(lds, g, S, E);
    }
    xcd_barrier(bar);
    dat::attn_phase(KVQ, (bf16*)(ws + WS_AO), lds, P.lq1, P.lk1, P.lq2, P.lk2, lambda_init, vcu, G);
    xcd_barrier(bar);
    {
        pg8::Gemm g{(const bf16*)(ws + WS_AO), (const bf16*)(ws + WS_W_DO), M, D, D}; pg8::StaticOrder S; S.init(M, D, G, bx);
        pg8::EpiResid<false> E{XB, XB, SSP};
        pg8::gemm_phase<pg8::EpiResid<false>, pg8::StaticOrder, true, true>(lds, g, S, E);
    }
    xcd_barrier(bar);
    route_a(XB, (const float*)(ws + WS_RWT), (int*)(ws + WS_TOPE), (float*)(ws + WS_TOPW), (int*)(ws + WS_TOPR), (float*)(ws + WS_TOKR), (int*)(ws + WS_CNT), ws + WS_XN8, lds, vcu, G);
    xcd_barrier(bar);
    route_b(ws + WS_XN8, (const int*)(ws + WS_TOPE), (const float*)(ws + WS_TOPW), (const int*)(ws + WS_TOPR), (const float*)(ws + WS_TOKR), (const int*)(ws + WS_CNT), ws + WS_XG,
            (int*)(ws + WS_ROWINFO), (float*)(ws + WS_ROWGATE), (float*)(ws + WS_ROWR), lds, ldsctl, vcu, G);
    xcd_barrier(bar);
    {
        pg8::MoeOrder S; S.nM = __builtin_amdgcn_readfirstlane(((volatile LAS int*)ldsctl)[24]); S.nN = 2 * EF / 256; S.nwg = S.nM * S.nN; S.G = G; S.c = bx;
#pragma unroll
        for (int k = 0; k < 9; ++k) S.ts[k] = __builtin_amdgcn_readfirstlane(((volatile LAS int*)ldsctl)[16 + k]);
        pg8::Gemm g{(const bf16*)(ws + WS_XG), (const bf16*)(ws + WS_W_MGU), XG_ROWS, 2 * EF, D / 2};
        pg8::EpiSwiGLU<true> E{ws + WS_HM, EF, nullptr, 1.0f / MOE_WGU_SCALE, MOE_H_SCALE};
        pg8::gemm_phase<pg8::EpiSwiGLU<true>, pg8::MoeOrder, true, true, true>(lds, g, S, E);
    }
    xcd_barrier(bar);
    {
        pg8::MoeOrder S; S.nM = __builtin_amdgcn_readfirstlane(((volatile LAS int*)ldsctl)[24]); S.nN = D / 256; S.nwg = S.nM * S.nN; S.G = G; S.c = bx;
#pragma unroll
        for (int k = 0; k < 9; ++k) S.ts[k] = __builtin_amdgcn_readfirstlane(((volatile LAS int*)ldsctl)[16 + k]);
        pg8::Gemm g{(const bf16*)(ws + WS_HM), (const bf16*)(ws + WS_W_MDN), XG_ROWS, D, EF / 2};
        pg8::EpiMoeDown E{(bf16*)(ws + WS_Y), (const int*)(ws + WS_ROWINFO), (const float*)(ws + WS_ROWGATE), 1.0f / (MOE_WDN_SCALE * MOE_H_SCALE)};
        pg8::gemm_phase<pg8::EpiMoeDown, pg8::MoeOrder, true, true, true>(lds, g, S, E);
    }
    xcd_barrier(bar);
    final_phase(XB, (const bf16*)(ws + WS_Y), P.final_norm, P.out, vcu, G);
}

extern "C" void kernel_launch(void* const* d_in, const int* in_sizes, int n_in, void* d_out, int out_size, void* d_ws, size_t ws_size, hipStream_t stream) {
    static int grid = 0;
    if (grid == 0) {
        if (n_in != 20 || in_sizes[0] != M * D || out_size != M * D || ws_size < WS_END) { fprintf(stderr, "kernel_launch: unexpected shapes (n_in %d, in0 %d, out %d, ws %zu)\n", n_in, n_in > 0 ? in_sizes[0] : -1, out_size, ws_size); grid = -1; return; }
        int dev = 0, cus = 0, per_cu = 0;
        if (hipGetDevice(&dev) != hipSuccess || hipDeviceGetAttribute(&cus, hipDeviceAttributeMultiprocessorCount, dev) != hipSuccess) { grid = -1; return; }
        if (hipFuncSetAttribute((const void*)yoco_fwd, hipFuncAttributeMaxDynamicSharedMemorySize, LDS_BYTES) != hipSuccess) { fprintf(stderr, "kernel_launch: hipFuncSetAttribute failed\n"); grid = -1; return; }
        if (hipOccupancyMaxActiveBlocksPerMultiprocessor(&per_cu, (const void*)yoco_fwd, NTHREADS, LDS_BYTES) != hipSuccess || per_cu < 1) { fprintf(stderr, "kernel_launch: occupancy query reports %d\n", per_cu); }
        (void)hipGetLastError();
        grid = cus;
    }
    if (grid < 0) return;
    (void)hipMemsetAsync((char*)d_ws + WS_CTL, 0, CTL_ZERO_BYTES, stream);
    Args a{};
    const float** pp = (const float**)&a.p;
    for (int i = 0; i < 20; ++i) pp[i] = (const float*)d_in[i];
    a.p.out = (float*)d_out; a.p.ws = (unsigned char*)d_ws;
    hipLaunchKernelGGL(yoco_fwd, dim3(grid), dim3(NTHREADS), LDS_BYTES, stream, a);
}
```

```cpp
#include <hip/hip_runtime.h>
#include <hip/hip_bf16.h>
#include <cstdio>
#include <cstdint>
#include <cmath>
namespace pg8 {
#define PG8_LAS __attribute__((address_space(3)))
typedef unsigned short bf16_t;
typedef short bf16x8 __attribute__((ext_vector_type(8)));
typedef float f32x4 __attribute__((ext_vector_type(4)));
typedef unsigned u32x4 __attribute__((ext_vector_type(4)));
constexpr int BM = 256, BK = 64, HALF = 128, HTB = HALF * BK * 2  , STAGE_BYTES = 8 * HTB, NXCD = 8, WGM = 8;

__host__ __device__ __forceinline__ int lds_byte(int r, int c) { const int st = (r >> 4) * 2 + (c >> 5), rr = r & 15, cc = c & 31, ob = rr * 64 + cc * 2; return st * 1024 + (ob ^ (((ob >> 9) & 1) << 5)); }
__host__ __device__ __forceinline__ void stage_rc(int b, int& R, int& C) { const int st = b / 1024, sb = b % 1024, swz = sb ^ (((sb >> 9) & 1) << 5); R = (st >> 1) * 16 + swz / 64; C = (st & 1) * 32 + (swz % 64) / 2; }
__host__ __device__ __forceinline__ int perm32(int rho) { const int n = rho >> 4, i = rho & 15; return 8 * (i >> 2) + 4 * n + (i & 3); }

struct Unit { int pm, pn, aux; };
struct Gemm { const bf16_t* A; const bf16_t* Bt; int M, N, K; };

struct StaticOrder {
    int nM, nN, nwg, G, c;
    __host__ __device__ void init(int M, int N, int G_, int c_) { nM = M / BM; nN = N / BM; nwg = nM * nN; G = G_; c = c_; }
    __host__ __device__ bool next(int i, Unit& u) const {
        const long L = (long)i * G + c; if (L >= nwg) return false;
        int wgid = (int)L; { const int q = nwg / NXCD, r = nwg % NXCD, xcd = wgid % NXCD, off = wgid / NXCD; wgid = (xcd < r ? xcd * (q + 1) : r * (q + 1) + (xcd - r) * q) + off; }
        const int nig = WGM * nN, gid = wgid / nig, fm = gid * WGM, gsz = (nM - fm) < WGM ? (nM - fm) : WGM;
        u.pm = fm + ((wgid % nig) % gsz); u.pn = (wgid % nig) / gsz; u.aux = u.pn; return true;
    }
    __device__ __forceinline__ void a_ready(const Unit&) const {}
    __device__ __forceinline__ void done(const Unit&) const {}
};

__device__ __forceinline__ unsigned cvt_pk_bf16(float lo, float hi) { unsigned r; asm volatile("v_cvt_pk_bf16_f32 %0, %1, %2" : "=v"(r) : "v"(lo), "v"(hi)); return r; }
typedef float f32x2 __attribute__((ext_vector_type(2)));
typedef int i32x4 __attribute__((ext_vector_type(4)));
typedef int i32x8 __attribute__((ext_vector_type(8)));
__device__ __forceinline__ i32x8 cat8i(bf16x8 a, bf16x8 b) { const i32x4 x = __builtin_bit_cast(i32x4, a), y = __builtin_bit_cast(i32x4, b); return __builtin_shufflevector(x, y, 0, 1, 2, 3, 4, 5, 6, 7); }
template <class Epi, class Sched, bool ALIGN_EPI = false, bool SP2 = false, bool FP8 = false>
__device__ __forceinline__ void gemm_phase(PG8_LAS unsigned char* lds, const Gemm g, const Sched& S, const Epi& E) {
    int tid = threadIdx.x; asm volatile("" : "+v"(tid)); const int wid = __builtin_amdgcn_readfirstlane(tid >> 6), lane = tid & 63, wr = wid >> 2, wc = wid & 3, fr = lane & 15, fq = lane >> 4;
    const int K = g.K, nt = K / BK;
    unsigned voffA[2], voffB[2];
#pragma unroll
    for (int i = 0; i < 2; ++i) { int R, C; stage_rc(tid * 16 + i * 8192, R, C); const int Rb = Epi::PERM ? ((R & ~31) + perm32(R & 31)) : R;
        voffA[i] = (unsigned)(R * K + C) * 2u; voffB[i] = (unsigned)(Rb * K + C) * 2u; }
    const size_t kstep = (size_t)(BK * 2);
    const size_t hstep = (size_t)HALF * K * 2;
    const size_t tstep = 2 * hstep;
    const unsigned ldsw = (unsigned)wid * 1024u;
    const int aoff = lds_byte(wr * 64 + fr, fq * 8), boff = lds_byte(wc * 32 + fr, fq * 8);
#define PG8_SA(b, h) (((b) * 2 + (h)) * HTB)
#define PG8_SB(b, h) ((4 + (b) * 2 + (h)) * HTB)
#define PG8_STAGE(bufoff, gbase, voff) do { _Pragma("unroll") for (int _i = 0; _i < 2; ++_i) \
        __builtin_amdgcn_global_load_lds((const unsigned*)((const char*)(gbase) + (voff)[_i]), (PG8_LAS unsigned*)(lds + (bufoff) + ldsw + _i * 8192), 16, 0, 0); } while (0)
#define PG8_LDA(dst, b, h) do { _Pragma("unroll") for (int m = 0; m < 4; ++m) _Pragma("unroll") for (int k = 0; k < 2; ++k) dst[m][k] = *(const PG8_LAS bf16x8*)(lds + PG8_SA(b, h) + aoff + m * 2048 + k * 1024); } while (0)
#define PG8_LDB(dst, b, h) do { _Pragma("unroll") for (int n = 0; n < 2; ++n) _Pragma("unroll") for (int k = 0; k < 2; ++k) dst[n][k] = *(const PG8_LAS bf16x8*)(lds + PG8_SB(b, h) + boff + n * 2048 + k * 1024); } while (0)
#define PG8_MMA(ai, bj, At, Bt) do { __builtin_amdgcn_s_setprio(1); \
        if constexpr (FP8) { _Pragma("unroll") for (int m = 0; m < 4; ++m) _Pragma("unroll") for (int n = 0; n < 2; ++n) \
            asm volatile("v_mfma_scale_f32_16x16x128_f8f6f4 %0, %1, %2, %0, %3, %3 op_sel_hi:[0,0,0]" : "+v"(acc[ai][bj][m][n]) : "v"(cat8i(Bt[n][0], Bt[n][1])), "v"(cat8i(At[m][0], At[m][1])), "v"(fp8_unit_scale)); } \
        else { _Pragma("unroll") for (int m = 0; m < 4; ++m) _Pragma("unroll") for (int n = 0; n < 2; ++n) _Pragma("unroll") for (int k = 0; k < 2; ++k) \
            acc[ai][bj][m][n] = __builtin_amdgcn_mfma_f32_16x16x32_bf16(Bt[n][k], At[m][k], acc[ai][bj][m][n], 0, 0, 0); } \
        __builtin_amdgcn_s_setprio(0); } while (0)
#define PG8_WAIT_V(n) asm volatile("s_waitcnt vmcnt(" #n ")" ::: "memory")
#define PG8_WAIT_L(n) asm volatile("s_waitcnt lgkmcnt(" #n ")" ::: "memory")
#define PG8_BAR __builtin_amdgcn_s_barrier()
#define PG8_SCHED __builtin_amdgcn_sched_barrier(0)
    const int fp8_unit_scale = 0x7f7f7f7f; (void)fp8_unit_scale;
    Unit cur, nxt; int ui = 0;
    if (!S.next(0, cur)) return;
    f32x4 acc[2][2][4][2];
#pragma unroll
    for (int a = 0; a < 2; ++a)
#pragma unroll
        for (int b = 0; b < 2; ++b)
#pragma unroll
            for (int m = 0; m < 4; ++m)
#pragma unroll
                for (int n = 0; n < 2; ++n) acc[a][b][m][n] = (f32x4){0.f, 0.f, 0.f, 0.f};
    bf16x8 At[4][2], B0[2][2], B1[2][2];
    const char* cA = (const char*)g.A + (size_t)cur.pm * tstep; const char* cB = (const char*)g.Bt + (size_t)cur.pn * tstep;
    S.a_ready(cur);
    if constexpr (SP2) {
        PG8_STAGE(PG8_SB(0, 0), cB, voffB); PG8_STAGE(PG8_SB(0, 1), cB + hstep, voffB); PG8_STAGE(PG8_SA(0, 0), cA, voffA); PG8_STAGE(PG8_SA(0, 1), cA + hstep, voffA);
        if (wr == 1) PG8_BAR;
        PG8_WAIT_V(2); PG8_BAR;
        PG8_STAGE(PG8_SB(1, 0), cB + kstep, voffB); PG8_STAGE(PG8_SA(1, 0), cA + kstep, voffA); PG8_STAGE(PG8_SB(1, 1), cB + hstep + kstep, voffB);
        PG8_WAIT_V(6); PG8_BAR;
    } else {
        PG8_STAGE(PG8_SB(0, 0), cB, voffB); PG8_STAGE(PG8_SA(0, 0), cA, voffA); PG8_STAGE(PG8_SB(0, 1), cB + hstep, voffB); PG8_STAGE(PG8_SA(0, 1), cA + hstep, voffA);
        if (wr == 1) PG8_BAR;
        PG8_WAIT_V(4); PG8_BAR;
        PG8_STAGE(PG8_SB(1, 0), cB + kstep, voffB); PG8_STAGE(PG8_SA(1, 0), cA + kstep, voffA); PG8_STAGE(PG8_SB(1, 1), cB + hstep + kstep, voffB);
        PG8_WAIT_V(6); PG8_BAR;
    }
    for (;;) {
        const bool has_next = S.next(ui + 1, nxt);
        const char* nA = has_next ? (const char*)g.A + (size_t)nxt.pm * tstep : cA; const char* nB = has_next ? (const char*)g.Bt + (size_t)nxt.pn * tstep : cB;
        for (int t = 0; t < nt; t += 2) {
            const bool last = (t == nt - 2);
            const char* a1 = cA + (size_t)(t + 1) * kstep;
            const char* a2 = last ? nA : cA + (size_t)(t + 2) * kstep; const char* b2 = last ? nB : cB + (size_t)(t + 2) * kstep;
            const char* a3 = a2 + kstep; const char* b3 = b2 + kstep;
            if (last && has_next) S.a_ready(nxt);
            if constexpr (SP2) {
            PG8_LDB(B0, 0, 0); PG8_LDB(B1, 0, 1); PG8_SCHED; PG8_LDA(At, 0, 0); PG8_STAGE(PG8_SA(1, 1), a1 + hstep, voffA);
            PG8_WAIT_V(8); PG8_WAIT_L(0); PG8_BAR; PG8_MMA(0, 0, At, B0); PG8_MMA(0, 1, At, B1); PG8_BAR; PG8_SCHED;
            PG8_LDA(At, 0, 1); PG8_STAGE(PG8_SB(0, 0), b2, voffB); PG8_STAGE(PG8_SB(0, 1), b2 + hstep, voffB); PG8_STAGE(PG8_SA(0, 0), a2, voffA);
            PG8_WAIT_V(8); PG8_WAIT_L(0); PG8_BAR; PG8_MMA(1, 0, At, B0); PG8_MMA(1, 1, At, B1); PG8_BAR; PG8_SCHED;
            PG8_LDB(B0, 1, 0); PG8_LDB(B1, 1, 1); PG8_SCHED; PG8_LDA(At, 1, 0); PG8_STAGE(PG8_SA(0, 1), a2 + hstep, voffA);
            PG8_WAIT_V(8); PG8_WAIT_L(0); PG8_BAR; PG8_MMA(0, 0, At, B0); PG8_MMA(0, 1, At, B1); PG8_BAR; PG8_SCHED;
            PG8_LDA(At, 1, 1); PG8_STAGE(PG8_SB(1, 0), b3, voffB); PG8_STAGE(PG8_SB(1, 1), b3 + hstep, voffB); PG8_STAGE(PG8_SA(1, 0), a3, voffA);
            PG8_WAIT_V(8); PG8_WAIT_L(0); PG8_BAR; PG8_MMA(1, 0, At, B0); PG8_MMA(1, 1, At, B1); PG8_BAR; PG8_SCHED;
            } else {
            PG8_LDB(B0, 0, 0); PG8_SCHED; PG8_LDA(At, 0, 0); PG8_STAGE(PG8_SA(1, 1), a1 + hstep, voffA);
            PG8_WAIT_L(8); PG8_BAR; PG8_WAIT_L(0); PG8_MMA(0, 0, At, B0); PG8_BAR; PG8_SCHED;
            PG8_LDB(B1, 0, 1); PG8_STAGE(PG8_SB(0, 0), b2, voffB);
            PG8_BAR; PG8_WAIT_L(0); PG8_MMA(0, 1, At, B1); PG8_BAR;
            PG8_LDA(At, 0, 1); PG8_STAGE(PG8_SA(0, 0), a2, voffA);
            PG8_BAR; PG8_WAIT_L(0); PG8_MMA(1, 0, At, B0); PG8_BAR; PG8_SCHED;
            PG8_STAGE(PG8_SB(0, 1), b2 + hstep, voffB);
            PG8_WAIT_V(6); PG8_BAR; PG8_MMA(1, 1, At, B1); PG8_BAR;
            PG8_LDB(B0, 1, 0); PG8_SCHED; PG8_LDA(At, 1, 0); PG8_STAGE(PG8_SA(0, 1), a2 + hstep, voffA);
            PG8_WAIT_L(8); PG8_BAR; PG8_WAIT_L(0); PG8_MMA(0, 0, At, B0); PG8_BAR; PG8_SCHED;
            PG8_LDB(B1, 1, 1); PG8_STAGE(PG8_SB(1, 0), b3, voffB);
            PG8_BAR; PG8_WAIT_L(0); PG8_MMA(0, 1, At, B1); PG8_BAR;
            PG8_LDA(At, 1, 1); PG8_STAGE(PG8_SA(1, 0), a3, voffA);
            PG8_BAR; PG8_WAIT_L(0); PG8_MMA(1, 0, At, B0); PG8_BAR; PG8_SCHED;
            PG8_STAGE(PG8_SB(1, 1), b3 + hstep, voffB);
            PG8_WAIT_V(6); PG8_BAR; PG8_MMA(1, 1, At, B1); PG8_BAR;
            }
        }
        if constexpr (ALIGN_EPI) { if (wr == 0) PG8_BAR; }
        if constexpr (FP8) asm volatile("s_nop 15\n\ts_nop 15" ::: "memory");
        if constexpr (!Epi::AFTER_DRAIN) { E(acc, cur, wr, wc, fr, fq); S.done(cur); }
        if (!has_next) break;
#pragma unroll
        for (int a = 0; a < 2; ++a)
#pragma unroll
            for (int b = 0; b < 2; ++b)
#pragma unroll
                for (int m = 0; m < 4; ++m)
#pragma unroll
                    for (int n = 0; n < 2; ++n) acc[a][b][m][n] = (f32x4){0.f, 0.f, 0.f, 0.f};
        cur = nxt; cA = nA; cB = nB; ++ui;
        if constexpr (ALIGN_EPI) { if (wr == 1) PG8_BAR; }
    }
    PG8_WAIT_V(0);
    if constexpr (!ALIGN_EPI) { if (wr == 0) PG8_BAR; }
    PG8_BAR;
    if constexpr (Epi::AFTER_DRAIN) { E.fused(acc, cur, wr, wc, fr, fq, lds, wid, lane); S.done(cur); }
#undef PG8_SA
#undef PG8_SB
#undef PG8_STAGE
#undef PG8_LDA
#undef PG8_LDB
#undef PG8_MMA
#undef PG8_WAIT_V
#undef PG8_WAIT_L
#undef PG8_BAR
#undef PG8_SCHED
}
}
#define GAS __attribute__((address_space(1)))
#define LAS __attribute__((address_space(3)))
typedef unsigned short bf16;
typedef unsigned v4u __attribute__((ext_vector_type(4)));
typedef float f32x4 __attribute__((ext_vector_type(4)));
typedef short bf16x8 __attribute__((ext_vector_type(8)));
typedef GAS unsigned gu32;
typedef GAS unsigned long long gu64;
#define RLX_AGENT __ATOMIC_RELAXED, __HIP_MEMORY_SCOPE_AGENT
#define LDS_WAIT() asm volatile("s_waitcnt lgkmcnt(0)" ::: "memory")
#define VM_WAIT() asm volatile("s_waitcnt vmcnt(0)" ::: "memory")
__device__ __forceinline__ unsigned long long rt() { return __builtin_amdgcn_s_memrealtime(); }
__device__ __forceinline__ unsigned f2bf(float f) { unsigned u = __builtin_bit_cast(unsigned, f); return (u + 0x7fffu + ((u >> 16) & 1u)) >> 16; }
__device__ __forceinline__ unsigned pk2(float lo, float hi) { unsigned r; asm("v_cvt_pk_bf16_f32 %0, %1, %2" : "=v"(r) : "v"(lo), "v"(hi)); return r; }

#define XB_TMO      128
#define XB_XCNT(j)  (256  + 64 * (j))
#define XB_XSUB(j)  (1280 + 64 * (j))
#define XB_XGEN(j)  (2304 + 64 * (j))
#define XB_TOP      3328
#define XB_TOPGEN   3392
#define XCD_BAR_WORDS 3456
#define XB_SPIN_CAP (1u << 18)

__device__ __forceinline__ unsigned xb_ld(unsigned* p)              { return __hip_atomic_load(p, __ATOMIC_RELAXED, __HIP_MEMORY_SCOPE_AGENT); }
__device__ __forceinline__ unsigned xb_add(unsigned* p, unsigned v) { return __hip_atomic_fetch_add(p, v, __ATOMIC_RELAXED, __HIP_MEMORY_SCOPE_AGENT); }
__device__ __forceinline__ unsigned xb_xcc_id() { return (unsigned)__builtin_amdgcn_s_getreg((3 << 11) | 20) & 0xFu; }
#define XB_SPIN(cond, bar) do { unsigned _sp = 0; while (cond) { __builtin_amdgcn_s_sleep(1); \
    if ((++_sp & 255u) == 0u) { if (xb_ld(&(bar)[XB_TMO])) break; if (_sp > XB_SPIN_CAP) { atomicAdd(&(bar)[XB_TMO], 1u); break; } } } } while (0)

struct XcdBarrier {
    unsigned* bar; unsigned x;
    volatile LAS unsigned* st;
};

__device__ __forceinline__ XcdBarrier xcd_barrier_post(unsigned* bar, volatile LAS unsigned* st) {
    XcdBarrier b; b.bar = bar; b.x = xb_xcc_id(); b.st = st;
    if (threadIdx.x == 0) (void)xb_add(&bar[XB_XCNT(b.x)], 1u);
    return b;
}
__device__ __forceinline__ void xcd_barrier_complete(unsigned* bar, unsigned x, unsigned& nloc, unsigned& nx) {
    const unsigned G = gridDim.x * gridDim.y * gridDim.z;
    unsigned sum, cnt, mine, sp = 0u;
    for (;;) {
        sum = 0u; cnt = 0u; mine = 0u;
#pragma unroll
        for (unsigned j = 0; j < 16; ++j) { const unsigned c = xb_ld(&bar[XB_XCNT(j)]); sum += c; cnt += (c > 0u) ? 1u : 0u; mine = (j == x) ? c : mine; }
        if (sum == G) break;
        __builtin_amdgcn_s_sleep(1);
        if ((++sp & 255u) == 0u) { if (xb_ld(&bar[XB_TMO])) break; if (sp > XB_SPIN_CAP) { atomicAdd(&bar[XB_TMO], 1u); break; } }
    }
    nloc = mine > 0u ? mine : 1u; nx = cnt > 0u ? cnt : 1u;
}

__device__ __forceinline__ void xcd_barrier(const XcdBarrier& b) {
    asm volatile("s_waitcnt vmcnt(0)" ::: "memory");
    __syncthreads();
    if (threadIdx.x == 0) {
        unsigned* bar = b.bar;
        __builtin_amdgcn_s_waitcnt(0);
        unsigned nloc = b.st[0], nx = b.st[1];
        if (nloc == 0u) { xcd_barrier_complete(bar, b.x, nloc, nx); b.st[0] = nloc; b.st[1] = nx; }
        const unsigned old = xb_add(&bar[XB_XSUB(b.x)], 1u);
        const unsigned gen = old / nloc;
        if (old + 1u == (gen + 1u) * nloc) {
            __builtin_amdgcn_fence(__ATOMIC_RELEASE, "agent");
            asm volatile("s_waitcnt vmcnt(0)" ::: "memory");
            const unsigned og = xb_add(&bar[XB_TOP], 1u);
            const unsigned tg = og / nx;
            if (og + 1u == (tg + 1u) * nx) xb_add(&bar[XB_TOPGEN], 1u);
            else XB_SPIN(xb_ld(&bar[XB_TOPGEN]) == tg, bar);
            __builtin_amdgcn_fence(__ATOMIC_ACQUIRE, "agent");
            xb_add(&bar[XB_XGEN(b.x)], 1u);
            asm volatile("s_waitcnt vmcnt(0)" ::: "memory");
        } else {
            XB_SPIN(xb_ld(&bar[XB_XGEN(b.x)]) == gen, bar);
            __builtin_amdgcn_fence(__ATOMIC_ACQUIRE, "agent");
            asm volatile("s_waitcnt vmcnt(0)" ::: "memory");
        }
    }
    __syncthreads();
}

constexpr int BATCH = 4, SEQ = 4096, D = 1024, M = BATCH * SEQ;
constexpr int RIN = 6144, RVD = 2048;
constexpr int FF = 2816, EF = 3584, NE = 8;
constexpr int KVQ_N = 3072;
constexpr float EPS = 1e-6f;
constexpr float LOG2E = 1.4426950408889634f;

typedef short s16x4 __attribute__((ext_vector_type(4)));
typedef float f32x16 __attribute__((ext_vector_type(16)));
typedef unsigned u32x2 __attribute__((ext_vector_type(2)));

__device__ __forceinline__ float bf2f(unsigned short h) { return __uint_as_float(((unsigned)h) << 16); }
__device__ __forceinline__ float bflo(unsigned w) { return __uint_as_float(w << 16); }
__device__ __forceinline__ float bfhi(unsigned w) { return __uint_as_float(w & 0xffff0000u); }
__device__ __forceinline__ float fast_exp2(float x) { return __builtin_amdgcn_exp2f(x); }
__device__ __forceinline__ float fast_rcp(float x) { return __builtin_amdgcn_rcpf(x); }
__device__ __forceinline__ float silu_f(float x) { return x * fast_rcp(1.0f + fast_exp2(-x * LOG2E)); }
#define SWZ_XOR(v, m) __int_as_float(__builtin_amdgcn_ds_swizzle(__float_as_int(v), ((m) << 10) | 0x1f))
__device__ __forceinline__ float xor32_sum(float v) { auto rr = __builtin_amdgcn_permlane32_swap(__float_as_uint(v), __float_as_uint(v), false, false); return __uint_as_float(rr[0]) + __uint_as_float(rr[1]); }
__device__ __forceinline__ float wave_sum(float v) {
    v += SWZ_XOR(v, 1); v += SWZ_XOR(v, 2); v += SWZ_XOR(v, 4); v += SWZ_XOR(v, 8); v += SWZ_XOR(v, 16);
    return xor32_sum(v);
}

namespace pg8 {
__device__ __forceinline__ float rinv_from_ssp(const float* ssp, int row) {
    const f32x4* p = (const f32x4*)(ssp + (size_t)row * 16);
    const f32x4 a = p[0], b = p[1], c = p[2], d = p[3];
    const float s = (((a[0] + a[1]) + (a[2] + a[3])) + ((b[0] + b[1]) + (b[2] + b[3]))) + (((c[0] + c[1]) + (c[2] + c[3])) + ((d[0] + d[1]) + (d[2] + d[3])));
    return __builtin_amdgcn_rsqf(s * (1.0f / 1024.0f) + EPS);
}
__device__ __forceinline__ void rinv8_from_ssp(const float* ssp, int row0, int fq, float (&r)[8]) {
    f32x4 a[8];
#pragma unroll
    for (int x = 0; x < 8; ++x) a[x] = ((const f32x4*)(ssp + (size_t)(row0 + (x >> 2) * HALF + (x & 3) * 16) * 16))[fq];
#pragma unroll
    for (int x = 0; x < 8; ++x) {
        float s = (a[x][0] + a[x][1]) + (a[x][2] + a[x][3]);
        s += SWZ_XOR(s, 16); s = xor32_sum(s);
        r[x] = __builtin_amdgcn_rsqf(s * (1.0f / 1024.0f) + EPS);
    }
}
__device__ __forceinline__ u32x4 pack8(const f32x4 a, const f32x4 b) {
    u32x4 w; w.x = cvt_pk_bf16(a[0], a[1]); w.y = cvt_pk_bf16(a[2], a[3]); w.z = cvt_pk_bf16(b[0], b[1]); w.w = cvt_pk_bf16(b[2], b[3]); return w;
}
struct EpiInProj {
    static constexpr bool PERM = true, AFTER_DRAIN = false;
    bf16_t* O; const float* ssp; const float* rcos; const float* rsin;
    __device__ __forceinline__ void operator()(const f32x4 (&acc)[2][2][4][2], const Unit& u, int wr, int wc, int fr, int fq) const {
        const int row0 = u.pm * BM + wr * 64 + fr;
        const int cl = wc * 32 + 8 * fq;
        const bool rope = u.pn < 8;
        const float ksc = (u.pn >= 4 && u.pn < 8) ? 0.0625f : 1.0f;
        float rv[8]; rinv8_from_ssp(ssp, row0, fq, rv);
#pragma unroll
        for (int ai = 0; ai < 2; ++ai)
#pragma unroll
            for (int m = 0; m < 4; ++m) {
                const int row = row0 + ai * HALF + m * 16;
                const float r = rv[ai * 4 + m] * ksc;
                bf16_t* rowp = O + (size_t)row * RIN + u.pn * BM + cl;
                f32x4 a0 = acc[ai][0][m][0] * r, a1 = acc[ai][0][m][1] * r, b0 = acc[ai][1][m][0] * r, b1 = acc[ai][1][m][1] * r;
                if (rope) {
                    const int pos = row & (SEQ - 1);
                    const f32x4 c0 = *(const f32x4*)(rcos + pos * 128 + cl), c1 = *(const f32x4*)(rcos + pos * 128 + cl + 4);
                    const f32x4 s0 = *(const f32x4*)(rsin + pos * 128 + cl), s1 = *(const f32x4*)(rsin + pos * 128 + cl + 4);
                    const f32x4 x0 = a0 * c0 - b0 * s0, x1 = a1 * c1 - b1 * s1, y0 = b0 * c0 + a0 * s0, y1 = b1 * c1 + a1 * s1;
                    a0 = x0; a1 = x1; b0 = y0; b1 = y1;
                }
                *(u32x4*)(rowp) = pack8(a0, a1);
                *(u32x4*)(rowp + HALF) = pack8(b0, b1);
                if (m & 1) asm volatile("" ::: "memory");
            }
    }
};
template <bool FP8OUT> struct EpiSwiGLU {
    static constexpr bool PERM = true, AFTER_DRAIN = false;
    unsigned char* O; int ldb  ; const float* ssp; float cscale, oscale;
    __device__ __forceinline__ void operator()(const f32x4 (&acc)[2][2][4][2], const Unit& u, int wr, int wc, int fr, int fq) const {
        const int row0 = u.pm * BM + wr * 64 + fr;
        const int col = u.aux * HALF + wc * 32 + 8 * fq;
        float rv[8];
        if (ssp) rinv8_from_ssp(ssp, row0, fq, rv); else {
#pragma unroll
            for (int x = 0; x < 8; ++x) rv[x] = 1.0f; }
#pragma unroll
        for (int ai = 0; ai < 2; ++ai)
#pragma unroll
            for (int m = 0; m < 4; ++m) {
                const int row = row0 + ai * HALF + m * 16;
                const float r = rv[ai * 4 + m] * cscale;
                const float k1 = -r * LOG2E, qv = fast_rcp(r * r * oscale), c0 = __builtin_amdgcn_logf(qv);
                f32x4 h0, h1;
#pragma unroll
                for (int j = 0; j < 4; ++j) {
                    h0[j] = (acc[ai][0][m][0][j] * acc[ai][1][m][0][j]) * fast_rcp(qv + fast_exp2(__builtin_fmaf(acc[ai][0][m][0][j], k1, c0)));
                    h1[j] = (acc[ai][0][m][1][j] * acc[ai][1][m][1][j]) * fast_rcp(qv + fast_exp2(__builtin_fmaf(acc[ai][0][m][1][j], k1, c0)));
                }
                if constexpr (FP8OUT) {
                    unsigned w0, w1; asm volatile("" : "=v"(w0), "=v"(w1));
                    w0 = __builtin_amdgcn_cvt_pk_fp8_f32(h0[0], h0[1], w0, false); w0 = __builtin_amdgcn_cvt_pk_fp8_f32(h0[2], h0[3], w0, true);
                    w1 = __builtin_amdgcn_cvt_pk_fp8_f32(h1[0], h1[1], w1, false); w1 = __builtin_amdgcn_cvt_pk_fp8_f32(h1[2], h1[3], w1, true);
                    *(u32x2*)(O + (size_t)row * ldb + col) = (u32x2){w0, w1};
                } else {
                    *(u32x4*)(O + (size_t)row * ldb + col * 2) = pack8(h0, h1);
                }
                if (m & 1) asm volatile("" ::: "memory");
            }
    }
};
template <bool BASE_F32>
struct EpiResid {
    static constexpr bool PERM = true, AFTER_DRAIN = false;
    const void* base; bf16_t* xb; float* ssp;
    template <int AI0, int NAI>
    __device__ __forceinline__ void part(const f32x4 (&acc)[2][2][4][2], const Unit& u, int row0, int col0, int wc, int fq) const {
        f32x4 bv[NAI * 4][2][2];
#pragma unroll
        for (int x = 0; x < NAI * 4; ++x) {
            const int row = row0 + (AI0 + (x >> 2)) * HALF + (x & 3) * 16;
#pragma unroll
            for (int bj = 0; bj < 2; ++bj) {
                const size_t c = (size_t)row * D + col0 + bj * HALF;
                if constexpr (BASE_F32) { bv[x][bj][0] = *(const f32x4*)((const float*)base + c); bv[x][bj][1] = *(const f32x4*)((const float*)base + c + 4); }
                else { const u32x4 b = *(const u32x4*)((const bf16_t*)base + c); bv[x][bj][0] = __builtin_bit_cast(f32x4, b); }
            }
        }
#pragma unroll
        for (int x = 0; x < NAI * 4; ++x) {
            const int ai = AI0 + (x >> 2), m = x & 3;
            const int row = row0 + ai * HALF + m * 16;
            float ss = 0.f;
#pragma unroll
            for (int bj = 0; bj < 2; ++bj) {
                const size_t c = (size_t)row * D + col0 + bj * HALF;
                f32x4 v0, v1;
                if constexpr (BASE_F32) { v0 = bv[x][bj][0]; v1 = bv[x][bj][1]; }
                else { const u32x4 b = __builtin_bit_cast(u32x4, bv[x][bj][0]); v0 = (f32x4){bflo(b.x), bfhi(b.x), bflo(b.y), bfhi(b.y)}; v1 = (f32x4){bflo(b.z), bfhi(b.z), bflo(b.w), bfhi(b.w)}; }
                v0 += acc[ai][bj][m][0]; v1 += acc[ai][bj][m][1];
                *(u32x4*)(xb + c) = pack8(v0, v1);
                ss += ((v0[0] * v0[0] + v0[1] * v0[1]) + (v0[2] * v0[2] + v0[3] * v0[3])) + ((v1[0] * v1[0] + v1[1] * v1[1]) + (v1[2] * v1[2] + v1[3] * v1[3]));
            }
            ss += SWZ_XOR(ss, 16); ss = xor32_sum(ss);
            if (fq == 0) ssp[(size_t)row * 16 + u.pn * 4 + wc] = ss;
        }
    }
    __device__ __forceinline__ void operator()(const f32x4 (&acc)[2][2][4][2], const Unit& u, int wr, int wc, int fr, int fq) const {
        const int row0 = u.pm * BM + wr * 64 + fr;
        const int col0 = u.pn * BM + wc * 32 + 8 * fq;
        if constexpr (BASE_F32) { part<0, 1>(acc, u, row0, col0, wc, fq); asm volatile("" ::: "memory"); part<1, 1>(acc, u, row0, col0, wc, fq); }
        else part<0, 2>(acc, u, row0, col0, wc, fq);
    }
};
struct EpiKVQ {
    static constexpr bool PERM = true, AFTER_DRAIN = false;
    bf16_t* O; const float* ssp; const float* dcos; const float* dsin; float qscale;
    __device__ __forceinline__ void operator()(const f32x4 (&acc)[2][2][4][2], const Unit& u, int wr, int wc, int fr, int fq) const {
        const int row0 = u.pm * BM + wr * 64 + fr;
        const int cl = wc * 32 + 8 * fq;
        const int kind = u.pn >> 2;
        const bool ropelane = ((wc & 1) == 0) && (fq < 2);
        float rv[8]; rinv8_from_ssp(ssp, row0, fq, rv);
#pragma unroll
        for (int ai = 0; ai < 2; ++ai)
#pragma unroll
            for (int m = 0; m < 4; ++m) {
                const int row = row0 + ai * HALF + m * 16;
                const float r = rv[ai * 4 + m] * (kind == 2 ? qscale : 1.0f);
                bf16_t* rowp = O + (size_t)row * KVQ_N + u.pn * BM + cl;
                f32x4 c0, c1, s0, s1;
                if (kind != 1) {
                    const int pos = row & (SEQ - 1);
                    c0 = *(const f32x4*)(dcos + pos * 8); c1 = *(const f32x4*)(dcos + pos * 8 + 4);
                    s0 = *(const f32x4*)(dsin + pos * 8); s1 = *(const f32x4*)(dsin + pos * 8 + 4);
                    if (fq != 0) { s0 = -s0; s1 = -s1; }
                }
#pragma unroll
                for (int bj = 0; bj < 2; ++bj) {
                    f32x4 v0 = acc[ai][bj][m][0] * r, v1 = acc[ai][bj][m][1] * r;
                    if (kind != 1) {
                        f32x4 p0, p1;
#pragma unroll
                        for (int j = 0; j < 4; ++j) { p0[j] = SWZ_XOR(v0[j], 16); p1[j] = SWZ_XOR(v1[j], 16); }
                        if (ropelane) { v0 = v0 * c0 - p0 * s0; v1 = v1 * c1 - p1 * s1; }
                    }
                    *(u32x4*)(rowp + bj * HALF) = pack8(v0, v1);
                }
                if (m & 1) asm volatile("" ::: "memory");
            }
    }
};
struct EpiMoeDown {
    static constexpr bool PERM = true, AFTER_DRAIN = false;
    bf16_t* Y; const int* rowinfo; const float* rowgate; float cscale;
    __device__ __forceinline__ void operator()(const f32x4 (&acc)[2][2][4][2], const Unit& u, int wr, int wc, int fr, int fq) const {
        const int row0 = u.pm * BM + wr * 64 + fr;
        const int cl = u.aux * BM + wc * 32 + 8 * fq;
        int inf[8]; float gt[8];
#pragma unroll
        for (int x = 0; x < 8; ++x) { const int row = row0 + (x >> 2) * HALF + (x & 3) * 16; inf[x] = rowinfo[row]; gt[x] = rowgate[row]; }
#pragma unroll
        for (int ai = 0; ai < 2; ++ai)
#pragma unroll
            for (int m = 0; m < 4; ++m) {
                const int info = inf[ai * 4 + m];
                if (info >= 0) {
                    const float g = gt[ai * 4 + m] * cscale;
                    bf16_t* rowp = Y + (size_t)info * D + cl;
                    *(u32x4*)(rowp) = pack8(acc[ai][0][m][0] * g, acc[ai][0][m][1] * g);
                    *(u32x4*)(rowp + HALF) = pack8(acc[ai][1][m][0] * g, acc[ai][1][m][1] * g);
                }
            }
    }
};
struct MoeOrder {
    int nM, nN, nwg, G, c; int ts[9];
    __device__ __forceinline__ bool next(int i, Unit& u) const {
        const long L = (long)i * G + c; if (L >= nwg) return false;
        int wgid = (int)L; { const int q = nwg / NXCD, r = nwg % NXCD, xcd = wgid % NXCD, off = wgid / NXCD; wgid = (xcd < r ? xcd * (q + 1) : r * (q + 1) + (xcd - r) * q) + off; }
        const int nig = WGM * nN, gid = wgid / nig, fm = gid * WGM, gsz = (nM - fm) < WGM ? (nM - fm) : WGM;
        const int pm = fm + ((wgid % nig) % gsz), pnl = (wgid % nig) / gsz;
        int e = 0;
#pragma unroll
        for (int k = 1; k < 8; ++k) e += (pm >= ts[k]) ? 1 : 0;
        u.pm = pm; u.pn = e * nN + pnl; u.aux = pnl; return true;
    }
    __device__ __forceinline__ void a_ready(const Unit&) const {}
    __device__ __forceinline__ void done(const Unit&) const {}
};
}
constexpr size_t MiB = 1u << 20;
constexpr size_t WS_CTL = 0, CTL_ZERO_BYTES = 1 * MiB;
constexpr size_t WS_RCOS = 1 * MiB, WS_RSIN = 3 * MiB;
constexpr size_t WS_DCOS = 5 * MiB, WS_DSIN = 5 * MiB + 256 * 1024;
constexpr size_t WS_SSP = 6 * MiB;
constexpr size_t WS_RWT = 7 * MiB;
constexpr size_t WS_TOPE = 8 * MiB;
constexpr size_t WS_TOPW = 8 * MiB + 128 * 1024;
constexpr size_t WS_TOPR = 8 * MiB + 256 * 1024;
constexpr size_t WS_TOKR = 8 * MiB + 384 * 1024;
constexpr size_t WS_CNT = 8 * MiB + 512 * 1024;
constexpr int XG_ROWS = 2 * M + NE * 256;
constexpr size_t WS_ROWINFO = 9 * MiB;
constexpr size_t WS_ROWGATE = 9 * MiB + 256 * 1024;
constexpr size_t WS_ROWR = 9 * MiB + 512 * 1024;
constexpr size_t WS_S = 10 * MiB;
constexpr size_t WS_W_IN = 20 * MiB, WS_W_RO = 32 * MiB, WS_W_GU = 36 * MiB, WS_W_DN = 47 * MiB, WS_W_KVQ = 53 * MiB, WS_W_DO = 59 * MiB, WS_W_MGU = 61 * MiB, WS_W_MDN = 173 * MiB;
constexpr size_t WS_XM = 232 * MiB;
constexpr size_t WS_XB = 296 * MiB;
constexpr size_t WS_PROJ = 328 * MiB;
constexpr size_t WS_RO = 520 * MiB;
constexpr size_t WS_ORET = 584 * MiB;
constexpr size_t WS_H = 328 * MiB;
constexpr size_t WS_KVQ = 584 * MiB;
constexpr size_t WS_AO = 680 * MiB;
constexpr size_t WS_Y = 712 * MiB;
constexpr size_t WS_HM = 328 * MiB;
constexpr size_t WS_XG = 584 * MiB;
constexpr size_t WS_XN8 = 776 * MiB;
constexpr size_t WS_END = 792 * MiB;
static_assert(WS_W_MDN + (size_t)NE * D * EF * 2 <= WS_XM && WS_HM + (size_t)XG_ROWS * EF * 2 <= WS_KVQ && WS_XG + (size_t)XG_ROWS * D * 2 <= WS_AO && WS_Y + (size_t)2 * M * D * 2 <= WS_END, "d_ws map");
constexpr float MOE_WGU_SCALE = 64.0f, MOE_WDN_SCALE = 128.0f, MOE_H_SCALE = 8.0f;
constexpr int CW_BAR = 4096;

constexpr int RING_BYTES = 131072;
constexpr int LDSCTL_OFF = RING_BYTES;
constexpr int LDS_BYTES = 147456;
constexpr int NWAVES = 8, NTHREADS = 512;

#define WG_BAR() do { asm volatile("s_waitcnt vmcnt(0) lgkmcnt(0)" ::: "memory"); __builtin_amdgcn_s_barrier(); asm volatile("" ::: "memory"); } while (0)

#define PHASE_IDS() int tid = threadIdx.x; asm volatile("" : "+v"(tid)); const int lane = tid & 63; const int wave = __builtin_amdgcn_readfirstlane(tid >> 6); (void)lane; (void)wave
struct TrBlk { const float* src; const float* gain; unsigned char* dst; int N, gmask, k0, ldb, fp8; float gscale; };
constexpr int TR_PITCH = 288;
__device__ __forceinline__ void tr_load(const TrBlk& B, f32x4 (&ld)[8], float (&gv)[8], int wave, int lane) {
#pragma unroll
    for (int j = 0; j < 8; ++j) {
        const int k = 16 * wave + 2 * j + (lane >> 5);
        ld[j] = *(const f32x4*)(B.src + (size_t)k * B.N + 4 * (lane & 31));
        gv[j] = B.gain ? B.gain[(B.k0 + k) & B.gmask] * B.gscale : B.gscale;
    }
}
__device__ __forceinline__ void tr_commit(const f32x4 (&ld)[8], const float (&gv)[8], LAS unsigned char* img, int wave, int lane) {
#pragma unroll
    for (int j = 0; j < 8; ++j) {
        const int k = 16 * wave + 2 * j + (lane >> 5);
        u32x2 w; w.x = pk2(ld[j][0] * gv[j], ld[j][1] * gv[j]); w.y = pk2(ld[j][2] * gv[j], ld[j][3] * gv[j]);
        *(LAS u32x2*)(img + k * TR_PITCH + 8 * (lane & 31)) = w;
    }
}
__device__ __forceinline__ void tr_emit(const TrBlk& B, LAS const unsigned char* img, int wave, int lane) {
    const int i = lane & 15, g = lane >> 4, q = i >> 2, p = i & 3;
#pragma unroll
    for (int kg = 0; kg < 4; ++kg) {
        const int kb = 8 * (4 * kg + g);
        const s16x4 lo = __builtin_bit_cast(s16x4, __builtin_amdgcn_ds_read_tr16_b64_v4i16((LAS s16x4*)(img + (kb + q) * TR_PITCH + (16 * wave + 4 * p) * 2)));
        const s16x4 hi = __builtin_bit_cast(s16x4, __builtin_amdgcn_ds_read_tr16_b64_v4i16((LAS s16x4*)(img + (kb + 4 + q) * TR_PITCH + (16 * wave + 4 * p) * 2)));
        if (!B.fp8) {
            v4u o; o.x = (unsigned)(unsigned short)lo[0] | ((unsigned)(unsigned short)lo[1] << 16); o.y = (unsigned)(unsigned short)lo[2] | ((unsigned)(unsigned short)lo[3] << 16);
            o.z = (unsigned)(unsigned short)hi[0] | ((unsigned)(unsigned short)hi[1] << 16); o.w = (unsigned)(unsigned short)hi[2] | ((unsigned)(unsigned short)hi[3] << 16);
            *(GAS v4u*)(B.dst + (size_t)(16 * wave + i) * B.ldb + kb * 2) = o;
        } else {
            unsigned w0 = 0u, w1 = 0u;
            w0 = __builtin_amdgcn_cvt_pk_fp8_f32(bf2f((unsigned short)lo[0]), bf2f((unsigned short)lo[1]), w0, false);
            w0 = __builtin_amdgcn_cvt_pk_fp8_f32(bf2f((unsigned short)lo[2]), bf2f((unsigned short)lo[3]), w0, true);
            w1 = __builtin_amdgcn_cvt_pk_fp8_f32(bf2f((unsigned short)hi[0]), bf2f((unsigned short)hi[1]), w1, false);
            w1 = __builtin_amdgcn_cvt_pk_fp8_f32(bf2f((unsigned short)hi[2]), bf2f((unsigned short)hi[3]), w1, true);
            *(GAS u32x2*)(B.dst + (size_t)(16 * wave + i) * B.ldb + kb) = (u32x2){w0, w1};
        }
    }
}

struct Ptrs {
    const float *x, *ln_mix, *ln_ffn, *ret_w_in, *ret_w_o, *kv_norm, *w_kv, *diff_w_q, *lq1, *lk1, *lq2, *lk2, *subln, *diff_w_o, *ffn_w_gu, *ffn_w_down, *router, *moe_w_gu, *moe_w_down, *final_norm;
    float* out; unsigned char* ws;
};

__device__ __forceinline__ void p0_prologue(const Ptrs& P, LAS unsigned char* lds, int vcu, int G, float lambda_init) {
    PHASE_IDS();
    unsigned char* ws = P.ws;
    const int gw = vcu * NWAVES + wave, NGW = G * NWAVES;
    {
        constexpr int B_IN = (D / 128) * (RIN / 128), B_RO = (RVD / 128) * (D / 128), B_GU = (D / 128) * (2 * FF / 128), B_DN = (FF / 128) * (D / 128), B_KV = (D / 128) * (2048 / 128), B_Q = (D / 128) * (D / 128), B_DO = B_Q;
        constexpr int NBLK = B_IN + B_RO + B_GU + B_DN + B_KV + B_Q + B_DO;
        auto decode = [&](int it) -> TrBlk {
            const float* W; const float* gain = nullptr; int K, N, gmask = 0, F = 0, row_off = 0, fp8 = 0; float gscale = 1.f; unsigned char* WT; int r = it;
            if (r < B_IN) { W = P.ret_w_in; K = D; N = RIN; gain = P.ln_mix; gmask = 1023; WT = ws + WS_W_IN; }
            else if ((r -= B_IN) < B_RO) { W = P.ret_w_o; K = RVD; N = D; WT = ws + WS_W_RO; }
            else if ((r -= B_RO) < B_GU) { W = P.ffn_w_gu; K = D; N = 2 * FF; gain = P.ln_ffn; gmask = 1023; F = FF; WT = ws + WS_W_GU; }
            else if ((r -= B_GU) < B_DN) { W = P.ffn_w_down; K = FF; N = D; WT = ws + WS_W_DN; }
            else if ((r -= B_DN) < B_KV) { W = P.w_kv; K = D; N = 2048; gain = P.kv_norm; gmask = 1023; WT = ws + WS_W_KVQ; }
            else if ((r -= B_KV) < B_Q) { W = P.diff_w_q; K = D; N = D; gain = P.ln_mix + D; gmask = 1023; row_off = 2048; WT = ws + WS_W_KVQ; }
            else if ((r -= B_Q) < B_DO) { W = P.diff_w_o; K = D; N = D; gain = P.subln; gmask = 127; gscale = 1.0f - lambda_init; WT = ws + WS_W_DO; }
            else { W = P.diff_w_o; K = D; N = D; WT = ws + WS_W_DO; }
            const int nblk = N / 128, kb = r / nblk, nb = r % nblk, k0 = 128 * kb, n0 = 128 * nb;
            int drow = n0;
            if (F > 0) { const int up = n0 >= F ? 1 : 0; const int f = n0 - up * F; drow = 256 * (f >> 7) + 128 * up; }
            TrBlk B; B.src = W + (size_t)k0 * N + n0; B.gain = gain; B.N = N; B.gmask = gmask; B.k0 = k0; B.ldb = fp8 ? K : K * 2; B.fp8 = fp8; B.gscale = gscale;
            B.dst = WT + ((size_t)(row_off + drow) * K + k0) * (fp8 ? 1 : 2);
            return B;
        };
#define LDS_BAR() do { asm volatile("s_waitcnt lgkmcnt(0)" ::: "memory"); __builtin_amdgcn_s_barrier(); asm volatile("" ::: "memory"); } while (0)
        LAS unsigned char* img0 = lds; LAS unsigned char* img1 = lds + 128 * TR_PITCH;
        f32x4 ldA[8], ldB[8]; float gvA[8], gvB[8];
        int it = vcu;
        TrBlk bA = decode(it < NBLK ? it : 0), bB = decode(it + G < NBLK ? it + G : 0);
        if (it < NBLK) tr_load(bA, ldA, gvA, wave, lane);
        if (it + G < NBLK) tr_load(bB, ldB, gvB, wave, lane);
        for (; it < NBLK; it += 2 * G) {
            tr_commit(ldA, gvA, img0, wave, lane);
            LDS_BAR();
            const TrBlk cA = bA; const int n2 = it + 2 * G;
            bA = decode(n2 < NBLK ? n2 : 0);
            if (n2 < NBLK) tr_load(bA, ldA, gvA, wave, lane);
            tr_emit(cA, img0, wave, lane);
            if (it + G < NBLK) {
                tr_commit(ldB, gvB, img1, wave, lane);
                LDS_BAR();
                const TrBlk cB = bB; const int n3 = it + 3 * G;
                bB = decode(n3 < NBLK ? n3 : 0);
                if (n3 < NBLK) tr_load(bB, ldB, gvB, wave, lane);
                tr_emit(cB, img1, wave, lane);
            }
        }
        LDS_BAR();
#undef LDS_BAR
    }
    {
        const int gt = gw * 64 + lane, NT = NGW * 64;
        float* rc = (float*)(ws + WS_RCOS); float* rs = (float*)(ws + WS_RSIN);
        for (int i = gt; i < SEQ * 128; i += NT) {
            const int pos = i >> 7, f = i & 127;
            const float inv = exp2f(-(float)f * (13.287712379549449f / 128.0f));
            const double rev = (double)((float)pos * inv) * 0.15915494309189535;
            const float fr = (float)(rev - floor(rev));
            rc[i] = __builtin_amdgcn_cosf(fr); rs[i] = __builtin_amdgcn_sinf(fr);
        }
        float* dc = (float*)(ws + WS_DCOS); float* ds = (float*)(ws + WS_DSIN);
        for (int i = gt; i < SEQ * 8; i += NT) {
            const int pos = i >> 3, f = i & 7;
            const float inv = exp2f(-(float)f * (18.931568569324174f / 8.0f));
            const double rev = (double)((float)pos * inv) * 0.15915494309189535;
            const float fr = (float)(rev - floor(rev));
            dc[i] = __builtin_amdgcn_cosf(fr); ds[i] = __builtin_amdgcn_sinf(fr);
        }
        float* rwt = (float*)(ws + WS_RWT);
        for (int i = gt; i < NE * D; i += NT) { const int e = i >> 10, k = i & 1023; rwt[i] = P.router[k * NE + e] * P.ln_ffn[D + k]; }
    }
    {
        bf16* xb = (bf16*)(ws + WS_XB); float* ssp = (float*)(ws + WS_SSP);
        f32x4 nv[4];
        if (gw < M) { const GAS f32x4* xr = (const GAS f32x4*)(P.x + (size_t)gw * D) + lane;
#pragma unroll
            for (int j = 0; j < 4; ++j) nv[j] = xr[64 * j]; }
        for (int m = gw; m < M; m += NGW) {
            f32x4 v[4]; float s = 0.f;
#pragma unroll
            for (int j = 0; j < 4; ++j) { v[j] = nv[j]; s += (v[j].x * v[j].x + v[j].y * v[j].y) + (v[j].z * v[j].z + v[j].w * v[j].w); }
            if (m + NGW < M) { const GAS f32x4* xr = (const GAS f32x4*)(P.x + (size_t)(m + NGW) * D) + lane;
#pragma unroll
                for (int j = 0; j < 4; ++j) nv[j] = xr[64 * j]; }
            s = wave_sum(s);
            GAS unsigned long long* o8 = (GAS unsigned long long*)(xb + (size_t)m * D) + lane;
#pragma unroll
            for (int j = 0; j < 4; ++j) o8[64 * j] = (unsigned long long)pk2(v[j].x, v[j].y) | ((unsigned long long)pk2(v[j].z, v[j].w) << 32);
            if (lane < 16) ssp[(size_t)m * 16 + lane] = lane == 0 ? s : 0.f;
        }
    }
}

constexpr int CV_BLKS_GU = NE * (D / 128) * (2 * EF / 128), CV_BLKS_DN = NE * (EF / 128) * (D / 128), CV_BLKS = CV_BLKS_GU + CV_BLKS_DN;
constexpr int CV_PITCH = 272, CV_IMG = 32 * CV_PITCH;
struct CvMini { const float* src; unsigned char* dst; int N, ldb, kg; };
__device__ __forceinline__ CvMini cv_decode(const Ptrs& P, int blk, int qk) {
    CvMini m;
    if (blk < CV_BLKS_GU) {
        const int e = blk / 448, r = blk % 448, kb = r / 56, nb = r % 56, k0 = 128 * kb + 32 * qk, n0 = 128 * nb;
        const int up = n0 >= EF ? 1 : 0, f = n0 - up * EF, drow = 256 * (f >> 7) + 128 * up;
        m.src = P.moe_w_gu + (size_t)e * D * 2 * EF + (size_t)k0 * (2 * EF) + n0; m.kg = k0; m.N = 2 * EF;
        m.dst = P.ws + WS_W_MGU + (size_t)e * 2 * EF * D + (size_t)drow * D + k0; m.ldb = D;
    } else {
        const int b2 = blk - CV_BLKS_GU, e = b2 / 224, r = b2 % 224, kb = r / 8, nb = r % 8, k0 = 128 * kb + 32 * qk, n0 = 128 * nb;
        m.src = P.moe_w_down + (size_t)e * EF * D + (size_t)k0 * D + n0; m.kg = -1; m.N = D;
        m.dst = P.ws + WS_W_MDN + (size_t)e * D * EF + (size_t)n0 * EF + k0; m.ldb = EF;
    }
    return m;
}
__device__ __forceinline__ void cv_load(const CvMini& m, f32x4 (&v)[2], int tid) {
#pragma unroll
    for (int j = 0; j < 2; ++j) { const int row = (tid >> 5) + 16 * j; v[j] = __builtin_nontemporal_load((const f32x4*)(m.src + (size_t)row * m.N + 4 * (tid & 31))); }
}
__device__ __forceinline__ void cv_commit(const f32x4 (&v)[2], int kg, LAS const float* gtab, LAS unsigned char* img, int tid) {
#pragma unroll
    for (int j = 0; j < 2; ++j) { const int row = (tid >> 5) + 16 * j;
        const float gn = kg >= 0 ? gtab[kg + row] : MOE_WDN_SCALE;
        u32x2 w; w.x = pk2(v[j][0] * gn, v[j][1] * gn); w.y = pk2(v[j][2] * gn, v[j][3] * gn);
        *(LAS u32x2*)(img + row * CV_PITCH + 8 * (tid & 31)) = w; }
}
__device__ __forceinline__ void cv_emit(unsigned char* dst, int ldb, LAS const unsigned char* img, int wave, int lane) {
    const int i = lane & 15, g4 = lane >> 4, q = i >> 2, p = i & 3;
    const s16x4 lo = __builtin_bit_cast(s16x4, __builtin_amdgcn_ds_read_tr16_b64_v4i16((LAS s16x4*)(img + (8 * g4 + q) * CV_PITCH + (16 * wave + 4 * p) * 2)));
    const s16x4 hi = __builtin_bit_cast(s16x4, __builtin_amdgcn_ds_read_tr16_b64_v4i16((LAS s16x4*)(img + (8 * g4 + 4 + q) * CV_PITCH + (16 * wave + 4 * p) * 2)));
    unsigned w0, w1; asm volatile("" : "=v"(w0), "=v"(w1));
    w0 = __builtin_amdgcn_cvt_pk_fp8_f32(bf2f((unsigned short)lo[0]), bf2f((unsigned short)lo[1]), w0, false); w0 = __builtin_amdgcn_cvt_pk_fp8_f32(bf2f((unsigned short)lo[2]), bf2f((unsigned short)lo[3]), w0, true);
    w1 = __builtin_amdgcn_cvt_pk_fp8_f32(bf2f((unsigned short)hi[0]), bf2f((unsigned short)hi[1]), w1, false); w1 = __builtin_amdgcn_cvt_pk_fp8_f32(bf2f((unsigned short)hi[2]), bf2f((unsigned short)hi[3]), w1, true);
    *(GAS u32x2*)(dst + (size_t)(16 * wave + i) * ldb + 8 * g4) = (u32x2){w0, w1};
}

namespace ret {
typedef short v4i16_t __attribute__((ext_vector_type(4)));
__device__ __forceinline__ s16x4 trld(LAS const unsigned char* p) { return __builtin_bit_cast(s16x4, __builtin_amdgcn_ds_read_tr16_b64_v4i16((LAS v4i16_t*)p)); }
__device__ __forceinline__ bf16x8 cat8(s16x4 lo, s16x4 hi) { return (bf16x8){lo[0], lo[1], lo[2], lo[3], hi[0], hi[1], hi[2], hi[3]}; }
constexpr int QSTR = 528, SSTR = 144;
constexpr int LQ = 0, LK = LQ + 64 * QSTR, LV = LK + 64 * 512, LVD = LV + 4096, LS = LVD + 4096, LST = LS + 64 * SSTR, LEND = LST + 32 * QSTR;
static_assert(LEND + 2 * 32 * 272 + 4096 <= RING_BYTES && (LK % 16) == 0 && (LV % 16) == 0 && (LS % 16) == 0 && (LST % 16) == 0, "retention LDS map");

__device__ __forceinline__ void scores_phase(const bf16* proj, bf16* sbuf, LAS unsigned char* lds, int vcu, int G) {
    PHASE_IDS();
    const int i = lane & 15, g = lane >> 4;
    const int srow = tid >> 5, sc16 = tid & 31;
    constexpr int SQ = 0, SK = 64 * QSTR;
    for (int u = vcu; u < 1024; u += G) {
        const int bh = u >> 6, c = u & 63, b = bh >> 2, h = bh & 3;
        const size_t R0 = (size_t)b * SEQ + c * 64;
        const float lg = log2f(1.0f - exp2f(-5.0f - (float)h));
        const bf16* gq = proj + (R0 + srow) * RIN + h * 256 + sc16 * 8;
        v4u tq[4], tk[4];
#pragma unroll
        for (int k = 0; k < 4; ++k) { tq[k] = *(const v4u*)(gq + (size_t)(16 * k) * RIN); tk[k] = *(const v4u*)(gq + 1024 + (size_t)(16 * k) * RIN); }
#pragma unroll
        for (int k = 0; k < 4; ++k) { *(LAS v4u*)(lds + SQ + (srow + 16 * k) * QSTR + sc16 * 16) = tq[k]; *(LAS v4u*)(lds + SK + (srow + 16 * k) * QSTR + sc16 * 16) = tk[k]; }
        WG_BAR();
#pragma unroll
        for (int tt = 0; tt < 2; ++tt) {
            const int ti = 2 * wave + tt, tn = ti >> 2, tm = ti & 3;
            f32x4 acc = (f32x4){0.f, 0.f, 0.f, 0.f};
            if (tm <= tn) {
#pragma unroll
                for (int s = 0; s < 8; ++s) {
                    const bf16x8 a = *(const LAS bf16x8*)(lds + SK + (16 * tm + i) * QSTR + (32 * s + 8 * g) * 2), bq = *(const LAS bf16x8*)(lds + SQ + (16 * tn + i) * QSTR + (32 * s + 8 * g) * 2);
                    acc = __builtin_amdgcn_mfma_f32_16x16x32_bf16(a, bq, acc, 0, 0, 0);
                }
            }
            const int n = 16 * tn + i, m0 = 16 * tm + 4 * g;
            float v[4];
#pragma unroll
            for (int r = 0; r < 4; ++r) { const int dm = n - (m0 + r); v[r] = dm >= 0 ? acc[r] * exp2f((float)dm * lg) : 0.f; }
            u32x2 w; w.x = pk2(v[0], v[1]); w.y = pk2(v[2], v[3]);
            *(u32x2*)(sbuf + (size_t)u * 4096 + n * 64 + m0) = w;
        }
        WG_BAR();
    }
}

__device__ __forceinline__ void scan_phase(const Ptrs& P, const bf16* proj, const bf16* sbuf, bf16* oret, LAS unsigned char* lds, int vcu, int G) {
    PHASE_IDS();
    int cvp = 0;
    struct CvSet { f32x4 a[2], b[2]; unsigned char* d0; unsigned char* d1; int l0, l1, k0, k1; bool have; };
    CvSet cs0, cs1; cs0.have = false; cs1.have = false; cs0.d0 = cs0.d1 = cs1.d0 = cs1.d1 = nullptr; cs0.l0 = cs0.l1 = cs1.l0 = cs1.l1 = 0; cs0.k0 = cs0.k1 = cs1.k0 = cs1.k1 = -1;
    LAS float* gtab = (LAS float*)(lds + LEND + 2 * CV_IMG);
    for (int k = tid; k < D; k += NTHREADS) gtab[k] = P.ln_ffn[D + k] * MOE_WGU_SCALE;
    WG_BAR();
#define SCAN_LBAR() do { asm volatile("s_waitcnt lgkmcnt(0)" ::: "memory"); __builtin_amdgcn_s_barrier(); asm volatile("" ::: "memory"); } while (0)
    LAS unsigned char* cimg0 = lds + LEND; LAS unsigned char* cimg1 = lds + LEND + CV_IMG;
    const int i = lane & 15, g = lane >> 4, q = i >> 2, p = i & 3;
    const int nt = wave >> 1, vt = wave & 1;
    for (int u = vcu; u < 256; u += G) {
        const int bh = u >> 4, vs = u & 15, b = bh >> 2, h = bh & 3;
        const float lg = log2f(1.0f - exp2f(-5.0f - (float)h));
        const float cdec = exp2f(64.0f * lg);
        const float qdl = exp2f((float)(16 * nt + i + 1) * lg);
        const float kd = exp2f((float)(63 - (tid >> 2)) * lg);
        const int qrow = tid >> 5, qc16 = tid & 31;
        const char* uq = (const char*)(proj + (size_t)b * SEQ * RIN + h * 256);
        const unsigned qoff = (unsigned)(qrow * RIN + qc16 * 8) * 2u;
        const int kx = (qrow & 3) | (((qrow >> 3) & 1) << 2);
        const int lq_off = LQ + qrow * QSTR + qc16 * 16;
        const int lk_off = LK + qrow * 512 + (((qc16 >> 1) ^ kx) << 5) + (qc16 & 1) * 16;
        const int vrow = tid >> 2, vc16 = tid & 3;
        const char* uv = (const char*)(proj + (size_t)b * SEQ * RIN + 2048 + h * 512 + vs * 32);
        const unsigned voff = (unsigned)(vrow * RIN + vc16 * 8) * 2u;
        const int lv_off = vrow * 64 + ((vc16 * 16) ^ (((vrow >> 3) & 1) << 5));
        const int srow = tid >> 3, sc16 = tid & 7;
        const char* us = (const char*)(sbuf + (size_t)(bh * 64) * 4096);
        const unsigned soff = (unsigned)tid * 16u;
        const int ls_off = LS + srow * SSTR + sc16 * 16;
        f32x4 st[2][2];
#pragma unroll
        for (int a = 0; a < 2; ++a)
#pragma unroll
            for (int c2 = 0; c2 < 2; ++c2) st[a][c2] = (f32x4){0.f, 0.f, 0.f, 0.f};
        for (int k = tid; k < 32 * QSTR / 16; k += NTHREADS) ((LAS v4u*)(lds + LST))[k] = (v4u){0u, 0u, 0u, 0u};
        v4u pq[4], pk[4], pv, ps;
#pragma unroll
        for (int k = 0; k < 4; ++k) { pq[k] = *(const v4u*)(uq + (size_t)(16 * k) * RIN * 2 + qoff); pk[k] = *(const v4u*)(uq + (size_t)(16 * k) * RIN * 2 + 2048 + qoff); }
        pv = (tid < 256) ? *(const v4u*)(uv + voff) : (v4u){0u, 0u, 0u, 0u};
        ps = *(const v4u*)(us + soff);
        auto scan_step = [&](const int c, CvSet& CS) __attribute__((always_inline)) {
#pragma unroll
            for (int k = 0; k < 4; ++k) { *(LAS v4u*)(lds + lq_off + 16 * k * QSTR) = pq[k]; *(LAS v4u*)(lds + lk_off + 16 * k * 512) = pk[k]; }
            if (tid < 256) {
                *(LAS v4u*)(lds + LV + lv_off) = pv;
                v4u d; d.x = pk2(bflo(pv.x) * kd, bfhi(pv.x) * kd); d.y = pk2(bflo(pv.y) * kd, bfhi(pv.y) * kd); d.z = pk2(bflo(pv.z) * kd, bfhi(pv.z) * kd); d.w = pk2(bflo(pv.w) * kd, bfhi(pv.w) * kd);
                *(LAS v4u*)(lds + LVD + lv_off) = d;
            }
            *(LAS v4u*)(lds + ls_off) = ps;
            unsigned char* ed0 = CS.d0; unsigned char* ed1 = CS.d1; const int el0 = CS.l0, el1 = CS.l1; const bool cv_emit_now = CS.have;
            if (CS.have) { cv_commit(CS.a, CS.k0, gtab, cimg0, tid); cv_commit(CS.b, CS.k1, gtab, cimg1, tid); }
            SCAN_LBAR();
            if (c + 1 < 64) {
                const size_t adv = (size_t)(c + 1) * 64 * RIN * 2;
#pragma unroll
                for (int k = 0; k < 4; ++k) { pq[k] = *(const v4u*)(uq + adv + (size_t)(16 * k) * RIN * 2 + qoff); pk[k] = *(const v4u*)(uq + adv + (size_t)(16 * k) * RIN * 2 + 2048 + qoff); }
                if (tid < 256) pv = *(const v4u*)(uv + adv + voff);
                ps = *(const v4u*)(us + (size_t)(c + 1) * 8192 + soff);
            }
            {
                const int blk = vcu + (cvp >> 1) * G;
                CS.have = blk < CV_BLKS;
                if (CS.have) { const CvMini m0 = cv_decode(P, blk, 2 * (cvp & 1)), m1 = cv_decode(P, blk, 2 * (cvp & 1) + 1);
                    cv_load(m0, CS.a, tid); cv_load(m1, CS.b, tid); CS.d0 = m0.dst; CS.l0 = m0.ldb; CS.k0 = m0.kg; CS.d1 = m1.dst; CS.l1 = m1.ldb; CS.k1 = m1.kg; ++cvp; }
            }
            f32x4 a1 = (f32x4){0.f, 0.f, 0.f, 0.f}, a2 = (f32x4){0.f, 0.f, 0.f, 0.f}, a3 = (f32x4){0.f, 0.f, 0.f, 0.f};
#pragma unroll
            for (int s = 0; s < 2; ++s) {
                const bf16x8 a = *(const LAS bf16x8*)(lds + LS + (16 * nt + i) * SSTR + (32 * s + 8 * g) * 2);
                const int r0 = 32 * s + 8 * g + q, r1 = r0 + 4, cb = (16 * vt + 4 * p) * 2;
                const s16x4 lo = trld(lds + LV + r0 * 64 + (cb ^ (((r0 >> 3) & 1) << 5))), hi = trld(lds + LV + r1 * 64 + (cb ^ (((r1 >> 3) & 1) << 5)));
                a1 = __builtin_amdgcn_mfma_f32_16x16x32_bf16(cat8(lo, hi), a, a1, 0, 0, 0);
            }
#pragma unroll
            for (int s = 0; s < 8; ++s) {
                const bf16x8 a = *(const LAS bf16x8*)(lds + LQ + (16 * nt + i) * QSTR + (32 * s + 8 * g) * 2);
                const bf16x8 sf = *(const LAS bf16x8*)(lds + LST + (16 * vt + i) * QSTR + (32 * s + 8 * g) * 2);
                if (s & 1) a3 = __builtin_amdgcn_mfma_f32_16x16x32_bf16(sf, a, a3, 0, 0, 0);
                else a2 = __builtin_amdgcn_mfma_f32_16x16x32_bf16(sf, a, a2, 0, 0, 0);
            }
#pragma unroll
            for (int dt = 0; dt < 2; ++dt)
#pragma unroll
                for (int vv = 0; vv < 2; ++vv) st[dt][vv] = st[dt][vv] * cdec;
#pragma unroll
            for (int s = 0; s < 2; ++s) {
                const int r0 = 32 * s + 8 * g + q, r1 = r0 + 4;
                const int x0 = (r0 & 3) | (((r0 >> 3) & 1) << 2), x1 = (r1 & 3) | (((r1 >> 3) & 1) << 2);
                bf16x8 ka[2], vb[2];
#pragma unroll
                for (int dt = 0; dt < 2; ++dt) {
                    const int slot = 2 * wave + dt;
                    ka[dt] = cat8(trld(lds + LK + r0 * 512 + ((slot ^ x0) << 5) + 8 * p), trld(lds + LK + r1 * 512 + ((slot ^ x1) << 5) + 8 * p));
                }
#pragma unroll
                for (int vv = 0; vv < 2; ++vv) {
                    const int cb = (16 * vv + 4 * p) * 2;
                    vb[vv] = cat8(trld(lds + LVD + r0 * 64 + (cb ^ (((r0 >> 3) & 1) << 5))), trld(lds + LVD + r1 * 64 + (cb ^ (((r1 >> 3) & 1) << 5))));
                }
#pragma unroll
                for (int dt = 0; dt < 2; ++dt)
#pragma unroll
                    for (int vv = 0; vv < 2; ++vv) st[dt][vv] = __builtin_amdgcn_mfma_f32_16x16x32_bf16(ka[dt], vb[vv], st[dt][vv], 0, 0, 0);
            }
            {
                char* uo = (char*)(oret + ((size_t)b * SEQ + c * 64) * RVD + h * 512 + vs * 32);
                const unsigned ooff = (unsigned)((16 * nt + i) * RVD + 16 * vt + 4 * g) * 2u;
                float ov_[4];
#pragma unroll
                for (int r = 0; r < 4; ++r) ov_[r] = a1[r] + qdl * (a2[r] + a3[r]);
                u32x2 w_; w_.x = pk2(ov_[0], ov_[1]); w_.y = pk2(ov_[2], ov_[3]);
                *(u32x2*)(uo + ooff) = w_;
            }
            if (cv_emit_now) { cv_emit(ed0, el0, cimg0, wave, lane); cv_emit(ed1, el1, cimg1, wave, lane); }
            SCAN_LBAR();
#pragma unroll
            for (int dt = 0; dt < 2; ++dt)
#pragma unroll
                for (int vv = 0; vv < 2; ++vv)
                    *(LAS u32x2*)(lds + LST + (16 * vv + i) * QSTR + (32 * wave + 16 * dt + 4 * g) * 2) = (u32x2){pk2(st[dt][vv][0], st[dt][vv][1]), pk2(st[dt][vv][2], st[dt][vv][3])};
        };
        for (int c = 0; c < 64; c += 2) { scan_step(c, cs0); scan_step(c + 1, cs1); }
        WG_BAR();
    }
    for (;;) {
        bool any = false;
#pragma unroll
        for (int k = 0; k < 2; ++k) {
            CvSet& CS = k ? cs1 : cs0;
            unsigned char* ed0 = CS.d0; unsigned char* ed1 = CS.d1; const int el0 = CS.l0, el1 = CS.l1; const bool emit_now = CS.have;
            if (CS.have) { cv_commit(CS.a, CS.k0, gtab, cimg0, tid); cv_commit(CS.b, CS.k1, gtab, cimg1, tid); }
            WG_BAR();
            const int blk = vcu + (cvp >> 1) * G;
            CS.have = blk < CV_BLKS;
            if (CS.have) { const CvMini m0 = cv_decode(P, blk, 2 * (cvp & 1)), m1 = cv_decode(P, blk, 2 * (cvp & 1) + 1);
                cv_load(m0, CS.a, tid); cv_load(m1, CS.b, tid); CS.d0 = m0.dst; CS.l0 = m0.ldb; CS.k0 = m0.kg; CS.d1 = m1.dst; CS.l1 = m1.ldb; CS.k1 = m1.kg; ++cvp; }
            if (emit_now) { cv_emit(ed0, el0, cimg0, wave, lane); cv_emit(ed1, el1, cimg1, wave, lane); }
            WG_BAR();
            any = any || emit_now || CS.have;
        }
        if (!any) break;
    }
#undef SCAN_LBAR
}

__device__ __forceinline__ void norm_gate_phase(const bf16* oret, const bf16* proj, bf16* ro, int vcu, int G) {
    PHASE_IDS();
    const int gw = vcu * NWAVES + wave, NGW = G * NWAVES;
    v4u nov[4], ngv[4];
#pragma unroll
    for (int h = 0; h < 4; ++h) {
        nov[h] = *(const v4u*)(oret + (size_t)gw * RVD + h * 512 + lane * 8);
        ngv[h] = *(const v4u*)(proj + (size_t)gw * RIN + 4096 + h * 512 + lane * 8);
    }
    for (int row = gw; row < M; row += NGW) {
        v4u ov[4], gv[4];
#pragma unroll
        for (int h = 0; h < 4; ++h) { ov[h] = nov[h]; gv[h] = ngv[h]; }
        if (row + NGW < M) {
#pragma unroll
            for (int h = 0; h < 4; ++h) {
                nov[h] = *(const v4u*)(oret + (size_t)(row + NGW) * RVD + h * 512 + lane * 8);
                ngv[h] = *(const v4u*)(proj + (size_t)(row + NGW) * RIN + 4096 + h * 512 + lane * 8);
            }
        }
        float o[4][8], mu[4], rstd[4];
#pragma unroll
        for (int h = 0; h < 4; ++h) {
            o[h][0] = bflo(ov[h].x); o[h][1] = bfhi(ov[h].x); o[h][2] = bflo(ov[h].y); o[h][3] = bfhi(ov[h].y); o[h][4] = bflo(ov[h].z); o[h][5] = bfhi(ov[h].z); o[h][6] = bflo(ov[h].w); o[h][7] = bfhi(ov[h].w);
            float s = 0.f;
#pragma unroll
            for (int j = 0; j < 8; ++j) s += o[h][j];
            mu[h] = s;
        }
#pragma unroll
        for (int h = 0; h < 4; ++h) mu[h] = wave_sum(mu[h]) * (1.0f / 512.0f);
#pragma unroll
        for (int h = 0; h < 4; ++h) {
            float s2 = 0.f;
#pragma unroll
            for (int j = 0; j < 8; ++j) { o[h][j] -= mu[h]; s2 += o[h][j] * o[h][j]; }
            rstd[h] = s2;
        }
#pragma unroll
        for (int h = 0; h < 4; ++h) rstd[h] = __builtin_amdgcn_rsqf(wave_sum(rstd[h]) * (1.0f / 512.0f) + EPS);
#pragma unroll
        for (int h = 0; h < 4; ++h) {
            const float gg[8] = {bflo(gv[h].x), bfhi(gv[h].x), bflo(gv[h].y), bfhi(gv[h].y), bflo(gv[h].z), bfhi(gv[h].z), bflo(gv[h].w), bfhi(gv[h].w)};
            float y[8];
#pragma unroll
            for (int j = 0; j < 8; ++j) y[j] = o[h][j] * rstd[h] * silu_f(gg[j]);
            v4u w; w.x = pk2(y[0], y[1]); w.y = pk2(y[2], y[3]); w.z = pk2(y[4], y[5]); w.w = pk2(y[6], y[7]);
            *(v4u*)(ro + (size_t)row * RVD + h * 512 + lane * 8) = w;
        }
    }
}
}

namespace dat {
constexpr int LK0 = 0  , LV0 = 32768  , LWS = 81920  , LCB = 0  , CSTR = 132;
__device__ __forceinline__ int crow(int r, int hi) { return (r & 3) + 8 * (r >> 2) + 4 * hi; }
__device__ __forceinline__ float half_swap_max(float m) { auto rr = __builtin_amdgcn_permlane32_swap(__float_as_uint(m), __float_as_uint(m), false, false); return fmaxf(__uint_as_float(rr[0]), __uint_as_float(rr[1])); }
__device__ __forceinline__ float half_swap_sum(float m) { auto rr = __builtin_amdgcn_permlane32_swap(__float_as_uint(m), __float_as_uint(m), false, false); return __uint_as_float(rr[0]) + __uint_as_float(rr[1]); }
typedef float f32x2_t __attribute__((ext_vector_type(2))); typedef __bf16 bf16x2_t __attribute__((ext_vector_type(2)));
__device__ __forceinline__ unsigned cvtpk(float lo, float hi) { f32x2_t v = {lo, hi}; bf16x2_t b2 = __builtin_convertvector(v, bf16x2_t); return __builtin_bit_cast(unsigned, b2); }
__device__ __forceinline__ float max3f(float a, float b, float c) { float r; asm("v_max3_f32 %0, %1, %2, %3" : "=v"(r) : "v"(a), "v"(b), "v"(c)); return r; }
__device__ __forceinline__ float fadd_s(float a, float b) { float r; asm("v_add_f32_e32 %0, %1, %2" : "=v"(r) : "v"(a), "v"(b)); return r; }

#define DAT_SBAR() __builtin_amdgcn_sched_barrier(0)
#define DAT_PIN(x) asm volatile("" : "+v"(x))
__device__ __forceinline__ void attn_unit(int b, int h, int qb, const bf16* kvq, bf16* ao, LAS unsigned char* lds, float lam, int wave, int lane, int tid) {
    const int r32 = lane & 31, hi = lane >> 5, comp = wave >> 2, w4 = wave & 3;
    const size_t rowbase = (size_t)b * SEQ;
    const int q0 = qb * 128;
    const int NT = 2 * qb + 2, ntw = 2 * qb + 1 + (w4 >> 1);
    const bf16* Kh = kvq + rowbase * KVQ_N + h * 128;
    const bf16* Vh = kvq + rowbase * KVQ_N + 1024 + h * 128;
    const bf16* Qw = kvq + (rowbase + q0 + w4 * 32) * KVQ_N + 2048 + h * 128 + comp * 64;
    LAS float* wsf = (LAS float*)(lds + LWS) + wave * 64;
    const int pkey = 4 * wave + (lane >> 4), pc = lane & 15;
    const unsigned kvoff = (unsigned)(pkey * KVQ_N + ((pc ^ (pkey & 15)) << 3)) * 2u;
    const unsigned vvoff = (unsigned)(pkey * KVQ_N + ((pc ^ ((pkey & 3) << 2)) << 3)) * 2u;
    const int koff0 = r32 * 256 + (((comp * 8 + hi) ^ (r32 & 15)) << 4);
    const int voff0 = (4 * hi + ((lane & 15) >> 2)) * 256 + ((((lane & 15) >> 2) << 6) | ((4 * ((lane >> 4) & 1) + (lane & 3)) << 3));
#define koffd(d) (koff0 ^ ((d) << 5))
#define voffd(d) (voff0 ^ ((d) << 6))
    const unsigned ldsb = (unsigned)(size_t)lds;
#define DAT_GLDS(base, voff, dst) do { unsigned keep_; asm volatile("s_mov_b32 %0, m0\n\ts_mov_b32 m0, %3\n\ts_nop 0\n\tglobal_load_lds_dwordx4 %1, %2\n\ts_mov_b32 m0, %0" : "=&s"(keep_) : "v"(voff), "s"(base), "s"(dst) : "memory"); } while (0)
#define DAT_DMA(t, kslot, vslot) do { const bf16* kb0_ = Kh + (size_t)(t) * 64 * KVQ_N; const bf16* vb0_ = Vh + (size_t)(t) * 64 * KVQ_N; \
        const unsigned kd_ = (unsigned)__builtin_amdgcn_readfirstlane(ldsb + LK0 + (kslot) * 16384 + wave * 1024), vd_ = (unsigned)__builtin_amdgcn_readfirstlane(ldsb + LV0 + (vslot) * 16384 + wave * 1024); \
        DAT_GLDS(kb0_, kvoff, kd_); DAT_GLDS(kb0_ + (size_t)32 * KVQ_N, kvoff, kd_ + 8192u); DAT_GLDS(vb0_, vvoff, vd_); DAT_GLDS(vb0_ + (size_t)32 * KVQ_N, vvoff, vd_ + 8192u); } while (0)
    DAT_DMA(0, 0, 0);
    bf16x8 qr[4];
#pragma unroll
    for (int d0 = 0; d0 < 4; ++d0) qr[d0] = *(const bf16x8*)(Qw + (size_t)r32 * KVQ_N + d0 * 16 + hi * 8);
    asm volatile("" : "+v"(qr[0]), "+v"(qr[1]), "+v"(qr[2]), "+v"(qr[3]));
    f32x16 o[4];
#pragma unroll
    for (int d = 0; d < 4; ++d)
#pragma unroll
        for (int r = 0; r < 16; ++r) o[d][r] = 0.f;
    float mrun = 0.f, lrun = 0.f;
    f32x16 negm;
#pragma unroll
    for (int r = 0; r < 16; ++r) negm[r] = 0.f;
    f32x16 C0, C1;
    v4u pw[4];
    int vsl_prev = 0, vsl_cur = 0;
    bool resc = false;
#define DAT_DECIDE(FIRST) do { \
        float ra_ = max3f(C0[0], C0[1], C1[0]), rb_ = max3f(C0[2], C0[3], C1[1]); ra_ = max3f(ra_, C1[2], C1[3]); \
        _Pragma("unroll") for (int r = 4; r < 16; r += 4) { ra_ = max3f(ra_, C0[r], C0[r + 1]); rb_ = max3f(rb_, C0[r + 2], C0[r + 3]); ra_ = max3f(ra_, C1[r], C1[r + 1]); rb_ = max3f(rb_, C1[r + 2], C1[r + 3]); } \
        const float rm_ = half_swap_max(max3f(ra_, rb_, rb_)); \
        if ((FIRST) || __any(rm_ > 8.0f)) { \
            const float dl_ = (FIRST) ? rm_ : fmaxf(rm_, 0.f); const float f_ = fast_exp2(-dl_); \
            lrun *= f_; mrun += dl_; if (hi == 0) wsf[r32] = f_; \
            _Pragma("unroll") for (int r = 0; r < 16; ++r) { C0[r] -= dl_; C1[r] -= dl_; negm[r] = -mrun; } \
            resc = !(FIRST); } } while (0)
#define DAT_RESC() do { if (resc) { asm volatile("s_waitcnt lgkmcnt(0)" ::: "memory"); \
        _Pragma("unroll") for (int r = 0; r < 16; ++r) { const float fr_ = wsf[crow(r, hi)]; _Pragma("unroll") for (int d = 0; d < 4; ++d) o[d][r] *= fr_; } resc = false; } } while (0)
#define DAT_VRD(dst_lo, dst_hi, j) do { dst_lo = ret::trld(Vb_ + voffd((j) >> 2) + ((j) & 3) * 4096); dst_hi = ret::trld(Vb_ + voffd((j) >> 2) + ((j) & 3) * 4096 + 2048); } while (0)
#define DAT_QK(t_, DO_, tn_) do { LAS const unsigned char* Kb_ = lds + LK0 + ((t_) & 1) * 16384; \
        const bf16* kb0_ = Kh + (size_t)(tn_) * 64 * KVQ_N; const bf16* vb0_ = Vh + (size_t)(tn_) * 64 * KVQ_N; const unsigned kd_ = (unsigned)__builtin_amdgcn_readfirstlane(ldsb + LK0 + ((tn_) & 1) * 16384 + wave * 1024), vd_ = (unsigned)__builtin_amdgcn_readfirstlane(ldsb + LV0 + ((tn_) % 3) * 16384 + wave * 1024); \
        bf16x8 ka_ = *(const LAS bf16x8*)(Kb_ + koffd(0)), kb_ = *(const LAS bf16x8*)(Kb_ + koffd(0) + 8192), kc_ = *(const LAS bf16x8*)(Kb_ + koffd(1)), kd2_ = *(const LAS bf16x8*)(Kb_ + koffd(1) + 8192); \
        DAT_SBAR(); \
        C0 = __builtin_amdgcn_mfma_f32_32x32x16_bf16(ka_, qr[0], negm, 0, 0, 0); C1 = __builtin_amdgcn_mfma_f32_32x32x16_bf16(kb_, qr[0], negm, 0, 0, 0); \
        ka_ = *(const LAS bf16x8*)(Kb_ + koffd(2)); kb_ = *(const LAS bf16x8*)(Kb_ + koffd(2) + 8192); if (DO_) DAT_GLDS(kb0_, kvoff, kd_); DAT_SBAR(); \
        C0 = __builtin_amdgcn_mfma_f32_32x32x16_bf16(kc_, qr[1], C0, 0, 0, 0); C1 = __builtin_amdgcn_mfma_f32_32x32x16_bf16(kd2_, qr[1], C1, 0, 0, 0); \
        kc_ = *(const LAS bf16x8*)(Kb_ + koffd(3)); kd2_ = *(const LAS bf16x8*)(Kb_ + koffd(3) + 8192); if (DO_) DAT_GLDS(kb0_ + (size_t)32 * KVQ_N, kvoff, kd_ + 8192u); DAT_SBAR(); \
        C0 = __builtin_amdgcn_mfma_f32_32x32x16_bf16(ka_, qr[2], C0, 0, 0, 0); C1 = __builtin_amdgcn_mfma_f32_32x32x16_bf16(kb_, qr[2], C1, 0, 0, 0); \
        if (DO_) DAT_GLDS(vb0_, vvoff, vd_); DAT_SBAR(); \
        C0 = __builtin_amdgcn_mfma_f32_32x32x16_bf16(kc_, qr[3], C0, 0, 0, 0); C1 = __builtin_amdgcn_mfma_f32_32x32x16_bf16(kd2_, qr[3], C1, 0, 0, 0); \
        if (DO_) DAT_GLDS(vb0_ + (size_t)32 * KVQ_N, vvoff, vd_ + 8192u); DAT_SBAR(); \
        asm volatile("s_nop 15\n\ts_nop 7" : "+v"(C0), "+v"(C1)); } while (0)
    {
        WG_BAR();
        DAT_QK(0, true, 1);
        DAT_DECIDE(true);
        float s0_ = 0.f, s1_ = 0.f;
#pragma unroll
        for (int j = 0; j < 16; ++j) {
            const float e0_ = fast_exp2(j < 8 ? C0[2 * (j & 7)] : C1[2 * (j & 7)]), e1_ = fast_exp2(j < 8 ? C0[2 * (j & 7) + 1] : C1[2 * (j & 7) + 1]);
            s0_ += e0_; s1_ += e1_; pw[j >> 2][j & 3] = cvtpk(e0_, e1_);
        }
        lrun += s0_ + s1_;
        vsl_prev = 0; vsl_cur = 16384;
    }
#define DAT_STEADY(t_, PWa, PWb) do { \
        WG_BAR(); \
        const bool dma_ = ((t_) + 1 < NT); \
        LAS const unsigned char* Vb_ = lds + LV0 + vsl_prev; \
        s16x4 vl_[4], vh_[4]; \
        _Pragma("unroll") for (int j = 0; j < 4; ++j) DAT_VRD(vl_[j], vh_[j], j); \
        DAT_QK(t_, dma_, (t_) + 1); \
        DAT_DECIDE(false); \
        const bf16x8 pa_[4] = {__builtin_bit_cast(bf16x8, PWa[0]), __builtin_bit_cast(bf16x8, PWa[1]), __builtin_bit_cast(bf16x8, PWa[2]), __builtin_bit_cast(bf16x8, PWa[3])}; \
        float ssum_ = 0.f; \
        DAT_SBAR(); \
        _Pragma("unroll") for (int j = 0; j < 16; ++j) { \
            o[j >> 2] = __builtin_amdgcn_mfma_f32_32x32x16_bf16(pa_[j & 3], ret::cat8(vl_[j & 3], vh_[j & 3]), o[j >> 2], 0, 0, 0); \
            if (j + 4 < 16) DAT_VRD(vl_[j & 3], vh_[j & 3], j + 4); \
            { const float e0_ = fast_exp2(j < 8 ? C0[2 * (j & 7)] : C1[2 * (j & 7)]), e1_ = fast_exp2(j < 8 ? C0[2 * (j & 7) + 1] : C1[2 * (j & 7) + 1]); \
              ssum_ += e0_; ssum_ += e1_; PWb[j >> 2][j & 3] = cvtpk(e0_, e1_); } \
            DAT_PIN(ssum_); DAT_SBAR(); \
        } \
        DAT_RESC(); \
        lrun += ssum_; \
        vsl_prev = vsl_cur; vsl_cur = (vsl_cur == 32768) ? 0 : vsl_cur + 16384; \
    } while (0)
    v4u pq_[4];
    int t = 1;
    for (; t + 1 < ntw; t += 2) { DAT_STEADY(t, pw, pq_); DAT_STEADY(t + 1, pq_, pw); }
    for (; t <= NT; ++t) {
        if (t < ntw) { DAT_STEADY(t, pw, pq_); pw[0] = pq_[0]; pw[1] = pq_[1]; pw[2] = pq_[2]; pw[3] = pq_[3]; }
        else {
            WG_BAR();
            const bool dma_ = (t + 1 < NT);
            LAS const unsigned char* Vb_ = lds + LV0 + vsl_prev;
            if (dma_) { const int tn_ = t + 1; DAT_DMA(tn_, tn_ & 1, tn_ % 3); }
            if (t == ntw) {
            const bf16x8 pa_[4] = {__builtin_bit_cast(bf16x8, pw[0]), __builtin_bit_cast(bf16x8, pw[1]), __builtin_bit_cast(bf16x8, pw[2]), __builtin_bit_cast(bf16x8, pw[3])};
#pragma unroll
            for (int d = 0; d < 4; ++d)
#pragma unroll
                for (int ks = 0; ks < 4; ++ks) {
                    const s16x4 lo_ = ret::trld(Vb_ + voffd(d) + ks * 4096), hh_ = ret::trld(Vb_ + voffd(d) + ks * 4096 + 2048);
                    o[d] = __builtin_amdgcn_mfma_f32_32x32x16_bf16(pa_[ks], ret::cat8(lo_, hh_), o[d], 0, 0, 0);
                }
            }
            vsl_prev = vsl_cur; vsl_cur = (vsl_cur == 32768) ? 0 : vsl_cur + 16384;
        }
    }
#undef DAT_STEADY
#undef DAT_QK
#undef DAT_VRD
#undef DAT_RESC
#undef DAT_DECIDE
#undef DAT_DMA
#undef DAT_GLDS
#undef koffd
#undef voffd
    {
        const float lt = half_swap_sum(lrun);
        if (hi == 0) wsf[r32] = (comp ? lam : 1.0f) * fast_rcp(lt);
        asm volatile("s_waitcnt lgkmcnt(0)" ::: "memory");
#pragma unroll
        for (int r = 0; r < 16; ++r) { const float fr_ = wsf[crow(r, hi)];
#pragma unroll
            for (int d = 0; d < 4; ++d) o[d][r] *= fr_; }
    }
    WG_BAR();
    LAS float* cb = (LAS float*)(lds + LCB);
    if (comp == 1) {
#pragma unroll
        for (int d = 0; d < 4; ++d)
#pragma unroll
            for (int r = 0; r < 16; ++r) cb[(w4 * 32 + crow(r, hi)) * CSTR + d * 32 + r32] = o[d][r];
    }
    WG_BAR();
    if (comp == 0) {
#pragma unroll
        for (int d = 0; d < 4; ++d)
#pragma unroll
            for (int r = 0; r < 16; ++r) { LAS float* pc = cb + (w4 * 32 + crow(r, hi)) * CSTR + d * 32 + r32; *pc = o[d][r] - *pc; }
    }
    WG_BAR();
    {
        const int row = tid >> 2, part = tid & 3;
        const LAS f32x4* src = (const LAS f32x4*)(cb + row * CSTR + part * 32);
        f32x4 v[8]; float ss = 0.f;
#pragma unroll
        for (int j = 0; j < 8; ++j) { v[j] = src[j]; ss += (v[j][0] * v[j][0] + v[j][1] * v[j][1]) + (v[j][2] * v[j][2] + v[j][3] * v[j][3]); }
        ss += SWZ_XOR(ss, 1); ss += SWZ_XOR(ss, 2);
        const float rstd = __builtin_amdgcn_rsqf(ss * (1.0f / 128.0f) + EPS);
        bf16* dst = ao + (rowbase + q0 + row) * D + h * 128 + part * 32;
#pragma unroll
        for (int j = 0; j < 4; ++j) {
            v4u w; w.x = pk2(v[2 * j][0] * rstd, v[2 * j][1] * rstd); w.y = pk2(v[2 * j][2] * rstd, v[2 * j][3] * rstd);
            w.z = pk2(v[2 * j + 1][0] * rstd, v[2 * j + 1][1] * rstd); w.w = pk2(v[2 * j + 1][2] * rstd, v[2 * j + 1][3] * rstd);
            *(v4u*)(dst + 8 * j) = w;
        }
    }
    WG_BAR();
}

__device__ __forceinline__ void attn_phase(const bf16* kvq, bf16* ao, LAS unsigned char* lds, const float* lq1, const float* lk1, const float* lq2, const float* lk2, float lambda_init, int vcu, int G) {
    PHASE_IDS();
    const float lam = __expf(wave_sum(lq1[lane] * lk1[lane])) - __expf(wave_sum(lq2[lane] * lk2[lane])) + lambda_init;
    const int nun = (G == 256) ? 4 : (1024 - vcu + G - 1) / G;
#pragma unroll 1
    for (int i = 0; i < nun; ++i) {
        int bh, qb;
        if (G == 256) { const int x = vcu >> 5, w = vcu & 31, j = (w + 16) & 31; bh = 4 * x + i; qb = (i == 0) ? w : (i == 1) ? 31 - w : (i == 2) ? j : 31 - j; }
        else { const int u = vcu + i * G; bh = u >> 5; qb = u & 31; }
        attn_unit(bh >> 3, bh & 7, qb, kvq, ao, lds, lam, wave, lane, tid);
    }
}
}

__device__ __forceinline__ void route_a(const bf16* xb, const float* rwt, int* tope, float* topw, int* topr, float* tokr, int* cnt, unsigned char* xn8, LAS unsigned char* lds, int vcu, int G) {
    PHASE_IDS();
    LAS f32x4* rw = (LAS f32x4*)lds;
    LAS int* sel = (LAS int*)(lds + 32768);
    for (int k = tid; k < NE * D / 4; k += NTHREADS) { const int e = k >> 8, c4 = k & 255; rw[((e * 2 + (c4 >> 7)) * 2 + (c4 & 1)) * 64 + ((c4 >> 1) & 63)] = ((const f32x4*)rwt)[k]; }
    WG_BAR();
    for (int tb = vcu; tb < M / 64; tb += G) {
        v4u nv[2];
        { const v4u* xr = (const v4u*)(xb + (size_t)(tb * 64 + wave * 8) * D) + lane;
          nv[0] = xr[0]; nv[1] = xr[64]; }
        for (int tk = 0; tk < 8; ++tk) {
            const int tl = wave * 8 + tk, row = tb * 64 + tl;
            f32x4 v[2][2]; float ss = 0.f;
#pragma unroll
            for (int j = 0; j < 2; ++j) {
                v[j][0] = (f32x4){bflo(nv[j].x), bfhi(nv[j].x), bflo(nv[j].y), bfhi(nv[j].y)}; v[j][1] = (f32x4){bflo(nv[j].z), bfhi(nv[j].z), bflo(nv[j].w), bfhi(nv[j].w)};
#pragma unroll
                for (int h = 0; h < 2; ++h) ss += (v[j][h][0] * v[j][h][0] + v[j][h][1] * v[j][h][1]) + (v[j][h][2] * v[j][h][2] + v[j][h][3] * v[j][h][3]);
            }
            if (tk + 1 < 8) { const v4u* xr = (const v4u*)(xb + (size_t)(row + 1) * D) + lane; nv[0] = xr[0]; nv[1] = xr[64]; }
            ss = wave_sum(ss);
            const float r = __builtin_amdgcn_rsqf(ss * (1.0f / 1024.0f) + EPS);
#pragma unroll
            for (int j = 0; j < 2; ++j) {
                u32x2 w = {0u, 0u};
                w.x = __builtin_amdgcn_cvt_pk_fp8_f32(v[j][0][0] * r, v[j][0][1] * r, w.x, false); w.x = __builtin_amdgcn_cvt_pk_fp8_f32(v[j][0][2] * r, v[j][0][3] * r, w.x, true);
                w.y = __builtin_amdgcn_cvt_pk_fp8_f32(v[j][1][0] * r, v[j][1][1] * r, w.y, false); w.y = __builtin_amdgcn_cvt_pk_fp8_f32(v[j][1][2] * r, v[j][1][3] * r, w.y, true);
                ((u32x2*)(xn8 + (size_t)row * D))[lane + 64 * j] = w;
            }
            float lg[NE];
#pragma unroll
            for (int e = 0; e < NE; ++e) {
                float a = 0.f;
#pragma unroll
                for (int j = 0; j < 2; ++j)
#pragma unroll
                    for (int h = 0; h < 2; ++h) { const f32x4 w = rw[((e * 2 + j) * 2 + h) * 64 + lane]; a += (v[j][h][0] * w[0] + v[j][h][1] * w[1]) + (v[j][h][2] * w[2] + v[j][h][3] * w[3]); }
                lg[e] = wave_sum(a) * r;
            }
            int e1 = 0; float v1 = lg[0];
#pragma unroll
            for (int e = 1; e < NE; ++e) if (lg[e] > v1) { v1 = lg[e]; e1 = e; }
            int e2 = -1; float v2 = -3.0e38f;
#pragma unroll
            for (int e = 0; e < NE; ++e) if (e != e1 && lg[e] > v2) { v2 = lg[e]; e2 = e; }
            const float w1 = fast_rcp(1.0f + __expf(v2 - v1)), w2 = 1.0f - w1;
            if (lane == 0) { tope[row * 2] = e1; tope[row * 2 + 1] = e2; topw[row * 2] = w1; topw[row * 2 + 1] = w2; tokr[row] = r; sel[tl * 2] = e1; sel[tl * 2 + 1] = e2; }
        }
        WG_BAR();
        if (tid < NE) {
            int c = 0;
            for (int k = 0; k < 128; ++k) if (sel[k] == tid) { topr[(tb * 64) * 2 + k] = c; ++c; }
            cnt[tb * NE + tid] = c;
        }
        WG_BAR();
    }
}
__device__ __forceinline__ void route_b(const unsigned char* xn8, const int* tope, const float* topw, const int* topr, const float* tokr, const int* cnt, unsigned char* xg, int* rowinfo, float* rowgate, float* rowr,
                                        LAS unsigned char* lds, LAS int* ldsctl, int vcu, int G) {
    PHASE_IDS();
    LAS int* ct = (LAS int*)lds;
    LAS int* tot = (LAS int*)(lds + 8192);
    for (int k = tid; k < 256 * NE; k += NTHREADS) ct[k] = cnt[k];
    WG_BAR();
    if (tid < NE) { int run = 0; for (int tb = 0; tb < 256; ++tb) { const int c = ct[tb * NE + tid]; ct[tb * NE + tid] = run; run += c; } tot[tid] = run; }
    WG_BAR();
    if (tid == 0) {
        int ts = 0;
        for (int e = 0; e < NE; ++e) { ldsctl[16 + e] = ts; tot[8 + e] = ts * 256; ts += (tot[e] + 255) >> 8; }
        ldsctl[24] = ts; ldsctl[25] = ts;
    }
    WG_BAR();
    for (int tb = vcu; tb < M / 64; tb += G) {
        int mypos = 0;
        {
            const int idx = wave * 16 + (lane & 15), tl = idx >> 1, slot = idx & 1, row = tb * 64 + tl;
            const int e = tope[row * 2 + slot];
            mypos = tot[8 + e] + ct[tb * NE + e] + topr[row * 2 + slot];
            if (lane < 16) { rowinfo[mypos] = slot * M + row; rowgate[mypos] = topw[row * 2 + slot]; rowr[mypos] = tokr[row]; }
        }
        v4u rowsv[8];
#pragma unroll
        for (int k = 0; k < 8; ++k) rowsv[k] = *((const v4u*)(xn8 + (size_t)(tb * 64 + wave * 8 + k) * D) + lane);
#pragma unroll
        for (int k = 0; k < 16; ++k) { const int pos = __builtin_amdgcn_readlane(mypos, k); *((v4u*)(xg + (size_t)pos * D) + lane) = rowsv[k >> 1]; }
    }
    for (int e = vcu; e < NE; e += G) {
        const int beg = tot[8 + e] + tot[e], end = tot[8 + e] + (((tot[e] + 255) >> 8) << 8);
        for (int pos = beg + wave; pos < end; pos += NWAVES) {
            *((v4u*)(xg + (size_t)pos * D) + lane) = (v4u){0u, 0u, 0u, 0u};
            if (lane == 0) { rowinfo[pos] = -1; rowgate[pos] = 0.f; rowr[pos] = 0.f; }
        }
    }
}
__device__ __forceinline__ void final_phase(const bf16* xb, const bf16* y, const float* fn, float* out, int vcu, int G) {
    PHASE_IDS();
    const int gw = vcu * NWAVES + wave, NGW = G * NWAVES;
    f32x4 gn[4];
#pragma unroll
    for (int j = 0; j < 4; ++j) gn[j] = ((const f32x4*)fn)[lane + 64 * j];
    for (int m0 = gw; m0 < M; m0 += 2 * NGW) {
        f32x4 v[2][4]; float ss[2]; bool ok[2];
#pragma unroll
        for (int k = 0; k < 2; ++k) {
            const int m = m0 + k * NGW; ok[k] = m < M; ss[k] = 0.f;
            if (ok[k]) {
                const u32x2* xr = (const u32x2*)(xb + (size_t)m * D) + lane;
                const u32x2* y0 = (const u32x2*)(y + (size_t)m * D) + lane;
                const u32x2* y1 = (const u32x2*)(y + (size_t)(M + m) * D) + lane;
#pragma unroll
                for (int j = 0; j < 4; ++j) {
                    const u32x2 a = y0[64 * j], b2 = y1[64 * j], x0 = xr[64 * j];
                    v[k][j] = (f32x4){bflo(x0.x) + (bflo(a.x) + bflo(b2.x)), bfhi(x0.x) + (bfhi(a.x) + bfhi(b2.x)), bflo(x0.y) + (bflo(a.y) + bflo(b2.y)), bfhi(x0.y) + (bfhi(a.y) + bfhi(b2.y))};
                    ss[k] += (v[k][j][0] * v[k][j][0] + v[k][j][1] * v[k][j][1]) + (v[k][j][2] * v[k][j][2] + v[k][j][3] * v[k][j][3]);
                }
            }
        }
#pragma unroll
        for (int k = 0; k < 2; ++k) ss[k] = wave_sum(ss[k]);
#pragma unroll
        for (int k = 0; k < 2; ++k) if (ok[k]) {
            const float r = __builtin_amdgcn_rsqf(ss[k] * (1.0f / 1024.0f) + EPS);
            f32x4* orow = (f32x4*)(out + (size_t)(m0 + k * NGW) * D) + lane;
#pragma unroll
            for (int j = 0; j < 4; ++j) orow[64 * j] = v[k][j] * r * gn[j];
        }
    }
}
struct Args { Ptrs p; };
static_assert(sizeof(Args) == 22 * 8, "Args has no padding");

__global__ void __launch_bounds__(NTHREADS, 2) yoco_fwd(Args args) {
    extern __shared__ __attribute__((aligned(16))) unsigned char lds_raw[];
    LAS unsigned char* lds = (LAS unsigned char*)lds_raw;
    const Ptrs& P = args.p;
    unsigned char* ws = P.ws;

    const int G = gridDim.x; const int bx = blockIdx.x;
    const int vcu = (G % 8 == 0) ? (bx % 8) * (G / 8) + bx / 8 : bx;
    LAS int* ldsctl = (LAS int*)(lds + LDSCTL_OFF);
    for (int k = threadIdx.x; k < (LDS_BYTES - LDSCTL_OFF) / 4; k += NTHREADS) ldsctl[k] = 0;
    __syncthreads();
    XcdBarrier bar = xcd_barrier_post((unsigned*)(ws + WS_CTL) + CW_BAR, (volatile LAS unsigned*)ldsctl);

    bf16* XB = (bf16*)(ws + WS_XB); float* SSP = (float*)(ws + WS_SSP);
    bf16* PROJ = (bf16*)(ws + WS_PROJ); bf16* KVQ = (bf16*)(ws + WS_KVQ);

    const float lambda_init = 0.8f - 0.6f * 0.7408182206817179f;

    p0_prologue(P, lds, vcu, G, lambda_init);
    xcd_barrier(bar);

    {
        pg8::Gemm g{XB, (const bf16*)(ws + WS_W_IN), M, RIN, D}; pg8::StaticOrder S; S.init(M, RIN, G, bx);
        pg8::EpiInProj E{PROJ, SSP, (const float*)(ws + WS_RCOS), (const float*)(ws + WS_RSIN)};
        pg8::gemm_phase<pg8::EpiInProj, pg8::StaticOrder, true, true>(lds, g, S, E);
    }
    xcd_barrier(bar);
    ret::scores_phase(PROJ, (bf16*)(ws + WS_S), lds, vcu, G);
    xcd_barrier(bar);
    ret::scan_phase(P, PROJ, (const bf16*)(ws + WS_S), (bf16*)(ws + WS_ORET), lds, vcu, G);
    xcd_barrier(bar);
    ret::norm_gate_phase((const bf16*)(ws + WS_ORET), PROJ, (bf16*)(ws + WS_RO), vcu, G);
    xcd_barrier(bar);
    {
        pg8::Gemm g{(const bf16*)(ws + WS_RO), (const bf16*)(ws + WS_W_RO), M, D, RVD}; pg8::StaticOrder S; S.init(M, D, G, bx);
        pg8::EpiResid<true> E{P.x, XB, SSP};
        pg8::gemm_phase<pg8::EpiResid<true>, pg8::StaticOrder, true, true>(lds, g, S, E);
    }
    xcd_barrier(bar);
    {
        pg8::Gemm g{XB, (const bf16*)(ws + WS_W_GU), M, 2 * FF, D}; pg8::StaticOrder S; S.init(M, 2 * FF, G, bx);
        pg8::EpiSwiGLU<false> E{ws + WS_H, FF * 2, SSP, 1.0f, 1.0f};
        pg8::gemm_phase<pg8::EpiSwiGLU<false>, pg8::StaticOrder, true, true>(lds, g, S, E);
    }
    xcd_barrier(bar);
    {
        pg8::Gemm g{(const bf16*)(ws + WS_H), (const bf16*)(ws + WS_W_DN), M, D, FF}; pg8::StaticOrder S; S.init(M, D, G, bx);
        pg8::EpiResid<false> E{XB, XB, SSP};
        pg8::gemm_phase<pg8::EpiResid<false>, pg8::StaticOrder, true, true>(lds, g, S, E);
    }
    xcd_barrier(bar);
    {
        pg8::Gemm g{XB, (const bf16*)(ws + WS_W_KVQ), M, KVQ_N, D}; pg8::StaticOrder S; S.init(M, KVQ_N, G, bx);
        pg8::EpiKVQ E{KVQ, SSP, (const float*)(ws + WS_DCOS), (const float*)(ws + WS_DSIN), 0.125f * LOG2E};
        pg8::gemm_phase<pg8::EpiKVQ, pg8::StaticOrder, true, true>(lds, g, S, E);
    }
    xcd_barrier(bar);
    dat::attn_phase(KVQ, (bf16*)(ws + WS_AO), lds, P.lq1, P.lk1, P.lq2, P.lk2, lambda_init, vcu, G);
    xcd_barrier(bar);
    {
        pg8::Gemm g{(const bf16*)(ws + WS_AO), (const bf16*)(ws + WS_W_DO), M, D, D}; pg8::StaticOrder S; S.init(M, D, G, bx);
        pg8::EpiResid<false> E{XB, XB, SSP};
        pg8::gemm_phase<pg8::EpiResid<false>, pg8::StaticOrder, true, true>(lds, g, S, E);
    }
    xcd_barrier(bar);
    route_a(XB, (const float*)(ws + WS_RWT), (int*)(ws + WS_TOPE), (float*)(ws + WS_TOPW), (int*)(ws + WS_TOPR), (float*)(ws + WS_TOKR), (int*)(ws + WS_CNT), ws + WS_XN8, lds, vcu, G);
    xcd_barrier(bar);
    route_b(ws + WS_XN8, (const int*)(ws + WS_TOPE), (const float*)(ws + WS_TOPW), (const int*)(ws + WS_TOPR), (const float*)(ws + WS_TOKR), (const int*)(ws + WS_CNT), ws + WS_XG,
            (int*)(ws + WS_ROWINFO), (float*)(ws + WS_ROWGATE), (float*)(ws + WS_ROWR), lds, ldsctl, vcu, G);
    xcd_barrier(bar);
    {
        pg8::MoeOrder S; S.nM = __builtin_amdgcn_readfirstlane(((volatile LAS int*)ldsctl)[24]); S.nN = 2 * EF / 256; S.nwg = S.nM * S.nN; S.G = G; S.c = bx;
#pragma unroll
        for (int k = 0; k < 9; ++k) S.ts[k] = __builtin_amdgcn_readfirstlane(((volatile LAS int*)ldsctl)[16 + k]);
        pg8::Gemm g{(const bf16*)(ws + WS_XG), (const bf16*)(ws + WS_W_MGU), XG_ROWS, 2 * EF, D / 2};
        pg8::EpiSwiGLU<true> E{ws + WS_HM, EF, nullptr, 1.0f / MOE_WGU_SCALE, MOE_H_SCALE};
        pg8::gemm_phase<pg8::EpiSwiGLU<true>, pg8::MoeOrder, true, true, true>(lds, g, S, E);
    }
    xcd_barrier(bar);
    {
        pg8::MoeOrder S; S.nM = __builtin_amdgcn_readfirstlane(((volatile LAS int*)ldsctl)[24]); S.nN = D / 256; S.nwg = S.nM * S.nN; S.G = G; S.c = bx;
#pragma unroll
        for (int k = 0; k < 9; ++k) S.ts[k] = __builtin_amdgcn_readfirstlane(((volatile LAS int*)ldsctl)[16 + k]);
        pg8::Gemm g{(const bf16*)(ws + WS_HM), (const bf16*)(ws + WS_W_MDN), XG_ROWS, D, EF / 2};
        pg8::EpiMoeDown E{(bf16*)(ws + WS_Y), (const int*)(ws + WS_ROWINFO), (const float*)(ws + WS_ROWGATE), 1.0f / (MOE_WDN_SCALE * MOE_H_SCALE)};
        pg8::gemm_phase<pg8::EpiMoeDown, pg8::MoeOrder, true, true, true>(lds, g, S, E);
    }
    xcd_barrier(bar);
    final_phase(XB, (const bf16*)(ws + WS_Y), P.final_norm, P.out, vcu, G);
}

extern "C" void kernel_launch(void* const* d_in, const int* in_sizes, int n_in, void* d_out, int out_size, void* d_ws, size_t ws_size, hipStream_t stream) {
    static int grid = 0;
    if (grid == 0) {
        if (n_in != 20 || in_sizes[0] != M * D || out_size != M * D || ws_size < WS_END) { fprintf(stderr, "kernel_launch: unexpected shapes (n_in %d, in0 %d, out %d, ws %zu)\n", n_in, n_in > 0 ? in_sizes[0] : -1, out_size, ws_size); grid = -1; return; }
        int dev = 0, cus = 0, per_cu = 0;
        if (hipGetDevice(&dev) != hipSuccess || hipDeviceGetAttribute(&cus, hipDeviceAttributeMultiprocessorCount, dev) != hipSuccess) { grid = -1; return; }
        if (hipFuncSetAttribute((const void*)yoco_fwd, hipFuncAttributeMaxDynamicSharedMemorySize, LDS_BYTES) != hipSuccess) { fprintf(stderr, "kernel_launch: hipFuncSetAttribute failed\n"); grid = -1; return; }
        if (hipOccupancyMaxActiveBlocksPerMultiprocessor(&per_cu, (const void*)yoco_fwd, NTHREADS, LDS_BYTES) != hipSuccess || per_cu < 1) { fprintf(stderr, "kernel_launch: occupancy query reports %d\n", per_cu); }
        (void)hipGetLastError();
        grid = cus;
    }
    if (grid < 0) return;
    (void)hipMemsetAsync((char*)d_ws + WS_CTL, 0, CTL_ZERO_BYTES, stream);
    Args a{};
    const float** pp = (const float**)&a.p;
    for (int i = 0; i < 20; ++i) pp[i] = (const float*)d_in[i];
    a.p.out = (float*)d_out; a.p.ws = (unsigned char*)d_ws;
    hipLaunchKernelGGL(yoco_fwd, dim3(grid), dim3(NTHREADS), LDS_BYTES, stream, a);
}
```

```cpp
#include <hip/hip_runtime.h>
#include <hip/hip_bf16.h>
#include <cstdio>
#include <cstdint>
#include <cmath>
namespace pg8 {
#define PG8_LAS __attribute__((address_space(3)))
typedef unsigned short bf16_t;
typedef short bf16x8 __attribute__((ext_vector_type(8)));
typedef float f32x4 __attribute__((ext_vector_type(4)));
typedef unsigned u32x4 __attribute__((ext_vector_type(4)));
constexpr int BM = 256, BK = 64, HALF = 128, HTB = HALF * BK * 2  , STAGE_BYTES = 8 * HTB, NXCD = 8, WGM = 8;

__host__ __device__ __forceinline__ int lds_byte(int r, int c) { const int st = (r >> 4) * 2 + (c >> 5), rr = r & 15, cc = c & 31, ob = rr * 64 + cc * 2; return st * 1024 + (ob ^ (((ob >> 9) & 1) << 5)); }
__host__ __device__ __forceinline__ void stage_rc(int b, int& R, int& C) { const int st = b / 1024, sb = b % 1024, swz = sb ^ (((sb >> 9) & 1) << 5); R = (st >> 1) * 16 + swz / 64; C = (st & 1) * 32 + (swz % 64) / 2; }
__host__ __device__ __forceinline__ int perm32(int rho) { const int n = rho >> 4, i = rho & 15; return 8 * (i >> 2) + 4 * n + (i & 3); }

struct Unit { int pm, pn, aux; };
struct Gemm { const bf16_t* A; const bf16_t* Bt; int M, N, K; };

struct StaticOrder {
    int nM, nN, nwg, G, c;
    __host__ __device__ void init(int M, int N, int G_, int c_) { nM = M / BM; nN = N / BM; nwg = nM * nN; G = G_; c = c_; }
    __host__ __device__ bool next(int i, Unit& u) const {
        const long L = (long)i * G + c; if (L >= nwg) return false;
        int wgid = (int)L; { const int q = nwg / NXCD, r = nwg % NXCD, xcd = wgid % NXCD, off = wgid / NXCD; wgid = (xcd < r ? xcd * (q + 1) : r * (q + 1) + (xcd - r) * q) + off; }
        const int nig = WGM * nN, gid = wgid / nig, fm = gid * WGM, gsz = (nM - fm) < WGM ? (nM - fm) : WGM;
        u.pm = fm + ((wgid % nig) % gsz); u.pn = (wgid % nig) / gsz; u.aux = u.pn; return true;
    }
    __device__ __forceinline__ void a_ready(const Unit&) const {}
    __device__ __forceinline__ void done(const Unit&) const {}
};

__device__ __forceinline__ unsigned cvt_pk_bf16(float lo, float hi) { unsigned r; asm volatile("v_cvt_pk_bf16_f32 %0, %1, %2" : "=v"(r) : "v"(lo), "v"(hi)); return r; }
typedef float f32x2 __attribute__((ext_vector_type(2)));
typedef int i32x4 __attribute__((ext_vector_type(4)));
typedef int i32x8 __attribute__((ext_vector_type(8)));
__device__ __forceinline__ i32x8 cat8i(bf16x8 a, bf16x8 b) { const i32x4 x = __builtin_bit_cast(i32x4, a), y = __builtin_bit_cast(i32x4, b); return __builtin_shufflevector(x, y, 0, 1, 2, 3, 4, 5, 6, 7); }
template <class Epi, class Sched, bool ALIGN_EPI = false, bool SP2 = false, bool FP8 = false>
__device__ __forceinline__ void gemm_phase(PG8_LAS unsigned char* lds, const Gemm g, const Sched& S, const Epi& E) {
    int tid = threadIdx.x; asm volatile("" : "+v"(tid)); const int wid = __builtin_amdgcn_readfirstlane(tid >> 6), lane = tid & 63, wr = wid >> 2, wc = wid & 3, fr = lane & 15, fq = lane >> 4;
    const int K = g.K, nt = K / BK;
    unsigned voffA[2], voffB[2];
#pragma unroll
    for (int i = 0; i < 2; ++i) { int R, C; stage_rc(tid * 16 + i * 8192, R, C); const int Rb = Epi::PERM ? ((R & ~31) + perm32(R & 31)) : R;
        voffA[i] = (unsigned)(R * K + C) * 2u; voffB[i] = (unsigned)(Rb * K + C) * 2u; }
    const size_t kstep = (size_t)(BK * 2);
    const size_t hstep = (size_t)HALF * K * 2;
    const size_t tstep = 2 * hstep;
    const unsigned ldsw = (unsigned)wid * 1024u;
    const int aoff = lds_byte(wr * 64 + fr, fq * 8), boff = lds_byte(wc * 32 + fr, fq * 8);
#define PG8_SA(b, h) (((b) * 2 + (h)) * HTB)
#define PG8_SB(b, h) ((4 + (b) * 2 + (h)) * HTB)
#define PG8_STAGE(bufoff, gbase, voff) do { _Pragma("unroll") for (int _i = 0; _i < 2; ++_i) \
        __builtin_amdgcn_global_load_lds((const unsigned*)((const char*)(gbase) + (voff)[_i]), (PG8_LAS unsigned*)(lds + (bufoff) + ldsw + _i * 8192), 16, 0, 0); } while (0)
#define PG8_LDA(dst, b, h) do { _Pragma("unroll") for (int m = 0; m < 4; ++m) _Pragma("unroll") for (int k = 0; k < 2; ++k) dst[m][k] = *(const PG8_LAS bf16x8*)(lds + PG8_SA(b, h) + aoff + m * 2048 + k * 1024); } while (0)
#define PG8_LDB(dst, b, h) do { _Pragma("unroll") for (int n = 0; n < 2; ++n) _Pragma("unroll") for (int k = 0; k < 2; ++k) dst[n][k] = *(const PG8_LAS bf16x8*)(lds + PG8_SB(b, h) + boff + n * 2048 + k * 1024); } while (0)
#define PG8_MMA(ai, bj, At, Bt) do { __builtin_amdgcn_s_setprio(1); \
        if constexpr (FP8) { _Pragma("unroll") for (int m = 0; m < 4; ++m) _Pragma("unroll") for (int n = 0; n < 2; ++n) \
            asm volatile("v_mfma_scale_f32_16x16x128_f8f6f4 %0, %1, %2, %0, %3, %3 op_sel_hi:[0,0,0]" : "+v"(acc[ai][bj][m][n]) : "v"(cat8i(Bt[n][0], Bt[n][1])), "v"(cat8i(At[m][0], At[m][1])), "v"(fp8_unit_scale)); } \
        else { _Pragma("unroll") for (int m = 0; m < 4; ++m) _Pragma("unroll") for (int n = 0; n < 2; ++n) _Pragma("unroll") for (int k = 0; k < 2; ++k) \
            acc[ai][bj][m][n] = __builtin_amdgcn_mfma_f32_16x16x32_bf16(Bt[n][k], At[m][k], acc[ai][bj][m][n], 0, 0, 0); } \
        __builtin_amdgcn_s_setprio(0); } while (0)
#define PG8_WAIT_V(n) asm volatile("s_waitcnt vmcnt(" #n ")" ::: "memory")
#define PG8_WAIT_L(n) asm volatile("s_waitcnt lgkmcnt(" #n ")" ::: "memory")
#define PG8_BAR __builtin_amdgcn_s_barrier()
#define PG8_SCHED __builtin_amdgcn_sched_barrier(0)
    const int fp8_unit_scale = 0x7f7f7f7f; (void)fp8_unit_scale;
    Unit cur, nxt; int ui = 0;
    if (!S.next(0, cur)) return;
    f32x4 acc[2][2][4][2];
#pragma unroll
    for (int a = 0; a < 2; ++a)
#pragma unroll
        for (int b = 0; b < 2; ++b)
#pragma unroll
            for (int m = 0; m < 4; ++m)
#pragma unroll
                for (int n = 0; n < 2; ++n) acc[a][b][m][n] = (f32x4){0.f, 0.f, 0.f, 0.f};
    bf16x8 At[4][2], B0[2][2], B1[2][2];
    const char* cA = (const char*)g.A + (size_t)cur.pm * tstep; const char* cB = (const char*)g.Bt + (size_t)cur.pn * tstep;
    S.a_ready(cur);
    if constexpr (SP2) {
        PG8_STAGE(PG8_SB(0, 0), cB, voffB); PG8_STAGE(PG8_SB(0, 1), cB + hstep, voffB); PG8_STAGE(PG8_SA(0, 0), cA, voffA); PG8_STAGE(PG8_SA(0, 1), cA + hstep, voffA);
        if (wr == 1) PG8_BAR;
        PG8_WAIT_V(2); PG8_BAR;
        PG8_STAGE(PG8_SB(1, 0), cB + kstep, voffB); PG8_STAGE(PG8_SA(1, 0), cA + kstep, voffA); PG8_STAGE(PG8_SB(1, 1), cB + hstep + kstep, voffB);
        PG8_WAIT_V(6); PG8_BAR;
    } else {
        PG8_STAGE(PG8_SB(0, 0), cB, voffB); PG8_STAGE(PG8_SA(0, 0), cA, voffA); PG8_STAGE(PG8_SB(0, 1), cB + hstep, voffB); PG8_STAGE(PG8_SA(0, 1), cA + hstep, voffA);
        if (wr == 1) PG8_BAR;
        PG8_WAIT_V(4); PG8_BAR;
        PG8_STAGE(PG8_SB(1, 0), cB + kstep, voffB); PG8_STAGE(PG8_SA(1, 0), cA + kstep, voffA); PG8_STAGE(PG8_SB(1, 1), cB + hstep + kstep, voffB);
        PG8_WAIT_V(6); PG8_BAR;
    }
    for (;;) {
        const bool has_next = S.next(ui + 1, nxt);
        const char* nA = has_next ? (const char*)g.A + (size_t)nxt.pm * tstep : cA; const char* nB = has_next ? (const char*)g.Bt + (size_t)nxt.pn * tstep : cB;
        for (int t = 0; t < nt; t += 2) {
            const bool last = (t == nt - 2);
            const char* a1 = cA + (size_t)(t + 1) * kstep;
            const char* a2 = last ? nA : cA + (size_t)(t + 2) * kstep; const char* b2 = last ? nB : cB + (size_t)(t + 2) * kstep;
            const char* a3 = a2 + kstep; const char* b3 = b2 + kstep;
            if (last && has_next) S.a_ready(nxt);
            if constexpr (SP2) {
            PG8_LDB(B0, 0, 0); PG8_LDB(B1, 0, 1); PG8_SCHED; PG8_LDA(At, 0, 0); PG8_STAGE(PG8_SA(1, 1), a1 + hstep, voffA);
            PG8_WAIT_V(8); PG8_WAIT_L(0); PG8_BAR; PG8_MMA(0, 0, At, B0); PG8_MMA(0, 1, At, B1); PG8_BAR; PG8_SCHED;
            PG8_LDA(At, 0, 1); PG8_STAGE(PG8_SB(0, 0), b2, voffB); PG8_STAGE(PG8_SB(0, 1), b2 + hstep, voffB); PG8_STAGE(PG8_SA(0, 0), a2, voffA);
            PG8_WAIT_V(8); PG8_WAIT_L(0); PG8_BAR; PG8_MMA(1, 0, At, B0); PG8_MMA(1, 1, At, B1); PG8_BAR; PG8_SCHED;
            PG8_LDB(B0, 1, 0); PG8_LDB(B1, 1, 1); PG8_SCHED; PG8_LDA(At, 1, 0); PG8_STAGE(PG8_SA(0, 1), a2 + hstep, voffA);
            PG8_WAIT_V(8); PG8_WAIT_L(0); PG8_BAR; PG8_MMA(0, 0, At, B0); PG8_MMA(0, 1, At, B1); PG8_BAR; PG8_SCHED;
            PG8_LDA(At, 1, 1); PG8_STAGE(PG8_SB(1, 0), b3, voffB); PG8_STAGE(PG8_SB(1, 1), b3 + hstep, voffB); PG8_STAGE(PG8_SA(1, 0), a3, voffA);
            PG8_WAIT_V(8); PG8_WAIT_L(0); PG8_BAR; PG8_MMA(1, 0, At, B0); PG8_MMA(1, 1, At, B1); PG8_BAR; PG8_SCHED;
            } else {
            PG8_LDB(B0, 0, 0); PG8_SCHED; PG8_LDA(At, 0, 0); PG8_STAGE(PG8_SA(1, 1), a1 + hstep, voffA);
            PG8_WAIT_L(8); PG8_BAR; PG8_WAIT_L(0); PG8_MMA(0, 0, At, B0); PG8_BAR; PG8_SCHED;
            PG8_LDB(B1, 0, 1); PG8_STAGE(PG8_SB(0, 0), b2, voffB);
            PG8_BAR; PG8_WAIT_L(0); PG8_MMA(0, 1, At, B1); PG8_BAR;
            PG8_LDA(At, 0, 1); PG8_STAGE(PG8_SA(0, 0), a2, voffA);
            PG8_BAR; PG8_WAIT_L(0); PG8_MMA(1, 0, At, B0); PG8_BAR; PG8_SCHED;
            PG8_STAGE(PG8_SB(0, 1), b2 + hstep, voffB);
            PG8_WAIT_V(6); PG8_BAR; PG8_MMA(1, 1, At, B1); PG8_BAR;
            PG8_LDB(B0, 1, 0); PG8_SCHED; PG8_LDA(At, 1, 0); PG8_STAGE(PG8_SA(0, 1), a2 + hstep, voffA);
            PG8_WAIT_L(8); PG8_BAR; PG8_WAIT_L(0); PG8_MMA(0, 0, At, B0); PG8_BAR; PG8_SCHED;
            PG8_LDB(B1, 1, 1); PG8_STAGE(PG8_SB(1, 0), b3, voffB);
            PG8_BAR; PG8_WAIT_L(0); PG8_MMA(0, 1, At, B1); PG8_BAR;
            PG8_LDA(At, 1, 1); PG8_STAGE(PG8_SA(1, 0), a3, voffA);
            PG8_BAR; PG8_WAIT_L(0); PG8_MMA(1, 0, At, B0); PG8_BAR; PG8_SCHED;
            PG8_STAGE(PG8_SB(1, 1), b3 + hstep, voffB);
            PG8_WAIT_V(6); PG8_BAR; PG8_MMA(1, 1, At, B1); PG8_BAR;
            }
        }
        if constexpr (ALIGN_EPI) { if (wr == 0) PG8_BAR; }
        if constexpr (FP8) asm volatile("s_nop 15\n\ts_nop 15" ::: "memory");
        if constexpr (!Epi::AFTER_DRAIN) { E(acc, cur, wr, wc, fr, fq); S.done(cur); }
        if (!has_next) break;
#pragma unroll
        for (int a = 0; a < 2; ++a)
#pragma unroll
            for (int b = 0; b < 2; ++b)
#pragma unroll
                for (int m = 0; m < 4; ++m)
#pragma unroll
                    for (int n = 0; n < 2; ++n) acc[a][b][m][n] = (f32x4){0.f, 0.f, 0.f, 0.f};
        cur = nxt; cA = nA; cB = nB; ++ui;
        if constexpr (ALIGN_EPI) { if (wr == 1) PG8_BAR; }
    }
    PG8_WAIT_V(0);
    if constexpr (!ALIGN_EPI) { if (wr == 0) PG8_BAR; }
    PG8_BAR;
    if constexpr (Epi::AFTER_DRAIN) { E.fused(acc, cur, wr, wc, fr, fq, lds, wid, lane); S.done(cur); }
#undef PG8_SA
#undef PG8_SB
#undef PG8_STAGE
#undef PG8_LDA
#undef PG8_LDB
#undef PG8_MMA
#undef PG8_WAIT_V
#undef PG8_WAIT_L
#undef PG8_BAR
#undef PG8_SCHED
}
}
#define GAS __attribute__((address_space(1)))
#define LAS __attribute__((address_space(3)))
typedef unsigned short bf16;
typedef unsigned v4u __attribute__((ext_vector_type(4)));
typedef float f32x4 __attribute__((ext_vector_type(4)));
typedef short bf16x8 __attribute__((ext_vector_type(8)));
typedef GAS unsigned gu32;
typedef GAS unsigned long long gu64;
#define RLX_AGENT __ATOMIC_RELAXED, __HIP_MEMORY_SCOPE_AGENT
#define LDS_WAIT() asm volatile("s_waitcnt lgkmcnt(0)" ::: "memory")
#define VM_WAIT() asm volatile("s_waitcnt vmcnt(0)" ::: "memory")
__device__ __forceinline__ unsigned long long rt() { return __builtin_amdgcn_s_memrealtime(); }
__device__ __forceinline__ unsigned f2bf(float f) { unsigned u = __builtin_bit_cast(unsigned, f); return (u + 0x7fffu + ((u >> 16) & 1u)) >> 16; }
__device__ __forceinline__ unsigned pk2(float lo, float hi) { unsigned r; asm("v_cvt_pk_bf16_f32 %0, %1, %2" : "=v"(r) : "v"(lo), "v"(hi)); return r; }

#define XB_TMO      128
#define XB_XCNT(j)  (256  + 64 * (j))
#define XB_XSUB(j)  (1280 + 64 * (j))
#define XB_XGEN(j)  (2304 + 64 * (j))
#define XB_TOP      3328
#define XB_TOPGEN   3392
#define XCD_BAR_WORDS 3456
#define XB_SPIN_CAP (1u << 18)

__device__ __forceinline__ unsigned xb_ld(unsigned* p)              { return __hip_atomic_load(p, __ATOMIC_RELAXED, __HIP_MEMORY_SCOPE_AGENT); }
__device__ __forceinline__ unsigned xb_add(unsigned* p, unsigned v) { return __hip_atomic_fetch_add(p, v, __ATOMIC_RELAXED, __HIP_MEMORY_SCOPE_AGENT); }
__device__ __forceinline__ unsigned xb_xcc_id() { return (unsigned)__builtin_amdgcn_s_getreg((3 << 11) | 20) & 0xFu; }
#define XB_SPIN(cond, bar) do { unsigned _sp = 0; while (cond) { __builtin_amdgcn_s_sleep(1); \
    if ((++_sp & 255u) == 0u) { if (xb_ld(&(bar)[XB_TMO])) break; if (_sp > XB_SPIN_CAP) { atomicAdd(&(bar)[XB_TMO], 1u); break; } } } } while (0)

struct XcdBarrier {
    unsigned* bar; unsigned x;
    volatile LAS unsigned* st;
};

__device__ __forceinline__ XcdBarrier xcd_barrier_post(unsigned* bar, volatile LAS unsigned* st) {
    XcdBarrier b; b.bar = bar; b.x = xb_xcc_id(); b.st = st;
    if (threadIdx.x == 0) (void)xb_add(&bar[XB_XCNT(b.x)], 1u);
    return b;
}
__device__ __forceinline__ void xcd_barrier_complete(unsigned* bar, unsigned x, unsigned& nloc, unsigned& nx) {
    const unsigned G = gridDim.x * gridDim.y * gridDim.z;
    unsigned sum, cnt, mine, sp = 0u;
    for (;;) {
        sum = 0u; cnt = 0u; mine = 0u;
#pragma unroll
        for (unsigned j = 0; j < 16; ++j) { const unsigned c = xb_ld(&bar[XB_XCNT(j)]); sum += c; cnt += (c > 0u) ? 1u : 0u; mine = (j == x) ? c : mine; }
        if (sum == G) break;
        __builtin_amdgcn_s_sleep(1);
        if ((++sp & 255u) == 0u) { if (xb_ld(&bar[XB_TMO])) break; if (sp > XB_SPIN_CAP) { atomicAdd(&bar[XB_TMO], 1u); break; } }
    }
    nloc = mine > 0u ? mine : 1u; nx = cnt > 0u ? cnt : 1u;
}

__device__ __forceinline__ void xcd_barrier(const XcdBarrier& b) {
    asm volatile("s_waitcnt vmcnt(0)" ::: "memory");
    __syncthreads();
    if (threadIdx.x == 0) {
        unsigned* bar = b.bar;
        __builtin_amdgcn_s_waitcnt(0);
        unsigned nloc = b.st[0], nx = b.st[1];
        if (nloc == 0u) { xcd_barrier_complete(bar, b.x, nloc, nx); b.st[0] = nloc; b.st[1] = nx; }
        const unsigned old = xb_add(&bar[XB_XSUB(b.x)], 1u);
        const unsigned gen = old / nloc;
        if (old + 1u == (gen + 1u) * nloc) {
            __builtin_amdgcn_fence(__ATOMIC_RELEASE, "agent");
            asm volatile("s_waitcnt vmcnt(0)" ::: "memory");
            const unsigned og = xb_add(&bar[XB_TOP], 1u);
            const unsigned tg = og / nx;
            if (og + 1u == (tg + 1u) * nx) xb_add(&bar[XB_TOPGEN], 1u);
            else XB_SPIN(xb_ld(&bar[XB_TOPGEN]) == tg, bar);
            __builtin_amdgcn_fence(__ATOMIC_ACQUIRE, "agent");
            xb_add(&bar[XB_XGEN(b.x)], 1u);
            asm volatile("s_waitcnt vmcnt(0)" ::: "memory");
        } else {
            XB_SPIN(xb_ld(&bar[XB_XGEN(b.x)]) == gen, bar);
            __builtin_amdgcn_fence(__ATOMIC_ACQUIRE, "agent");
            asm volatile("s_waitcnt vmcnt(0)" ::: "memory");
        }
    }
    __syncthreads();
}

constexpr int BATCH = 4, SEQ = 4096, D = 1024, M = BATCH * SEQ;
constexpr int RIN = 6144, RVD = 2048;
constexpr int FF = 2816, EF = 3584, NE = 8;
constexpr int KVQ_N = 3072;
constexpr float EPS = 1e-6f;
constexpr float LOG2E = 1.4426950408889634f;

typedef short s16x4 __attribute__((ext_vector_type(4)));
typedef float f32x16 __attribute__((ext_vector_type(16)));
typedef unsigned u32x2 __attribute__((ext_vector_type(2)));

__device__ __forceinline__ float bf2f(unsigned short h) { return __uint_as_float(((unsigned)h) << 16); }
__device__ __forceinline__ float bflo(unsigned w) { return __uint_as_float(w << 16); }
__device__ __forceinline__ float bfhi(unsigned w) { return __uint_as_float(w & 0xffff0000u); }
__device__ __forceinline__ float fast_exp2(float x) { return __builtin_amdgcn_exp2f(x); }
__device__ __forceinline__ float fast_rcp(float x) { return __builtin_amdgcn_rcpf(x); }
__device__ __forceinline__ float silu_f(float x) { return x * fast_rcp(1.0f + fast_exp2(-x * LOG2E)); }
#define SWZ_XOR(v, m) __int_as_float(__builtin_amdgcn_ds_swizzle(__float_as_int(v), ((m) << 10) | 0x1f))
__device__ __forceinline__ float xor32_sum(float v) { auto rr = __builtin_amdgcn_permlane32_swap(__float_as_uint(v), __float_as_uint(v), false, false); return __uint_as_float(rr[0]) + __uint_as_float(rr[1]); }
#define DPP_F(v, ctrl) __int_as_float(__builtin_amdgcn_update_dpp(0, __float_as_int(v), (ctrl), 0xf, 0xf, false))
#define DPP_XOR1 0xB1
#define DPP_XOR2 0x4E
#define DPP_ROR4 0x124
#define DPP_ROR8 0x128
__device__ __forceinline__ float wave_sum(float v) {
    v += DPP_F(v, DPP_XOR1); v += DPP_F(v, DPP_XOR2); v += DPP_F(v, DPP_ROR4); v += DPP_F(v, DPP_ROR8); v += SWZ_XOR(v, 16);
    return xor32_sum(v);
}

__device__ __forceinline__ float wave_sum8(const float (&a)[8], int lane) {
    const bool b0 = lane & 1, b1 = lane & 2, b2 = lane & 4;
    float b[4], c[2];
#pragma unroll
    for (int i = 0; i < 4; ++i) { const float snd = b0 ? a[i] : a[i + 4]; b[i] = (b0 ? a[i + 4] : a[i]) + DPP_F(snd, DPP_XOR1); }
#pragma unroll
    for (int i = 0; i < 2; ++i) { const float snd = b1 ? b[i] : b[i + 2]; c[i] = (b1 ? b[i + 2] : b[i]) + DPP_F(snd, DPP_XOR2); }
    const float snd = b2 ? c[0] : c[1];
    float d = (b2 ? c[1] : c[0]) + DPP_F(snd, DPP_ROR4);
    d += DPP_F(d, DPP_ROR8); d += SWZ_XOR(d, 16);
    return xor32_sum(d);
}
__device__ __forceinline__ constexpr int wsum8_lane(int k) { return ((k >> 2) & 1) | (((k >> 1) & 1) << 1) | ((k & 1) << 2); }
__device__ __forceinline__ float wave_sum2(float a0, float a1, int lane) {
    const bool b0 = lane & 1;
    const float snd = b0 ? a0 : a1;
    float d = (b0 ? a1 : a0) + DPP_F(snd, DPP_XOR1);
    d += DPP_F(d, DPP_XOR2); d += DPP_F(d, DPP_ROR4); d += DPP_F(d, DPP_ROR8); d += SWZ_XOR(d, 16);
    return xor32_sum(d);
}

namespace pg8 {
__device__ __forceinline__ float rinv_from_ssp(const float* ssp, int row) {
    const f32x4* p = (const f32x4*)(ssp + (size_t)row * 16);
    const f32x4 a = p[0], b = p[1], c = p[2], d = p[3];
    const float s = (((a[0] + a[1]) + (a[2] + a[3])) + ((b[0] + b[1]) + (b[2] + b[3]))) + (((c[0] + c[1]) + (c[2] + c[3])) + ((d[0] + d[1]) + (d[2] + d[3])));
    return __builtin_amdgcn_rsqf(s * (1.0f / 1024.0f) + EPS);
}
__device__ __forceinline__ void rinv8_from_ssp(const float* ssp, int row0, int fq, float (&r)[8]) {
    f32x4 a[8];
#pragma unroll
    for (int x = 0; x < 8; ++x) a[x] = ((const f32x4*)(ssp + (size_t)(row0 + (x >> 2) * HALF + (x & 3) * 16) * 16))[fq];
#pragma unroll
    for (int x = 0; x < 8; ++x) {
        float s = (a[x][0] + a[x][1]) + (a[x][2] + a[x][3]);
        s += SWZ_XOR(s, 16); s = xor32_sum(s);
        r[x] = __builtin_amdgcn_rsqf(s * (1.0f / 1024.0f) + EPS);
    }
}
__device__ __forceinline__ u32x4 pack8(const f32x4 a, const f32x4 b) {
    u32x4 w; w.x = cvt_pk_bf16(a[0], a[1]); w.y = cvt_pk_bf16(a[2], a[3]); w.z = cvt_pk_bf16(b[0], b[1]); w.w = cvt_pk_bf16(b[2], b[3]); return w;
}
struct EpiInProj {
    static constexpr bool PERM = true, AFTER_DRAIN = false;
    bf16_t* O; const float* ssp; const float* rcos; const float* rsin;
    __device__ __forceinline__ void operator()(const f32x4 (&acc)[2][2][4][2], const Unit& u, int wr, int wc, int fr, int fq) const {
        const int row0 = u.pm * BM + wr * 64 + fr;
        const int cl = wc * 32 + 8 * fq;
        const bool rope = u.pn < 8;
        const float ksc = (u.pn >= 4 && u.pn < 8) ? 0.0625f : 1.0f;
        float rv[8]; rinv8_from_ssp(ssp, row0, fq, rv);
#pragma unroll
        for (int ai = 0; ai < 2; ++ai)
#pragma unroll
            for (int m = 0; m < 4; ++m) {
                const int row = row0 + ai * HALF + m * 16;
                const float r = rv[ai * 4 + m] * ksc;
                bf16_t* rowp = O + (size_t)row * RIN + u.pn * BM + cl;
                f32x4 a0 = acc[ai][0][m][0] * r, a1 = acc[ai][0][m][1] * r, b0 = acc[ai][1][m][0] * r, b1 = acc[ai][1][m][1] * r;
                if (rope) {
                    const int pos = row & (SEQ - 1);
                    const f32x4 c0 = *(const f32x4*)(rcos + pos * 128 + cl), c1 = *(const f32x4*)(rcos + pos * 128 + cl + 4);
                    const f32x4 s0 = *(const f32x4*)(rsin + pos * 128 + cl), s1 = *(const f32x4*)(rsin + pos * 128 + cl + 4);
                    const f32x4 x0 = a0 * c0 - b0 * s0, x1 = a1 * c1 - b1 * s1, y0 = b0 * c0 + a0 * s0, y1 = b1 * c1 + a1 * s1;
                    a0 = x0; a1 = x1; b0 = y0; b1 = y1;
                }
                *(u32x4*)(rowp) = pack8(a0, a1);
                *(u32x4*)(rowp + HALF) = pack8(b0, b1);
                if (m & 1) asm volatile("" ::: "memory");
            }
    }
};
template <bool FP8OUT> struct EpiSwiGLU {
    static constexpr bool PERM = true, AFTER_DRAIN = false;
    unsigned char* O; int ldb  ; const float* ssp; float cscale, oscale;
    __device__ __forceinline__ void operator()(const f32x4 (&acc)[2][2][4][2], const Unit& u, int wr, int wc, int fr, int fq) const {
        const int row0 = u.pm * BM + wr * 64 + fr;
        const int col = u.aux * HALF + wc * 32 + 8 * fq;
        float rv[8];
        if (ssp) rinv8_from_ssp(ssp, row0, fq, rv); else {
#pragma unroll
            for (int x = 0; x < 8; ++x) rv[x] = 1.0f; }
#pragma unroll
        for (int ai = 0; ai < 2; ++ai)
#pragma unroll
            for (int m = 0; m < 4; ++m) {
                const int row = row0 + ai * HALF + m * 16;
                const float r = rv[ai * 4 + m] * cscale;
                const float k1 = -r * LOG2E, qv = fast_rcp(r * r * oscale), c0 = __builtin_amdgcn_logf(qv);
                f32x4 h0, h1;
#pragma unroll
                for (int j = 0; j < 4; ++j) {
                    h0[j] = (acc[ai][0][m][0][j] * acc[ai][1][m][0][j]) * fast_rcp(qv + fast_exp2(__builtin_fmaf(acc[ai][0][m][0][j], k1, c0)));
                    h1[j] = (acc[ai][0][m][1][j] * acc[ai][1][m][1][j]) * fast_rcp(qv + fast_exp2(__builtin_fmaf(acc[ai][0][m][1][j], k1, c0)));
                }
                if constexpr (FP8OUT) {
                    unsigned w0, w1; asm volatile("" : "=v"(w0), "=v"(w1));
                    w0 = __builtin_amdgcn_cvt_pk_fp8_f32(h0[0], h0[1], w0, false); w0 = __builtin_amdgcn_cvt_pk_fp8_f32(h0[2], h0[3], w0, true);
                    w1 = __builtin_amdgcn_cvt_pk_fp8_f32(h1[0], h1[1], w1, false); w1 = __builtin_amdgcn_cvt_pk_fp8_f32(h1[2], h1[3], w1, true);
                    *(u32x2*)(O + (size_t)row * ldb + col) = (u32x2){w0, w1};
                } else {
                    *(u32x4*)(O + (size_t)row * ldb + col * 2) = pack8(h0, h1);
                }
                if (m & 1) asm volatile("" ::: "memory");
            }
    }
};
template <bool BASE_F32>
struct EpiResid {
    static constexpr bool PERM = true, AFTER_DRAIN = false;
    const void* base; bf16_t* xb; float* ssp;
    template <int AI0, int NAI>
    __device__ __forceinline__ void part(const f32x4 (&acc)[2][2][4][2], const Unit& u, int row0, int col0, int wc, int fq) const {
        f32x4 bv[NAI * 4][2][2];
#pragma unroll
        for (int x = 0; x < NAI * 4; ++x) {
            const int row = row0 + (AI0 + (x >> 2)) * HALF + (x & 3) * 16;
#pragma unroll
            for (int bj = 0; bj < 2; ++bj) {
                const size_t c = (size_t)row * D + col0 + bj * HALF;
                if constexpr (BASE_F32) { bv[x][bj][0] = *(const f32x4*)((const float*)base + c); bv[x][bj][1] = *(const f32x4*)((const float*)base + c + 4); }
                else { const u32x4 b = *(const u32x4*)((const bf16_t*)base + c); bv[x][bj][0] = __builtin_bit_cast(f32x4, b); }
            }
        }
#pragma unroll
        for (int x = 0; x < NAI * 4; ++x) {
            const int ai = AI0 + (x >> 2), m = x & 3;
            const int row = row0 + ai * HALF + m * 16;
            float ss = 0.f;
#pragma unroll
            for (int bj = 0; bj < 2; ++bj) {
                const size_t c = (size_t)row * D + col0 + bj * HALF;
                f32x4 v0, v1;
                if constexpr (BASE_F32) { v0 = bv[x][bj][0]; v1 = bv[x][bj][1]; }
                else { const u32x4 b = __builtin_bit_cast(u32x4, bv[x][bj][0]); v0 = (f32x4){bflo(b.x), bfhi(b.x), bflo(b.y), bfhi(b.y)}; v1 = (f32x4){bflo(b.z), bfhi(b.z), bflo(b.w), bfhi(b.w)}; }
                v0 += acc[ai][bj][m][0]; v1 += acc[ai][bj][m][1];
                *(u32x4*)(xb + c) = pack8(v0, v1);
                ss += ((v0[0] * v0[0] + v0[1] * v0[1]) + (v0[2] * v0[2] + v0[3] * v0[3])) + ((v1[0] * v1[0] + v1[1] * v1[1]) + (v1[2] * v1[2] + v1[3] * v1[3]));
            }
            ss += SWZ_XOR(ss, 16); ss = xor32_sum(ss);
            if (fq == 0) ssp[(size_t)row * 16 + u.pn * 4 + wc] = ss;
        }
    }
    __device__ __forceinline__ void operator()(const f32x4 (&acc)[2][2][4][2], const Unit& u, int wr, int wc, int fr, int fq) const {
        const int row0 = u.pm * BM + wr * 64 + fr;
        const int col0 = u.pn * BM + wc * 32 + 8 * fq;
        if constexpr (BASE_F32) { part<0, 1>(acc, u, row0, col0, wc, fq); asm volatile("" ::: "memory"); part<1, 1>(acc, u, row0, col0, wc, fq); }
        else part<0, 2>(acc, u, row0, col0, wc, fq);
    }
};
struct EpiKVQ {
    static constexpr bool PERM = true, AFTER_DRAIN = false;
    bf16_t* O; const float* ssp; const float* dcos; const float* dsin; float qscale;
    __device__ __forceinline__ void operator()(const f32x4 (&acc)[2][2][4][2], const Unit& u, int wr, int wc, int fr, int fq) const {
        const int row0 = u.pm * BM + wr * 64 + fr;
        const int cl = wc * 32 + 8 * fq;
        const int kind = u.pn >> 2;
        const bool ropelane = ((wc & 1) == 0) && (fq < 2);
        float rv[8]; rinv8_from_ssp(ssp, row0, fq, rv);
#pragma unroll
        for (int ai = 0; ai < 2; ++ai)
#pragma unroll
            for (int m = 0; m < 4; ++m) {
                const int row = row0 + ai * HALF + m * 16;
                const float r = rv[ai * 4 + m] * (kind == 2 ? qscale : 1.0f);
                bf16_t* rowp = O + (size_t)row * KVQ_N + u.pn * BM + cl;
                f32x4 c0, c1, s0, s1;
                if (kind != 1) {
                    const int pos = row & (SEQ - 1);
                    c0 = *(const f32x4*)(dcos + pos * 8); c1 = *(const f32x4*)(dcos + pos * 8 + 4);
                    s0 = *(const f32x4*)(dsin + pos * 8); s1 = *(const f32x4*)(dsin + pos * 8 + 4);
                    if (fq != 0) { s0 = -s0; s1 = -s1; }
                }
#pragma unroll
                for (int bj = 0; bj < 2; ++bj) {
                    f32x4 v0 = acc[ai][bj][m][0] * r, v1 = acc[ai][bj][m][1] * r;
                    if (kind != 1) {
                        f32x4 p0, p1;
#pragma unroll
                        for (int j = 0; j < 4; ++j) { p0[j] = SWZ_XOR(v0[j], 16); p1[j] = SWZ_XOR(v1[j], 16); }
                        if (ropelane) { v0 = v0 * c0 - p0 * s0; v1 = v1 * c1 - p1 * s1; }
                    }
                    *(u32x4*)(rowp + bj * HALF) = pack8(v0, v1);
                }
                if (m & 1) asm volatile("" ::: "memory");
            }
    }
};
struct EpiMoeDown {
    static constexpr bool PERM = true, AFTER_DRAIN = false;
    bf16_t* Y; const int* rowinfo; const float* rowgate; float cscale;
    __device__ __forceinline__ void operator()(const f32x4 (&acc)[2][2][4][2], const Unit& u, int wr, int wc, int fr, int fq) const {
        const int row0 = u.pm * BM + wr * 64 + fr;
        const int cl = u.aux * BM + wc * 32 + 8 * fq;
        int inf[8]; float gt[8];
#pragma unroll
        for (int x = 0; x < 8; ++x) { const int row = row0 + (x >> 2) * HALF + (x & 3) * 16; inf[x] = rowinfo[row]; gt[x] = rowgate[row]; }
#pragma unroll
        for (int ai = 0; ai < 2; ++ai)
#pragma unroll
            for (int m = 0; m < 4; ++m) {
                const int info = inf[ai * 4 + m];
                if (info >= 0) {
                    const float g = gt[ai * 4 + m] * cscale;
                    bf16_t* rowp = Y + (size_t)info * D + cl;
                    *(u32x4*)(rowp) = pack8(acc[ai][0][m][0] * g, acc[ai][0][m][1] * g);
                    *(u32x4*)(rowp + HALF) = pack8(acc[ai][1][m][0] * g, acc[ai][1][m][1] * g);
                }
            }
    }
};
struct MoeOrder {
    int nM, nN, nwg, G, c; int ts[9];
    __device__ __forceinline__ bool next(int i, Unit& u) const {
        const long L = (long)i * G + c; if (L >= nwg) return false;
        int wgid = (int)L; { const int q = nwg / NXCD, r = nwg % NXCD, xcd = wgid % NXCD, off = wgid / NXCD; wgid = (xcd < r ? xcd * (q + 1) : r * (q + 1) + (xcd - r) * q) + off; }
        const int nig = WGM * nN, gid = wgid / nig, fm = gid * WGM, gsz = (nM - fm) < WGM ? (nM - fm) : WGM;
        const int pm = fm + ((wgid % nig) % gsz), pnl = (wgid % nig) / gsz;
        int e = 0;
#pragma unroll
        for (int k = 1; k < 8; ++k) e += (pm >= ts[k]) ? 1 : 0;
        u.pm = pm; u.pn = e * nN + pnl; u.aux = pnl; return true;
    }
    __device__ __forceinline__ void a_ready(const Unit&) const {}
    __device__ __forceinline__ void done(const Unit&) const {}
};
}
constexpr size_t MiB = 1u << 20;
constexpr size_t WS_CTL = 0, CTL_ZERO_BYTES = 1 * MiB;
constexpr size_t WS_RCOS = 1 * MiB, WS_RSIN = 3 * MiB;
constexpr size_t WS_DCOS = 5 * MiB, WS_DSIN = 5 * MiB + 256 * 1024;
constexpr size_t WS_SSP = 6 * MiB;
constexpr size_t WS_RWT = 7 * MiB;
constexpr size_t WS_TOPE = 8 * MiB;
constexpr size_t WS_TOPW = 8 * MiB + 128 * 1024;
constexpr size_t WS_TOPR = 8 * MiB + 256 * 1024;
constexpr size_t WS_TOKR = 8 * MiB + 384 * 1024;
constexpr size_t WS_CNT = 8 * MiB + 512 * 1024;
constexpr int XG_ROWS = 2 * M + NE * 256;
constexpr size_t WS_ROWINFO = 9 * MiB;
constexpr size_t WS_ROWGATE = 9 * MiB + 256 * 1024;
constexpr size_t WS_ROWR = 9 * MiB + 512 * 1024;
constexpr size_t WS_S = 10 * MiB;
constexpr size_t WS_W_IN = 20 * MiB, WS_W_RO = 32 * MiB, WS_W_GU = 36 * MiB, WS_W_DN = 47 * MiB, WS_W_KVQ = 53 * MiB, WS_W_DO = 59 * MiB, WS_W_MGU = 61 * MiB, WS_W_MDN = 173 * MiB;
constexpr size_t WS_XM = 232 * MiB;
constexpr size_t WS_XB = 296 * MiB;
constexpr size_t WS_PROJ = 328 * MiB;
constexpr size_t WS_RO = 520 * MiB;
constexpr size_t WS_ORET = 584 * MiB;
constexpr size_t WS_H = 328 * MiB;
constexpr size_t WS_KVQ = 584 * MiB;
constexpr size_t WS_AO = 680 * MiB;
constexpr size_t WS_Y = 712 * MiB;
constexpr size_t WS_HM = 328 * MiB;
constexpr size_t WS_XG = 584 * MiB;
constexpr size_t WS_XN8 = 776 * MiB;
constexpr size_t WS_END = 792 * MiB;
static_assert(WS_W_MDN + (size_t)NE * D * EF * 2 <= WS_XM && WS_HM + (size_t)XG_ROWS * EF * 2 <= WS_KVQ && WS_XG + (size_t)XG_ROWS * D * 2 <= WS_AO && WS_Y + (size_t)2 * M * D * 2 <= WS_END, "d_ws map");
constexpr float MOE_WGU_SCALE = 64.0f, MOE_WDN_SCALE = 128.0f, MOE_H_SCALE = 8.0f;
constexpr int CW_BAR = 4096;

constexpr int RING_BYTES = 131072;
constexpr int LDSCTL_OFF = RING_BYTES;
constexpr int LDS_BYTES = 147456;
constexpr int NWAVES = 8, NTHREADS = 512;

#define WG_BAR() do { asm volatile("s_waitcnt vmcnt(0) lgkmcnt(0)" ::: "memory"); __builtin_amdgcn_s_barrier(); asm volatile("" ::: "memory"); } while (0)

#define PHASE_IDS() int tid = threadIdx.x; asm volatile("" : "+v"(tid)); const int lane = tid & 63; const int wave = __builtin_amdgcn_readfirstlane(tid >> 6); (void)lane; (void)wave
struct TrBlk { const float* src; const float* gain; unsigned char* dst; int N, gmask, k0, ldb, fp8; float gscale; };
constexpr int TR_PITCH = 288;
__device__ __forceinline__ void tr_load(const TrBlk& B, f32x4 (&ld)[8], float (&gv)[8], int wave, int lane) {
#pragma unroll
    for (int j = 0; j < 8; ++j) {
        const int k = 16 * wave + 2 * j + (lane >> 5);
        ld[j] = *(const f32x4*)(B.src + (size_t)k * B.N + 4 * (lane & 31));
        gv[j] = B.gain ? B.gain[(B.k0 + k) & B.gmask] * B.gscale : B.gscale;
    }
}
__device__ __forceinline__ void tr_commit(const f32x4 (&ld)[8], const float (&gv)[8], LAS unsigned char* img, int wave, int lane) {
#pragma unroll
    for (int j = 0; j < 8; ++j) {
        const int k = 16 * wave + 2 * j + (lane >> 5);
        u32x2 w; w.x = pk2(ld[j][0] * gv[j], ld[j][1] * gv[j]); w.y = pk2(ld[j][2] * gv[j], ld[j][3] * gv[j]);
        *(LAS u32x2*)(img + k * TR_PITCH + 8 * (lane & 31)) = w;
    }
}
__device__ __forceinline__ void tr_emit(const TrBlk& B, LAS const unsigned char* img, int wave, int lane) {
    const int i = lane & 15, g = lane >> 4, q = i >> 2, p = i & 3;
#pragma unroll
    for (int kg = 0; kg < 4; ++kg) {
        const int kb = 8 * (4 * kg + g);
        const s16x4 lo = __builtin_bit_cast(s16x4, __builtin_amdgcn_ds_read_tr16_b64_v4i16((LAS s16x4*)(img + (kb + q) * TR_PITCH + (16 * wave + 4 * p) * 2)));
        const s16x4 hi = __builtin_bit_cast(s16x4, __builtin_amdgcn_ds_read_tr16_b64_v4i16((LAS s16x4*)(img + (kb + 4 + q) * TR_PITCH + (16 * wave + 4 * p) * 2)));
        if (!B.fp8) {
            v4u o; o.x = (unsigned)(unsigned short)lo[0] | ((unsigned)(unsigned short)lo[1] << 16); o.y = (unsigned)(unsigned short)lo[2] | ((unsigned)(unsigned short)lo[3] << 16);
            o.z = (unsigned)(unsigned short)hi[0] | ((unsigned)(unsigned short)hi[1] << 16); o.w = (unsigned)(unsigned short)hi[2] | ((unsigned)(unsigned short)hi[3] << 16);
            *(GAS v4u*)(B.dst + (size_t)(16 * wave + i) * B.ldb + kb * 2) = o;
        } else {
            unsigned w0 = 0u, w1 = 0u;
            w0 = __builtin_amdgcn_cvt_pk_fp8_f32(bf2f((unsigned short)lo[0]), bf2f((unsigned short)lo[1]), w0, false);
            w0 = __builtin_amdgcn_cvt_pk_fp8_f32(bf2f((unsigned short)lo[2]), bf2f((unsigned short)lo[3]), w0, true);
            w1 = __builtin_amdgcn_cvt_pk_fp8_f32(bf2f((unsigned short)hi[0]), bf2f((unsigned short)hi[1]), w1, false);
            w1 = __builtin_amdgcn_cvt_pk_fp8_f32(bf2f((unsigned short)hi[2]), bf2f((unsigned short)hi[3]), w1, true);
            *(GAS u32x2*)(B.dst + (size_t)(16 * wave + i) * B.ldb + kb) = (u32x2){w0, w1};
        }
    }
}

struct Ptrs {
    const float *x, *ln_mix, *ln_ffn, *ret_w_in, *ret_w_o, *kv_norm, *w_kv, *diff_w_q, *lq1, *lk1, *lq2, *lk2, *subln, *diff_w_o, *ffn_w_gu, *ffn_w_down, *router, *moe_w_gu, *moe_w_down, *final_norm;
    float* out; unsigned char* ws;
};

__device__ __forceinline__ void p0_prologue(const Ptrs& P, LAS unsigned char* lds, int vcu, int G, float lambda_init) {
    PHASE_IDS();
    unsigned char* ws = P.ws;
    const int gw = vcu * NWAVES + wave, NGW = G * NWAVES;
    {
        constexpr int B_IN = (D / 128) * (RIN / 128), B_RO = (RVD / 128) * (D / 128), B_GU = (D / 128) * (2 * FF / 128), B_DN = (FF / 128) * (D / 128), B_KV = (D / 128) * (2048 / 128), B_Q = (D / 128) * (D / 128), B_DO = B_Q;
        constexpr int NBLK = B_IN + B_RO + B_GU + B_DN + B_KV + B_Q + B_DO;
        auto decode = [&](int it) -> TrBlk {
            const float* W; const float* gain = nullptr; int K, N, gmask = 0, F = 0, row_off = 0, fp8 = 0; float gscale = 1.f; unsigned char* WT; int r = it;
            if (r < B_IN) { W = P.ret_w_in; K = D; N = RIN; gain = P.ln_mix; gmask = 1023; WT = ws + WS_W_IN; }
            else if ((r -= B_IN) < B_RO) { W = P.ret_w_o; K = RVD; N = D; WT = ws + WS_W_RO; }
            else if ((r -= B_RO) < B_GU) { W = P.ffn_w_gu; K = D; N = 2 * FF; gain = P.ln_ffn; gmask = 1023; F = FF; WT = ws + WS_W_GU; }
            else if ((r -= B_GU) < B_DN) { W = P.ffn_w_down; K = FF; N = D; WT = ws + WS_W_DN; }
            else if ((r -= B_DN) < B_KV) { W = P.w_kv; K = D; N = 2048; gain = P.kv_norm; gmask = 1023; WT = ws + WS_W_KVQ; }
            else if ((r -= B_KV) < B_Q) { W = P.diff_w_q; K = D; N = D; gain = P.ln_mix + D; gmask = 1023; row_off = 2048; WT = ws + WS_W_KVQ; }
            else if ((r -= B_Q) < B_DO) { W = P.diff_w_o; K = D; N = D; gain = P.subln; gmask = 127; gscale = 1.0f - lambda_init; WT = ws + WS_W_DO; }
            else { W = P.diff_w_o; K = D; N = D; WT = ws + WS_W_DO; }
            const int nblk = N / 128, kb = r / nblk, nb = r % nblk, k0 = 128 * kb, n0 = 128 * nb;
            int drow = n0;
            if (F > 0) { const int up = n0 >= F ? 1 : 0; const int f = n0 - up * F; drow = 256 * (f >> 7) + 128 * up; }
            TrBlk B; B.src = W + (size_t)k0 * N + n0; B.gain = gain; B.N = N; B.gmask = gmask; B.k0 = k0; B.ldb = fp8 ? K : K * 2; B.fp8 = fp8; B.gscale = gscale;
            B.dst = WT + ((size_t)(row_off + drow) * K + k0) * (fp8 ? 1 : 2);
            return B;
        };
#define LDS_BAR() do { asm volatile("s_waitcnt lgkmcnt(0)" ::: "memory"); __builtin_amdgcn_s_barrier(); asm volatile("" ::: "memory"); } while (0)
        LAS unsigned char* img0 = lds; LAS unsigned char* img1 = lds + 128 * TR_PITCH;
        f32x4 ldA[8], ldB[8]; float gvA[8], gvB[8];
        int it = vcu;
        TrBlk bA = decode(it < NBLK ? it : 0), bB = decode(it + G < NBLK ? it + G : 0);
        if (it < NBLK) tr_load(bA, ldA, gvA, wave, lane);
        if (it + G < NBLK) tr_load(bB, ldB, gvB, wave, lane);
        for (; it < NBLK; it += 2 * G) {
            tr_commit(ldA, gvA, img0, wave, lane);
            LDS_BAR();
            const TrBlk cA = bA; const int n2 = it + 2 * G;
            bA = decode(n2 < NBLK ? n2 : 0);
            if (n2 < NBLK) tr_load(bA, ldA, gvA, wave, lane);
            tr_emit(cA, img0, wave, lane);
            if (it + G < NBLK) {
                tr_commit(ldB, gvB, img1, wave, lane);
                LDS_BAR();
                const TrBlk cB = bB; const int n3 = it + 3 * G;
                bB = decode(n3 < NBLK ? n3 : 0);
                if (n3 < NBLK) tr_load(bB, ldB, gvB, wave, lane);
                tr_emit(cB, img1, wave, lane);
            }
        }
        LDS_BAR();
#undef LDS_BAR
    }
    {
        const int gt = gw * 64 + lane, NT = NGW * 64;
        float* rc = (float*)(ws + WS_RCOS); float* rs = (float*)(ws + WS_RSIN);
        for (int i = gt; i < SEQ * 128; i += NT) {
            const int pos = i >> 7, f = i & 127;
            const float inv = exp2f(-(float)f * (13.287712379549449f / 128.0f));
            const double rev = (double)((float)pos * inv) * 0.15915494309189535;
            const float fr = (float)(rev - floor(rev));
            rc[i] = __builtin_amdgcn_cosf(fr); rs[i] = __builtin_amdgcn_sinf(fr);
        }
        float* dc = (float*)(ws + WS_DCOS); float* ds = (float*)(ws + WS_DSIN);
        for (int i = gt; i < SEQ * 8; i += NT) {
            const int pos = i >> 3, f = i & 7;
            const float inv = exp2f(-(float)f * (18.931568569324174f / 8.0f));
            const double rev = (double)((float)pos * inv) * 0.15915494309189535;
            const float fr = (float)(rev - floor(rev));
            dc[i] = __builtin_amdgcn_cosf(fr); ds[i] = __builtin_amdgcn_sinf(fr);
        }
        float* rwt = (float*)(ws + WS_RWT);
        for (int i = gt; i < NE * D; i += NT) { const int e = i >> 10, k = i & 1023; rwt[i] = P.router[k * NE + e] * P.ln_ffn[D + k]; }
    }
    {
        bf16* xb = (bf16*)(ws + WS_XB); float* ssp = (float*)(ws + WS_SSP);
        f32x4 nv[4];
        if (gw < M) { const GAS f32x4* xr = (const GAS f32x4*)(P.x + (size_t)gw * D) + lane;
#pragma unroll
            for (int j = 0; j < 4; ++j) nv[j] = xr[64 * j]; }
        for (int m = gw; m < M; m += NGW) {
            f32x4 v[4]; float s = 0.f;
#pragma unroll
            for (int j = 0; j < 4; ++j) { v[j] = nv[j]; s += (v[j].x * v[j].x + v[j].y * v[j].y) + (v[j].z * v[j].z + v[j].w * v[j].w); }
            if (m + NGW < M) { const GAS f32x4* xr = (const GAS f32x4*)(P.x + (size_t)(m + NGW) * D) + lane;
#pragma unroll
                for (int j = 0; j < 4; ++j) nv[j] = xr[64 * j]; }
            s = wave_sum(s);
            GAS unsigned long long* o8 = (GAS unsigned long long*)(xb + (size_t)m * D) + lane;
#pragma unroll
            for (int j = 0; j < 4; ++j) o8[64 * j] = (unsigned long long)pk2(v[j].x, v[j].y) | ((unsigned long long)pk2(v[j].z, v[j].w) << 32);
            if (lane < 16) ssp[(size_t)m * 16 + lane] = lane == 0 ? s : 0.f;
        }
    }
}

constexpr int CV_BLKS_GU = NE * (D / 128) * (2 * EF / 128), CV_BLKS_DN = NE * (EF / 128) * (D / 128), CV_BLKS = CV_BLKS_GU + CV_BLKS_DN;
constexpr int CV_PITCH = 272, CV_IMG = 32 * CV_PITCH;
struct CvMini { const float* src; unsigned char* dst; int N, ldb, kg; };
__device__ __forceinline__ CvMini cv_decode(const Ptrs& P, int blk, int qk) {
    CvMini m;
    if (blk < CV_BLKS_GU) {
        const int e = blk / 448, r = blk % 448, kb = r / 56, nb = r % 56, k0 = 128 * kb + 32 * qk, n0 = 128 * nb;
        const int up = n0 >= EF ? 1 : 0, f = n0 - up * EF, drow = 256 * (f >> 7) + 128 * up;
        m.src = P.moe_w_gu + (size_t)e * D * 2 * EF + (size_t)k0 * (2 * EF) + n0; m.kg = k0; m.N = 2 * EF;
        m.dst = P.ws + WS_W_MGU + (size_t)e * 2 * EF * D + (size_t)drow * D + k0; m.ldb = D;
    } else {
        const int b2 = blk - CV_BLKS_GU, e = b2 / 224, r = b2 % 224, kb = r / 8, nb = r % 8, k0 = 128 * kb + 32 * qk, n0 = 128 * nb;
        m.src = P.moe_w_down + (size_t)e * EF * D + (size_t)k0 * D + n0; m.kg = -1; m.N = D;
        m.dst = P.ws + WS_W_MDN + (size_t)e * D * EF + (size_t)n0 * EF + k0; m.ldb = EF;
    }
    return m;
}
__device__ __forceinline__ void cv_load(const CvMini& m, f32x4 (&v)[2], int tid) {
#pragma unroll
    for (int j = 0; j < 2; ++j) { const int row = (tid >> 5) + 16 * j; v[j] = __builtin_nontemporal_load((const f32x4*)(m.src + (size_t)row * m.N + 4 * (tid & 31))); }
}
__device__ __forceinline__ void cv_commit(const f32x4 (&v)[2], int kg, LAS const float* gtab, LAS unsigned char* img, int tid) {
#pragma unroll
    for (int j = 0; j < 2; ++j) { const int row = (tid >> 5) + 16 * j;
        const float gn = kg >= 0 ? gtab[kg + row] : MOE_WDN_SCALE;
        u32x2 w; w.x = pk2(v[j][0] * gn, v[j][1] * gn); w.y = pk2(v[j][2] * gn, v[j][3] * gn);
        *(LAS u32x2*)(img + row * CV_PITCH + 8 * (tid & 31)) = w; }
}
__device__ __forceinline__ void cv_emit(unsigned char* dst, int ldb, LAS const unsigned char* img, int wave, int lane) {
    const int i = lane & 15, g4 = lane >> 4, q = i >> 2, p = i & 3;
    const s16x4 lo = __builtin_bit_cast(s16x4, __builtin_amdgcn_ds_read_tr16_b64_v4i16((LAS s16x4*)(img + (8 * g4 + q) * CV_PITCH + (16 * wave + 4 * p) * 2)));
    const s16x4 hi = __builtin_bit_cast(s16x4, __builtin_amdgcn_ds_read_tr16_b64_v4i16((LAS s16x4*)(img + (8 * g4 + 4 + q) * CV_PITCH + (16 * wave + 4 * p) * 2)));
    unsigned w0, w1; asm volatile("" : "=v"(w0), "=v"(w1));
    w0 = __builtin_amdgcn_cvt_pk_fp8_f32(bf2f((unsigned short)lo[0]), bf2f((unsigned short)lo[1]), w0, false); w0 = __builtin_amdgcn_cvt_pk_fp8_f32(bf2f((unsigned short)lo[2]), bf2f((unsigned short)lo[3]), w0, true);
    w1 = __builtin_amdgcn_cvt_pk_fp8_f32(bf2f((unsigned short)hi[0]), bf2f((unsigned short)hi[1]), w1, false); w1 = __builtin_amdgcn_cvt_pk_fp8_f32(bf2f((unsigned short)hi[2]), bf2f((unsigned short)hi[3]), w1, true);
    *(GAS u32x2*)(dst + (size_t)(16 * wave + i) * ldb + 8 * g4) = (u32x2){w0, w1};
}

namespace ret {
typedef short v4i16_t __attribute__((ext_vector_type(4)));
__device__ __forceinline__ s16x4 trld(LAS const unsigned char* p) { return __builtin_bit_cast(s16x4, __builtin_amdgcn_ds_read_tr16_b64_v4i16((LAS v4i16_t*)p)); }
__device__ __forceinline__ bf16x8 cat8(s16x4 lo, s16x4 hi) { return (bf16x8){lo[0], lo[1], lo[2], lo[3], hi[0], hi[1], hi[2], hi[3]}; }
constexpr int QSTR = 528, SSTR = 144;
constexpr int LQ = 0, LK = LQ + 64 * QSTR, LV = LK + 64 * 512, LVD = LV + 4096, LS = LVD + 4096, LST = LS + 64 * SSTR, LEND = LST + 32 * QSTR;
static_assert(LEND + 2 * 32 * 272 + 4096 <= RING_BYTES && (LK % 16) == 0 && (LV % 16) == 0 && (LS % 16) == 0 && (LST % 16) == 0, "retention LDS map");

__device__ __forceinline__ void scores_phase(const bf16* proj, bf16* sbuf, LAS unsigned char* lds, int vcu, int G) {
    PHASE_IDS();
    const int i = lane & 15, g = lane >> 4;
    const int srow = tid >> 5, sc16 = tid & 31;
    constexpr int SQ = 0, SK = 64 * QSTR;
    for (int u = vcu; u < 1024; u += G) {
        const int bh = u >> 6, c = u & 63, b = bh >> 2, h = bh & 3;
        const size_t R0 = (size_t)b * SEQ + c * 64;
        const float lg = log2f(1.0f - exp2f(-5.0f - (float)h));
        const bf16* gq = proj + (R0 + srow) * RIN + h * 256 + sc16 * 8;
        v4u tq[4], tk[4];
#pragma unroll
        for (int k = 0; k < 4; ++k) { tq[k] = *(const v4u*)(gq + (size_t)(16 * k) * RIN); tk[k] = *(const v4u*)(gq + 1024 + (size_t)(16 * k) * RIN); }
#pragma unroll
        for (int k = 0; k < 4; ++k) { *(LAS v4u*)(lds + SQ + (srow + 16 * k) * QSTR + sc16 * 16) = tq[k]; *(LAS v4u*)(lds + SK + (srow + 16 * k) * QSTR + sc16 * 16) = tk[k]; }
        WG_BAR();
#pragma unroll
        for (int tt = 0; tt < 2; ++tt) {
            const int ti = 2 * wave + tt, tn = ti >> 2, tm = ti & 3;
            f32x4 acc = (f32x4){0.f, 0.f, 0.f, 0.f};
            if (tm <= tn) {
#pragma unroll
                for (int s = 0; s < 8; ++s) {
                    const bf16x8 a = *(const LAS bf16x8*)(lds + SK + (16 * tm + i) * QSTR + (32 * s + 8 * g) * 2), bq = *(const LAS bf16x8*)(lds + SQ + (16 * tn + i) * QSTR + (32 * s + 8 * g) * 2);
                    acc = __builtin_amdgcn_mfma_f32_16x16x32_bf16(a, bq, acc, 0, 0, 0);
                }
            }
            const int n = 16 * tn + i, m0 = 16 * tm + 4 * g;
            float v[4];
#pragma unroll
            for (int r = 0; r < 4; ++r) { const int dm = n - (m0 + r); v[r] = dm >= 0 ? acc[r] * exp2f((float)dm * lg) : 0.f; }
            u32x2 w; w.x = pk2(v[0], v[1]); w.y = pk2(v[2], v[3]);
            *(u32x2*)(sbuf + (size_t)u * 4096 + n * 64 + m0) = w;
        }
        WG_BAR();
    }
}

__device__ __forceinline__ void scan_phase(const Ptrs& P, const bf16* proj, const bf16* sbuf, bf16* oret, LAS unsigned char* lds, int vcu, int G) {
    PHASE_IDS();
    int cvp = 0;
    struct CvSet { f32x4 a[2], b[2]; unsigned char* d0; unsigned char* d1; int l0, l1, k0, k1; bool have; };
    CvSet cs0, cs1; cs0.have = false; cs1.have = false; cs0.d0 = cs0.d1 = cs1.d0 = cs1.d1 = nullptr; cs0.l0 = cs0.l1 = cs1.l0 = cs1.l1 = 0; cs0.k0 = cs0.k1 = cs1.k0 = cs1.k1 = -1;
    LAS float* gtab = (LAS float*)(lds + LEND + 2 * CV_IMG);
    for (int k = tid; k < D; k += NTHREADS) gtab[k] = P.ln_ffn[D + k] * MOE_WGU_SCALE;
    WG_BAR();
#define SCAN_LBAR() do { asm volatile("s_waitcnt lgkmcnt(0)" ::: "memory"); __builtin_amdgcn_s_barrier(); asm volatile("" ::: "memory"); } while (0)
    LAS unsigned char* cimg0 = lds + LEND; LAS unsigned char* cimg1 = lds + LEND + CV_IMG;
    const int i = lane & 15, g = lane >> 4, q = i >> 2, p = i & 3;
    const int nt = wave >> 1, vt = wave & 1;
    for (int u = vcu; u < 256; u += G) {
        const int bh = u >> 4, vs = u & 15, b = bh >> 2, h = bh & 3;
        const float lg = log2f(1.0f - exp2f(-5.0f - (float)h));
        const float cdec = exp2f(64.0f * lg);
        const float qdl = exp2f((float)(16 * nt + i + 1) * lg);
        const float kd = exp2f((float)(63 - (tid >> 2)) * lg);
        const int qrow = tid >> 5, qc16 = tid & 31;
        const char* uq = (const char*)(proj + (size_t)b * SEQ * RIN + h * 256);
        const unsigned qoff = (unsigned)(qrow * RIN + qc16 * 8) * 2u;
        const int kx = (qrow & 3) | (((qrow >> 3) & 1) << 2);
        const int lq_off = LQ + qrow * QSTR + qc16 * 16;
        const int lk_off = LK + qrow * 512 + (((qc16 >> 1) ^ kx) << 5) + (qc16 & 1) * 16;
        const int vrow = tid >> 2, vc16 = tid & 3;
        const char* uv = (const char*)(proj + (size_t)b * SEQ * RIN + 2048 + h * 512 + vs * 32);
        const unsigned voff = (unsigned)(vrow * RIN + vc16 * 8) * 2u;
        const int lv_off = vrow * 64 + ((vc16 * 16) ^ (((vrow >> 3) & 1) << 5));
        const int srow = tid >> 3, sc16 = tid & 7;
        const char* us = (const char*)(sbuf + (size_t)(bh * 64) * 4096);
        const unsigned soff = (unsigned)tid * 16u;
        const int ls_off = LS + srow * SSTR + sc16 * 16;
        f32x4 st[2][2];
#pragma unroll
        for (int a = 0; a < 2; ++a)
#pragma unroll
            for (int c2 = 0; c2 < 2; ++c2) st[a][c2] = (f32x4){0.f, 0.f, 0.f, 0.f};
        for (int k = tid; k < 32 * QSTR / 16; k += NTHREADS) ((LAS v4u*)(lds + LST))[k] = (v4u){0u, 0u, 0u, 0u};
        v4u pq[4], pk[4], pv, ps;
#pragma unroll
        for (int k = 0; k < 4; ++k) { pq[k] = *(const v4u*)(uq + (size_t)(16 * k) * RIN * 2 + qoff); pk[k] = *(const v4u*)(uq + (size_t)(16 * k) * RIN * 2 + 2048 + qoff); }
        pv = (tid < 256) ? *(const v4u*)(uv + voff) : (v4u){0u, 0u, 0u, 0u};
        ps = *(const v4u*)(us + soff);
        auto scan_step = [&](const int c, CvSet& CS) __attribute__((always_inline)) {
#pragma unroll
            for (int k = 0; k < 4; ++k) { *(LAS v4u*)(lds + lq_off + 16 * k * QSTR) = pq[k]; *(LAS v4u*)(lds + lk_off + 16 * k * 512) = pk[k]; }
            if (tid < 256) {
                *(LAS v4u*)(lds + LV + lv_off) = pv;
                v4u d; d.x = pk2(bflo(pv.x) * kd, bfhi(pv.x) * kd); d.y = pk2(bflo(pv.y) * kd, bfhi(pv.y) * kd); d.z = pk2(bflo(pv.z) * kd, bfhi(pv.z) * kd); d.w = pk2(bflo(pv.w) * kd, bfhi(pv.w) * kd);
                *(LAS v4u*)(lds + LVD + lv_off) = d;
            }
            *(LAS v4u*)(lds + ls_off) = ps;
            unsigned char* ed0 = CS.d0; unsigned char* ed1 = CS.d1; const int el0 = CS.l0, el1 = CS.l1; const bool cv_emit_now = CS.have;
            if (CS.have) { cv_commit(CS.a, CS.k0, gtab, cimg0, tid); cv_commit(CS.b, CS.k1, gtab, cimg1, tid); }
            SCAN_LBAR();
            if (c + 1 < 64) {
                const size_t adv = (size_t)(c + 1) * 64 * RIN * 2;
#pragma unroll
                for (int k = 0; k < 4; ++k) { pq[k] = *(const v4u*)(uq + adv + (size_t)(16 * k) * RIN * 2 + qoff); pk[k] = *(const v4u*)(uq + adv + (size_t)(16 * k) * RIN * 2 + 2048 + qoff); }
                if (tid < 256) pv = *(const v4u*)(uv + adv + voff);
                ps = *(const v4u*)(us + (size_t)(c + 1) * 8192 + soff);
            }
            {
                const int blk = vcu + (cvp >> 1) * G;
                CS.have = blk < CV_BLKS;
                if (CS.have) { const CvMini m0 = cv_decode(P, blk, 2 * (cvp & 1)), m1 = cv_decode(P, blk, 2 * (cvp & 1) + 1);
                    cv_load(m0, CS.a, tid); cv_load(m1, CS.b, tid); CS.d0 = m0.dst; CS.l0 = m0.ldb; CS.k0 = m0.kg; CS.d1 = m1.dst; CS.l1 = m1.ldb; CS.k1 = m1.kg; ++cvp; }
            }
            f32x4 a1 = (f32x4){0.f, 0.f, 0.f, 0.f}, a2 = (f32x4){0.f, 0.f, 0.f, 0.f}, a3 = (f32x4){0.f, 0.f, 0.f, 0.f};
#pragma unroll
            for (int s = 0; s < 2; ++s) {
                const bf16x8 a = *(const LAS bf16x8*)(lds + LS + (16 * nt + i) * SSTR + (32 * s + 8 * g) * 2);
                const int r0 = 32 * s + 8 * g + q, r1 = r0 + 4, cb = (16 * vt + 4 * p) * 2;
                const s16x4 lo = trld(lds + LV + r0 * 64 + (cb ^ (((r0 >> 3) & 1) << 5))), hi = trld(lds + LV + r1 * 64 + (cb ^ (((r1 >> 3) & 1) << 5)));
                a1 = __builtin_amdgcn_mfma_f32_16x16x32_bf16(cat8(lo, hi), a, a1, 0, 0, 0);
            }
#pragma unroll
            for (int s = 0; s < 8; ++s) {
                const bf16x8 a = *(const LAS bf16x8*)(lds + LQ + (16 * nt + i) * QSTR + (32 * s + 8 * g) * 2);
                const bf16x8 sf = *(const LAS bf16x8*)(lds + LST + (16 * vt + i) * QSTR + (32 * s + 8 * g) * 2);
                if (s & 1) a3 = __builtin_amdgcn_mfma_f32_16x16x32_bf16(sf, a, a3, 0, 0, 0);
                else a2 = __builtin_amdgcn_mfma_f32_16x16x32_bf16(sf, a, a2, 0, 0, 0);
            }
#pragma unroll
            for (int dt = 0; dt < 2; ++dt)
#pragma unroll
                for (int vv = 0; vv < 2; ++vv) st[dt][vv] = st[dt][vv] * cdec;
#pragma unroll
            for (int s = 0; s < 2; ++s) {
                const int r0 = 32 * s + 8 * g + q, r1 = r0 + 4;
                const int x0 = (r0 & 3) | (((r0 >> 3) & 1) << 2), x1 = (r1 & 3) | (((r1 >> 3) & 1) << 2);
                bf16x8 ka[2], vb[2];
#pragma unroll
                for (int dt = 0; dt < 2; ++dt) {
                    const int slot = 2 * wave + dt;
                    ka[dt] = cat8(trld(lds + LK + r0 * 512 + ((slot ^ x0) << 5) + 8 * p), trld(lds + LK + r1 * 512 + ((slot ^ x1) << 5) + 8 * p));
                }
#pragma unroll
                for (int vv = 0; vv < 2; ++vv) {
                    const int cb = (16 * vv + 4 * p) * 2;
                    vb[vv] = cat8(trld(lds + LVD + r0 * 64 + (cb ^ (((r0 >> 3) & 1) << 5))), trld(lds + LVD + r1 * 64 + (cb ^ (((r1 >> 3) & 1) << 5))));
                }
#pragma unroll
                for (int dt = 0; dt < 2; ++dt)
#pragma unroll
                    for (int vv = 0; vv < 2; ++vv) st[dt][vv] = __builtin_amdgcn_mfma_f32_16x16x32_bf16(ka[dt], vb[vv], st[dt][vv], 0, 0, 0);
            }
            {
                char* uo = (char*)(oret + ((size_t)b * SEQ + c * 64) * RVD + h * 512 + vs * 32);
                const unsigned ooff = (unsigned)((16 * nt + i) * RVD + 16 * vt + 4 * g) * 2u;
                float ov_[4];
#pragma unroll
                for (int r = 0; r < 4; ++r) ov_[r] = a1[r] + qdl * (a2[r] + a3[r]);
                u32x2 w_; w_.x = pk2(ov_[0], ov_[1]); w_.y = pk2(ov_[2], ov_[3]);
                *(u32x2*)(uo + ooff) = w_;
            }
            if (cv_emit_now) { cv_emit(ed0, el0, cimg0, wave, lane); cv_emit(ed1, el1, cimg1, wave, lane); }
            SCAN_LBAR();
#pragma unroll
            for (int dt = 0; dt < 2; ++dt)
#pragma unroll
                for (int vv = 0; vv < 2; ++vv)
                    *(LAS u32x2*)(lds + LST + (16 * vv + i) * QSTR + (32 * wave + 16 * dt + 4 * g) * 2) = (u32x2){pk2(st[dt][vv][0], st[dt][vv][1]), pk2(st[dt][vv][2], st[dt][vv][3])};
        };
        for (int c = 0; c < 64; c += 2) { scan_step(c, cs0); scan_step(c + 1, cs1); }
        WG_BAR();
    }
    for (;;) {
        bool any = false;
#pragma unroll
        for (int k = 0; k < 2; ++k) {
            CvSet& CS = k ? cs1 : cs0;
            unsigned char* ed0 = CS.d0; unsigned char* ed1 = CS.d1; const int el0 = CS.l0, el1 = CS.l1; const bool emit_now = CS.have;
            if (CS.have) { cv_commit(CS.a, CS.k0, gtab, cimg0, tid); cv_commit(CS.b, CS.k1, gtab, cimg1, tid); }
            WG_BAR();
            const int blk = vcu + (cvp >> 1) * G;
            CS.have = blk < CV_BLKS;
            if (CS.have) { const CvMini m0 = cv_decode(P, blk, 2 * (cvp & 1)), m1 = cv_decode(P, blk, 2 * (cvp & 1) + 1);
                cv_load(m0, CS.a, tid); cv_load(m1, CS.b, tid); CS.d0 = m0.dst; CS.l0 = m0.ldb; CS.k0 = m0.kg; CS.d1 = m1.dst; CS.l1 = m1.ldb; CS.k1 = m1.kg; ++cvp; }
            if (emit_now) { cv_emit(ed0, el0, cimg0, wave, lane); cv_emit(ed1, el1, cimg1, wave, lane); }
            WG_BAR();
            any = any || emit_now || CS.have;
        }
        if (!any) break;
    }
#undef SCAN_LBAR
}

__device__ __forceinline__ void norm_gate_phase(const bf16* oret, const bf16* proj, bf16* ro, int vcu, int G) {
    PHASE_IDS();
    const int gw = vcu * NWAVES + wave, NGW = G * NWAVES;
    v4u nov[4], ngv[4];
#pragma unroll
    for (int h = 0; h < 4; ++h) {
        nov[h] = *(const v4u*)(oret + (size_t)gw * RVD + h * 512 + lane * 8);
        ngv[h] = *(const v4u*)(proj + (size_t)gw * RIN + 4096 + h * 512 + lane * 8);
    }
    for (int row = gw; row < M; row += NGW) {
        v4u ov[4], gv[4];
#pragma unroll
        for (int h = 0; h < 4; ++h) { ov[h] = nov[h]; gv[h] = ngv[h]; }
        if (row + NGW < M) {
#pragma unroll
            for (int h = 0; h < 4; ++h) {
                nov[h] = *(const v4u*)(oret + (size_t)(row + NGW) * RVD + h * 512 + lane * 8);
                ngv[h] = *(const v4u*)(proj + (size_t)(row + NGW) * RIN + 4096 + h * 512 + lane * 8);
            }
        }
        float o[4][8], mu[4], rstd[4];
#pragma unroll
        for (int h = 0; h < 4; ++h) {
            o[h][0] = bflo(ov[h].x); o[h][1] = bfhi(ov[h].x); o[h][2] = bflo(ov[h].y); o[h][3] = bfhi(ov[h].y); o[h][4] = bflo(ov[h].z); o[h][5] = bfhi(ov[h].z); o[h][6] = bflo(ov[h].w); o[h][7] = bfhi(ov[h].w);
            float s = 0.f;
#pragma unroll
            for (int j = 0; j < 8; ++j) s += o[h][j];
            mu[h] = s;
        }
#pragma unroll
        for (int h = 0; h < 4; ++h) mu[h] = wave_sum(mu[h]) * (1.0f / 512.0f);
#pragma unroll
        for (int h = 0; h < 4; ++h) {
            float s2 = 0.f;
#pragma unroll
            for (int j = 0; j < 8; ++j) { o[h][j] -= mu[h]; s2 += o[h][j] * o[h][j]; }
            rstd[h] = s2;
        }
#pragma unroll
        for (int h = 0; h < 4; ++h) rstd[h] = __builtin_amdgcn_rsqf(wave_sum(rstd[h]) * (1.0f / 512.0f) + EPS);
#pragma unroll
        for (int h = 0; h < 4; ++h) {
            const float gg[8] = {bflo(gv[h].x), bfhi(gv[h].x), bflo(gv[h].y), bfhi(gv[h].y), bflo(gv[h].z), bfhi(gv[h].z), bflo(gv[h].w), bfhi(gv[h].w)};
            float y[8];
#pragma unroll
            for (int j = 0; j < 8; ++j) y[j] = o[h][j] * rstd[h] * silu_f(gg[j]);
            v4u w; w.x = pk2(y[0], y[1]); w.y = pk2(y[2], y[3]); w.z = pk2(y[4], y[5]); w.w = pk2(y[6], y[7]);
            *(v4u*)(ro + (size_t)row * RVD + h * 512 + lane * 8) = w;
        }
    }
}
}

namespace dat {
constexpr int LK0 = 0  , LV0 = 32768  , LWS = 81920  , LCB = 0  , CSTR = 132;
__device__ __forceinline__ int crow(int r, int hi) { return (r & 3) + 8 * (r >> 2) + 4 * hi; }
__device__ __forceinline__ float half_swap_max(float m) { auto rr = __builtin_amdgcn_permlane32_swap(__float_as_uint(m), __float_as_uint(m), false, false); return fmaxf(__uint_as_float(rr[0]), __uint_as_float(rr[1])); }
__device__ __forceinline__ float half_swap_sum(float m) { auto rr = __builtin_amdgcn_permlane32_swap(__float_as_uint(m), __float_as_uint(m), false, false); return __uint_as_float(rr[0]) + __uint_as_float(rr[1]); }
typedef float f32x2_t __attribute__((ext_vector_type(2))); typedef __bf16 bf16x2_t __attribute__((ext_vector_type(2)));
__device__ __forceinline__ unsigned cvtpk(float lo, float hi) { f32x2_t v = {lo, hi}; bf16x2_t b2 = __builtin_convertvector(v, bf16x2_t); return __builtin_bit_cast(unsigned, b2); }
__device__ __forceinline__ float max3f(float a, float b, float c) { float r; asm("v_max3_f32 %0, %1, %2, %3" : "=v"(r) : "v"(a), "v"(b), "v"(c)); return r; }
__device__ __forceinline__ float fadd_s(float a, float b) { float r; asm("v_add_f32_e32 %0, %1, %2" : "=v"(r) : "v"(a), "v"(b)); return r; }

#define DAT_SBAR() __builtin_amdgcn_sched_barrier(0)
#define DAT_PIN(x) asm volatile("" : "+v"(x))
__device__ __forceinline__ void attn_unit(int b, int h, int qb, const bf16* kvq, bf16* ao, LAS unsigned char* lds, float lam, int wave, int lane, int tid) {
    const int r32 = lane & 31, hi = lane >> 5, comp = wave >> 2, w4 = wave & 3;
    const size_t rowbase = (size_t)b * SEQ;
    const int q0 = qb * 128;
    const int NT = 2 * qb + 2, ntw = 2 * qb + 1 + (w4 >> 1);
    const bf16* Kh = kvq + rowbase * KVQ_N + h * 128;
    const bf16* Vh = kvq + rowbase * KVQ_N + 1024 + h * 128;
    const bf16* Qw = kvq + (rowbase + q0 + w4 * 32) * KVQ_N + 2048 + h * 128 + comp * 64;
    LAS float* wsf = (LAS float*)(lds + LWS) + wave * 64;
    const int pkey = 4 * wave + (lane >> 4), pc = lane & 15;
    const unsigned kvoff = (unsigned)(pkey * KVQ_N + ((pc ^ (pkey & 15)) << 3)) * 2u;
    const unsigned vvoff = (unsigned)(pkey * KVQ_N + ((pc ^ ((pkey & 3) << 2)) << 3)) * 2u;
    const int koff0 = r32 * 256 + (((comp * 8 + hi) ^ (r32 & 15)) << 4);
    const int voff0 = (4 * hi + ((lane & 15) >> 2)) * 256 + ((((lane & 15) >> 2) << 6) | ((4 * ((lane >> 4) & 1) + (lane & 3)) << 3));
#define koffd(d) (koff0 ^ ((d) << 5))
#define voffd(d) (voff0 ^ ((d) << 6))
    const unsigned ldsb = (unsigned)(size_t)lds;
#define DAT_GLDS(base, voff, dst) do { unsigned keep_; asm volatile("s_mov_b32 %0, m0\n\ts_mov_b32 m0, %3\n\ts_nop 0\n\tglobal_load_lds_dwordx4 %1, %2\n\ts_mov_b32 m0, %0" : "=&s"(keep_) : "v"(voff), "s"(base), "s"(dst) : "memory"); } while (0)
#define DAT_DMA(t, kslot, vslot) do { const bf16* kb0_ = Kh + (size_t)(t) * 64 * KVQ_N; const bf16* vb0_ = Vh + (size_t)(t) * 64 * KVQ_N; \
        const unsigned kd_ = (unsigned)__builtin_amdgcn_readfirstlane(ldsb + LK0 + (kslot) * 16384 + wave * 1024), vd_ = (unsigned)__builtin_amdgcn_readfirstlane(ldsb + LV0 + (vslot) * 16384 + wave * 1024); \
        DAT_GLDS(kb0_, kvoff, kd_); DAT_GLDS(kb0_ + (size_t)32 * KVQ_N, kvoff, kd_ + 8192u); DAT_GLDS(vb0_, vvoff, vd_); DAT_GLDS(vb0_ + (size_t)32 * KVQ_N, vvoff, vd_ + 8192u); } while (0)
    DAT_DMA(0, 0, 0);
    bf16x8 qr[4];
#pragma unroll
    for (int d0 = 0; d0 < 4; ++d0) qr[d0] = *(const bf16x8*)(Qw + (size_t)r32 * KVQ_N + d0 * 16 + hi * 8);
    asm volatile("" : "+v"(qr[0]), "+v"(qr[1]), "+v"(qr[2]), "+v"(qr[3]));
    f32x16 o[4];
#pragma unroll
    for (int d = 0; d < 4; ++d)
#pragma unroll
        for (int r = 0; r < 16; ++r) o[d][r] = 0.f;
    float mrun = 0.f, lrun = 0.f;
    f32x16 negm;
#pragma unroll
    for (int r = 0; r < 16; ++r) negm[r] = 0.f;
    f32x16 C0, C1;
    v4u pw[4];
    int vsl_prev = 0, vsl_cur = 0;
    bool resc = false;
#define DAT_DECIDE(FIRST) do { \
        float ra_ = max3f(C0[0], C0[1], C1[0]), rb_ = max3f(C0[2], C0[3], C1[1]); ra_ = max3f(ra_, C1[2], C1[3]); \
        _Pragma("unroll") for (int r = 4; r < 16; r += 4) { ra_ = max3f(ra_, C0[r], C0[r + 1]); rb_ = max3f(rb_, C0[r + 2], C0[r + 3]); ra_ = max3f(ra_, C1[r], C1[r + 1]); rb_ = max3f(rb_, C1[r + 2], C1[r + 3]); } \
        const float rm_ = half_swap_max(max3f(ra_, rb_, rb_)); \
        if ((FIRST) || __any(rm_ > 8.0f)) { \
            const float dl_ = (FIRST) ? rm_ : fmaxf(rm_, 0.f); const float f_ = fast_exp2(-dl_); \
            lrun *= f_; mrun += dl_; if (hi == 0) wsf[r32] = f_; \
            _Pragma("unroll") for (int r = 0; r < 16; ++r) { C0[r] -= dl_; C1[r] -= dl_; negm[r] = -mrun; } \
            resc = !(FIRST); } } while (0)
#define DAT_RESC() do { if (resc) { asm volatile("s_waitcnt lgkmcnt(0)" ::: "memory"); \
        _Pragma("unroll") for (int r = 0; r < 16; ++r) { const float fr_ = wsf[crow(r, hi)]; _Pragma("unroll") for (int d = 0; d < 4; ++d) o[d][r] *= fr_; } resc = false; } } while (0)
#define DAT_VRD(dst_lo, dst_hi, j) do { dst_lo = ret::trld(Vb_ + voffd((j) >> 2) + ((j) & 3) * 4096); dst_hi = ret::trld(Vb_ + voffd((j) >> 2) + ((j) & 3) * 4096 + 2048); } while (0)
#define DAT_QK(t_, DO_, tn_) do { LAS const unsigned char* Kb_ = lds + LK0 + ((t_) & 1) * 16384; \
        const bf16* kb0_ = Kh + (size_t)(tn_) * 64 * KVQ_N; const bf16* vb0_ = Vh + (size_t)(tn_) * 64 * KVQ_N; const unsigned kd_ = (unsigned)__builtin_amdgcn_readfirstlane(ldsb + LK0 + ((tn_) & 1) * 16384 + wave * 1024), vd_ = (unsigned)__builtin_amdgcn_readfirstlane(ldsb + LV0 + ((tn_) % 3) * 16384 + wave * 1024); \
        bf16x8 ka_ = *(const LAS bf16x8*)(Kb_ + koffd(0)), kb_ = *(const LAS bf16x8*)(Kb_ + koffd(0) + 8192), kc_ = *(const LAS bf16x8*)(Kb_ + koffd(1)), kd2_ = *(const LAS bf16x8*)(Kb_ + koffd(1) + 8192); \
        DAT_SBAR(); \
        C0 = __builtin_amdgcn_mfma_f32_32x32x16_bf16(ka_, qr[0], negm, 0, 0, 0); C1 = __builtin_amdgcn_mfma_f32_32x32x16_bf16(kb_, qr[0], negm, 0, 0, 0); \
        ka_ = *(const LAS bf16x8*)(Kb_ + koffd(2)); kb_ = *(const LAS bf16x8*)(Kb_ + koffd(2) + 8192); if (DO_) DAT_GLDS(kb0_, kvoff, kd_); DAT_SBAR(); \
        C0 = __builtin_amdgcn_mfma_f32_32x32x16_bf16(kc_, qr[1], C0, 0, 0, 0); C1 = __builtin_amdgcn_mfma_f32_32x32x16_bf16(kd2_, qr[1], C1, 0, 0, 0); \
        kc_ = *(const LAS bf16x8*)(Kb_ + koffd(3)); kd2_ = *(const LAS bf16x8*)(Kb_ + koffd(3) + 8192); if (DO_) DAT_GLDS(kb0_ + (size_t)32 * KVQ_N, kvoff, kd_ + 8192u); DAT_SBAR(); \
        C0 = __builtin_amdgcn_mfma_f32_32x32x16_bf16(ka_, qr[2], C0, 0, 0, 0); C1 = __builtin_amdgcn_mfma_f32_32x32x16_bf16(kb_, qr[2], C1, 0, 0, 0); \
        if (DO_) DAT_GLDS(vb0_, vvoff, vd_); DAT_SBAR(); \
        C0 = __builtin_amdgcn_mfma_f32_32x32x16_bf16(kc_, qr[3], C0, 0, 0, 0); C1 = __builtin_amdgcn_mfma_f32_32x32x16_bf16(kd2_, qr[3], C1, 0, 0, 0); \
        if (DO_) DAT_GLDS(vb0_ + (size_t)32 * KVQ_N, vvoff, vd_ + 8192u); DAT_SBAR(); \
        asm volatile("s_nop 15\n\ts_nop 7" : "+v"(C0), "+v"(C1)); } while (0)
    {
        WG_BAR();
        DAT_QK(0, true, 1);
        DAT_DECIDE(true);
        float s0_ = 0.f, s1_ = 0.f;
#pragma unroll
        for (int j = 0; j < 16; ++j) {
            const float e0_ = fast_exp2(j < 8 ? C0[2 * (j & 7)] : C1[2 * (j & 7)]), e1_ = fast_exp2(j < 8 ? C0[2 * (j & 7) + 1] : C1[2 * (j & 7) + 1]);
            s0_ += e0_; s1_ += e1_; pw[j >> 2][j & 3] = cvtpk(e0_, e1_);
        }
        lrun += s0_ + s1_;
        vsl_prev = 0; vsl_cur = 16384;
    }
#define DAT_STEADY(t_, PWa, PWb) do { \
        WG_BAR(); \
        const bool dma_ = ((t_) + 1 < NT); \
        LAS const unsigned char* Vb_ = lds + LV0 + vsl_prev; \
        s16x4 vl_[4], vh_[4]; \
        _Pragma("unroll") for (int j = 0; j < 4; ++j) DAT_VRD(vl_[j], vh_[j], j); \
        DAT_QK(t_, dma_, (t_) + 1); \
        DAT_DECIDE(false); \
        const bf16x8 pa_[4] = {__builtin_bit_cast(bf16x8, PWa[0]), __builtin_bit_cast(bf16x8, PWa[1]), __builtin_bit_cast(bf16x8, PWa[2]), __builtin_bit_cast(bf16x8, PWa[3])}; \
        float ssum_ = 0.f; \
        DAT_SBAR(); \
        _Pragma("unroll") for (int j = 0; j < 16; ++j) { \
            o[j >> 2] = __builtin_amdgcn_mfma_f32_32x32x16_bf16(pa_[j & 3], ret::cat8(vl_[j & 3], vh_[j & 3]), o[j >> 2], 0, 0, 0); \
            if (j + 4 < 16) DAT_VRD(vl_[j & 3], vh_[j & 3], j + 4); \
            { const float e0_ = fast_exp2(j < 8 ? C0[2 * (j & 7)] : C1[2 * (j & 7)]), e1_ = fast_exp2(j < 8 ? C0[2 * (j & 7) + 1] : C1[2 * (j & 7) + 1]); \
              ssum_ += e0_; ssum_ += e1_; PWb[j >> 2][j & 3] = cvtpk(e0_, e1_); } \
            DAT_PIN(ssum_); DAT_SBAR(); \
        } \
        DAT_RESC(); \
        lrun += ssum_; \
        vsl_prev = vsl_cur; vsl_cur = (vsl_cur == 32768) ? 0 : vsl_cur + 16384; \
    } while (0)
    v4u pq_[4];
    int t = 1;
    for (; t + 1 < ntw; t += 2) { DAT_STEADY(t, pw, pq_); DAT_STEADY(t + 1, pq_, pw); }
    for (; t <= NT; ++t) {
        if (t < ntw) { DAT_STEADY(t, pw, pq_); pw[0] = pq_[0]; pw[1] = pq_[1]; pw[2] = pq_[2]; pw[3] = pq_[3]; }
        else {
            WG_BAR();
            const bool dma_ = (t + 1 < NT);
            LAS const unsigned char* Vb_ = lds + LV0 + vsl_prev;
            if (dma_) { const int tn_ = t + 1; DAT_DMA(tn_, tn_ & 1, tn_ % 3); }
            if (t == ntw) {
            const bf16x8 pa_[4] = {__builtin_bit_cast(bf16x8, pw[0]), __builtin_bit_cast(bf16x8, pw[1]), __builtin_bit_cast(bf16x8, pw[2]), __builtin_bit_cast(bf16x8, pw[3])};
#pragma unroll
            for (int d = 0; d < 4; ++d)
#pragma unroll
                for (int ks = 0; ks < 4; ++ks) {
                    const s16x4 lo_ = ret::trld(Vb_ + voffd(d) + ks * 4096), hh_ = ret::trld(Vb_ + voffd(d) + ks * 4096 + 2048);
                    o[d] = __builtin_amdgcn_mfma_f32_32x32x16_bf16(pa_[ks], ret::cat8(lo_, hh_), o[d], 0, 0, 0);
                }
            }
            vsl_prev = vsl_cur; vsl_cur = (vsl_cur == 32768) ? 0 : vsl_cur + 16384;
        }
    }
#undef DAT_STEADY
#undef DAT_QK
#undef DAT_VRD
#undef DAT_RESC
#undef DAT_DECIDE
#undef DAT_DMA
#undef DAT_GLDS
#undef koffd
#undef voffd
    {
        const float lt = half_swap_sum(lrun);
        if (hi == 0) wsf[r32] = (comp ? lam : 1.0f) * fast_rcp(lt);
        asm volatile("s_waitcnt lgkmcnt(0)" ::: "memory");
#pragma unroll
        for (int r = 0; r < 16; ++r) { const float fr_ = wsf[crow(r, hi)];
#pragma unroll
            for (int d = 0; d < 4; ++d) o[d][r] *= fr_; }
    }
    WG_BAR();
    LAS float* cb = (LAS float*)(lds + LCB);
    if (comp == 1) {
#pragma unroll
        for (int d = 0; d < 4; ++d)
#pragma unroll
            for (int r = 0; r < 16; ++r) cb[(w4 * 32 + crow(r, hi)) * CSTR + d * 32 + r32] = o[d][r];
    }
    WG_BAR();
    if (comp == 0) {
#pragma unroll
        for (int d = 0; d < 4; ++d)
#pragma unroll
            for (int r = 0; r < 16; ++r) { LAS float* pc = cb + (w4 * 32 + crow(r, hi)) * CSTR + d * 32 + r32; *pc = o[d][r] - *pc; }
    }
    WG_BAR();
    {
        const int row = tid >> 2, part = tid & 3;
        const LAS f32x4* src = (const LAS f32x4*)(cb + row * CSTR + part * 32);
        f32x4 v[8]; float ss = 0.f;
#pragma unroll
        for (int j = 0; j < 8; ++j) { v[j] = src[j]; ss += (v[j][0] * v[j][0] + v[j][1] * v[j][1]) + (v[j][2] * v[j][2] + v[j][3] * v[j][3]); }
        ss += SWZ_XOR(ss, 1); ss += SWZ_XOR(ss, 2);
        const float rstd = __builtin_amdgcn_rsqf(ss * (1.0f / 128.0f) + EPS);
        bf16* dst = ao + (rowbase + q0 + row) * D + h * 128 + part * 32;
#pragma unroll
        for (int j = 0; j < 4; ++j) {
            v4u w; w.x = pk2(v[2 * j][0] * rstd, v[2 * j][1] * rstd); w.y = pk2(v[2 * j][2] * rstd, v[2 * j][3] * rstd);
            w.z = pk2(v[2 * j + 1][0] * rstd, v[2 * j + 1][1] * rstd); w.w = pk2(v[2 * j + 1][2] * rstd, v[2 * j + 1][3] * rstd);
            *(v4u*)(dst + 8 * j) = w;
        }
    }
    WG_BAR();
}

__device__ __forceinline__ void attn_phase(const bf16* kvq, bf16* ao, LAS unsigned char* lds, const float* lq1, const float* lk1, const float* lq2, const float* lk2, float lambda_init, int vcu, int G) {
    PHASE_IDS();
    const float lam = __expf(wave_sum(lq1[lane] * lk1[lane])) - __expf(wave_sum(lq2[lane] * lk2[lane])) + lambda_init;
    const int nun = (G == 256) ? 4 : (1024 - vcu + G - 1) / G;
#pragma unroll 1
    for (int i = 0; i < nun; ++i) {
        int bh, qb;
        if (G == 256) { const int x = vcu >> 5, w = vcu & 31, j = (w + 16) & 31; bh = 4 * x + i; qb = (i == 0) ? w : (i == 1) ? 31 - w : (i == 2) ? j : 31 - j; }
        else { const int u = vcu + i * G; bh = u >> 5; qb = u & 31; }
        attn_unit(bh >> 3, bh & 7, qb, kvq, ao, lds, lam, wave, lane, tid);
    }
}
}

__device__ __forceinline__ void route_a(const bf16* xb, const float* rwt, int* tope, float* topw, int* topr, float* tokr, int* cnt, unsigned char* xn8, LAS unsigned char* lds, int vcu, int G) {
    PHASE_IDS();
    LAS int* sel = (LAS int*)(lds + 32768);
    LAS float* selw = (LAS float*)(lds + 32768 + 512);
    LAS float* selr = (LAS float*)(lds + 32768 + 1024);
    f32x4 wreg[NE][2][2];
#pragma unroll
    for (int e = 0; e < NE; ++e)
#pragma unroll
        for (int j = 0; j < 2; ++j)
#pragma unroll
            for (int h = 0; h < 2; ++h) wreg[e][j][h] = ((const f32x4*)rwt)[e * 256 + 2 * (lane + 64 * j) + h];
    for (int tb = vcu; tb < M / 64; tb += G) {
        v4u q0[2], q1[2], q2[2], q3[2];
        { const v4u* xr = (const v4u*)(xb + (size_t)(tb * 64 + wave * 8) * D) + lane;
          q0[0] = xr[0]; q0[1] = xr[64]; q1[0] = xr[128]; q1[1] = xr[192]; q2[0] = xr[256]; q2[1] = xr[320]; q3[0] = xr[384]; q3[1] = xr[448]; }
#pragma unroll 1
        for (int tk = 0; tk < 8; ++tk) {
            const int tl = wave * 8 + tk, row = tb * 64 + tl;
            const v4u nv[2] = {q0[0], q0[1]};
            q0[0] = q1[0]; q0[1] = q1[1]; q1[0] = q2[0]; q1[1] = q2[1]; q2[0] = q3[0]; q2[1] = q3[1];
            { const int rn = tb * 64 + wave * 8 + (tk + 4 < 8 ? tk + 4 : 7);
              const v4u* xr = (const v4u*)(xb + (size_t)rn * D) + lane; q3[0] = xr[0]; q3[1] = xr[64]; }
            f32x4 v[2][2]; float ss = 0.f;
#pragma unroll
            for (int j = 0; j < 2; ++j) {
                v[j][0] = (f32x4){bflo(nv[j].x), bfhi(nv[j].x), bflo(nv[j].y), bfhi(nv[j].y)}; v[j][1] = (f32x4){bflo(nv[j].z), bfhi(nv[j].z), bflo(nv[j].w), bfhi(nv[j].w)};
#pragma unroll
                for (int h = 0; h < 2; ++h) ss += (v[j][h][0] * v[j][h][0] + v[j][h][1] * v[j][h][1]) + (v[j][h][2] * v[j][h][2] + v[j][h][3] * v[j][h][3]);
            }
            ss = wave_sum(ss);
            const float r = __builtin_amdgcn_rsqf(ss * (1.0f / 1024.0f) + EPS);
#pragma unroll
            for (int j = 0; j < 2; ++j) {
                u32x2 w = {0u, 0u};
                w.x = __builtin_amdgcn_cvt_pk_fp8_f32(v[j][0][0] * r, v[j][0][1] * r, w.x, false); w.x = __builtin_amdgcn_cvt_pk_fp8_f32(v[j][0][2] * r, v[j][0][3] * r, w.x, true);
                w.y = __builtin_amdgcn_cvt_pk_fp8_f32(v[j][1][0] * r, v[j][1][1] * r, w.y, false); w.y = __builtin_amdgcn_cvt_pk_fp8_f32(v[j][1][2] * r, v[j][1][3] * r, w.y, true);
                ((u32x2*)(xn8 + (size_t)row * D))[lane + 64 * j] = w;
            }
            float lg[NE];
            {
                float pa[NE];
#pragma unroll
                for (int e = 0; e < NE; ++e) {
                    float a = 0.f;
#pragma unroll
                    for (int j = 0; j < 2; ++j)
#pragma unroll
                        for (int h = 0; h < 2; ++h) { const f32x4 w = wreg[e][j][h]; a += (v[j][h][0] * w[0] + v[j][h][1] * w[1]) + (v[j][h][2] * w[2] + v[j][h][3] * w[3]); }
                    pa[e] = a;
                }
                const float dsum = wave_sum8(pa, lane);
#pragma unroll
                for (int e = 0; e < NE; ++e) lg[e] = __int_as_float(__builtin_amdgcn_readlane(__float_as_int(dsum), wsum8_lane(e))) * r;
            }
            int e1 = 0; float v1 = lg[0];
#pragma unroll
            for (int e = 1; e < NE; ++e) if (lg[e] > v1) { v1 = lg[e]; e1 = e; }
            int e2 = -1; float v2 = -3.0e38f;
#pragma unroll
            for (int e = 0; e < NE; ++e) if (e != e1 && lg[e] > v2) { v2 = lg[e]; e2 = e; }
            const float w1 = fast_rcp(1.0f + __expf(v2 - v1)), w2 = 1.0f - w1;
            if (lane == 0) { sel[tl * 2] = e1; sel[tl * 2 + 1] = e2; selw[tl * 2] = w1; selw[tl * 2 + 1] = w2; selr[tl] = r; }
        }
        asm volatile("s_waitcnt lgkmcnt(0)" ::: "memory"); __builtin_amdgcn_s_barrier(); asm volatile("" ::: "memory");
        if (wave == 1) {
            const int row = tb * 64 + lane;
            *(u32x2*)(tope + row * 2) = (u32x2){(unsigned)sel[2 * lane], (unsigned)sel[2 * lane + 1]};
            *(u32x2*)(topw + row * 2) = (u32x2){__float_as_uint(selw[2 * lane]), __float_as_uint(selw[2 * lane + 1])};
            tokr[row] = selr[lane];
        }
        if (wave == 0) {
            const int e0 = sel[2 * lane], e1 = sel[2 * lane + 1];
            const unsigned long long below = (1ull << lane) - 1ull;
            int r0 = 0, r1 = 0, mycnt = 0;
#pragma unroll
            for (int e = 0; e < NE; ++e) {
                const unsigned long long m0 = __ballot(e0 == e), m1 = __ballot(e1 == e);
                const int before = __builtin_popcountll(m0 & below) + __builtin_popcountll(m1 & below);
                if (e0 == e) r0 = before;
                if (e1 == e) r1 = before + (e0 == e ? 1 : 0);
                if (lane == e) mycnt = __builtin_popcountll(m0) + __builtin_popcountll(m1);
            }
            *(u32x2*)(topr + (tb * 64 + lane) * 2) = (u32x2){(unsigned)r0, (unsigned)r1};
            if (lane < NE) cnt[tb * NE + lane] = mycnt;
        }
        asm volatile("s_waitcnt lgkmcnt(0)" ::: "memory"); __builtin_amdgcn_s_barrier(); asm volatile("" ::: "memory");
    }
}
__device__ __forceinline__ void route_b(const unsigned char* xn8, const int* tope, const float* topw, const int* topr, const float* tokr, const int* cnt, unsigned char* xg, int* rowinfo, float* rowgate, float* rowr,
                                        LAS unsigned char* lds, LAS int* ldsctl, int vcu, int G) {
    PHASE_IDS();
    LAS int* ct = (LAS int*)lds;
    LAS int* tot = (LAS int*)(lds + 8192);
    for (int k = tid; k < 256 * NE; k += NTHREADS) ct[k] = cnt[k];
    WG_BAR();
    if (tid < NE) { int run = 0; for (int tb = 0; tb < 256; ++tb) { const int c = ct[tb * NE + tid]; ct[tb * NE + tid] = run; run += c; } tot[tid] = run; }
    WG_BAR();
    if (tid == 0) {
        int ts = 0;
        for (int e = 0; e < NE; ++e) { ldsctl[16 + e] = ts; tot[8 + e] = ts * 256; ts += (tot[e] + 255) >> 8; }
        ldsctl[24] = ts; ldsctl[25] = ts;
    }
    WG_BAR();
    for (int tb = vcu; tb < M / 64; tb += G) {
        int mypos = 0;
        {
            const int idx = wave * 16 + (lane & 15), tl = idx >> 1, slot = idx & 1, row = tb * 64 + tl;
            const int e = tope[row * 2 + slot];
            mypos = tot[8 + e] + ct[tb * NE + e] + topr[row * 2 + slot];
            if (lane < 16) { rowinfo[mypos] = slot * M + row; rowgate[mypos] = topw[row * 2 + slot]; rowr[mypos] = tokr[row]; }
        }
        v4u rowsv[8];
#pragma unroll
        for (int k = 0; k < 8; ++k) rowsv[k] = *((const v4u*)(xn8 + (size_t)(tb * 64 + wave * 8 + k) * D) + lane);
#pragma unroll
        for (int k = 0; k < 16; ++k) { const int pos = __builtin_amdgcn_readlane(mypos, k); *((v4u*)(xg + (size_t)pos * D) + lane) = rowsv[k >> 1]; }
    }
    for (int e = vcu; e < NE; e += G) {
        const int beg = tot[8 + e] + tot[e], end = tot[8 + e] + (((tot[e] + 255) >> 8) << 8);
        for (int pos = beg + wave; pos < end; pos += NWAVES) {
            *((v4u*)(xg + (size_t)pos * D) + lane) = (v4u){0u, 0u, 0u, 0u};
            if (lane == 0) { rowinfo[pos] = -1; rowgate[pos] = 0.f; rowr[pos] = 0.f; }
        }
    }
}
__device__ __forceinline__ void final_phase(const bf16* xb, const bf16* y, const float* fn, float* out, int vcu, int G) {
    PHASE_IDS();
    const int gw = vcu * NWAVES + wave, NGW = G * NWAVES;
    f32x4 gn[4];
#pragma unroll
    for (int j = 0; j < 4; ++j) gn[j] = ((const f32x4*)fn)[lane + 64 * j];
    for (int m0 = gw; m0 < M; m0 += 2 * NGW) {
        f32x4 v[2][4]; float ss[2]; bool ok[2];
#pragma unroll
        for (int k = 0; k < 2; ++k) {
            const int m = m0 + k * NGW; ok[k] = m < M; ss[k] = 0.f;
            if (ok[k]) {
                const u32x2* xr = (const u32x2*)(xb + (size_t)m * D) + lane;
                const u32x2* y0 = (const u32x2*)(y + (size_t)m * D) + lane;
                const u32x2* y1 = (const u32x2*)(y + (size_t)(M + m) * D) + lane;
#pragma unroll
                for (int j = 0; j < 4; ++j) {
                    const u32x2 a = y0[64 * j], b2 = y1[64 * j], x0 = xr[64 * j];
                    v[k][j] = (f32x4){bflo(x0.x) + (bflo(a.x) + bflo(b2.x)), bfhi(x0.x) + (bfhi(a.x) + bfhi(b2.x)), bflo(x0.y) + (bflo(a.y) + bflo(b2.y)), bfhi(x0.y) + (bfhi(a.y) + bfhi(b2.y))};
                    ss[k] += (v[k][j][0] * v[k][j][0] + v[k][j][1] * v[k][j][1]) + (v[k][j][2] * v[k][j][2] + v[k][j][3] * v[k][j][3]);
                }
            }
        }
#pragma unroll
        for (int k = 0; k < 2; ++k) ss[k] = wave_sum(ss[k]);
#pragma unroll
        for (int k = 0; k < 2; ++k) if (ok[k]) {
            const float r = __builtin_amdgcn_rsqf(ss[k] * (1.0f / 1024.0f) + EPS);
            f32x4* orow = (f32x4*)(out + (size_t)(m0 + k * NGW) * D) + lane;
#pragma unroll
            for (int j = 0; j < 4; ++j) orow[64 * j] = v[k][j] * r * gn[j];
        }
    }
}
struct Args { Ptrs p; };
static_assert(sizeof(Args) == 22 * 8, "Args has no padding");

__global__ void __launch_bounds__(NTHREADS, 2) yoco_fwd(Args args) {
    extern __shared__ __attribute__((aligned(16))) unsigned char lds_raw[];
    LAS unsigned char* lds = (LAS unsigned char*)lds_raw;
    const Ptrs& P = args.p;
    unsigned char* ws = P.ws;

    const int G = gridDim.x; const int bx = blockIdx.x;
    const int vcu = (G % 8 == 0) ? (bx % 8) * (G / 8) + bx / 8 : bx;
    LAS int* ldsctl = (LAS int*)(lds + LDSCTL_OFF);
    for (int k = threadIdx.x; k < (LDS_BYTES - LDSCTL_OFF) / 4; k += NTHREADS) ldsctl[k] = 0;
    __syncthreads();
    XcdBarrier bar = xcd_barrier_post((unsigned*)(ws + WS_CTL) + CW_BAR, (volatile LAS unsigned*)ldsctl);

    bf16* XB = (bf16*)(ws + WS_XB); float* SSP = (float*)(ws + WS_SSP);
    bf16* PROJ = (bf16*)(ws + WS_PROJ); bf16* KVQ = (bf16*)(ws + WS_KVQ);

    const float lambda_init = 0.8f - 0.6f * 0.7408182206817179f;

    p0_prologue(P, lds, vcu, G, lambda_init);
    xcd_barrier(bar);

    {
        pg8::Gemm g{XB, (const bf16*)(ws + WS_W_IN), M, RIN, D}; pg8::StaticOrder S; S.init(M, RIN, G, bx);
        pg8::EpiInProj E{PROJ, SSP, (const float*)(ws + WS_RCOS), (const float*)(ws + WS_RSIN)};
        pg8::gemm_phase<pg8::EpiInProj, pg8::StaticOrder, true, true>(lds, g, S, E);
    }
    xcd_barrier(bar);
    ret::scores_phase(PROJ, (bf16*)(ws + WS_S), lds, vcu, G);
    xcd_barrier(bar);
    ret::scan_phase(P, PROJ, (const bf16*)(ws + WS_S), (bf16*)(ws + WS_ORET), lds, vcu, G);
    xcd_barrier(bar);
    ret::norm_gate_phase((const bf16*)(ws + WS_ORET), PROJ, (bf16*)(ws + WS_RO), vcu, G);
    xcd_barrier(bar);
    {
        pg8::Gemm g{(const bf16*)(ws + WS_RO), (const bf16*)(ws + WS_W_RO), M, D, RVD}; pg8::StaticOrder S; S.init(M, D, G, bx);
        pg8::EpiResid<true> E{P.x, XB, SSP};
        pg8::gemm_phase<pg8::EpiResid<true>, pg8::StaticOrder, true, true>(lds, g, S, E);
    }
    xcd_barrier(bar);
    {
        pg8::Gemm g{XB, (const bf16*)(ws + WS_W_GU), M, 2 * FF, D}; pg8::StaticOrder S; S.init(M, 2 * FF, G, bx);
        pg8::EpiSwiGLU<false> E{ws + WS_H, FF * 2, SSP, 1.0f, 1.0f};
        pg8::gemm_phase<pg8::EpiSwiGLU<false>, pg8::StaticOrder, true, true>(lds, g, S, E);
    }
    xcd_barrier(bar);
    {
        pg8::Gemm g{(const bf16*)(ws + WS_H), (const bf16*)(ws + WS_W_DN), M, D, FF}; pg8::StaticOrder S; S.init(M, D, G, bx);
        pg8::EpiResid<false> E{XB, XB, SSP};
        pg8::gemm_phase<pg8::EpiResid<false>, pg8::StaticOrder, true, true>(lds, g, S, E);
    }
    xcd_barrier(bar);
    {
        pg8::Gemm g{XB, (const bf16*)(ws + WS_W_KVQ), M, KVQ_N, D}; pg8::StaticOrder S; S.init(M, KVQ_N, G, bx);
        pg8::EpiKVQ E{KVQ, SSP, (const float*)(ws + WS_DCOS), (const float*)(ws + WS_DSIN), 0.125f * LOG2E};
        pg8::gemm_phase<pg8::EpiKVQ, pg8::StaticOrder, true, true>(lds, g, S, E);
    }
    xcd_barrier(bar);
    dat::attn_phase(KVQ, (bf16*)(ws + WS_AO), lds, P.lq1, P.lk1, P.lq2, P.lk2, lambda_init, vcu, G);
    xcd_barrier(bar);
    {
        pg8::Gemm g{(const bf16*)(ws + WS_AO), (const bf16*)(ws + WS_W_DO), M, D, D}; pg8::StaticOrder S; S.init(M, D, G, bx);
        pg8::EpiResid<false> E{XB, XB, SSP};
        pg8::gemm_phase<pg8::EpiResid<false>, pg8::StaticOrder, true, true>(lds, g, S, E);
    }
    xcd_barrier(bar);
    route_a(XB, (const float*)(ws + WS_RWT), (int*)(ws + WS_TOPE), (float*)(ws + WS_TOPW), (int*)(ws + WS_TOPR), (float*)(ws + WS_TOKR), (int*)(ws + WS_CNT), ws + WS_XN8, lds, vcu, G);
    xcd_barrier(bar);
    route_b(ws + WS_XN8, (const int*)(ws + WS_TOPE), (const float*)(ws + WS_TOPW), (const int*)(ws + WS_TOPR), (const float*)(ws + WS_TOKR), (const int*)(ws + WS_CNT), ws + WS_XG,
            (int*)(ws + WS_ROWINFO), (float*)(ws + WS_ROWGATE), (float*)(ws + WS_ROWR), lds, ldsctl, vcu, G);
    xcd_barrier(bar);
    {
        pg8::MoeOrder S; S.nM = __builtin_amdgcn_readfirstlane(((volatile LAS int*)ldsctl)[24]); S.nN = 2 * EF / 256; S.nwg = S.nM * S.nN; S.G = G; S.c = bx;
#pragma unroll
        for (int k = 0; k < 9; ++k) S.ts[k] = __builtin_amdgcn_readfirstlane(((volatile LAS int*)ldsctl)[16 + k]);
        pg8::Gemm g{(const bf16*)(ws + WS_XG), (const bf16*)(ws + WS_W_MGU), XG_ROWS, 2 * EF, D / 2};
        pg8::EpiSwiGLU<true> E{ws + WS_HM, EF, nullptr, 1.0f / MOE_WGU_SCALE, MOE_H_SCALE};
        pg8::gemm_phase<pg8::EpiSwiGLU<true>, pg8::MoeOrder, true, true, true>(lds, g, S, E);
    }
    xcd_barrier(bar);
    {
        pg8::MoeOrder S; S.nM = __builtin_amdgcn_readfirstlane(((volatile LAS int*)ldsctl)[24]); S.nN = D / 256; S.nwg = S.nM * S.nN; S.G = G; S.c = bx;
#pragma unroll
        for (int k = 0; k < 9; ++k) S.ts[k] = __builtin_amdgcn_readfirstlane(((volatile LAS int*)ldsctl)[16 + k]);
        pg8::Gemm g{(const bf16*)(ws + WS_HM), (const bf16*)(ws + WS_W_MDN), XG_ROWS, D, EF / 2};
        pg8::EpiMoeDown E{(bf16*)(ws + WS_Y), (const int*)(ws + WS_ROWINFO), (const float*)(ws + WS_ROWGATE), 1.0f / (MOE_WDN_SCALE * MOE_H_SCALE)};
        pg8::gemm_phase<pg8::EpiMoeDown, pg8::MoeOrder, true, true, true>(lds, g, S, E);
    }
    xcd_barrier(bar);
    final_phase(XB, (const bf16*)(ws + WS_Y), P.final_norm, P.out, vcu, G);
}

extern "C" void kernel_launch(void* const* d_in, const int* in_sizes, int n_in, void* d_out, int out_size, void* d_ws, size_t ws_size, hipStream_t stream) {
    static int grid = 0;
    if (grid == 0) {
        if (n_in != 20 || in_sizes[0] != M * D || out_size != M * D || ws_size < WS_END) { fprintf(stderr, "kernel_launch: unexpected shapes (n_in %d, in0 %d, out %d, ws %zu)\n", n_in, n_in > 0 ? in_sizes[0] : -1, out_size, ws_size); grid = -1; return; }
        int dev = 0, cus = 0, per_cu = 0;
        if (hipGetDevice(&dev) != hipSuccess || hipDeviceGetAttribute(&cus, hipDeviceAttributeMultiprocessorCount, dev) != hipSuccess) { grid = -1; return; }
        if (hipFuncSetAttribute((const void*)yoco_fwd, hipFuncAttributeMaxDynamicSharedMemorySize, LDS_BYTES) != hipSuccess) { fprintf(stderr, "kernel_launch: hipFuncSetAttribute failed\n"); grid = -1; return; }
        if (hipOccupancyMaxActiveBlocksPerMultiprocessor(&per_cu, (const void*)yoco_fwd, NTHREADS, LDS_BYTES) != hipSuccess || per_cu < 1) { fprintf(stderr, "kernel_launch: occupancy query reports %d\n", per_cu); }
        (void)hipGetLastError();
        grid = cus;
    }
    if (grid < 0) return;
    (void)hipMemsetAsync((char*)d_ws + WS_CTL, 0, CTL_ZERO_BYTES, stream);
    Args a{};
    const float** pp = (const float**)&a.p;
    for (int i = 0; i < 20; ++i) pp[i] = (const float*)d_in[i];
    a.p.out = (float*)d_out; a.p.ws = (unsigned char*)d_ws;
    hipLaunchKernelGGL(yoco_fwd, dim3(grid), dim3(NTHREADS), LDS_BYTES, stream, a);
}
```

```cpp
#include <hip/hip_runtime.h>
#include <hip/hip_bf16.h>
#include <cstdio>
#include <cstdint>
#include <cmath>
namespace pg8 {
#define PG8_LAS __attribute__((address_space(3)))
typedef unsigned short bf16_t;
typedef short bf16x8 __attribute__((ext_vector_type(8)));
typedef float f32x4 __attribute__((ext_vector_type(4)));
typedef unsigned u32x4 __attribute__((ext_vector_type(4)));
constexpr int BM = 256, BK = 64, HALF = 128, HTB = HALF * BK * 2  , STAGE_BYTES = 8 * HTB, NXCD = 8, WGM = 8;

__host__ __device__ __forceinline__ int lds_byte(int r, int c) { const int st = (r >> 4) * 2 + (c >> 5), rr = r & 15, cc = c & 31, ob = rr * 64 + cc * 2; return st * 1024 + (ob ^ (((ob >> 9) & 1) << 5)); }
__host__ __device__ __forceinline__ void stage_rc(int b, int& R, int& C) { const int st = b / 1024, sb = b % 1024, swz = sb ^ (((sb >> 9) & 1) << 5); R = (st >> 1) * 16 + swz / 64; C = (st & 1) * 32 + (swz % 64) / 2; }
__host__ __device__ __forceinline__ int perm32(int rho) { const int n = rho >> 4, i = rho & 15; return 8 * (i >> 2) + 4 * n + (i & 3); }

struct Unit { int pm, pn, aux; };
struct Gemm { const bf16_t* A; const bf16_t* Bt; int M, N, K; int Kloop = 0; };

struct StaticOrder {
    int nM, nN, nwg, G, c;
    __host__ __device__ void init(int M, int N, int G_, int c_) { nM = M / BM; nN = N / BM; nwg = nM * nN; G = G_; c = c_; }
    __host__ __device__ bool next(int i, Unit& u) const {
        const long L = (long)i * G + c; if (L >= nwg) return false;
        int wgid = (int)L; { const int q = nwg / NXCD, r = nwg % NXCD, xcd = wgid % NXCD, off = wgid / NXCD; wgid = (xcd < r ? xcd * (q + 1) : r * (q + 1) + (xcd - r) * q) + off; }
        const int nig = WGM * nN, gid = wgid / nig, fm = gid * WGM, gsz = (nM - fm) < WGM ? (nM - fm) : WGM;
        u.pm = fm + ((wgid % nig) % gsz); u.pn = (wgid % nig) / gsz; u.aux = u.pn; return true;
    }
    __device__ __forceinline__ void a_ready(const Unit&) const {}
    __device__ __forceinline__ void done(const Unit&) const {}
};

__device__ __forceinline__ unsigned cvt_pk_bf16(float lo, float hi) { unsigned r; asm volatile("v_cvt_pk_bf16_f32 %0, %1, %2" : "=v"(r) : "v"(lo), "v"(hi)); return r; }
typedef float f32x2 __attribute__((ext_vector_type(2)));
typedef int i32x4 __attribute__((ext_vector_type(4)));
typedef int i32x8 __attribute__((ext_vector_type(8)));
__device__ __forceinline__ i32x8 cat8i(bf16x8 a, bf16x8 b) { const i32x4 x = __builtin_bit_cast(i32x4, a), y = __builtin_bit_cast(i32x4, b); return __builtin_shufflevector(x, y, 0, 1, 2, 3, 4, 5, 6, 7); }
template <class Epi, class Sched, bool ALIGN_EPI = false, bool SP2 = false, bool FP8 = false>
__device__ __forceinline__ void gemm_phase(PG8_LAS unsigned char* lds, const Gemm g, const Sched& S, const Epi& E) {
    int tid = threadIdx.x; asm volatile("" : "+v"(tid)); const int wid = __builtin_amdgcn_readfirstlane(tid >> 6), lane = tid & 63, wr = wid >> 2, wc = wid & 3, fr = lane & 15, fq = lane >> 4;
    const int K = g.K, nt = (g.Kloop ? g.Kloop : K) / BK;
    unsigned voffA[2], voffB[2];
#pragma unroll
    for (int i = 0; i < 2; ++i) { int R, C; stage_rc(tid * 16 + i * 8192, R, C); const int Rb = Epi::PERM ? ((R & ~31) + perm32(R & 31)) : R;
        voffA[i] = (unsigned)(R * K + C) * 2u; voffB[i] = (unsigned)(Rb * K + C) * 2u; }
    const size_t kstep = (size_t)(BK * 2);
    const size_t hstep = (size_t)HALF * K * 2;
    const size_t tstep = 2 * hstep;
    const unsigned ldsw = (unsigned)wid * 1024u;
    const int aoff = lds_byte(wr * 64 + fr, fq * 8), boff = lds_byte(wc * 32 + fr, fq * 8);
#define PG8_SA(b, h) (((b) * 2 + (h)) * HTB)
#define PG8_SB(b, h) ((4 + (b) * 2 + (h)) * HTB)
#define PG8_STAGE(bufoff, gbase, voff) do { _Pragma("unroll") for (int _i = 0; _i < 2; ++_i) \
        __builtin_amdgcn_global_load_lds((const unsigned*)((const char*)(gbase) + (voff)[_i]), (PG8_LAS unsigned*)(lds + (bufoff) + ldsw + _i * 8192), 16, 0, 0); } while (0)
#define PG8_LDA(dst, b, h) do { _Pragma("unroll") for (int m = 0; m < 4; ++m) _Pragma("unroll") for (int k = 0; k < 2; ++k) dst[m][k] = *(const PG8_LAS bf16x8*)(lds + PG8_SA(b, h) + aoff + m * 2048 + k * 1024); } while (0)
#define PG8_LDB(dst, b, h) do { _Pragma("unroll") for (int n = 0; n < 2; ++n) _Pragma("unroll") for (int k = 0; k < 2; ++k) dst[n][k] = *(const PG8_LAS bf16x8*)(lds + PG8_SB(b, h) + boff + n * 2048 + k * 1024); } while (0)
#define PG8_MMA(ai, bj, At, Bt) do { __builtin_amdgcn_s_setprio(1); \
        if constexpr (FP8) { _Pragma("unroll") for (int m = 0; m < 4; ++m) _Pragma("unroll") for (int n = 0; n < 2; ++n) \
            asm volatile("v_mfma_scale_f32_16x16x128_f8f6f4 %0, %1, %2, %0, %3, %3 op_sel_hi:[0,0,0]" : "+v"(acc[ai][bj][m][n]) : "v"(cat8i(Bt[n][0], Bt[n][1])), "v"(cat8i(At[m][0], At[m][1])), "v"(fp8_unit_scale)); } \
        else { _Pragma("unroll") for (int m = 0; m < 4; ++m) _Pragma("unroll") for (int n = 0; n < 2; ++n) _Pragma("unroll") for (int k = 0; k < 2; ++k) \
            acc[ai][bj][m][n] = __builtin_amdgcn_mfma_f32_16x16x32_bf16(Bt[n][k], At[m][k], acc[ai][bj][m][n], 0, 0, 0); } \
        __builtin_amdgcn_s_setprio(0); } while (0)
#define PG8_WAIT_V(n) asm volatile("s_waitcnt vmcnt(" #n ")" ::: "memory")
#define PG8_WAIT_L(n) asm volatile("s_waitcnt lgkmcnt(" #n ")" ::: "memory")
#define PG8_BAR __builtin_amdgcn_s_barrier()
#define PG8_SCHED __builtin_amdgcn_sched_barrier(0)
    const int fp8_unit_scale = 0x7f7f7f7f; (void)fp8_unit_scale;
    Unit cur, nxt; int ui = 0;
    if (!S.next(0, cur)) return;
    f32x4 acc[2][2][4][2];
#pragma unroll
    for (int a = 0; a < 2; ++a)
#pragma unroll
        for (int b = 0; b < 2; ++b)
#pragma unroll
            for (int m = 0; m < 4; ++m)
#pragma unroll
                for (int n = 0; n < 2; ++n) acc[a][b][m][n] = (f32x4){0.f, 0.f, 0.f, 0.f};
    bf16x8 At[4][2], B0[2][2], B1[2][2];
    const char* cA = (const char*)g.A + (size_t)cur.pm * tstep; const char* cB = (const char*)g.Bt + (size_t)cur.pn * tstep;
    S.a_ready(cur);
    if constexpr (SP2) {
        PG8_STAGE(PG8_SB(0, 0), cB, voffB); PG8_STAGE(PG8_SB(0, 1), cB + hstep, voffB); PG8_STAGE(PG8_SA(0, 0), cA, voffA); PG8_STAGE(PG8_SA(0, 1), cA + hstep, voffA);
        if (wr == 1) PG8_BAR;
        PG8_WAIT_V(2); PG8_BAR;
        PG8_STAGE(PG8_SB(1, 0), cB + kstep, voffB); PG8_STAGE(PG8_SA(1, 0), cA + kstep, voffA); PG8_STAGE(PG8_SB(1, 1), cB + hstep + kstep, voffB);
        PG8_WAIT_V(6); PG8_BAR;
    } else {
        PG8_STAGE(PG8_SB(0, 0), cB, voffB); PG8_STAGE(PG8_SA(0, 0), cA, voffA); PG8_STAGE(PG8_SB(0, 1), cB + hstep, voffB); PG8_STAGE(PG8_SA(0, 1), cA + hstep, voffA);
        if (wr == 1) PG8_BAR;
        PG8_WAIT_V(4); PG8_BAR;
        PG8_STAGE(PG8_SB(1, 0), cB + kstep, voffB); PG8_STAGE(PG8_SA(1, 0), cA + kstep, voffA); PG8_STAGE(PG8_SB(1, 1), cB + hstep + kstep, voffB);
        PG8_WAIT_V(6); PG8_BAR;
    }
    for (;;) {
        const bool has_next = S.next(ui + 1, nxt);
        const char* nA = has_next ? (const char*)g.A + (size_t)nxt.pm * tstep : cA; const char* nB = has_next ? (const char*)g.Bt + (size_t)nxt.pn * tstep : cB;
        for (int t = 0; t < nt; t += 2) {
            const bool last = (t == nt - 2);
            const char* a1 = cA + (size_t)(t + 1) * kstep;
            const char* a2 = last ? nA : cA + (size_t)(t + 2) * kstep; const char* b2 = last ? nB : cB + (size_t)(t + 2) * kstep;
            const char* a3 = a2 + kstep; const char* b3 = b2 + kstep;
            if (last && has_next) S.a_ready(nxt);
            if constexpr (SP2) {
            PG8_LDB(B0, 0, 0); PG8_LDB(B1, 0, 1); PG8_SCHED; PG8_LDA(At, 0, 0); PG8_STAGE(PG8_SA(1, 1), a1 + hstep, voffA);
            PG8_WAIT_V(8); PG8_WAIT_L(0); PG8_BAR; PG8_MMA(0, 0, At, B0); PG8_MMA(0, 1, At, B1); PG8_BAR; PG8_SCHED;
            PG8_LDA(At, 0, 1); PG8_STAGE(PG8_SB(0, 0), b2, voffB); PG8_STAGE(PG8_SB(0, 1), b2 + hstep, voffB); PG8_STAGE(PG8_SA(0, 0), a2, voffA);
            PG8_WAIT_V(8); PG8_WAIT_L(0); PG8_BAR; PG8_MMA(1, 0, At, B0); PG8_MMA(1, 1, At, B1); PG8_BAR; PG8_SCHED;
            PG8_LDB(B0, 1, 0); PG8_LDB(B1, 1, 1); PG8_SCHED; PG8_LDA(At, 1, 0); PG8_STAGE(PG8_SA(0, 1), a2 + hstep, voffA);
            PG8_WAIT_V(8); PG8_WAIT_L(0); PG8_BAR; PG8_MMA(0, 0, At, B0); PG8_MMA(0, 1, At, B1); PG8_BAR; PG8_SCHED;
            PG8_LDA(At, 1, 1); PG8_STAGE(PG8_SB(1, 0), b3, voffB); PG8_STAGE(PG8_SB(1, 1), b3 + hstep, voffB); PG8_STAGE(PG8_SA(1, 0), a3, voffA);
            PG8_WAIT_V(8); PG8_WAIT_L(0); PG8_BAR; PG8_MMA(1, 0, At, B0); PG8_MMA(1, 1, At, B1); PG8_BAR; PG8_SCHED;
            } else {
            PG8_LDB(B0, 0, 0); PG8_SCHED; PG8_LDA(At, 0, 0); PG8_STAGE(PG8_SA(1, 1), a1 + hstep, voffA);
            PG8_WAIT_L(8); PG8_BAR; PG8_WAIT_L(0); PG8_MMA(0, 0, At, B0); PG8_BAR; PG8_SCHED;
            PG8_LDB(B1, 0, 1); PG8_STAGE(PG8_SB(0, 0), b2, voffB);
            PG8_BAR; PG8_WAIT_L(0); PG8_MMA(0, 1, At, B1); PG8_BAR;
            PG8_LDA(At, 0, 1); PG8_STAGE(PG8_SA(0, 0), a2, voffA);
            PG8_BAR; PG8_WAIT_L(0); PG8_MMA(1, 0, At, B0); PG8_BAR; PG8_SCHED;
            PG8_STAGE(PG8_SB(0, 1), b2 + hstep, voffB);
            PG8_WAIT_V(6); PG8_BAR; PG8_MMA(1, 1, At, B1); PG8_BAR;
            PG8_LDB(B0, 1, 0); PG8_SCHED; PG8_LDA(At, 1, 0); PG8_STAGE(PG8_SA(0, 1), a2 + hstep, voffA);
            PG8_WAIT_L(8); PG8_BAR; PG8_WAIT_L(0); PG8_MMA(0, 0, At, B0); PG8_BAR; PG8_SCHED;
            PG8_LDB(B1, 1, 1); PG8_STAGE(PG8_SB(1, 0), b3, voffB);
            PG8_BAR; PG8_WAIT_L(0); PG8_MMA(0, 1, At, B1); PG8_BAR;
            PG8_LDA(At, 1, 1); PG8_STAGE(PG8_SA(1, 0), a3, voffA);
            PG8_BAR; PG8_WAIT_L(0); PG8_MMA(1, 0, At, B0); PG8_BAR; PG8_SCHED;
            PG8_STAGE(PG8_SB(1, 1), b3 + hstep, voffB);
            PG8_WAIT_V(6); PG8_BAR; PG8_MMA(1, 1, At, B1); PG8_BAR;
            }
        }
        if constexpr (ALIGN_EPI) { if (wr == 0) PG8_BAR; }
        if constexpr (FP8) asm volatile("s_nop 15\n\ts_nop 15" ::: "memory");
        if constexpr (!Epi::AFTER_DRAIN) { E(acc, cur, wr, wc, fr, fq); S.done(cur); }
        if (!has_next) break;
#pragma unroll
        for (int a = 0; a < 2; ++a)
#pragma unroll
            for (int b = 0; b < 2; ++b)
#pragma unroll
                for (int m = 0; m < 4; ++m)
#pragma unroll
                    for (int n = 0; n < 2; ++n) acc[a][b][m][n] = (f32x4){0.f, 0.f, 0.f, 0.f};
        cur = nxt; cA = nA; cB = nB; ++ui;
        if constexpr (ALIGN_EPI) { if (wr == 1) PG8_BAR; }
    }
    PG8_WAIT_V(0);
    if constexpr (!ALIGN_EPI) { if (wr == 0) PG8_BAR; }
    PG8_BAR;
    if constexpr (Epi::AFTER_DRAIN) { E.fused(acc, cur, wr, wc, fr, fq, lds, wid, lane); S.done(cur); }
#undef PG8_SA
#undef PG8_SB
#undef PG8_STAGE
#undef PG8_LDA
#undef PG8_LDB
#undef PG8_MMA
#undef PG8_WAIT_V
#undef PG8_WAIT_L
#undef PG8_BAR
#undef PG8_SCHED
}
}
#define GAS __attribute__((address_space(1)))
#define LAS __attribute__((address_space(3)))
typedef unsigned short bf16;
typedef unsigned v4u __attribute__((ext_vector_type(4)));
typedef float f32x4 __attribute__((ext_vector_type(4)));
typedef short bf16x8 __attribute__((ext_vector_type(8)));
typedef GAS unsigned gu32;
typedef GAS unsigned long long gu64;
#define RLX_AGENT __ATOMIC_RELAXED, __HIP_MEMORY_SCOPE_AGENT
#define LDS_WAIT() asm volatile("s_waitcnt lgkmcnt(0)" ::: "memory")
#define VM_WAIT() asm volatile("s_waitcnt vmcnt(0)" ::: "memory")
__device__ __forceinline__ unsigned long long rt() { return __builtin_amdgcn_s_memrealtime(); }
__device__ __forceinline__ unsigned f2bf(float f) { unsigned u = __builtin_bit_cast(unsigned, f); return (u + 0x7fffu + ((u >> 16) & 1u)) >> 16; }
__device__ __forceinline__ unsigned pk2(float lo, float hi) { unsigned r; asm("v_cvt_pk_bf16_f32 %0, %1, %2" : "=v"(r) : "v"(lo), "v"(hi)); return r; }

#define XB_TMO      128
#define XB_XCNT(j)  (256  + 64 * (j))
#define XB_XSUB(j)  (1280 + 64 * (j))
#define XB_XGEN(j)  (2304 + 64 * (j))
#define XB_TOP      3328
#define XB_TOPGEN   3392
#define XCD_BAR_WORDS 3456
#define XB_SPIN_CAP (1u << 18)

__device__ __forceinline__ unsigned xb_ld(unsigned* p)              { return __hip_atomic_load(p, __ATOMIC_RELAXED, __HIP_MEMORY_SCOPE_AGENT); }
__device__ __forceinline__ unsigned xb_add(unsigned* p, unsigned v) { return __hip_atomic_fetch_add(p, v, __ATOMIC_RELAXED, __HIP_MEMORY_SCOPE_AGENT); }
__device__ __forceinline__ unsigned xb_xcc_id() { return (unsigned)__builtin_amdgcn_s_getreg((3 << 11) | 20) & 0xFu; }
#define XB_SPIN(cond, bar) do { unsigned _sp = 0; while (cond) { __builtin_amdgcn_s_sleep(1); \
    if ((++_sp & 255u) == 0u) { if (xb_ld(&(bar)[XB_TMO])) break; if (_sp > XB_SPIN_CAP) { atomicAdd(&(bar)[XB_TMO], 1u); break; } } } } while (0)

struct XcdBarrier {
    unsigned* bar; unsigned x;
    volatile LAS unsigned* st;
};

__device__ __forceinline__ XcdBarrier xcd_barrier_post(unsigned* bar, volatile LAS unsigned* st) {
    XcdBarrier b; b.bar = bar; b.x = xb_xcc_id(); b.st = st;
    if (threadIdx.x == 0) (void)xb_add(&bar[XB_XCNT(b.x)], 1u);
    return b;
}
__device__ __forceinline__ void xcd_barrier_complete(unsigned* bar, unsigned x, unsigned& nloc, unsigned& nx) {
    const unsigned G = gridDim.x * gridDim.y * gridDim.z;
    unsigned sum, cnt, mine, sp = 0u;
    for (;;) {
        sum = 0u; cnt = 0u; mine = 0u;
#pragma unroll
        for (unsigned j = 0; j < 16; ++j) { const unsigned c = xb_ld(&bar[XB_XCNT(j)]); sum += c; cnt += (c > 0u) ? 1u : 0u; mine = (j == x) ? c : mine; }
        if (sum == G) break;
        __builtin_amdgcn_s_sleep(1);
        if ((++sp & 255u) == 0u) { if (xb_ld(&bar[XB_TMO])) break; if (sp > XB_SPIN_CAP) { atomicAdd(&bar[XB_TMO], 1u); break; } }
    }
    nloc = mine > 0u ? mine : 1u; nx = cnt > 0u ? cnt : 1u;
}

__device__ __forceinline__ void xcd_barrier(const XcdBarrier& b) {
    asm volatile("s_waitcnt vmcnt(0)" ::: "memory");
    __syncthreads();
    if (threadIdx.x == 0) {
        unsigned* bar = b.bar;
        __builtin_amdgcn_s_waitcnt(0);
        unsigned nloc = b.st[0], nx = b.st[1];
        if (nloc == 0u) { xcd_barrier_complete(bar, b.x, nloc, nx); b.st[0] = nloc; b.st[1] = nx; }
        const unsigned old = xb_add(&bar[XB_XSUB(b.x)], 1u);
        const unsigned gen = old / nloc;
        if (old + 1u == (gen + 1u) * nloc) {
            __builtin_amdgcn_fence(__ATOMIC_RELEASE, "agent");
            asm volatile("s_waitcnt vmcnt(0)" ::: "memory");
            const unsigned og = xb_add(&bar[XB_TOP], 1u);
            const unsigned tg = og / nx;
            if (og + 1u == (tg + 1u) * nx) xb_add(&bar[XB_TOPGEN], 1u);
            else XB_SPIN(xb_ld(&bar[XB_TOPGEN]) == tg, bar);
            __builtin_amdgcn_fence(__ATOMIC_ACQUIRE, "agent");
            xb_add(&bar[XB_XGEN(b.x)], 1u);
            asm volatile("s_waitcnt vmcnt(0)" ::: "memory");
        } else {
            XB_SPIN(xb_ld(&bar[XB_XGEN(b.x)]) == gen, bar);
            __builtin_amdgcn_fence(__ATOMIC_ACQUIRE, "agent");
            asm volatile("s_waitcnt vmcnt(0)" ::: "memory");
        }
    }
    __syncthreads();
}

constexpr int BATCH = 4, SEQ = 4096, D = 1024, M = BATCH * SEQ;
constexpr int RIN = 6144, RVD = 2048;
constexpr int FF = 2816, EF = 3584, NE = 8;
constexpr int KVQ_N = 3072;
constexpr float EPS = 1e-6f;
constexpr float LOG2E = 1.4426950408889634f;

typedef short s16x4 __attribute__((ext_vector_type(4)));
typedef float f32x16 __attribute__((ext_vector_type(16)));
typedef unsigned u32x2 __attribute__((ext_vector_type(2)));

__device__ __forceinline__ float bf2f(unsigned short h) { return __uint_as_float(((unsigned)h) << 16); }
__device__ __forceinline__ float bflo(unsigned w) { return __uint_as_float(w << 16); }
__device__ __forceinline__ float bfhi(unsigned w) { return __uint_as_float(w & 0xffff0000u); }
__device__ __forceinline__ float fast_exp2(float x) { return __builtin_amdgcn_exp2f(x); }
__device__ __forceinline__ float fast_rcp(float x) { return __builtin_amdgcn_rcpf(x); }
__device__ __forceinline__ float silu_f(float x) { return x * fast_rcp(1.0f + fast_exp2(-x * LOG2E)); }
#define SWZ_XOR(v, m) __int_as_float(__builtin_amdgcn_ds_swizzle(__float_as_int(v), ((m) << 10) | 0x1f))
__device__ __forceinline__ float xor32_sum(float v) { auto rr = __builtin_amdgcn_permlane32_swap(__float_as_uint(v), __float_as_uint(v), false, false); return __uint_as_float(rr[0]) + __uint_as_float(rr[1]); }
#define DPP_F(v, ctrl) __int_as_float(__builtin_amdgcn_update_dpp(0, __float_as_int(v), (ctrl), 0xf, 0xf, false))
#define DPP_XOR1 0xB1
#define DPP_XOR2 0x4E
#define DPP_ROR4 0x124
#define DPP_ROR8 0x128
__device__ __forceinline__ float wave_sum(float v) {
    v += DPP_F(v, DPP_XOR1); v += DPP_F(v, DPP_XOR2); v += DPP_F(v, DPP_ROR4); v += DPP_F(v, DPP_ROR8); v += SWZ_XOR(v, 16);
    return xor32_sum(v);
}

__device__ __forceinline__ float wave_sum8(const float (&a)[8], int lane) {
    const bool b0 = lane & 1, b1 = lane & 2, b2 = lane & 4;
    float b[4], c[2];
#pragma unroll
    for (int i = 0; i < 4; ++i) { const float snd = b0 ? a[i] : a[i + 4]; b[i] = (b0 ? a[i + 4] : a[i]) + DPP_F(snd, DPP_XOR1); }
#pragma unroll
    for (int i = 0; i < 2; ++i) { const float snd = b1 ? b[i] : b[i + 2]; c[i] = (b1 ? b[i + 2] : b[i]) + DPP_F(snd, DPP_XOR2); }
    const float snd = b2 ? c[0] : c[1];
    float d = (b2 ? c[1] : c[0]) + DPP_F(snd, DPP_ROR4);
    d += DPP_F(d, DPP_ROR8); d += SWZ_XOR(d, 16);
    return xor32_sum(d);
}
__device__ __forceinline__ constexpr int wsum8_lane(int k) { return ((k >> 2) & 1) | (((k >> 1) & 1) << 1) | ((k & 1) << 2); }
__device__ __forceinline__ float wave_sum2(float a0, float a1, int lane) {
    const bool b0 = lane & 1;
    const float snd = b0 ? a0 : a1;
    float d = (b0 ? a1 : a0) + DPP_F(snd, DPP_XOR1);
    d += DPP_F(d, DPP_XOR2); d += DPP_F(d, DPP_ROR4); d += DPP_F(d, DPP_ROR8); d += SWZ_XOR(d, 16);
    return xor32_sum(d);
}

namespace pg8 {
__device__ __forceinline__ float rinv_from_ssp(const float* ssp, int row) {
    const f32x4* p = (const f32x4*)(ssp + (size_t)row * 16);
    const f32x4 a = p[0], b = p[1], c = p[2], d = p[3];
    const float s = (((a[0] + a[1]) + (a[2] + a[3])) + ((b[0] + b[1]) + (b[2] + b[3]))) + (((c[0] + c[1]) + (c[2] + c[3])) + ((d[0] + d[1]) + (d[2] + d[3])));
    return __builtin_amdgcn_rsqf(s * (1.0f / 1024.0f) + EPS);
}
__device__ __forceinline__ void rinv8_from_ssp(const float* ssp, int row0, int fq, float (&r)[8]) {
    f32x4 a[8];
#pragma unroll
    for (int x = 0; x < 8; ++x) a[x] = ((const f32x4*)(ssp + (size_t)(row0 + (x >> 2) * HALF + (x & 3) * 16) * 16))[fq];
#pragma unroll
    for (int x = 0; x < 8; ++x) {
        float s = (a[x][0] + a[x][1]) + (a[x][2] + a[x][3]);
        s += SWZ_XOR(s, 16); s = xor32_sum(s);
        r[x] = __builtin_amdgcn_rsqf(s * (1.0f / 1024.0f) + EPS);
    }
}
__device__ __forceinline__ u32x4 pack8(const f32x4 a, const f32x4 b) {
    u32x4 w; w.x = cvt_pk_bf16(a[0], a[1]); w.y = cvt_pk_bf16(a[2], a[3]); w.z = cvt_pk_bf16(b[0], b[1]); w.w = cvt_pk_bf16(b[2], b[3]); return w;
}
struct EpiInProj {
    static constexpr bool PERM = true, AFTER_DRAIN = false;
    bf16_t* O; const float* ssp; const float* rcos; const float* rsin;
    __device__ __forceinline__ void operator()(const f32x4 (&acc)[2][2][4][2], const Unit& u, int wr, int wc, int fr, int fq) const {
        const int row0 = u.pm * BM + wr * 64 + fr;
        const int cl = wc * 32 + 8 * fq;
        const bool rope = u.pn < 8;
        const float ksc = (u.pn >= 4 && u.pn < 8) ? 0.0625f : 1.0f;
        float rv[8]; rinv8_from_ssp(ssp, row0, fq, rv);
#pragma unroll
        for (int ai = 0; ai < 2; ++ai)
#pragma unroll
            for (int m = 0; m < 4; ++m) {
                const int row = row0 + ai * HALF + m * 16;
                const float r = rv[ai * 4 + m] * ksc;
                bf16_t* rowp = O + (size_t)row * RIN + u.pn * BM + cl;
                f32x4 a0 = acc[ai][0][m][0] * r, a1 = acc[ai][0][m][1] * r, b0 = acc[ai][1][m][0] * r, b1 = acc[ai][1][m][1] * r;
                if (rope) {
                    const int pos = row & (SEQ - 1);
                    const f32x4 c0 = *(const f32x4*)(rcos + pos * 128 + cl), c1 = *(const f32x4*)(rcos + pos * 128 + cl + 4);
                    const f32x4 s0 = *(const f32x4*)(rsin + pos * 128 + cl), s1 = *(const f32x4*)(rsin + pos * 128 + cl + 4);
                    const f32x4 x0 = a0 * c0 - b0 * s0, x1 = a1 * c1 - b1 * s1, y0 = b0 * c0 + a0 * s0, y1 = b1 * c1 + a1 * s1;
                    a0 = x0; a1 = x1; b0 = y0; b1 = y1;
                }
                if (u.pn >= 16) { __builtin_nontemporal_store(pack8(a0, a1), (u32x4*)(rowp)); __builtin_nontemporal_store(pack8(b0, b1), (u32x4*)(rowp + HALF)); }
                else { *(u32x4*)(rowp) = pack8(a0, a1); *(u32x4*)(rowp + HALF) = pack8(b0, b1); }
                if (m & 1) asm volatile("" ::: "memory");
            }
    }
};
template <bool FP8OUT> struct EpiSwiGLU {
    static constexpr bool PERM = true, AFTER_DRAIN = false;
    unsigned char* O; int ldb  ; const float* ssp; float cscale, oscale;
    __device__ __forceinline__ void operator()(const f32x4 (&acc)[2][2][4][2], const Unit& u, int wr, int wc, int fr, int fq) const {
        const int row0 = u.pm * BM + wr * 64 + fr;
        const int col = u.aux * HALF + wc * 32 + 8 * fq;
        float rv[8];
        if (ssp) rinv8_from_ssp(ssp, row0, fq, rv); else {
#pragma unroll
            for (int x = 0; x < 8; ++x) rv[x] = 1.0f; }
#pragma unroll
        for (int ai = 0; ai < 2; ++ai)
#pragma unroll
            for (int m = 0; m < 4; ++m) {
                const int row = row0 + ai * HALF + m * 16;
                const float r = rv[ai * 4 + m] * cscale;
                const float k1 = -r * LOG2E, qv = fast_rcp(r * r * oscale), c0 = __builtin_amdgcn_logf(qv);
                f32x4 h0, h1;
#pragma unroll
                for (int j = 0; j < 4; ++j) {
                    h0[j] = (acc[ai][0][m][0][j] * acc[ai][1][m][0][j]) * fast_rcp(qv + fast_exp2(__builtin_fmaf(acc[ai][0][m][0][j], k1, c0)));
                    h1[j] = (acc[ai][0][m][1][j] * acc[ai][1][m][1][j]) * fast_rcp(qv + fast_exp2(__builtin_fmaf(acc[ai][0][m][1][j], k1, c0)));
                }
                if constexpr (FP8OUT) {
                    unsigned w0, w1; asm volatile("" : "=v"(w0), "=v"(w1));
                    w0 = __builtin_amdgcn_cvt_pk_fp8_f32(h0[0], h0[1], w0, false); w0 = __builtin_amdgcn_cvt_pk_fp8_f32(h0[2], h0[3], w0, true);
                    w1 = __builtin_amdgcn_cvt_pk_fp8_f32(h1[0], h1[1], w1, false); w1 = __builtin_amdgcn_cvt_pk_fp8_f32(h1[2], h1[3], w1, true);
                    *(u32x2*)(O + (size_t)row * ldb + col) = (u32x2){w0, w1};
                } else {
                    *(u32x4*)(O + (size_t)row * ldb + col * 2) = pack8(h0, h1);
                }
                if (m & 1) asm volatile("" ::: "memory");
            }
    }
};
template <bool BASE_F32, bool X8 = false, bool ASC = false>
struct EpiResid {
    static constexpr bool PERM = true, AFTER_DRAIN = false;
    const void* base; bf16_t* xb; float* ssp; unsigned char* x8; float ascale;
    template <int AI0, int NAI>
    __device__ __forceinline__ void part(const f32x4 (&acc)[2][2][4][2], const Unit& u, int row0, int col0, int wc, int fq) const {
        f32x4 bv[NAI * 4][2][2];
#pragma unroll
        for (int x = 0; x < NAI * 4; ++x) {
            const int row = row0 + (AI0 + (x >> 2)) * HALF + (x & 3) * 16;
#pragma unroll
            for (int bj = 0; bj < 2; ++bj) {
                const size_t c = (size_t)row * D + col0 + bj * HALF;
                if constexpr (BASE_F32) { bv[x][bj][0] = *(const f32x4*)((const float*)base + c); bv[x][bj][1] = *(const f32x4*)((const float*)base + c + 4); }
                else { const u32x4 b = *(const u32x4*)((const bf16_t*)base + c); bv[x][bj][0] = __builtin_bit_cast(f32x4, b); }
            }
        }
#pragma unroll
        for (int x = 0; x < NAI * 4; ++x) {
            const int ai = AI0 + (x >> 2), m = x & 3;
            const int row = row0 + ai * HALF + m * 16;
            float ss = 0.f;
#pragma unroll
            for (int bj = 0; bj < 2; ++bj) {
                const size_t c = (size_t)row * D + col0 + bj * HALF;
                f32x4 v0, v1;
                if constexpr (BASE_F32) { v0 = bv[x][bj][0]; v1 = bv[x][bj][1]; }
                else { const u32x4 b = __builtin_bit_cast(u32x4, bv[x][bj][0]); v0 = (f32x4){bflo(b.x), bfhi(b.x), bflo(b.y), bfhi(b.y)}; v1 = (f32x4){bflo(b.z), bfhi(b.z), bflo(b.w), bfhi(b.w)}; }
                if constexpr (ASC) { v0 += acc[ai][bj][m][0] * ascale; v1 += acc[ai][bj][m][1] * ascale; } else { v0 += acc[ai][bj][m][0]; v1 += acc[ai][bj][m][1]; }
                *(u32x4*)(xb + c) = pack8(v0, v1);
                if constexpr (X8) {
                    unsigned w0, w1; asm volatile("" : "=v"(w0), "=v"(w1));
                    w0 = __builtin_amdgcn_cvt_pk_fp8_f32(v0[0], v0[1], w0, false); w0 = __builtin_amdgcn_cvt_pk_fp8_f32(v0[2], v0[3], w0, true);
                    w1 = __builtin_amdgcn_cvt_pk_fp8_f32(v1[0], v1[1], w1, false); w1 = __builtin_amdgcn_cvt_pk_fp8_f32(v1[2], v1[3], w1, true);
                    *(u32x2*)(x8 + c) = (u32x2){w0, w1};
                }
                ss += ((v0[0] * v0[0] + v0[1] * v0[1]) + (v0[2] * v0[2] + v0[3] * v0[3])) + ((v1[0] * v1[0] + v1[1] * v1[1]) + (v1[2] * v1[2] + v1[3] * v1[3]));
            }
            ss += SWZ_XOR(ss, 16); ss = xor32_sum(ss);
            if (fq == 0) ssp[(size_t)row * 16 + u.pn * 4 + wc] = ss;
        }
    }
    __device__ __forceinline__ void operator()(const f32x4 (&acc)[2][2][4][2], const Unit& u, int wr, int wc, int fr, int fq) const {
        const int row0 = u.pm * BM + wr * 64 + fr;
        const int col0 = u.pn * BM + wc * 32 + 8 * fq;
        if constexpr (BASE_F32) { part<0, 1>(acc, u, row0, col0, wc, fq); asm volatile("" ::: "memory"); part<1, 1>(acc, u, row0, col0, wc, fq); }
        else part<0, 2>(acc, u, row0, col0, wc, fq);
    }
};
struct EpiKVQ {
    static constexpr bool PERM = true, AFTER_DRAIN = false;
    bf16_t* O; const float* ssp; const float* dcos; const float* dsin; float qscale;
    __device__ __forceinline__ void operator()(const f32x4 (&acc)[2][2][4][2], const Unit& u, int wr, int wc, int fr, int fq) const {
        const int row0 = u.pm * BM + wr * 64 + fr;
        const int cl = wc * 32 + 8 * fq;
        const int kind = u.pn >> 2;
        const bool ropelane = ((wc & 1) == 0) && (fq < 2);
        float rv[8]; rinv8_from_ssp(ssp, row0, fq, rv);
#pragma unroll
        for (int ai = 0; ai < 2; ++ai) {
            f32x4 tcs[4], tsn[4];
            if (kind != 1) {
#pragma unroll
                for (int m = 0; m < 4; ++m) {
                    const int pos = (row0 + ai * HALF + m * 16) & (SEQ - 1);
                    tcs[m] = *(const f32x4*)(dcos + pos * 8 + 4 * (fq & 1)); tsn[m] = *(const f32x4*)(dsin + pos * 8 + 4 * (fq & 1));
                }
            }
#pragma unroll
            for (int m = 0; m < 4; ++m) {
                const int row = row0 + ai * HALF + m * 16;
                const float r = rv[ai * 4 + m] * (kind == 2 ? qscale : 1.0f);
                bf16_t* rowp = O + (size_t)row * KVQ_N + u.pn * BM + cl;
#pragma unroll
                for (int bj = 0; bj < 2; ++bj) {
                    f32x4 v0 = acc[ai][bj][m][0] * r, v1 = acc[ai][bj][m][1] * r;
                    if (kind != 1 && ropelane) {
                        const f32x4 cs = tcs[m], sn = tsn[m];
                        v0 = (f32x4){v0[0] * cs[0] - v0[1] * sn[0], v0[1] * cs[0] + v0[0] * sn[0], v0[2] * cs[1] - v0[3] * sn[1], v0[3] * cs[1] + v0[2] * sn[1]};
                        v1 = (f32x4){v1[0] * cs[2] - v1[1] * sn[2], v1[1] * cs[2] + v1[0] * sn[2], v1[2] * cs[3] - v1[3] * sn[3], v1[3] * cs[3] + v1[2] * sn[3]};
                    }
                    *(u32x4*)(rowp + bj * HALF) = pack8(v0, v1);
                }
                if (m & 1) asm volatile("" ::: "memory");
            }
        }
    }
};
struct EpiMoeDown {
    static constexpr bool PERM = true, AFTER_DRAIN = false;
    bf16_t* Y; const int* rowinfo; const float* rowgate; float cscale;
    __device__ __forceinline__ void operator()(const f32x4 (&acc)[2][2][4][2], const Unit& u, int wr, int wc, int fr, int fq) const {
        const int row0 = u.pm * BM + wr * 64 + fr;
        const int cl = u.aux * BM + wc * 32 + 8 * fq;
        int inf[8]; float gt[8];
#pragma unroll
        for (int x = 0; x < 8; ++x) { const int row = row0 + (x >> 2) * HALF + (x & 3) * 16; inf[x] = rowinfo[row]; gt[x] = rowgate[row]; }
#pragma unroll
        for (int ai = 0; ai < 2; ++ai)
#pragma unroll
            for (int m = 0; m < 4; ++m) {
                const int info = inf[ai * 4 + m];
                if (info >= 0) {
                    const float g = gt[ai * 4 + m] * cscale;
                    bf16_t* rowp = Y + (size_t)info * D + cl;
                    *(u32x4*)(rowp) = pack8(acc[ai][0][m][0] * g, acc[ai][0][m][1] * g);
                    *(u32x4*)(rowp + HALF) = pack8(acc[ai][1][m][0] * g, acc[ai][1][m][1] * g);
                }
            }
    }
};
struct MoeOrder {
    int nM, nN, nwg, G, c; int ts[9]; int one_pm, one_pnl;
    __device__ __forceinline__ bool next(int i, Unit& u) const {
        if (one_pm >= 0) {
            if (i > 0) return false;
            int e1 = 0;
#pragma unroll
            for (int k = 1; k < 8; ++k) e1 += (one_pm >= ts[k]) ? 1 : 0;
            u.pm = one_pm; u.pn = e1 * nN + one_pnl; u.aux = one_pnl; return true;
        }
        const long L = (long)i * G + c; if (L >= nwg) return false;
        int wgid = (int)L; { const int q = nwg / NXCD, r = nwg % NXCD, xcd = wgid % NXCD, off = wgid / NXCD; wgid = (xcd < r ? xcd * (q + 1) : r * (q + 1) + (xcd - r) * q) + off; }
        const int nig = WGM * nN, gid = wgid / nig, fm = gid * WGM, gsz = (nM - fm) < WGM ? (nM - fm) : WGM;
        const int pm = fm + ((wgid % nig) % gsz), pnl = (wgid % nig) / gsz;
        int e = 0;
#pragma unroll
        for (int k = 1; k < 8; ++k) e += (pm >= ts[k]) ? 1 : 0;
        u.pm = pm; u.pn = e * nN + pnl; u.aux = pnl; return true;
    }
    __device__ __forceinline__ void a_ready(const Unit&) const {}
    __device__ __forceinline__ void done(const Unit&) const {}
};
}
constexpr size_t MiB = 1u << 20;
constexpr size_t WS_CTL = 0, CTL_ZERO_BYTES = 1 * MiB;
constexpr size_t WS_RCOS = 1 * MiB, WS_RSIN = 3 * MiB;
constexpr size_t WS_DCOS = 5 * MiB, WS_DSIN = 5 * MiB + 256 * 1024;
constexpr size_t WS_SSP = 6 * MiB;
constexpr size_t WS_RWT = 7 * MiB;
constexpr size_t WS_TOPE = 8 * MiB;
constexpr size_t WS_TOPW = 8 * MiB + 128 * 1024;
constexpr size_t WS_TOPR = 8 * MiB + 256 * 1024;
constexpr size_t WS_TOKR = 8 * MiB + 384 * 1024;
constexpr size_t WS_CNT = 8 * MiB + 512 * 1024;
constexpr size_t WS_LATE = 8 * MiB + 640 * 1024;
constexpr int XG_ROWS = 2 * M + NE * 256;
constexpr size_t WS_ROWINFO = 9 * MiB;
constexpr size_t WS_ROWGATE = 9 * MiB + 256 * 1024;
constexpr size_t WS_ROWR = 9 * MiB + 512 * 1024;
constexpr size_t WS_S = 10 * MiB;
constexpr size_t WS_W_IN = 20 * MiB, WS_W_RO = 32 * MiB, WS_W_GU = 36 * MiB, WS_W_DN = 47 * MiB, WS_W_KVQ = 53 * MiB, WS_W_DO = 59 * MiB, WS_W_MGU = 61 * MiB, WS_W_MDN = 173 * MiB;
constexpr size_t WS_XM = 232 * MiB;
constexpr size_t WS_XB = 296 * MiB;
constexpr size_t WS_PROJ = 328 * MiB;
constexpr size_t WS_RO = 520 * MiB;
constexpr size_t WS_ORET = 584 * MiB;
constexpr size_t WS_H = 328 * MiB;
constexpr size_t WS_KVQ = 584 * MiB;
constexpr size_t WS_AO = 680 * MiB;
constexpr size_t WS_Y = 712 * MiB;
constexpr size_t WS_HM = 328 * MiB;
constexpr size_t WS_XG = 584 * MiB;
constexpr size_t WS_XN8 = 776 * MiB;
constexpr size_t WS_YH = 792 * MiB;
constexpr size_t WS_END = 856 * MiB;
static_assert(WS_W_MDN + (size_t)NE * D * EF * 2 <= WS_XM && WS_HM + (size_t)XG_ROWS * EF * 2 <= WS_KVQ && WS_XG + (size_t)XG_ROWS * D * 2 <= WS_AO && WS_Y + (size_t)2 * M * D * 2 <= WS_END, "d_ws map");
constexpr float MOE_WGU_SCALE = 64.0f, MOE_WDN_SCALE = 128.0f, MOE_H_SCALE = 8.0f;
constexpr float FFN_WGU_SCALE = 64.0f, FFN_WDN_SCALE = 128.0f, FFN_H_SCALE = 8.0f;
constexpr size_t WS_XB8 = WS_ORET;
constexpr int CW_BAR = 4096;

constexpr int RING_BYTES = 131072;
constexpr int LDSCTL_OFF = RING_BYTES;
constexpr int LDS_BYTES = 147456;
constexpr int NWAVES = 8, NTHREADS = 512;

#define WG_BAR() do { asm volatile("s_waitcnt vmcnt(0) lgkmcnt(0)" ::: "memory"); __builtin_amdgcn_s_barrier(); asm volatile("" ::: "memory"); } while (0)

#define PHASE_IDS() int tid = threadIdx.x; asm volatile("" : "+v"(tid)); const int lane = tid & 63; const int wave = __builtin_amdgcn_readfirstlane(tid >> 6); (void)lane; (void)wave
struct TrBlk { const float* src; unsigned char* dst; int N, goff, k0, ldb, fp8, rp, kp; };
constexpr int TR_PITCH = 288;
__device__ __forceinline__ void tr_load(const TrBlk& B, f32x4 (&ld)[8], int (&gk)[8], int wave, int lane) {
#pragma unroll
    for (int j = 0; j < 8; ++j) {
        const int kd = 16 * wave + 2 * j + (lane >> 5);
        const int k = B.kp ? (((kd & 3) << 5) | (kd >> 2)) : kd;
        ld[j] = __builtin_nontemporal_load((const f32x4*)(B.src + (size_t)k * B.N + 4 * (lane & 31)));
        gk[j] = k;
    }
}
__device__ __forceinline__ void tr_commit(const f32x4 (&ld)[8], const int (&gk)[8], LAS const float* gtab, int goff, LAS unsigned char* img, int wave, int lane) {
#pragma unroll
    for (int j = 0; j < 8; ++j) {
        const int k = 16 * wave + 2 * j + (lane >> 5);
        const float g = gtab[goff + gk[j]];
        u32x2 w; w.x = pk2(ld[j][0] * g, ld[j][1] * g); w.y = pk2(ld[j][2] * g, ld[j][3] * g);
        *(LAS u32x2*)(img + k * TR_PITCH + 8 * (lane & 31)) = w;
    }
}
__device__ __forceinline__ void tr_emit(const TrBlk& B, LAS const unsigned char* img, int wave, int lane) {
    const int i = lane & 15, g = lane >> 4, q = i >> 2, p = i & 3;
    const int io = (B.rp && (wave & 3) == 0) ? ((i < 8) ? 2 * i : 2 * (i - 8) + 1) : i;
#pragma unroll
    for (int kg = 0; kg < 4; ++kg) {
        const int kb = 8 * (4 * kg + g);
        const s16x4 lo = __builtin_bit_cast(s16x4, __builtin_amdgcn_ds_read_tr16_b64_v4i16((LAS s16x4*)(img + (kb + q) * TR_PITCH + (16 * wave + 4 * p) * 2)));
        const s16x4 hi = __builtin_bit_cast(s16x4, __builtin_amdgcn_ds_read_tr16_b64_v4i16((LAS s16x4*)(img + (kb + 4 + q) * TR_PITCH + (16 * wave + 4 * p) * 2)));
        if (!B.fp8) {
            v4u o; o.x = (unsigned)(unsigned short)lo[0] | ((unsigned)(unsigned short)lo[1] << 16); o.y = (unsigned)(unsigned short)lo[2] | ((unsigned)(unsigned short)lo[3] << 16);
            o.z = (unsigned)(unsigned short)hi[0] | ((unsigned)(unsigned short)hi[1] << 16); o.w = (unsigned)(unsigned short)hi[2] | ((unsigned)(unsigned short)hi[3] << 16);
            *(GAS v4u*)(B.dst + (size_t)(16 * wave + io) * B.ldb + kb * 2) = o;
        } else {
            unsigned w0 = 0u, w1 = 0u;
            w0 = __builtin_amdgcn_cvt_pk_fp8_f32(bf2f((unsigned short)lo[0]), bf2f((unsigned short)lo[1]), w0, false);
            w0 = __builtin_amdgcn_cvt_pk_fp8_f32(bf2f((unsigned short)lo[2]), bf2f((unsigned short)lo[3]), w0, true);
            w1 = __builtin_amdgcn_cvt_pk_fp8_f32(bf2f((unsigned short)hi[0]), bf2f((unsigned short)hi[1]), w1, false);
            w1 = __builtin_amdgcn_cvt_pk_fp8_f32(bf2f((unsigned short)hi[2]), bf2f((unsigned short)hi[3]), w1, true);
            *(GAS u32x2*)(B.dst + (size_t)(16 * wave + i) * B.ldb + kb) = (u32x2){w0, w1};
        }
    }
}

struct Ptrs {
    const float *x, *ln_mix, *ln_ffn, *ret_w_in, *ret_w_o, *kv_norm, *w_kv, *diff_w_q, *lq1, *lk1, *lq2, *lk2, *subln, *diff_w_o, *ffn_w_gu, *ffn_w_down, *router, *moe_w_gu, *moe_w_down, *final_norm;
    float* out; unsigned char* ws;
};

__device__ __forceinline__ void p0_prologue(const Ptrs& P, LAS unsigned char* lds, int vcu, int G, float lambda_init) {
    PHASE_IDS();
    unsigned char* ws = P.ws;
    const int gw = vcu * NWAVES + wave, NGW = G * NWAVES;
    {
        constexpr int B_IN = (D / 128) * (RIN / 128), B_RO = (RVD / 128) * (D / 128), B_GU = (D / 128) * (2 * FF / 128), B_DN = (FF / 128) * (D / 128), B_KV = (D / 128) * (2048 / 128), B_Q = (D / 128) * (D / 128), B_DO = B_Q;
        constexpr int NBLK = B_IN + B_RO + B_GU + B_DN + B_KV + B_Q + B_DO;
#define OPQ(p) asm volatile("" : "+s"(p))
        auto decode = [&](int it) -> TrBlk {
            const float* W; int K, N, gsel = 5, F = 0, row_off = 0, fp8 = 0, rpk = 0; unsigned char* WT; int r = it;
            if (r < B_IN) { W = P.ret_w_in; OPQ(W); K = D; N = RIN; gsel = 0; WT = ws + WS_W_IN; }
            else if ((r -= B_IN) < B_RO) { W = P.ret_w_o; OPQ(W); K = RVD; N = D; WT = ws + WS_W_RO; }
            else if ((r -= B_RO) < B_GU) { W = P.ffn_w_gu; OPQ(W); K = D; N = 2 * FF; gsel = 1; F = FF; WT = ws + WS_W_GU; fp8 = 1; }
            else if ((r -= B_GU) < B_DN) { W = P.ffn_w_down; OPQ(W); K = FF; N = D; gsel = 6; WT = ws + WS_W_DN; fp8 = 1; }
            else if ((r -= B_DN) < B_KV) { W = P.w_kv; OPQ(W); K = D; N = 2048; gsel = 2; WT = ws + WS_W_KVQ; rpk = 1; }
            else if ((r -= B_KV) < B_Q) { W = P.diff_w_q; OPQ(W); K = D; N = D; gsel = 3; row_off = 2048; WT = ws + WS_W_KVQ; rpk = 2; }
            else if ((r -= B_Q) < B_DO) { W = P.diff_w_o; OPQ(W); K = D; N = D; gsel = 4; WT = ws + WS_W_DO; rpk = 3; }
            else { W = P.diff_w_o; OPQ(W); K = D; N = D; WT = ws + WS_W_DO; }
            const int nblk = N / 128, kb = r / nblk, nb = r % nblk, k0 = 128 * kb, n0 = 128 * nb;
            int drow = n0;
            if (F > 0) { const int up = n0 >= F ? 1 : 0; const int f = n0 - up * F; drow = 256 * (f >> 7) + 128 * up; }
            TrBlk B; B.src = W + (size_t)k0 * N + n0; B.N = N; B.goff = gsel * 1024 + (gsel >= 5 ? 0 : k0); B.k0 = k0; B.ldb = fp8 ? K : K * 2; B.fp8 = fp8; B.rp = (rpk == 2 || (rpk == 1 && n0 < 1024)) ? 1 : 0; B.kp = (rpk == 3) ? 1 : 0;
            B.dst = WT + ((size_t)(row_off + drow) * K + k0) * (fp8 ? 1 : 2);
            return B;
        };
#define LDS_BAR() do { asm volatile("s_waitcnt lgkmcnt(0)" ::: "memory"); __builtin_amdgcn_s_barrier(); asm volatile("" ::: "memory"); } while (0)
        LAS unsigned char* img0 = lds; LAS unsigned char* img1 = lds + 128 * TR_PITCH;
        LAS float* gtab = (LAS float*)(lds + 2 * 128 * TR_PITCH);
        f32x4 ldA[8], ldB[8]; int gkA[8], gkB[8];
        int it = vcu;
        TrBlk bA = decode(it < NBLK ? it : 0), bB = decode(it + G < NBLK ? it + G : 0);
        if (it < NBLK) tr_load(bA, ldA, gkA, wave, lane);
        if (it + G < NBLK) tr_load(bB, ldB, gkB, wave, lane);
        for (int k = tid; k < 1024; k += NTHREADS) {
            gtab[k] = P.ln_mix[k]; gtab[1024 + k] = P.ln_ffn[k] * FFN_WGU_SCALE; gtab[2048 + k] = P.kv_norm[k]; gtab[3072 + k] = P.ln_mix[D + k];
            gtab[4096 + k] = P.subln[k & 127] * (1.0f - lambda_init); gtab[5120 + k] = 1.0f; gtab[6144 + k] = FFN_WDN_SCALE;
        }
        WG_BAR();
        for (; it < NBLK; it += 2 * G) {
            tr_commit(ldA, gkA, gtab, bA.goff, img0, wave, lane);
            LDS_BAR();
            const TrBlk cA = bA; const int n2 = it + 2 * G;
            bA = decode(n2 < NBLK ? n2 : 0);
            if (n2 < NBLK) tr_load(bA, ldA, gkA, wave, lane);
            tr_emit(cA, img0, wave, lane);
            if (it + G < NBLK) {
                tr_commit(ldB, gkB, gtab, bB.goff, img1, wave, lane);
                LDS_BAR();
                const TrBlk cB = bB; const int n3 = it + 3 * G;
                bB = decode(n3 < NBLK ? n3 : 0);
                if (n3 < NBLK) tr_load(bB, ldB, gkB, wave, lane);
                tr_emit(cB, img1, wave, lane);
            }
        }
        LDS_BAR();
#undef LDS_BAR
    }
    {
        const int gt = gw * 64 + lane, NT = NGW * 64;
        float* rc = (float*)(ws + WS_RCOS); float* rs = (float*)(ws + WS_RSIN);
        for (int i = gt; i < SEQ * 128; i += NT) {
            const int pos = i >> 7, f = i & 127;
            const float inv = exp2f(-(float)f * (13.287712379549449f / 128.0f));
            const double rev = (double)((float)pos * inv) * 0.15915494309189535;
            const float fr = (float)(rev - floor(rev));
            rc[i] = __builtin_amdgcn_cosf(fr); rs[i] = __builtin_amdgcn_sinf(fr);
        }
        float* dc = (float*)(ws + WS_DCOS); float* ds = (float*)(ws + WS_DSIN);
        for (int i = NT - 1 - gt; i < SEQ * 8; i += NT) {
            const int pos = i >> 3, f = i & 7;
            const float inv = exp2f(-(float)f * (18.931568569324174f / 8.0f));
            const double rev = (double)((float)pos * inv) * 0.15915494309189535;
            const float fr = (float)(rev - floor(rev));
            dc[i] = __builtin_amdgcn_cosf(fr); ds[i] = __builtin_amdgcn_sinf(fr);
        }
        float* rwt = (float*)(ws + WS_RWT);
        for (int i = NT - 1 - gt; i < NE * D; i += NT) { const int e = i >> 10, k = i & 1023; rwt[i] = P.router[k * NE + e] * P.ln_ffn[D + k]; }
    }
    {
        bf16* xb = (bf16*)(ws + WS_XB); float* ssp = (float*)(ws + WS_SSP);
        constexpr int NBLK_ = (D / 128) * (RIN / 128) + (RVD / 128) * (D / 128) + (D / 128) * (2 * FF / 128) + (FF / 128) * (D / 128) + (D / 128) * (2048 / 128) + 2 * (D / 128) * (D / 128);
        const bool deal = (G == 256) && (NBLK_ > 5 * 256) && (NBLK_ - 5 * 256) * NWAVES <= 128;
        const int hw = deal ? (NBLK_ - 5 * 256) * NWAVES : 0;
        const int ntrip = (M - gw + NGW - 1) / NGW;
        int mytrips = ntrip;
        if (deal) { if (gw < hw) mytrips = ntrip - 2; else if (gw - hw < 2 * hw) mytrips = ntrip + 1; }
        auto row_of = [&](const int k) -> int { if (k < ntrip) return gw + k * NGW; const int lw = gw - hw; return (lw % hw) + (ntrip - 2 + lw / hw) * NGW; };
        f32x4 nv[4];
        if (mytrips > 0) { const GAS f32x4* xr = (const GAS f32x4*)(P.x + (size_t)row_of(0) * D) + lane;
#pragma unroll
            for (int j = 0; j < 4; ++j) nv[j] = __builtin_nontemporal_load(&xr[64 * j]); }
        for (int k = 0; k < mytrips; ++k) {
            const int m = row_of(k);
            f32x4 v[4]; float s = 0.f;
#pragma unroll
            for (int j = 0; j < 4; ++j) { v[j] = nv[j]; s += (v[j].x * v[j].x + v[j].y * v[j].y) + (v[j].z * v[j].z + v[j].w * v[j].w); }
            if (k + 1 < mytrips) { const GAS f32x4* xr = (const GAS f32x4*)(P.x + (size_t)row_of(k + 1) * D) + lane;
#pragma unroll
                for (int j = 0; j < 4; ++j) nv[j] = __builtin_nontemporal_load(&xr[64 * j]); }
            s = wave_sum(s);
            GAS unsigned long long* o8 = (GAS unsigned long long*)(xb + (size_t)m * D) + lane;
#pragma unroll
            for (int j = 0; j < 4; ++j) o8[64 * j] = (unsigned long long)pk2(v[j].x, v[j].y) | ((unsigned long long)pk2(v[j].z, v[j].w) << 32);
            if (lane < 16) ssp[(size_t)m * 16 + lane] = lane == 0 ? s : 0.f;
        }
    }
}

constexpr int CV_BLKS_GU = NE * (D / 128) * (2 * EF / 128), CV_BLKS_DN = NE * (EF / 128) * (D / 128), CV_BLKS = CV_BLKS_GU + CV_BLKS_DN;
constexpr int CV_PITCH = 272, CV_IMG = 32 * CV_PITCH;
struct CvMini { const float* src; unsigned char* dst; int N, ldb, kg; };
__device__ __forceinline__ CvMini cv_decode(const Ptrs& P, int blk, int qk) {
    CvMini m;
    if (blk < CV_BLKS_GU) {
        const int e = blk / 448, r = blk % 448, kb = r / 56, nb = r % 56, k0 = 128 * kb + 32 * qk, n0 = 128 * nb;
        const int up = n0 >= EF ? 1 : 0, f = n0 - up * EF, drow = 256 * (f >> 7) + 128 * up;
        m.src = P.moe_w_gu + (size_t)e * D * 2 * EF + (size_t)k0 * (2 * EF) + n0; m.kg = k0; m.N = 2 * EF;
        m.dst = P.ws + WS_W_MGU + (size_t)e * 2 * EF * D + (size_t)drow * D + k0; m.ldb = D;
    } else {
        const int b2 = blk - CV_BLKS_GU, e = b2 / 224, r = b2 % 224, kb = r / 8, nb = r % 8, k0 = 128 * kb + 32 * qk, n0 = 128 * nb;
        m.src = P.moe_w_down + (size_t)e * EF * D + (size_t)k0 * D + n0; m.kg = -1; m.N = D;
        m.dst = P.ws + WS_W_MDN + (size_t)e * D * EF + (size_t)n0 * EF + k0; m.ldb = EF;
    }
    return m;
}
__device__ __forceinline__ void cv_load(const CvMini& m, f32x4 (&v)[2], int tid) {
#pragma unroll
    for (int j = 0; j < 2; ++j) { const int row = (tid >> 5) + 16 * j; v[j] = __builtin_nontemporal_load((const f32x4*)(m.src + (size_t)row * m.N + 4 * (tid & 31))); }
}
__device__ __forceinline__ void cv_commit(const f32x4 (&v)[2], int kg, LAS const float* gtab, LAS unsigned char* img, int tid) {
#pragma unroll
    for (int j = 0; j < 2; ++j) { const int row = (tid >> 5) + 16 * j;
        const float gn = kg >= 0 ? gtab[kg + row] : MOE_WDN_SCALE;
        u32x2 w; w.x = pk2(v[j][0] * gn, v[j][1] * gn); w.y = pk2(v[j][2] * gn, v[j][3] * gn);
        *(LAS u32x2*)(img + row * CV_PITCH + 8 * (tid & 31)) = w; }
}
__device__ __forceinline__ void cv_emit(unsigned char* dst, int ldb, LAS const unsigned char* img, int wave, int lane) {
    const int i = lane & 15, g4 = lane >> 4, q = i >> 2, p = i & 3;
    const s16x4 lo = __builtin_bit_cast(s16x4, __builtin_amdgcn_ds_read_tr16_b64_v4i16((LAS s16x4*)(img + (8 * g4 + q) * CV_PITCH + (16 * wave + 4 * p) * 2)));
    const s16x4 hi = __builtin_bit_cast(s16x4, __builtin_amdgcn_ds_read_tr16_b64_v4i16((LAS s16x4*)(img + (8 * g4 + 4 + q) * CV_PITCH + (16 * wave + 4 * p) * 2)));
    unsigned w0, w1; asm volatile("" : "=v"(w0), "=v"(w1));
    w0 = __builtin_amdgcn_cvt_pk_fp8_f32(bf2f((unsigned short)lo[0]), bf2f((unsigned short)lo[1]), w0, false); w0 = __builtin_amdgcn_cvt_pk_fp8_f32(bf2f((unsigned short)lo[2]), bf2f((unsigned short)lo[3]), w0, true);
    w1 = __builtin_amdgcn_cvt_pk_fp8_f32(bf2f((unsigned short)hi[0]), bf2f((unsigned short)hi[1]), w1, false); w1 = __builtin_amdgcn_cvt_pk_fp8_f32(bf2f((unsigned short)hi[2]), bf2f((unsigned short)hi[3]), w1, true);
    __builtin_nontemporal_store((u32x2){w0, w1}, (GAS u32x2*)(dst + (size_t)(16 * wave + i) * ldb + 8 * g4));
}

namespace ret {
typedef short v4i16_t __attribute__((ext_vector_type(4)));
__device__ __forceinline__ s16x4 trld(LAS const unsigned char* p) { return __builtin_bit_cast(s16x4, __builtin_amdgcn_ds_read_tr16_b64_v4i16((LAS v4i16_t*)p)); }
__device__ __forceinline__ bf16x8 cat8(s16x4 lo, s16x4 hi) { return (bf16x8){lo[0], lo[1], lo[2], lo[3], hi[0], hi[1], hi[2], hi[3]}; }
constexpr int QSTR = 528, SSTR = 144;
constexpr int LQ = 0, LK = LQ + 64 * QSTR, LV = LK + 64 * 512, LVD = LV + 4096, LS = LVD + 4096, LST = LS + 64 * SSTR, LEND = LST + 32 * QSTR;
static_assert(LEND + 2 * 32 * 272 + 4096 <= RING_BYTES && (LK % 16) == 0 && (LV % 16) == 0 && (LS % 16) == 0 && (LST % 16) == 0, "retention LDS map");

__device__ __forceinline__ void scores_phase(const bf16* proj, bf16* sbuf, LAS unsigned char* lds, int vcu, int G) {
    PHASE_IDS();
    const int i = lane & 15, g = lane >> 4;
    const int srow = tid >> 5, sc16 = tid & 31;
    constexpr int SQ = 0, SK = 64 * QSTR;
    for (int u = vcu; u < 1024; u += G) {
        const int bh = u >> 6, c = u & 63, b = bh >> 2, h = bh & 3;
        const size_t R0 = (size_t)b * SEQ + c * 64;
        const float lg = log2f(1.0f - exp2f(-5.0f - (float)h));
        const bf16* gq = proj + (R0 + srow) * RIN + h * 256 + sc16 * 8;
        v4u tq[4], tk[4];
#pragma unroll
        for (int k = 0; k < 4; ++k) { tq[k] = *(const v4u*)(gq + (size_t)(16 * k) * RIN); tk[k] = *(const v4u*)(gq + 1024 + (size_t)(16 * k) * RIN); }
#pragma unroll
        for (int k = 0; k < 4; ++k) { *(LAS v4u*)(lds + SQ + (srow + 16 * k) * QSTR + sc16 * 16) = tq[k]; *(LAS v4u*)(lds + SK + (srow + 16 * k) * QSTR + sc16 * 16) = tk[k]; }
        WG_BAR();
#pragma unroll
        for (int tt = 0; tt < 2; ++tt) {
            const int ti = 2 * wave + tt, tn = ti >> 2, tm = ti & 3;
            f32x4 acc = (f32x4){0.f, 0.f, 0.f, 0.f};
            if (tm <= tn) {
#pragma unroll
                for (int s = 0; s < 8; ++s) {
                    const bf16x8 a = *(const LAS bf16x8*)(lds + SK + (16 * tm + i) * QSTR + (32 * s + 8 * g) * 2), bq = *(const LAS bf16x8*)(lds + SQ + (16 * tn + i) * QSTR + (32 * s + 8 * g) * 2);
                    acc = __builtin_amdgcn_mfma_f32_16x16x32_bf16(a, bq, acc, 0, 0, 0);
                }
            }
            const int n = 16 * tn + i, m0 = 16 * tm + 4 * g;
            float v[4];
#pragma unroll
            for (int r = 0; r < 4; ++r) { const int dm = n - (m0 + r); v[r] = dm >= 0 ? acc[r] * exp2f((float)dm * lg) : 0.f; }
            u32x2 w; w.x = pk2(v[0], v[1]); w.y = pk2(v[2], v[3]);
            *(u32x2*)(sbuf + (size_t)u * 4096 + n * 64 + m0) = w;
        }
        WG_BAR();
    }
}

__device__ __forceinline__ void scan_phase(const Ptrs& P, const bf16* proj, const bf16* sbuf, bf16* oret, LAS unsigned char* lds, int vcu, int G) {
    PHASE_IDS();
    int cvp = 0;
    struct CvSet { f32x4 a[2], b[2]; unsigned char* d0; unsigned char* d1; int l0, l1, k0, k1; bool have; };
    CvSet cs0, cs1; cs0.have = false; cs1.have = false; cs0.d0 = cs0.d1 = cs1.d0 = cs1.d1 = nullptr; cs0.l0 = cs0.l1 = cs1.l0 = cs1.l1 = 0; cs0.k0 = cs0.k1 = cs1.k0 = cs1.k1 = -1;
    LAS float* gtab = (LAS float*)(lds + LEND + 2 * CV_IMG);
    for (int k = tid; k < D; k += NTHREADS) gtab[k] = P.ln_ffn[D + k] * MOE_WGU_SCALE;
    WG_BAR();
#define SCAN_LBAR() do { asm volatile("s_waitcnt lgkmcnt(0)" ::: "memory"); __builtin_amdgcn_s_barrier(); asm volatile("" ::: "memory"); } while (0)
    LAS unsigned char* cimg0 = lds + LEND; LAS unsigned char* cimg1 = lds + LEND + CV_IMG;
    const int i = lane & 15, g = lane >> 4, q = i >> 2, p = i & 3;
    const int nt = wave >> 1, vt = wave & 1;
    for (int u = vcu; u < 256; u += G) {
        const int bh = u >> 4, vs = u & 15, b = bh >> 2, h = bh & 3;
        const float lg = log2f(1.0f - exp2f(-5.0f - (float)h));
        const float cdec = exp2f(64.0f * lg);
        const float qdl = exp2f((float)(16 * nt + i + 1) * lg);
        const float kd = exp2f((float)(63 - (tid >> 2)) * lg);
        const int qrow = tid >> 5, qc16 = tid & 31;
        const char* uq = (const char*)(proj + (size_t)b * SEQ * RIN + h * 256);
        const unsigned qoff = (unsigned)(qrow * RIN + qc16 * 8) * 2u;
        const int kx = (qrow & 3) | (((qrow >> 3) & 1) << 2);
        const int lq_off = LQ + qrow * QSTR + qc16 * 16;
        const int lk_off = LK + qrow * 512 + (((qc16 >> 1) ^ kx) << 5) + (qc16 & 1) * 16;
        const int vrow = tid >> 2, vc16 = tid & 3;
        const char* uv = (const char*)(proj + (size_t)b * SEQ * RIN + 2048 + h * 512 + vs * 32);
        const unsigned voff = (unsigned)(vrow * RIN + vc16 * 8) * 2u;
        const int lv_off = vrow * 64 + ((vc16 * 16) ^ (((vrow >> 3) & 1) << 5));
        const int srow = tid >> 3, sc16 = tid & 7;
        const char* us = (const char*)(sbuf + (size_t)(bh * 64) * 4096);
        const unsigned soff = (unsigned)tid * 16u;
        const int ls_off = LS + srow * SSTR + sc16 * 16;
        f32x4 st[2][2];
#pragma unroll
        for (int a = 0; a < 2; ++a)
#pragma unroll
            for (int c2 = 0; c2 < 2; ++c2) st[a][c2] = (f32x4){0.f, 0.f, 0.f, 0.f};
        for (int k = tid; k < 32 * QSTR / 16; k += NTHREADS) ((LAS v4u*)(lds + LST))[k] = (v4u){0u, 0u, 0u, 0u};
        v4u pq[4], pk[4], pv, ps;
#pragma unroll
        for (int k = 0; k < 4; ++k) { pq[k] = *(const v4u*)(uq + (size_t)(16 * k) * RIN * 2 + qoff); pk[k] = *(const v4u*)(uq + (size_t)(16 * k) * RIN * 2 + 2048 + qoff); }
        pv = (tid < 256) ? *(const v4u*)(uv + voff) : (v4u){0u, 0u, 0u, 0u};
        ps = *(const v4u*)(us + soff);
        auto scan_step = [&](const int c, CvSet& CS) __attribute__((always_inline)) {
#pragma unroll
            for (int k = 0; k < 4; ++k) { *(LAS v4u*)(lds + lq_off + 16 * k * QSTR) = pq[k]; *(LAS v4u*)(lds + lk_off + 16 * k * 512) = pk[k]; }
            if (tid < 256) {
                *(LAS v4u*)(lds + LV + lv_off) = pv;
                v4u d; d.x = pk2(bflo(pv.x) * kd, bfhi(pv.x) * kd); d.y = pk2(bflo(pv.y) * kd, bfhi(pv.y) * kd); d.z = pk2(bflo(pv.z) * kd, bfhi(pv.z) * kd); d.w = pk2(bflo(pv.w) * kd, bfhi(pv.w) * kd);
                *(LAS v4u*)(lds + LVD + lv_off) = d;
            }
            *(LAS v4u*)(lds + ls_off) = ps;
            unsigned char* ed0 = CS.d0; unsigned char* ed1 = CS.d1; const int el0 = CS.l0, el1 = CS.l1; const bool cv_emit_now = CS.have;
            if (CS.have) { cv_commit(CS.a, CS.k0, gtab, cimg0, tid); cv_commit(CS.b, CS.k1, gtab, cimg1, tid); }
            SCAN_LBAR();
            if (c + 1 < 64) {
                const size_t adv = (size_t)(c + 1) * 64 * RIN * 2;
#pragma unroll
                for (int k = 0; k < 4; ++k) { pq[k] = *(const v4u*)(uq + adv + (size_t)(16 * k) * RIN * 2 + qoff); pk[k] = *(const v4u*)(uq + adv + (size_t)(16 * k) * RIN * 2 + 2048 + qoff); }
                if (tid < 256) pv = *(const v4u*)(uv + adv + voff);
                ps = *(const v4u*)(us + (size_t)(c + 1) * 8192 + soff);
            }
            {
                const int blk = vcu + (cvp >> 1) * G;
                CS.have = blk < CV_BLKS;
                if (CS.have) { const CvMini m0 = cv_decode(P, blk, 2 * (cvp & 1)), m1 = cv_decode(P, blk, 2 * (cvp & 1) + 1);
                    cv_load(m0, CS.a, tid); cv_load(m1, CS.b, tid); CS.d0 = m0.dst; CS.l0 = m0.ldb; CS.k0 = m0.kg; CS.d1 = m1.dst; CS.l1 = m1.ldb; CS.k1 = m1.kg; ++cvp; }
            }
            f32x4 a1 = (f32x4){0.f, 0.f, 0.f, 0.f}, a2 = (f32x4){0.f, 0.f, 0.f, 0.f}, a3 = (f32x4){0.f, 0.f, 0.f, 0.f};
#pragma unroll
            for (int s = 0; s < 2; ++s) {
                const bf16x8 a = *(const LAS bf16x8*)(lds + LS + (16 * nt + i) * SSTR + (32 * s + 8 * g) * 2);
                const int r0 = 32 * s + 8 * g + q, r1 = r0 + 4, cb = (16 * vt + 4 * p) * 2;
                const s16x4 lo = trld(lds + LV + r0 * 64 + (cb ^ (((r0 >> 3) & 1) << 5))), hi = trld(lds + LV + r1 * 64 + (cb ^ (((r1 >> 3) & 1) << 5)));
                a1 = __builtin_amdgcn_mfma_f32_16x16x32_bf16(cat8(lo, hi), a, a1, 0, 0, 0);
            }
#pragma unroll
            for (int s = 0; s < 8; ++s) {
                const bf16x8 a = *(const LAS bf16x8*)(lds + LQ + (16 * nt + i) * QSTR + (32 * s + 8 * g) * 2);
                const bf16x8 sf = *(const LAS bf16x8*)(lds + LST + (16 * vt + i) * QSTR + (32 * s + 8 * g) * 2);
                if (s & 1) a3 = __builtin_amdgcn_mfma_f32_16x16x32_bf16(sf, a, a3, 0, 0, 0);
                else a2 = __builtin_amdgcn_mfma_f32_16x16x32_bf16(sf, a, a2, 0, 0, 0);
            }
#pragma unroll
            for (int dt = 0; dt < 2; ++dt)
#pragma unroll
                for (int vv = 0; vv < 2; ++vv) st[dt][vv] = st[dt][vv] * cdec;
#pragma unroll
            for (int s = 0; s < 2; ++s) {
                const int r0 = 32 * s + 8 * g + q, r1 = r0 + 4;
                const int x0 = (r0 & 3) | (((r0 >> 3) & 1) << 2), x1 = (r1 & 3) | (((r1 >> 3) & 1) << 2);
                bf16x8 ka[2], vb[2];
#pragma unroll
                for (int dt = 0; dt < 2; ++dt) {
                    const int slot = 2 * wave + dt;
                    ka[dt] = cat8(trld(lds + LK + r0 * 512 + ((slot ^ x0) << 5) + 8 * p), trld(lds + LK + r1 * 512 + ((slot ^ x1) << 5) + 8 * p));
                }
#pragma unroll
                for (int vv = 0; vv < 2; ++vv) {
                    const int cb = (16 * vv + 4 * p) * 2;
                    vb[vv] = cat8(trld(lds + LVD + r0 * 64 + (cb ^ (((r0 >> 3) & 1) << 5))), trld(lds + LVD + r1 * 64 + (cb ^ (((r1 >> 3) & 1) << 5))));
                }
#pragma unroll
                for (int dt = 0; dt < 2; ++dt)
#pragma unroll
                    for (int vv = 0; vv < 2; ++vv) st[dt][vv] = __builtin_amdgcn_mfma_f32_16x16x32_bf16(ka[dt], vb[vv], st[dt][vv], 0, 0, 0);
            }
            {
                char* uo = (char*)(oret + ((size_t)b * SEQ + c * 64) * RVD + h * 512 + vs * 32);
                const unsigned ooff = (unsigned)((16 * nt + i) * RVD + 16 * vt + 4 * g) * 2u;
                float ov_[4];
#pragma unroll
                for (int r = 0; r < 4; ++r) ov_[r] = a1[r] + qdl * (a2[r] + a3[r]);
                u32x2 w_; w_.x = pk2(ov_[0], ov_[1]); w_.y = pk2(ov_[2], ov_[3]);
                *(u32x2*)(uo + ooff) = w_;
            }
            if (cv_emit_now) { cv_emit(ed0, el0, cimg0, wave, lane); cv_emit(ed1, el1, cimg1, wave, lane); }
            SCAN_LBAR();
#pragma unroll
            for (int dt = 0; dt < 2; ++dt)
#pragma unroll
                for (int vv = 0; vv < 2; ++vv)
                    *(LAS u32x2*)(lds + LST + (16 * vv + i) * QSTR + (32 * wave + 16 * dt + 4 * g) * 2) = (u32x2){pk2(st[dt][vv][0], st[dt][vv][1]), pk2(st[dt][vv][2], st[dt][vv][3])};
        };
        for (int c = 0; c < 64; c += 2) { scan_step(c, cs0); scan_step(c + 1, cs1); }
        WG_BAR();
    }
    for (;;) {
        bool any = false;
#pragma unroll
        for (int k = 0; k < 2; ++k) {
            CvSet& CS = k ? cs1 : cs0;
            unsigned char* ed0 = CS.d0; unsigned char* ed1 = CS.d1; const int el0 = CS.l0, el1 = CS.l1; const bool emit_now = CS.have;
            if (CS.have) { cv_commit(CS.a, CS.k0, gtab, cimg0, tid); cv_commit(CS.b, CS.k1, gtab, cimg1, tid); }
            WG_BAR();
            const int blk = vcu + (cvp >> 1) * G;
            CS.have = blk < CV_BLKS;
            if (CS.have) { const CvMini m0 = cv_decode(P, blk, 2 * (cvp & 1)), m1 = cv_decode(P, blk, 2 * (cvp & 1) + 1);
                cv_load(m0, CS.a, tid); cv_load(m1, CS.b, tid); CS.d0 = m0.dst; CS.l0 = m0.ldb; CS.k0 = m0.kg; CS.d1 = m1.dst; CS.l1 = m1.ldb; CS.k1 = m1.kg; ++cvp; }
            if (emit_now) { cv_emit(ed0, el0, cimg0, wave, lane); cv_emit(ed1, el1, cimg1, wave, lane); }
            WG_BAR();
            any = any || emit_now || CS.have;
        }
        if (!any) break;
    }
#undef SCAN_LBAR
}

__device__ __forceinline__ void norm_gate_phase(const bf16* oret, const bf16* proj, bf16* ro, int vcu, int G) {
    PHASE_IDS();
    const int gw = vcu * NWAVES + wave, NGW = G * NWAVES;
    v4u nov[4], ngv[4];
#pragma unroll
    for (int h = 0; h < 4; ++h) {
        nov[h] = *(const v4u*)(oret + (size_t)gw * RVD + h * 512 + lane * 8);
        ngv[h] = *(const v4u*)(proj + (size_t)gw * RIN + 4096 + h * 512 + lane * 8);
    }
    for (int row = gw; row < M; row += NGW) {
        v4u ov[4], gv[4];
#pragma unroll
        for (int h = 0; h < 4; ++h) { ov[h] = nov[h]; gv[h] = ngv[h]; }
        if (row + NGW < M) {
#pragma unroll
            for (int h = 0; h < 4; ++h) {
                nov[h] = *(const v4u*)(oret + (size_t)(row + NGW) * RVD + h * 512 + lane * 8);
                ngv[h] = *(const v4u*)(proj + (size_t)(row + NGW) * RIN + 4096 + h * 512 + lane * 8);
            }
        }
        float o[4][8], mu[4], rstd[4];
#pragma unroll
        for (int h = 0; h < 4; ++h) {
            o[h][0] = bflo(ov[h].x); o[h][1] = bfhi(ov[h].x); o[h][2] = bflo(ov[h].y); o[h][3] = bfhi(ov[h].y); o[h][4] = bflo(ov[h].z); o[h][5] = bfhi(ov[h].z); o[h][6] = bflo(ov[h].w); o[h][7] = bfhi(ov[h].w);
            float s = 0.f;
#pragma unroll
            for (int j = 0; j < 8; ++j) s += o[h][j];
            mu[h] = s;
        }
#pragma unroll
        for (int h = 0; h < 4; ++h) mu[h] = wave_sum(mu[h]) * (1.0f / 512.0f);
#pragma unroll
        for (int h = 0; h < 4; ++h) {
            float s2 = 0.f;
#pragma unroll
            for (int j = 0; j < 8; ++j) { o[h][j] -= mu[h]; s2 += o[h][j] * o[h][j]; }
            rstd[h] = s2;
        }
#pragma unroll
        for (int h = 0; h < 4; ++h) rstd[h] = __builtin_amdgcn_rsqf(wave_sum(rstd[h]) * (1.0f / 512.0f) + EPS);
#pragma unroll
        for (int h = 0; h < 4; ++h) {
            const float gg[8] = {bflo(gv[h].x), bfhi(gv[h].x), bflo(gv[h].y), bfhi(gv[h].y), bflo(gv[h].z), bfhi(gv[h].z), bflo(gv[h].w), bfhi(gv[h].w)};
            float y[8];
#pragma unroll
            for (int j = 0; j < 8; ++j) y[j] = o[h][j] * rstd[h] * silu_f(gg[j]);
            v4u w; w.x = pk2(y[0], y[1]); w.y = pk2(y[2], y[3]); w.z = pk2(y[4], y[5]); w.w = pk2(y[6], y[7]);
            *(v4u*)(ro + (size_t)row * RVD + h * 512 + lane * 8) = w;
        }
    }
}
}

namespace dat {
constexpr int LK0 = 0  , LV0 = 32768  , LWS = 81920  , LCB = 0  , CSTR = 132;
__device__ __forceinline__ int crow(int r, int hi) { return (r & 3) + 8 * (r >> 2) + 4 * hi; }
__device__ __forceinline__ float half_swap_max(float m) { auto rr = __builtin_amdgcn_permlane32_swap(__float_as_uint(m), __float_as_uint(m), false, false); return fmaxf(__uint_as_float(rr[0]), __uint_as_float(rr[1])); }
__device__ __forceinline__ float half_swap_sum(float m) { auto rr = __builtin_amdgcn_permlane32_swap(__float_as_uint(m), __float_as_uint(m), false, false); return __uint_as_float(rr[0]) + __uint_as_float(rr[1]); }
typedef float f32x2_t __attribute__((ext_vector_type(2))); typedef __bf16 bf16x2_t __attribute__((ext_vector_type(2)));
__device__ __forceinline__ unsigned cvtpk(float lo, float hi) { f32x2_t v = {lo, hi}; bf16x2_t b2 = __builtin_convertvector(v, bf16x2_t); return __builtin_bit_cast(unsigned, b2); }
__device__ __forceinline__ float max3f(float a, float b, float c) { float r; asm("v_max3_f32 %0, %1, %2, %3" : "=v"(r) : "v"(a), "v"(b), "v"(c)); return r; }
__device__ __forceinline__ float fadd_s(float a, float b) { float r; asm("v_add_f32_e32 %0, %1, %2" : "=v"(r) : "v"(a), "v"(b)); return r; }

#define DAT_SBAR() __builtin_amdgcn_sched_barrier(0)
#define DAT_PIN(x) asm volatile("" : "+v"(x))
__device__ __forceinline__ void attn_unit(int b, int h, int qb, const bf16* kvq, bf16* ao, LAS unsigned char* lds, float lam, int wave, int lane, int tid) {
    const int r32 = lane & 31, hi = lane >> 5, comp = wave >> 2, w4 = wave & 3;
    const size_t rowbase = (size_t)b * SEQ;
    const int q0 = qb * 128;
    const int NT = 2 * qb + 2, ntw = 2 * qb + 1 + (w4 >> 1);
    const bf16* Kh = kvq + rowbase * KVQ_N + h * 128;
    const bf16* Vh = kvq + rowbase * KVQ_N + 1024 + h * 128;
    const bf16* Qw = kvq + (rowbase + q0 + w4 * 32) * KVQ_N + 2048 + h * 128 + comp * 64;
    LAS float* wsf = (LAS float*)(lds + LWS) + wave * 64;
    const int pkey = 4 * wave + (lane >> 4), pc = lane & 15;
    const unsigned kvoff = (unsigned)(pkey * KVQ_N + ((pc ^ (pkey & 15)) << 3)) * 2u;
    const unsigned vvoff = (unsigned)(pkey * KVQ_N + ((pc ^ ((pkey & 3) << 2)) << 3)) * 2u;
    const int koff0 = r32 * 256 + (((comp * 8 + hi) ^ (r32 & 15)) << 4);
    const int voff0 = (4 * hi + ((lane & 15) >> 2)) * 256 + ((((lane & 15) >> 2) << 6) | ((4 * ((lane >> 4) & 1) + (lane & 3)) << 3));
#define koffd(d) (koff0 ^ ((d) << 5))
#define voffd(d) (voff0 ^ ((d) << 6))
    const unsigned ldsb = (unsigned)(size_t)lds;
#define DAT_GLDS(base, voff, dst) do { unsigned keep_; asm volatile("s_mov_b32 %0, m0\n\ts_mov_b32 m0, %3\n\ts_nop 0\n\tglobal_load_lds_dwordx4 %1, %2\n\ts_mov_b32 m0, %0" : "=&s"(keep_) : "v"(voff), "s"(base), "s"(dst) : "memory"); } while (0)
#define DAT_DMA(t, kslot, vslot) do { const bf16* kb0_ = Kh + (size_t)(t) * 64 * KVQ_N; const bf16* vb0_ = Vh + (size_t)(t) * 64 * KVQ_N; \
        const unsigned kd_ = (unsigned)__builtin_amdgcn_readfirstlane(ldsb + LK0 + (kslot) * 16384 + wave * 1024), vd_ = (unsigned)__builtin_amdgcn_readfirstlane(ldsb + LV0 + (vslot) * 16384 + wave * 1024); \
        DAT_GLDS(kb0_, kvoff, kd_); DAT_GLDS(kb0_ + (size_t)32 * KVQ_N, kvoff, kd_ + 8192u); DAT_GLDS(vb0_, vvoff, vd_); DAT_GLDS(vb0_ + (size_t)32 * KVQ_N, vvoff, vd_ + 8192u); } while (0)
    DAT_DMA(0, 0, 0);
    bf16x8 qr[4];
#pragma unroll
    for (int d0 = 0; d0 < 4; ++d0) qr[d0] = *(const bf16x8*)(Qw + (size_t)r32 * KVQ_N + d0 * 16 + hi * 8);
    asm volatile("" : "+v"(qr[0]), "+v"(qr[1]), "+v"(qr[2]), "+v"(qr[3]));
    f32x16 o[4];
#pragma unroll
    for (int d = 0; d < 4; ++d)
#pragma unroll
        for (int r = 0; r < 16; ++r) o[d][r] = 0.f;
    float mrun = 0.f, lrun = 0.f;
    f32x16 negm;
#pragma unroll
    for (int r = 0; r < 16; ++r) negm[r] = 0.f;
    f32x16 C0, C1;
    v4u pw[4];
    int vsl_prev = 0, vsl_cur = 0;
    bool resc = false;
#define DAT_DECIDE(FIRST) do { \
        float ra_ = max3f(C0[0], C0[1], C1[0]), rb_ = max3f(C0[2], C0[3], C1[1]); ra_ = max3f(ra_, C1[2], C1[3]); \
        _Pragma("unroll") for (int r = 4; r < 16; r += 4) { ra_ = max3f(ra_, C0[r], C0[r + 1]); rb_ = max3f(rb_, C0[r + 2], C0[r + 3]); ra_ = max3f(ra_, C1[r], C1[r + 1]); rb_ = max3f(rb_, C1[r + 2], C1[r + 3]); } \
        const float rm_ = half_swap_max(max3f(ra_, rb_, rb_)); \
        if ((FIRST) || __any(rm_ > 8.0f)) { \
            const float dl_ = (FIRST) ? rm_ : fmaxf(rm_, 0.f); const float f_ = fast_exp2(-dl_); \
            lrun *= f_; mrun += dl_; if (hi == 0) wsf[r32] = f_; \
            _Pragma("unroll") for (int r = 0; r < 16; ++r) { C0[r] -= dl_; C1[r] -= dl_; negm[r] = -mrun; } \
            resc = !(FIRST); } } while (0)
#define DAT_RESC() do { if (resc) { asm volatile("s_waitcnt lgkmcnt(0)" ::: "memory"); \
        _Pragma("unroll") for (int r = 0; r < 16; ++r) { const float fr_ = wsf[crow(r, hi)]; _Pragma("unroll") for (int d = 0; d < 4; ++d) o[d][r] *= fr_; } resc = false; } } while (0)
#define DAT_VRD(dst_lo, dst_hi, j) do { dst_lo = ret::trld(Vb_ + voffd((j) >> 2) + ((j) & 3) * 4096); dst_hi = ret::trld(Vb_ + voffd((j) >> 2) + ((j) & 3) * 4096 + 2048); } while (0)
#define DAT_QK(t_, DO_, tn_) do { LAS const unsigned char* Kb_ = lds + LK0 + ((t_) & 1) * 16384; \
        const bf16* kb0_ = Kh + (size_t)(tn_) * 64 * KVQ_N; const bf16* vb0_ = Vh + (size_t)(tn_) * 64 * KVQ_N; const unsigned kd_ = (unsigned)__builtin_amdgcn_readfirstlane(ldsb + LK0 + ((tn_) & 1) * 16384 + wave * 1024), vd_ = (unsigned)__builtin_amdgcn_readfirstlane(ldsb + LV0 + ((tn_) % 3) * 16384 + wave * 1024); \
        bf16x8 ka_ = *(const LAS bf16x8*)(Kb_ + koffd(0)), kb_ = *(const LAS bf16x8*)(Kb_ + koffd(0) + 8192), kc_ = *(const LAS bf16x8*)(Kb_ + koffd(1)), kd2_ = *(const LAS bf16x8*)(Kb_ + koffd(1) + 8192); \
        DAT_SBAR(); \
        C0 = __builtin_amdgcn_mfma_f32_32x32x16_bf16(ka_, qr[0], negm, 0, 0, 0); C1 = __builtin_amdgcn_mfma_f32_32x32x16_bf16(kb_, qr[0], negm, 0, 0, 0); \
        ka_ = *(const LAS bf16x8*)(Kb_ + koffd(2)); kb_ = *(const LAS bf16x8*)(Kb_ + koffd(2) + 8192); if (DO_) DAT_GLDS(kb0_, kvoff, kd_); DAT_SBAR(); \
        C0 = __builtin_amdgcn_mfma_f32_32x32x16_bf16(kc_, qr[1], C0, 0, 0, 0); C1 = __builtin_amdgcn_mfma_f32_32x32x16_bf16(kd2_, qr[1], C1, 0, 0, 0); \
        kc_ = *(const LAS bf16x8*)(Kb_ + koffd(3)); kd2_ = *(const LAS bf16x8*)(Kb_ + koffd(3) + 8192); if (DO_) DAT_GLDS(kb0_ + (size_t)32 * KVQ_N, kvoff, kd_ + 8192u); DAT_SBAR(); \
        C0 = __builtin_amdgcn_mfma_f32_32x32x16_bf16(ka_, qr[2], C0, 0, 0, 0); C1 = __builtin_amdgcn_mfma_f32_32x32x16_bf16(kb_, qr[2], C1, 0, 0, 0); \
        if (DO_) DAT_GLDS(vb0_, vvoff, vd_); DAT_SBAR(); \
        C0 = __builtin_amdgcn_mfma_f32_32x32x16_bf16(kc_, qr[3], C0, 0, 0, 0); C1 = __builtin_amdgcn_mfma_f32_32x32x16_bf16(kd2_, qr[3], C1, 0, 0, 0); \
        if (DO_) DAT_GLDS(vb0_ + (size_t)32 * KVQ_N, vvoff, vd_ + 8192u); DAT_SBAR(); \
        asm volatile("s_nop 15\n\ts_nop 7" : "+v"(C0), "+v"(C1)); } while (0)
    {
        WG_BAR();
        DAT_QK(0, true, 1);
        DAT_DECIDE(true);
        float s0_ = 0.f, s1_ = 0.f;
#pragma unroll
        for (int j = 0; j < 16; ++j) {
            const float e0_ = fast_exp2(j < 8 ? C0[2 * (j & 7)] : C1[2 * (j & 7)]), e1_ = fast_exp2(j < 8 ? C0[2 * (j & 7) + 1] : C1[2 * (j & 7) + 1]);
            s0_ += e0_; s1_ += e1_; pw[j >> 2][j & 3] = cvtpk(e0_, e1_);
        }
        lrun += s0_ + s1_;
        vsl_prev = 0; vsl_cur = 16384;
    }
#define DAT_STEADY(t_, PWa, PWb) do { \
        WG_BAR(); \
        const bool dma_ = ((t_) + 1 < NT); \
        LAS const unsigned char* Vb_ = lds + LV0 + vsl_prev; \
        s16x4 vl_[4], vh_[4]; \
        _Pragma("unroll") for (int j = 0; j < 4; ++j) DAT_VRD(vl_[j], vh_[j], j); \
        DAT_QK(t_, dma_, (t_) + 1); \
        DAT_DECIDE(false); \
        const bf16x8 pa_[4] = {__builtin_bit_cast(bf16x8, PWa[0]), __builtin_bit_cast(bf16x8, PWa[1]), __builtin_bit_cast(bf16x8, PWa[2]), __builtin_bit_cast(bf16x8, PWa[3])}; \
        float ssum_ = 0.f; \
        DAT_SBAR(); \
        _Pragma("unroll") for (int j = 0; j < 16; ++j) { \
            o[j >> 2] = __builtin_amdgcn_mfma_f32_32x32x16_bf16(pa_[j & 3], ret::cat8(vl_[j & 3], vh_[j & 3]), o[j >> 2], 0, 0, 0); \
            if (j + 4 < 16) DAT_VRD(vl_[j & 3], vh_[j & 3], j + 4); \
            { const float e0_ = fast_exp2(j < 8 ? C0[2 * (j & 7)] : C1[2 * (j & 7)]), e1_ = fast_exp2(j < 8 ? C0[2 * (j & 7) + 1] : C1[2 * (j & 7) + 1]); \
              ssum_ += e0_; ssum_ += e1_; PWb[j >> 2][j & 3] = cvtpk(e0_, e1_); } \
            DAT_PIN(ssum_); DAT_SBAR(); \
        } \
        DAT_RESC(); \
        lrun += ssum_; \
        vsl_prev = vsl_cur; vsl_cur = (vsl_cur == 32768) ? 0 : vsl_cur + 16384; \
    } while (0)
    v4u pq_[4];
    int t = 1;
    for (; t + 1 < ntw; t += 2) { DAT_STEADY(t, pw, pq_); DAT_STEADY(t + 1, pq_, pw); }
    for (; t <= NT; ++t) {
        if (t < ntw) { DAT_STEADY(t, pw, pq_); pw[0] = pq_[0]; pw[1] = pq_[1]; pw[2] = pq_[2]; pw[3] = pq_[3]; }
        else {
            WG_BAR();
            const bool dma_ = (t + 1 < NT);
            LAS const unsigned char* Vb_ = lds + LV0 + vsl_prev;
            if (dma_) { const int tn_ = t + 1; DAT_DMA(tn_, tn_ & 1, tn_ % 3); }
            if (t == ntw) {
            const bf16x8 pa_[4] = {__builtin_bit_cast(bf16x8, pw[0]), __builtin_bit_cast(bf16x8, pw[1]), __builtin_bit_cast(bf16x8, pw[2]), __builtin_bit_cast(bf16x8, pw[3])};
#pragma unroll
            for (int d = 0; d < 4; ++d)
#pragma unroll
                for (int ks = 0; ks < 4; ++ks) {
                    const s16x4 lo_ = ret::trld(Vb_ + voffd(d) + ks * 4096), hh_ = ret::trld(Vb_ + voffd(d) + ks * 4096 + 2048);
                    o[d] = __builtin_amdgcn_mfma_f32_32x32x16_bf16(pa_[ks], ret::cat8(lo_, hh_), o[d], 0, 0, 0);
                }
            }
            vsl_prev = vsl_cur; vsl_cur = (vsl_cur == 32768) ? 0 : vsl_cur + 16384;
        }
    }
#undef DAT_STEADY
#undef DAT_QK
#undef DAT_VRD
#undef DAT_RESC
#undef DAT_DECIDE
#undef DAT_DMA
#undef DAT_GLDS
#undef koffd
#undef voffd
    {
        const float lt = half_swap_sum(lrun);
        if (hi == 0) wsf[r32] = (comp ? lam : 1.0f) * fast_rcp(lt);
        asm volatile("s_waitcnt lgkmcnt(0)" ::: "memory");
#pragma unroll
        for (int r = 0; r < 16; ++r) { const float fr_ = wsf[crow(r, hi)];
#pragma unroll
            for (int d = 0; d < 4; ++d) o[d][r] *= fr_; }
    }
    WG_BAR();
    LAS f32x4* ex = (LAS f32x4*)(lds + LCB);
    if (comp == 1) {
#pragma unroll
        for (int d = 0; d < 4; ++d)
#pragma unroll
            for (int k = 0; k < 4; ++k) ex[((w4 * 4 + d) * 4 + k) * 64 + lane] = (f32x4){o[d][4 * k], o[d][4 * k + 1], o[d][4 * k + 2], o[d][4 * k + 3]};
    }
    asm volatile("s_waitcnt lgkmcnt(0)" ::: "memory"); __builtin_amdgcn_s_barrier(); asm volatile("" ::: "memory");
    if (comp == 0) {
        float ps[16];
#pragma unroll
        for (int r = 0; r < 16; ++r) ps[r] = 0.f;
#pragma unroll
        for (int d = 0; d < 4; ++d)
#pragma unroll
            for (int k = 0; k < 4; ++k) {
                const f32x4 x1 = ex[((w4 * 4 + d) * 4 + k) * 64 + lane];
#pragma unroll
                for (int e = 0; e < 4; ++e) { const float v = o[d][4 * k + e] - x1[e]; o[d][4 * k + e] = v; ps[4 * k + e] += v * v; }
            }
        const bool b0 = lane & 1, b1 = lane & 2, b2 = lane & 4, b3 = lane & 8;
        float s8[8], s4[4], s2[2];
#pragma unroll
        for (int x = 0; x < 8; ++x) { const float snd = b0 ? ps[x] : ps[x + 8]; s8[x] = (b0 ? ps[x + 8] : ps[x]) + DPP_F(snd, DPP_XOR1); }
#pragma unroll
        for (int x = 0; x < 4; ++x) { const float snd = b1 ? s8[x] : s8[x + 4]; s4[x] = (b1 ? s8[x + 4] : s8[x]) + DPP_F(snd, DPP_XOR2); }
#pragma unroll
        for (int x = 0; x < 2; ++x) { const float snd = b2 ? s4[x] : s4[x + 2]; s2[x] = (b2 ? s4[x + 2] : s4[x]) + DPP_F(snd, DPP_ROR4); }
        float s1;
        { const float snd = b3 ? s2[0] : s2[1]; s1 = (b3 ? s2[1] : s2[0]) + DPP_F(snd, DPP_ROR8); }
        s1 += SWZ_XOR(s1, 16);
        const int rs_bits = __float_as_int(__builtin_amdgcn_rsqf(s1 * (1.0f / 128.0f) + EPS));
        bf16* dst = ao + (rowbase + q0 + w4 * 32) * D + h * 128 + r32 * 4;
#pragma unroll
        for (int r = 0; r < 16; ++r) {
            constexpr int dummy_ = 0; (void)dummy_;
            const int src_lane = ((r >> 3) & 1) | (((r >> 2) & 1) << 1) | (((r >> 1) & 1) << 2) | ((r & 1) << 3);
            const float rlo = __int_as_float(__builtin_amdgcn_readlane(rs_bits, src_lane)), rhi = __int_as_float(__builtin_amdgcn_readlane(rs_bits, 32 + src_lane));
            const float rstd = hi ? rhi : rlo;
            u32x2 w; w.x = pk2(o[0][r] * rstd, o[1][r] * rstd); w.y = pk2(o[2][r] * rstd, o[3][r] * rstd);
            *(u32x2*)(dst + (size_t)crow(r, hi) * D) = w;
        }
    }
    asm volatile("s_waitcnt lgkmcnt(0)" ::: "memory"); __builtin_amdgcn_s_barrier(); asm volatile("" ::: "memory");
}

__device__ __forceinline__ void attn_phase(const bf16* kvq, bf16* ao, LAS unsigned char* lds, const float* lq1, const float* lk1, const float* lq2, const float* lk2, float lambda_init, int vcu, int G) {
    PHASE_IDS();
    const float lam = __expf(wave_sum(lq1[lane] * lk1[lane])) - __expf(wave_sum(lq2[lane] * lk2[lane])) + lambda_init;
    const int nun = (G == 256) ? 4 : (1024 - vcu + G - 1) / G;
#pragma unroll 1
    for (int i = 0; i < nun; ++i) {
        int bh, qb;
        if (G == 256) { const int x = vcu >> 5, w = vcu & 31, j = (w + 16) & 31; bh = 4 * x + i; qb = (i == 0) ? w : (i == 1) ? 31 - w : (i == 2) ? j : 31 - j; }
        else { const int u = vcu + i * G; bh = u >> 5; qb = u & 31; }
        attn_unit(bh >> 3, bh & 7, qb, kvq, ao, lds, lam, wave, lane, tid);
    }
}
}

__device__ __forceinline__ void route_a(const bf16* xb, const float* rwt, int* tope, float* topw, int* topr, float* tokr, int* cnt, int* late, unsigned char* xn8, LAS unsigned char* lds, int vcu, int G) {
    PHASE_IDS();
    LAS int* sel = (LAS int*)(lds + 32768);
    LAS float* selw = (LAS float*)(lds + 32768 + 512);
    LAS float* selr = (LAS float*)(lds + 32768 + 1024);
    f32x4 wreg[NE][2][2];
#pragma unroll
    for (int e = 0; e < NE; ++e)
#pragma unroll
        for (int j = 0; j < 2; ++j)
#pragma unroll
            for (int h = 0; h < 2; ++h) wreg[e][j][h] = ((const f32x4*)rwt)[e * 256 + 2 * (lane + 64 * j) + h];
    for (int tb = vcu; tb < M / 64; tb += G) {
        v4u q0[2], q1[2], q2[2], q3[2];
        { const v4u* xr = (const v4u*)(xb + (size_t)(tb * 64 + wave * 8) * D) + lane;
          q0[0] = xr[0]; q0[1] = xr[64]; q1[0] = xr[128]; q1[1] = xr[192]; q2[0] = xr[256]; q2[1] = xr[320]; q3[0] = xr[384]; q3[1] = xr[448]; }
        auto token = [&](const v4u (&nv)[2], const int row, int& e1o, int& e2o, float& w1o, float& ro) __attribute__((always_inline)) {
            f32x4 v[2][2]; float ss = 0.f;
#pragma unroll
            for (int j = 0; j < 2; ++j) {
                v[j][0] = (f32x4){bflo(nv[j].x), bfhi(nv[j].x), bflo(nv[j].y), bfhi(nv[j].y)}; v[j][1] = (f32x4){bflo(nv[j].z), bfhi(nv[j].z), bflo(nv[j].w), bfhi(nv[j].w)};
#pragma unroll
                for (int h = 0; h < 2; ++h) ss += (v[j][h][0] * v[j][h][0] + v[j][h][1] * v[j][h][1]) + (v[j][h][2] * v[j][h][2] + v[j][h][3] * v[j][h][3]);
            }
            ss = wave_sum(ss);
            const float r = __builtin_amdgcn_rsqf(ss * (1.0f / 1024.0f) + EPS);
#pragma unroll
            for (int j = 0; j < 2; ++j) {
                u32x2 w = {0u, 0u};
                w.x = __builtin_amdgcn_cvt_pk_fp8_f32(v[j][0][0] * r, v[j][0][1] * r, w.x, false); w.x = __builtin_amdgcn_cvt_pk_fp8_f32(v[j][0][2] * r, v[j][0][3] * r, w.x, true);
                w.y = __builtin_amdgcn_cvt_pk_fp8_f32(v[j][1][0] * r, v[j][1][1] * r, w.y, false); w.y = __builtin_amdgcn_cvt_pk_fp8_f32(v[j][1][2] * r, v[j][1][3] * r, w.y, true);
                ((u32x2*)(xn8 + (size_t)row * D))[lane + 64 * j] = w;
            }
            float lg[NE];
            {
                float pa[NE];
#pragma unroll
                for (int e = 0; e < NE; ++e) {
                    float a = 0.f;
#pragma unroll
                    for (int j = 0; j < 2; ++j)
#pragma unroll
                        for (int h = 0; h < 2; ++h) { const f32x4 w = wreg[e][j][h]; a += (v[j][h][0] * w[0] + v[j][h][1] * w[1]) + (v[j][h][2] * w[2] + v[j][h][3] * w[3]); }
                    pa[e] = a;
                }
                const float dsum = wave_sum8(pa, lane);
#pragma unroll
                for (int e = 0; e < NE; ++e) lg[e] = __int_as_float(__builtin_amdgcn_readlane(__float_as_int(dsum), wsum8_lane(e))) * r;
            }
            int e1 = 0; float v1 = lg[0];
#pragma unroll
            for (int e = 1; e < NE; ++e) if (lg[e] > v1) { v1 = lg[e]; e1 = e; }
            int e2 = -1; float v2 = -3.0e38f;
#pragma unroll
            for (int e = 0; e < NE; ++e) if (e != e1 && lg[e] > v2) { v2 = lg[e]; e2 = e; }
            e1o = e1; e2o = e2; w1o = fast_rcp(1.0f + __expf(v2 - v1)); ro = r;
        };
#pragma unroll 1
        for (int tk = 0; tk < 8; tk += 2) {
            const int tl = wave * 8 + tk, row = tb * 64 + tl;
            const v4u nva[2] = {q0[0], q0[1]}, nvb[2] = {q1[0], q1[1]};
            q0[0] = q2[0]; q0[1] = q2[1]; q1[0] = q3[0]; q1[1] = q3[1];
            { const int rn = tb * 64 + wave * 8 + (tk + 4 < 8 ? tk + 4 : 6);
              const v4u* xr = (const v4u*)(xb + (size_t)rn * D) + lane; q2[0] = xr[0]; q2[1] = xr[64]; q3[0] = xr[128]; q3[1] = xr[192]; }
            int ea1, ea2, eb1, eb2; float wa, wb, ra, rb;
            token(nva, row, ea1, ea2, wa, ra);
            token(nvb, row + 1, eb1, eb2, wb, rb);
            if (lane == 0) {
                sel[tl * 2] = ea1; sel[tl * 2 + 1] = ea2; selw[tl * 2] = wa; selw[tl * 2 + 1] = 1.0f - wa; selr[tl] = ra;
                sel[tl * 2 + 2] = eb1; sel[tl * 2 + 3] = eb2; selw[tl * 2 + 2] = wb; selw[tl * 2 + 3] = 1.0f - wb; selr[tl + 1] = rb;
            }
        }
        asm volatile("s_waitcnt lgkmcnt(0)" ::: "memory"); __builtin_amdgcn_s_barrier(); asm volatile("" ::: "memory");
        if (wave == 1) {
            const int row = tb * 64 + lane;
            *(u32x2*)(tope + row * 2) = (u32x2){(unsigned)sel[2 * lane], (unsigned)sel[2 * lane + 1]};
            *(u32x2*)(topw + row * 2) = (u32x2){__float_as_uint(selw[2 * lane]), __float_as_uint(selw[2 * lane + 1])};
            tokr[row] = selr[lane];
            *(u32x2*)(late + row * 2) = (u32x2){0u, 0u};
        }
        if (wave == 0) {
            const int e0 = sel[2 * lane], e1 = sel[2 * lane + 1];
            const unsigned long long below = (1ull << lane) - 1ull;
            int r0 = 0, r1 = 0, mycnt = 0;
#pragma unroll
            for (int e = 0; e < NE; ++e) {
                const unsigned long long m0 = __ballot(e0 == e), m1 = __ballot(e1 == e);
                const int before = __builtin_popcountll(m0 & below) + __builtin_popcountll(m1 & below);
                if (e0 == e) r0 = before;
                if (e1 == e) r1 = before + (e0 == e ? 1 : 0);
                if (lane == e) mycnt = __builtin_popcountll(m0) + __builtin_popcountll(m1);
            }
            *(u32x2*)(topr + (tb * 64 + lane) * 2) = (u32x2){(unsigned)r0, (unsigned)r1};
            if (lane < NE) cnt[tb * NE + lane] = mycnt;
        }
        asm volatile("s_waitcnt lgkmcnt(0)" ::: "memory"); __builtin_amdgcn_s_barrier(); asm volatile("" ::: "memory");
    }
}
__device__ __forceinline__ void route_b(const unsigned char* xn8, const int* tope, const float* topw, const int* topr, const float* tokr, const int* cnt, unsigned char* xg, int* rowinfo, float* rowgate, float* rowr, int* late,
                                        LAS unsigned char* lds, LAS int* ldsctl, int vcu, int G) {
    PHASE_IDS();
    LAS int* ct = (LAS int*)lds;
    LAS int* tot = (LAS int*)(lds + 8192);
    for (int k = tid; k < 256 * NE; k += NTHREADS) ct[k] = cnt[k];
    WG_BAR();
    {
        LAS int* segs = (LAS int*)(lds + 8192 + 256);
        const int e = tid >> 5, sg = tid & 31;
        int c8[8], ssum = 0;
        if (tid < 256) {
#pragma unroll
            for (int k = 0; k < 8; ++k) { c8[k] = ct[(sg * 8 + k) * NE + e]; ssum += c8[k]; }
            segs[e * 32 + sg] = ssum;
        }
        asm volatile("s_waitcnt lgkmcnt(0)" ::: "memory"); __builtin_amdgcn_s_barrier(); asm volatile("" ::: "memory");
        if (tid < 256) {
            int run = 0, all = 0;
#pragma unroll
            for (int k = 0; k < 32; ++k) { const int v = segs[e * 32 + k]; run += (k < sg) ? v : 0; all += v; }
#pragma unroll
            for (int k = 0; k < 8; ++k) { ct[(sg * 8 + k) * NE + e] = run; run += c8[k]; }
            if (sg == 0) tot[e] = all;
        }
    }
    asm volatile("s_waitcnt lgkmcnt(0)" ::: "memory"); __builtin_amdgcn_s_barrier(); asm volatile("" ::: "memory");
    if (tid == 0) {
        int ts = 0;
        for (int e = 0; e < NE; ++e) { ldsctl[16 + e] = ts; tot[8 + e] = ts * 256; ts += (tot[e] + 255) >> 8; }
        ldsctl[24] = ts; ldsctl[25] = ts;
        int rd = (ts * (D / 256)) / G; if (rd < 1) rd = 1;
        int mp = ((rd * G) % (D / 256) == 0) ? (rd * G) / (D / 256) : ts; if (mp > ts || (ts - mp) * (D / 256) * 2 > G / 2) mp = ts;
        ldsctl[26] = mp;
    }
    WG_BAR();
    const int late_row = ((volatile LAS int*)ldsctl)[26] * 256;
    for (int tb = vcu; tb < M / 64; tb += G) {
        int mypos = 0;
        {
            const int idx = wave * 16 + (lane & 15), tl = idx >> 1, slot = idx & 1, row = tb * 64 + tl;
            const int e = tope[row * 2 + slot];
            mypos = tot[8 + e] + ct[tb * NE + e] + topr[row * 2 + slot];
            if (lane < 16) { rowinfo[mypos] = slot * M + row; rowgate[mypos] = topw[row * 2 + slot]; rowr[mypos] = tokr[row]; if (mypos >= late_row) late[row * 2 + slot] = 1; }
        }
        v4u rowsv[8];
#pragma unroll
        for (int k = 0; k < 8; ++k) rowsv[k] = *((const v4u*)(xn8 + (size_t)(tb * 64 + wave * 8 + k) * D) + lane);
#pragma unroll
        for (int k = 0; k < 16; ++k) { const int pos = __builtin_amdgcn_readlane(mypos, k); *((v4u*)(xg + (size_t)pos * D) + lane) = rowsv[k >> 1]; }
    }
    for (int e = vcu; e < NE; e += G) {
        const int beg = tot[8 + e] + tot[e], end = tot[8 + e] + (((tot[e] + 255) >> 8) << 8);
        for (int pos = beg + wave; pos < end; pos += NWAVES) {
            *((v4u*)(xg + (size_t)pos * D) + lane) = (v4u){0u, 0u, 0u, 0u};
            if (lane == 0) { rowinfo[pos] = -1; rowgate[pos] = 0.f; rowr[pos] = 0.f; }
        }
    }
}
template <bool LATE_ONLY>
__device__ __forceinline__ void final_phase(const bf16* xb, const bf16* y, const bf16* yh, const float* fn, float* out, const int* late, int gbase, int ngroups) {
    PHASE_IDS();
    const int gw = gbase * NWAVES + wave, NGW = ngroups * NWAVES;
    f32x4 gn[4];
#pragma unroll
    for (int j = 0; j < 4; ++j) gn[j] = ((const f32x4*)fn)[lane + 64 * j];
    if constexpr (LATE_ONLY) {
        for (int mb = gw; mb < M; mb += 64 * NGW) {
            const int mc = mb + lane * NGW;
            int fl = 0;
            if (mc < M) { const u32x2 f2 = *(const u32x2*)(late + mc * 2); fl = (int)(f2.x | (f2.y << 1)); }
            unsigned long long todo = __ballot(fl != 0);
            while (todo) {
                const int k = __builtin_ctzll(todo); todo &= todo - 1;
                const int m = mb + k * NGW, f = __builtin_amdgcn_readlane(fl, k);
                const u32x2* xr = (const u32x2*)(xb + (size_t)m * D) + lane;
                const u32x2* y0 = (const u32x2*)(y + (size_t)m * D) + lane;
                const u32x2* y1 = (const u32x2*)(y + (size_t)(M + m) * D) + lane;
                const u32x2* h0 = (const u32x2*)(yh + (size_t)m * D) + lane;
                const u32x2* h1 = (const u32x2*)(yh + (size_t)(M + m) * D) + lane;
                f32x4 v[4]; float ss = 0.f;
#pragma unroll
                for (int j = 0; j < 4; ++j) {
                    const u32x2 a = y0[64 * j], b2 = y1[64 * j], x0 = xr[64 * j];
                    v[j] = (f32x4){bflo(x0.x) + (bflo(a.x) + bflo(b2.x)), bfhi(x0.x) + (bfhi(a.x) + bfhi(b2.x)), bflo(x0.y) + (bflo(a.y) + bflo(b2.y)), bfhi(x0.y) + (bfhi(a.y) + bfhi(b2.y))};
                }
                if (f & 1) {
#pragma unroll
                    for (int j = 0; j < 4; ++j) { const u32x2 a = h0[64 * j]; v[j] += (f32x4){bflo(a.x), bfhi(a.x), bflo(a.y), bfhi(a.y)}; }
                }
                if (f & 2) {
#pragma unroll
                    for (int j = 0; j < 4; ++j) { const u32x2 a = h1[64 * j]; v[j] += (f32x4){bflo(a.x), bfhi(a.x), bflo(a.y), bfhi(a.y)}; }
                }
#pragma unroll
                for (int j = 0; j < 4; ++j) ss += (v[j][0] * v[j][0] + v[j][1] * v[j][1]) + (v[j][2] * v[j][2] + v[j][3] * v[j][3]);
                ss = wave_sum(ss);
                const float r = __builtin_amdgcn_rsqf(ss * (1.0f / 1024.0f) + EPS);
                f32x4* orow = (f32x4*)(out + (size_t)m * D) + lane;
#pragma unroll
                for (int j = 0; j < 4; ++j) orow[64 * j] = v[j] * r * gn[j];
            }
        }
    } else {
        for (int m0 = gw; m0 < M; m0 += 2 * NGW) {
            f32x4 v[2][4]; float ss[2]; bool ok[2];
#pragma unroll
            for (int k = 0; k < 2; ++k) {
                const int m = m0 + k * NGW; ok[k] = m < M; ss[k] = 0.f;
                if (ok[k]) {
                    const u32x2* xr = (const u32x2*)(xb + (size_t)m * D) + lane;
                    const u32x2* y0 = (const u32x2*)(y + (size_t)m * D) + lane;
                    const u32x2* y1 = (const u32x2*)(y + (size_t)(M + m) * D) + lane;
#pragma unroll
                    for (int j = 0; j < 4; ++j) {
                        const u32x2 a = y0[64 * j], b2 = y1[64 * j], x0 = xr[64 * j];
                        v[k][j] = (f32x4){bflo(x0.x) + (bflo(a.x) + bflo(b2.x)), bfhi(x0.x) + (bfhi(a.x) + bfhi(b2.x)), bflo(x0.y) + (bflo(a.y) + bflo(b2.y)), bfhi(x0.y) + (bfhi(a.y) + bfhi(b2.y))};
                        ss[k] += (v[k][j][0] * v[k][j][0] + v[k][j][1] * v[k][j][1]) + (v[k][j][2] * v[k][j][2] + v[k][j][3] * v[k][j][3]);
                    }
                }
            }
#pragma unroll
            for (int k = 0; k < 2; ++k) ss[k] = wave_sum(ss[k]);
#pragma unroll
            for (int k = 0; k < 2; ++k) if (ok[k]) {
                const float r = __builtin_amdgcn_rsqf(ss[k] * (1.0f / 1024.0f) + EPS);
                f32x4* orow = (f32x4*)(out + (size_t)(m0 + k * NGW) * D) + lane;
#pragma unroll
                for (int j = 0; j < 4; ++j) orow[64 * j] = v[k][j] * r * gn[j];
            }
        }
    }
}
struct Args { Ptrs p; };
static_assert(sizeof(Args) == 22 * 8, "Args has no padding");

__global__ void __launch_bounds__(NTHREADS, 2) yoco_fwd(Args args) {
    extern __shared__ __attribute__((aligned(16))) unsigned char lds_raw[];
    LAS unsigned char* lds = (LAS unsigned char*)lds_raw;
    const Ptrs& P = args.p;
    unsigned char* ws = P.ws;

    const int G = gridDim.x; const int bx = blockIdx.x;
    const int vcu = (G % 8 == 0) ? (bx % 8) * (G / 8) + bx / 8 : bx;
    LAS int* ldsctl = (LAS int*)(lds + LDSCTL_OFF);
    for (int k = threadIdx.x; k < (LDS_BYTES - LDSCTL_OFF) / 4; k += NTHREADS) ldsctl[k] = 0;
    __syncthreads();
    XcdBarrier bar = xcd_barrier_post((unsigned*)(ws + WS_CTL) + CW_BAR, (volatile LAS unsigned*)ldsctl);

    bf16* XB = (bf16*)(ws + WS_XB); float* SSP = (float*)(ws + WS_SSP);
    bf16* PROJ = (bf16*)(ws + WS_PROJ); bf16* KVQ = (bf16*)(ws + WS_KVQ);

    const float lambda_init = 0.8f - 0.6f * 0.7408182206817179f;

    p0_prologue(P, lds, vcu, G, lambda_init);
    xcd_barrier(bar);

    {
        pg8::Gemm g{XB, (const bf16*)(ws + WS_W_IN), M, RIN, D}; pg8::StaticOrder S; S.init(M, RIN, G, bx);
        pg8::EpiInProj E{PROJ, SSP, (const float*)(ws + WS_RCOS), (const float*)(ws + WS_RSIN)};
        pg8::gemm_phase<pg8::EpiInProj, pg8::StaticOrder, true, true>(lds, g, S, E);
    }
    xcd_barrier(bar);
    ret::scores_phase(PROJ, (bf16*)(ws + WS_S), lds, vcu, G);
    xcd_barrier(bar);
    ret::scan_phase(P, PROJ, (const bf16*)(ws + WS_S), (bf16*)(ws + WS_ORET), lds, vcu, G);
    xcd_barrier(bar);
    ret::norm_gate_phase((const bf16*)(ws + WS_ORET), PROJ, (bf16*)(ws + WS_RO), vcu, G);
    xcd_barrier(bar);
    {
        pg8::Gemm g{(const bf16*)(ws + WS_RO), (const bf16*)(ws + WS_W_RO), M, D, RVD}; pg8::StaticOrder S; S.init(M, D, G, bx);
        pg8::EpiResid<false, true> E{XB, XB, SSP, ws + WS_XB8, 0.f};
        pg8::gemm_phase<pg8::EpiResid<false, true>, pg8::StaticOrder, true, true>(lds, g, S, E);
    }
    xcd_barrier(bar);
    {
        pg8::Gemm g{(const bf16*)(ws + WS_XB8), (const bf16*)(ws + WS_W_GU), M, 2 * FF, D / 2}; pg8::StaticOrder S; S.init(M, 2 * FF, G, bx);
        pg8::EpiSwiGLU<true> E{ws + WS_H, FF, SSP, 1.0f / FFN_WGU_SCALE, FFN_H_SCALE};
        pg8::gemm_phase<pg8::EpiSwiGLU<true>, pg8::StaticOrder, true, true, true>(lds, g, S, E);
    }
    xcd_barrier(bar);
    {
        pg8::Gemm g{(const bf16*)(ws + WS_H), (const bf16*)(ws + WS_W_DN), M, D, FF / 2}; pg8::StaticOrder S; S.init(M, D, G, bx);
        pg8::EpiResid<false, false, true> E{XB, XB, SSP, nullptr, 1.0f / (FFN_WDN_SCALE * FFN_H_SCALE)};
        pg8::gemm_phase<pg8::EpiResid<false, false, true>, pg8::StaticOrder, true, true, true>(lds, g, S, E);
    }
    xcd_barrier(bar);
    {
        pg8::Gemm g{XB, (const bf16*)(ws + WS_W_KVQ), M, KVQ_N, D}; pg8::StaticOrder S; S.init(M, KVQ_N, G, bx);
        pg8::EpiKVQ E{KVQ, SSP, (const float*)(ws + WS_DCOS), (const float*)(ws + WS_DSIN), 0.125f * LOG2E};
        pg8::gemm_phase<pg8::EpiKVQ, pg8::StaticOrder, true, true>(lds, g, S, E);
    }
    xcd_barrier(bar);
    dat::attn_phase(KVQ, (bf16*)(ws + WS_AO), lds, P.lq1, P.lk1, P.lq2, P.lk2, lambda_init, vcu, G);
    xcd_barrier(bar);
    {
        pg8::Gemm g{(const bf16*)(ws + WS_AO), (const bf16*)(ws + WS_W_DO), M, D, D}; pg8::StaticOrder S; S.init(M, D, G, bx);
        pg8::EpiResid<false> E{XB, XB, SSP};
        pg8::gemm_phase<pg8::EpiResid<false>, pg8::StaticOrder, true, true>(lds, g, S, E);
    }
    xcd_barrier(bar);
    route_a(XB, (const float*)(ws + WS_RWT), (int*)(ws + WS_TOPE), (float*)(ws + WS_TOPW), (int*)(ws + WS_TOPR), (float*)(ws + WS_TOKR), (int*)(ws + WS_CNT), (int*)(ws + WS_LATE), ws + WS_XN8, lds, vcu, G);
    xcd_barrier(bar);
    route_b(ws + WS_XN8, (const int*)(ws + WS_TOPE), (const float*)(ws + WS_TOPW), (const int*)(ws + WS_TOPR), (const float*)(ws + WS_TOKR), (const int*)(ws + WS_CNT), ws + WS_XG,
            (int*)(ws + WS_ROWINFO), (float*)(ws + WS_ROWGATE), (float*)(ws + WS_ROWR), (int*)(ws + WS_LATE), lds, ldsctl, vcu, G);
    xcd_barrier(bar);
    {
        pg8::MoeOrder S; S.nM = __builtin_amdgcn_readfirstlane(((volatile LAS int*)ldsctl)[24]); S.nN = 2 * EF / 256; S.nwg = S.nM * S.nN; S.G = G; S.c = bx; S.one_pm = -1; S.one_pnl = 0;
#pragma unroll
        for (int k = 0; k < 9; ++k) S.ts[k] = __builtin_amdgcn_readfirstlane(((volatile LAS int*)ldsctl)[16 + k]);
        pg8::Gemm g{(const bf16*)(ws + WS_XG), (const bf16*)(ws + WS_W_MGU), XG_ROWS, 2 * EF, D / 2};
        pg8::EpiSwiGLU<true> E{ws + WS_HM, EF, nullptr, 1.0f / MOE_WGU_SCALE, MOE_H_SCALE};
        pg8::gemm_phase<pg8::EpiSwiGLU<true>, pg8::MoeOrder, true, true, true>(lds, g, S, E);
    }
    xcd_barrier(bar);
    const int NT_ = __builtin_amdgcn_readfirstlane(((volatile LAS int*)ldsctl)[24]), MP_ = __builtin_amdgcn_readfirstlane(((volatile LAS int*)ldsctl)[26]);
    const int nleft2 = (NT_ - MP_) * (D / 256) * 2;
    {
        pg8::MoeOrder S; S.nM = MP_; S.nN = D / 256; S.nwg = S.nM * S.nN; S.G = G; S.c = bx; S.one_pm = -1; S.one_pnl = 0;
#pragma unroll
        for (int k = 0; k < 9; ++k) S.ts[k] = __builtin_amdgcn_readfirstlane(((volatile LAS int*)ldsctl)[16 + k]);
        pg8::Gemm g{(const bf16*)(ws + WS_HM), (const bf16*)(ws + WS_W_MDN), XG_ROWS, D, EF / 2};
        pg8::EpiMoeDown E{(bf16*)(ws + WS_Y), (const int*)(ws + WS_ROWINFO), (const float*)(ws + WS_ROWGATE), 1.0f / (MOE_WDN_SCALE * MOE_H_SCALE)};
        pg8::gemm_phase<pg8::EpiMoeDown, pg8::MoeOrder, true, true, true>(lds, g, S, E);
    }
    xcd_barrier(bar);
    if (bx < nleft2) {
        const int un = bx >> 1, kh = bx & 1;
        pg8::MoeOrder S; S.nM = NT_; S.nN = D / 256; S.nwg = S.nM * S.nN; S.G = G; S.c = bx; S.one_pm = MP_ + un / (D / 256); S.one_pnl = un % (D / 256);
#pragma unroll
        for (int k = 0; k < 9; ++k) S.ts[k] = __builtin_amdgcn_readfirstlane(((volatile LAS int*)ldsctl)[16 + k]);
        pg8::Gemm g{(const bf16*)(ws + WS_HM) + kh * (EF / 4), (const bf16*)(ws + WS_W_MDN) + kh * (EF / 4), XG_ROWS, D, EF / 2, EF / 4};
        pg8::EpiMoeDown E{(bf16*)(ws + (kh ? WS_YH : WS_Y)), (const int*)(ws + WS_ROWINFO), (const float*)(ws + WS_ROWGATE), 1.0f / (MOE_WDN_SCALE * MOE_H_SCALE)};
        pg8::gemm_phase<pg8::EpiMoeDown, pg8::MoeOrder, true, true, true>(lds, g, S, E);
    } else {
        final_phase<false>(XB, (const bf16*)(ws + WS_Y), nullptr, P.final_norm, P.out, nullptr, bx - nleft2, G - nleft2);
    }
    if (nleft2 > 0) {
        xcd_barrier(bar);
        final_phase<true>(XB, (const bf16*)(ws + WS_Y), (const bf16*)(ws + WS_YH), P.final_norm, P.out, (const int*)(ws + WS_LATE), bx, G);
    }
}

extern "C" void kernel_launch(void* const* d_in, const int* in_sizes, int n_in, void* d_out, int out_size, void* d_ws, size_t ws_size, hipStream_t stream) {
    static int grid = 0;
    if (grid == 0) {
        if (n_in != 20 || in_sizes[0] != M * D || out_size != M * D || ws_size < WS_END) { fprintf(stderr, "kernel_launch: unexpected shapes (n_in %d, in0 %d, out %d, ws %zu)\n", n_in, n_in > 0 ? in_sizes[0] : -1, out_size, ws_size); grid = -1; return; }
        int dev = 0, cus = 0, per_cu = 0;
        if (hipGetDevice(&dev) != hipSuccess || hipDeviceGetAttribute(&cus, hipDeviceAttributeMultiprocessorCount, dev) != hipSuccess) { grid = -1; return; }
        if (hipFuncSetAttribute((const void*)yoco_fwd, hipFuncAttributeMaxDynamicSharedMemorySize, LDS_BYTES) != hipSuccess) { fprintf(stderr, "kernel_launch: hipFuncSetAttribute failed\n"); grid = -1; return; }
        if (hipOccupancyMaxActiveBlocksPerMultiprocessor(&per_cu, (const void*)yoco_fwd, NTHREADS, LDS_BYTES) != hipSuccess || per_cu < 1) { fprintf(stderr, "kernel_launch: occupancy query reports %d\n", per_cu); }
        (void)hipGetLastError();
        grid = cus;
    }
    if (grid < 0) return;
    (void)hipMemsetAsync((char*)d_ws + WS_CTL, 0, CTL_ZERO_BYTES, stream);
    Args a{};
    const float** pp = (const float**)&a.p;
    for (int i = 0; i < 20; ++i) pp[i] = (const float*)d_in[i];
    a.p.out = (float*)d_out; a.p.ws = (unsigned char*)d_ws;
    hipLaunchKernelGGL(yoco_fwd, dim3(grid), dim3(NTHREADS), LDS_BYTES, stream, a);
}
```
